# Optimizing an MI355X kernel written in HIP

```python
import math
import jax, jax.numpy as jnp
from jax import lax
import numpy as np

D_MODEL = 1024
BATCH = 4
SEQ = 8192
DEPTH = 4

MEM_LEN = 256
S5_WIDTH = D_MODEL // 2
S5_GROUP_CH = 16
S5_GROUPS = S5_WIDTH // S5_GROUP_CH
S5_STATE = 64
RET_HEADS = 4
RET_DK = (D_MODEL - S5_WIDTH) // RET_HEADS
RET_DV = RET_DK
RET_WIDTH = RET_HEADS * RET_DV
RET_CHUNK = 128
MIX_WIDTH = S5_WIDTH + RET_WIDTH
IN_WIDTH = S5_WIDTH + 4 * RET_WIDTH
X_HEADS = 4
X_HEAD_DIM = D_MODEL // X_HEADS
D_FF = ((8 * D_MODEL // 3 + 255) // 256) * 256
ROPE_BASE = 10000.0
EPS = 1e-6

kernel_name = "hybrid_s5_retention_memxattn_swiglu"


def rms_norm(x, g):
    xf = x.astype(jnp.float32)
    y = xf * lax.rsqrt(jnp.mean(xf * xf, axis=-1, keepdims=True) + EPS)
    return (y * g.astype(jnp.float32)).astype(x.dtype)


def _complex_combine(left, right):
    ar1, ai1, br1, bi1 = left
    ar2, ai2, br2, bi2 = right
    ar = ar2 * ar1 - ai2 * ai1
    ai = ar2 * ai1 + ai2 * ar1
    br = ar2 * br1 - ai2 * bi1 + br2
    bi = ar2 * bi1 + ai2 * br1 + bi2
    return (ar, ai, br, bi)


def s5_mixer(u, lam_re, lam_im, log_step, b_re, b_im, c_re, c_im, d_skip, w_glu, b_glu):
    bsz, seq, _ = u.shape
    uf = u.astype(jnp.float32)
    ug = uf.reshape(bsz, seq, S5_GROUPS, S5_GROUP_CH)
    lr = lam_re.astype(jnp.float32)
    li = lam_im.astype(jnp.float32)
    step = jnp.exp(log_step.astype(jnp.float32))[:, None]
    mag = jnp.exp(lr * step)
    abar_r = mag * jnp.cos(li * step)
    abar_i = mag * jnp.sin(li * step)
    den = lr * lr + li * li
    f_r = ((abar_r - 1.0) * lr + abar_i * li) / den
    f_i = (abar_i * lr - (abar_r - 1.0) * li) / den
    br = b_re.astype(jnp.float32)
    bi = b_im.astype(jnp.float32)
    bb_r = f_r[..., None] * br - f_i[..., None] * bi
    bb_i = f_r[..., None] * bi + f_i[..., None] * br
    xr = jnp.einsum('blgh,gph->blgp', ug, bb_r)
    xi = jnp.einsum('blgh,gph->blgp', ug, bb_i)
    a_r = jnp.broadcast_to(abar_r[None, None], (1, seq) + abar_r.shape)
    a_i = jnp.broadcast_to(abar_i[None, None], (1, seq) + abar_i.shape)
    _, _, sr, si = lax.associative_scan(_complex_combine, (a_r, a_i, xr, xi), axis=1)
    y = (jnp.einsum('gnp,blgp->blgn', c_re.astype(jnp.float32), sr)
         - jnp.einsum('gnp,blgp->blgn', c_im.astype(jnp.float32), si))
    y = y.reshape(bsz, seq, S5_WIDTH) + d_skip.astype(jnp.float32) * uf
    z = jax.nn.gelu(y, approximate=False)
    z = z * jax.nn.sigmoid(z @ w_glu.astype(jnp.float32) + b_glu.astype(jnp.float32))
    return z.astype(u.dtype)


def rotary(x, positions):
    half = x.shape[-1] // 2
    inv_freq = 1.0 / (ROPE_BASE ** (jnp.arange(half, dtype=jnp.float32) / half))
    ang = positions.astype(jnp.float32)[..., None] * inv_freq
    cos = jnp.cos(ang)[:, :, None, :]
    sin = jnp.sin(ang)[:, :, None, :]
    xf = x.astype(jnp.float32)
    x1, x2 = xf[..., :half], xf[..., half:]
    return jnp.concatenate([x1 * cos - x2 * sin, x2 * cos + x1 * sin], axis=-1)


def retention(q, k, v, gate, positions, out_gain):
    bsz, seq, _ = q.shape
    nc = seq // RET_CHUNK
    qh = rotary(q.reshape(bsz, seq, RET_HEADS, RET_DK), positions)
    kh = rotary(k.reshape(bsz, seq, RET_HEADS, RET_DK), positions) * (RET_DK ** -0.5)
    vh = v.astype(jnp.float32).reshape(bsz, seq, RET_HEADS, RET_DV)
    qc = qh.reshape(bsz, nc, RET_CHUNK, RET_HEADS, RET_DK)
    kc = kh.reshape(bsz, nc, RET_CHUNK, RET_HEADS, RET_DK)
    vc = vh.reshape(bsz, nc, RET_CHUNK, RET_HEADS, RET_DV)
    lg = jnp.log1p(-jnp.exp2(-5.0 - jnp.arange(RET_HEADS, dtype=jnp.float32)))
    idx = jnp.arange(RET_CHUNK, dtype=jnp.float32)
    diff = idx[:, None] - idx[None, :]
    dmask = jnp.where(diff[None] >= 0,
                      jnp.exp(jnp.maximum(diff, 0.0)[None] * lg[:, None, None]), 0.0)
    scores = jnp.einsum('bnchd,bnshd->bnhcs', qc, kc) * dmask
    inner = jnp.einsum('bnhcs,bnshe->bnche', scores, vc)
    zeta = jnp.exp((RET_CHUNK - 1.0 - idx)[:, None] * lg[None, :])
    kv = jnp.einsum('bnshd,bnshe,sh->nbhde', kc, vc, zeta)
    g_chunk = jnp.exp(RET_CHUNK * lg)[None, :, None, None]

    def chunk_step(state, kv_j):
        return g_chunk * state + kv_j, state

    init = jnp.zeros((bsz, RET_HEADS, RET_DK, RET_DV), jnp.float32)
    _, r_prev = lax.scan(chunk_step, init, kv)
    xi = jnp.exp((idx + 1.0)[:, None] * lg[None, :])
    cross = jnp.einsum('bnchd,nbhde->bnche', qc, r_prev) * xi[None, None, :, :, None]
    o = (inner + cross).reshape(bsz, seq, RET_HEADS, RET_DV)
    mu = jnp.mean(o, axis=-1, keepdims=True)
    var = jnp.mean(jnp.square(o - mu), axis=-1, keepdims=True)
    o = (o - mu) * lax.rsqrt(var + EPS) * out_gain.astype(jnp.float32)
    o = o.reshape(bsz, seq, RET_WIDTH) * jax.nn.silu(gate.astype(jnp.float32))
    return o.astype(q.dtype)


def memory_cross_attention(h, m, wq, wk, wv, wo):
    bsz, seq, _ = h.shape
    q = (h @ wq).reshape(bsz, seq, X_HEADS, X_HEAD_DIM)
    k = (m @ wk).reshape(bsz, m.shape[1], X_HEADS, X_HEAD_DIM)
    v = (m @ wv).reshape(bsz, m.shape[1], X_HEADS, X_HEAD_DIM)
    s = jnp.einsum('blhd,bmhd->bhlm', q.astype(jnp.float32), k.astype(jnp.float32)) * (X_HEAD_DIM ** -0.5)
    p = jax.nn.softmax(s, axis=-1)
    o = jnp.einsum('bhlm,bmhd->blhd', p, v.astype(jnp.float32)).astype(h.dtype)
    return o.reshape(bsz, seq, D_MODEL) @ wo


def swiglu(h, w_gate, w_up, w_down):
    return (jax.nn.silu(h @ w_gate) * (h @ w_up)) @ w_down


def setup_inputs(seed: int = 0) -> dict:
    key = jax.random.key(seed)
    ks = iter(jax.random.split(key, 40))

    def nrm(shape, scale):
        return jax.random.normal(next(ks), shape, jnp.float32) * scale

    def gain(shape):
        return 1.0 + nrm(shape, 0.02)

    res_scale = 1.0 / math.sqrt(2.0 * DEPTH)
    x = nrm((BATCH, SEQ, D_MODEL), 1.0)
    mem = nrm((BATCH, MEM_LEN, D_MODEL), 1.0)
    positions = jnp.broadcast_to(jnp.arange(SEQ, dtype=jnp.int32)[None, :], (BATCH, SEQ))
    n_idx = jnp.arange(S5_STATE, dtype=jnp.float32)
    lam_re = -0.5 + nrm((DEPTH, S5_GROUPS, S5_STATE), 0.01)
    lam_im = math.pi * n_idx[None, None, :] + nrm((DEPTH, S5_GROUPS, S5_STATE), 0.01)
    log_step = jax.random.uniform(next(ks), (DEPTH, S5_GROUPS), jnp.float32,
                                  math.log(1e-3), math.log(1e-1))
    return {
        "x": x,
        "mem": mem,
        "positions": positions,
        "norm_mix": gain((DEPTH, D_MODEL)),
        "w_in": nrm((DEPTH, D_MODEL, IN_WIDTH), D_MODEL ** -0.5),
        "s5_lambda_re": lam_re,
        "s5_lambda_im": lam_im,
        "s5_log_step": log_step,
        "s5_b_re": nrm((DEPTH, S5_GROUPS, S5_STATE, S5_GROUP_CH), (2 * S5_GROUP_CH) ** -0.5),
        "s5_b_im": nrm((DEPTH, S5_GROUPS, S5_STATE, S5_GROUP_CH), (2 * S5_GROUP_CH) ** -0.5),
        "s5_c_re": nrm((DEPTH, S5_GROUPS, S5_GROUP_CH, S5_STATE), (2 * S5_STATE) ** -0.5),
        "s5_c_im": nrm((DEPTH, S5_GROUPS, S5_GROUP_CH, S5_STATE), (2 * S5_STATE) ** -0.5),
        "s5_d": nrm((DEPTH, S5_WIDTH), 1.0),
        "s5_w_glu": nrm((DEPTH, S5_WIDTH, S5_WIDTH), S5_WIDTH ** -0.5),
        "s5_b_glu": nrm((DEPTH, S5_WIDTH), 0.01),
        "s5_out_norm": gain((DEPTH, S5_WIDTH)),
        "ret_out_norm": gain((DEPTH, RET_HEADS, RET_DV)),
        "w_out": nrm((DEPTH, MIX_WIDTH, D_MODEL), MIX_WIDTH ** -0.5 * res_scale),
        "norm_cross": gain((DEPTH, D_MODEL)),
        "norm_mem": gain((DEPTH, D_MODEL)),
        "w_cq": nrm((DEPTH, D_MODEL, D_MODEL), D_MODEL ** -0.5),
        "w_ck": nrm((DEPTH, D_MODEL, D_MODEL), D_MODEL ** -0.5),
        "w_cv": nrm((DEPTH, D_MODEL, D_MODEL), D_MODEL ** -0.5),
        "w_co": nrm((DEPTH, D_MODEL, D_MODEL), D_MODEL ** -0.5 * res_scale),
        "norm_ffn": gain((DEPTH, D_MODEL)),
        "w_gate": nrm((DEPTH, D_MODEL, D_FF), D_MODEL ** -0.5),
        "w_up": nrm((DEPTH, D_MODEL, D_FF), D_MODEL ** -0.5),
        "w_down": nrm((DEPTH, D_FF, D_MODEL), D_FF ** -0.5 * res_scale),
        "norm_final": gain((D_MODEL,)),
    }


def reference(x, mem, positions, norm_mix, w_in, s5_lambda_re, s5_lambda_im, s5_log_step,
              s5_b_re, s5_b_im, s5_c_re, s5_c_im, s5_d, s5_w_glu, s5_b_glu, s5_out_norm,
              ret_out_norm, w_out, norm_cross, norm_mem, w_cq, w_ck, w_cv, w_co,
              norm_ffn, w_gate, w_up, w_down, norm_final):
    split_at = [S5_WIDTH, S5_WIDTH + RET_WIDTH, S5_WIDTH + 2 * RET_WIDTH, S5_WIDTH + 3 * RET_WIDTH]
    for l in range(DEPTH):
        h = rms_norm(x, norm_mix[l])
        proj = h @ w_in[l]
        u, q, k, v, g = jnp.split(proj, split_at, axis=-1)
        y_ssm = s5_mixer(u, s5_lambda_re[l], s5_lambda_im[l], s5_log_step[l],
                         s5_b_re[l], s5_b_im[l], s5_c_re[l], s5_c_im[l],
                         s5_d[l], s5_w_glu[l], s5_b_glu[l])
        y_ssm = rms_norm(y_ssm, s5_out_norm[l])
        y_ret = retention(q, k, v, g, positions, ret_out_norm[l])
        x = x + jnp.concatenate([y_ssm, y_ret], axis=-1) @ w_out[l]
        h = rms_norm(x, norm_cross[l])
        m = rms_norm(mem, norm_mem[l])
        x = x + memory_cross_attention(h, m, w_cq[l], w_ck[l], w_cv[l], w_co[l])
        h = rms_norm(x, norm_ffn[l])
        x = x + swiglu(h, w_gate[l], w_up[l], w_down[l])
    return rms_norm(x, norm_final)
```

```cpp
#include <hip/hip_runtime.h>
#include <cstdio>
#include <cstdint>
#include <cmath>

namespace base {
constexpr int D = 1024, B = 4, L = 8192, DEPTH = 4, MEM = 256;
constexpr int S5W = 512, S5G = 32, S5P = 64, RH = 4, RDK = 128, RW = 512, INW = 2560, XH = 4, XD = 256, FF = 2816;
constexpr float EPS = 1e-6f;
typedef float f32x16 __attribute__((ext_vector_type(16)));

template <int ACC>
__global__ void __launch_bounds__(256) k_gemm(const float* __restrict__ A, int lda, const float* __restrict__ Bm, int ldb, float* C, int ldc, int K) {
    __shared__ float As[16][129];
    __shared__ float Bs[16][128];
    const int tid = threadIdx.x, lane = tid & 63, w = tid >> 6, wr = w >> 1, wc = w & 1;
    const int m0 = blockIdx.y * 128, n0 = blockIdx.x * 128;
    f32x16 acc[2][2];
#pragma unroll
    for (int i = 0; i < 2; ++i)
#pragma unroll
        for (int j = 0; j < 2; ++j)
#pragma unroll
            for (int r = 0; r < 16; ++r) acc[i][j][r] = 0.f;
    for (int k0 = 0; k0 < K; k0 += 16) {
#pragma unroll
        for (int p = 0; p < 2; ++p) {
            const int row = p * 64 + (tid >> 2), k4 = (tid & 3) * 4;
            const float4 v = *(const float4*)(A + (size_t)(m0 + row) * lda + k0 + k4);
            As[k4 + 0][row] = v.x; As[k4 + 1][row] = v.y; As[k4 + 2][row] = v.z; As[k4 + 3][row] = v.w;
            const int kk = p * 8 + (tid >> 5), n4 = (tid & 31) * 4;
            *(float4*)&Bs[kk][n4] = *(const float4*)(Bm + (size_t)(k0 + kk) * ldb + n0 + n4);
        }
        __syncthreads();
#pragma unroll
        for (int kk = 0; kk < 16; kk += 2) {
            float a[2], b[2];
#pragma unroll
            for (int i = 0; i < 2; ++i) a[i] = As[kk + (lane >> 5)][wr * 64 + i * 32 + (lane & 31)];
#pragma unroll
            for (int j = 0; j < 2; ++j) b[j] = Bs[kk + (lane >> 5)][wc * 64 + j * 32 + (lane & 31)];
#pragma unroll
            for (int i = 0; i < 2; ++i)
#pragma unroll
                for (int j = 0; j < 2; ++j) acc[i][j] = __builtin_amdgcn_mfma_f32_32x32x2f32(a[i], b[j], acc[i][j], 0, 0, 0);
        }
        __syncthreads();
    }
#pragma unroll
    for (int i = 0; i < 2; ++i)
#pragma unroll
        for (int j = 0; j < 2; ++j)
#pragma unroll
            for (int r = 0; r < 16; ++r) {
                const int row = m0 + wr * 64 + i * 32 + (r & 3) + 8 * (r >> 2) + 4 * (lane >> 5), col = n0 + wc * 64 + j * 32 + (lane & 31);
                float* p = C + (size_t)row * ldc + col;
                if (ACC) *p += acc[i][j][r]; else *p = acc[i][j][r];
            }
}
static void gemm(hipStream_t s, const float* A, int lda, const float* Bm, int ldb, float* C, int ldc, int M, int N, int K, bool accum) {
    dim3 g(N / 128, M / 128);
    if (accum) hipLaunchKernelGGL(k_gemm<1>, g, dim3(256), 0, s, A, lda, Bm, ldb, C, ldc, K);
    else hipLaunchKernelGGL(k_gemm<0>, g, dim3(256), 0, s, A, lda, Bm, ldb, C, ldc, K);
}

__device__ __forceinline__ float wsum(float v) {
#pragma unroll
    for (int o = 1; o < 64; o <<= 1) v += __shfl_xor(v, o);
    return v;
}
__global__ void k_rmsnorm(const float* x, int ldx, const float* g, float* out, int ldo, int rows, int n) {
    const int row = blockIdx.x * (blockDim.x >> 6) + (threadIdx.x >> 6), lane = threadIdx.x & 63;
    if (row >= rows) return;
    const float* xr = x + (size_t)row * ldx; float s = 0.f;
    for (int i = lane; i < n; i += 64) { const float v = xr[i]; s += v * v; }
    const float r = rsqrtf(wsum(s) / (float)n + EPS);
    for (int i = lane; i < n; i += 64) out[(size_t)row * ldo + i] = xr[i] * r * g[i];
}
__global__ void k_copy(const float4* a, float4* b, size_t n) { for (size_t i = (size_t)blockIdx.x * blockDim.x + threadIdx.x; i < n; i += (size_t)gridDim.x * blockDim.x) b[i] = a[i]; }

__global__ void k_rope(float* proj, const int* pos, int rows) {
    const size_t idx = (size_t)blockIdx.x * blockDim.x + threadIdx.x;
    if (idx >= (size_t)rows * 2 * RH * 64) return;
    const int i = idx & 63, h = (idx >> 6) & 3, which = (idx >> 8) & 1; const size_t row = idx >> 9;
    const float inv = 1.0f / powf(10000.0f, (float)i / 64.0f);
    const float ang = (float)pos[row] * inv, c = cosf(ang), s = sinf(ang);
    float* p = proj + row * INW + S5W + which * RW + h * RDK;
    const float x1 = p[i], x2 = p[i + 64]; const float sc = which ? 0.08838834764831845f : 1.0f;
    p[i] = (x1 * c - x2 * s) * sc; p[i + 64] = (x2 * c + x1 * s) * sc;
}
__global__ void __launch_bounds__(64) k_s5(const float* proj, const float* lre, const float* lim, const float* lstep, const float* bre, const float* bim,
                                           const float* cre, const float* cim, const float* dsk, float* z, int rows) {
    const int g = blockIdx.x, p = threadIdx.x;
    __shared__ float sre[64], sim[64], Cr[16][65], Ci[16][65];
    const float lr = lre[g * 64 + p], li = lim[g * 64 + p], step = expf(lstep[g]);
    const float mag = expf(lr * step), ar = mag * cosf(li * step), ai = mag * sinf(li * step), den = lr * lr + li * li;
    const float fr = ((ar - 1.f) * lr + ai * li) / den, fi = (ai * lr - (ar - 1.f) * li) / den;
    float bbr[16], bbi[16];
#pragma unroll
    for (int h = 0; h < 16; ++h) { const float br = bre[(g * 64 + p) * 16 + h], bi = bim[(g * 64 + p) * 16 + h]; bbr[h] = fr * br - fi * bi; bbi[h] = fr * bi + fi * br; }
    for (int n = 0; n < 16; ++n) { Cr[n][p] = cre[(g * 16 + n) * 64 + p]; Ci[n][p] = cim[(g * 16 + n) * 64 + p]; }
    __syncthreads();
    float s_r = 0.f, s_i = 0.f;
    const int n = p & 15, q = p >> 4; const float dn = dsk[g * 16 + n];
    float4 nx[4];
    { const float4* up = (const float4*)(proj + g * 16);
#pragma unroll
      for (int j = 0; j < 4; ++j) nx[j] = up[j]; }
    float un_next = proj[g * 16 + n];
    for (int t = 0; t < rows; ++t) {
        float u[16];
#pragma unroll
        for (int j = 0; j < 4; ++j) { const float4 v = nx[j]; u[4 * j] = v.x; u[4 * j + 1] = v.y; u[4 * j + 2] = v.z; u[4 * j + 3] = v.w; }
        const float un = un_next;
        if (t + 1 < rows) { const float4* up = (const float4*)(proj + (size_t)(t + 1) * INW + g * 16);
#pragma unroll
            for (int j = 0; j < 4; ++j) nx[j] = up[j];
            un_next = proj[(size_t)(t + 1) * INW + g * 16 + n]; }
        float xr = 0.f, xi = 0.f;
#pragma unroll
        for (int h = 0; h < 16; ++h) { xr += bbr[h] * u[h]; xi += bbi[h] * u[h]; }
        const float nr = ar * s_r - ai * s_i + xr, ni = ar * s_i + ai * s_r + xi; s_r = nr; s_i = ni;
        sre[p] = s_r; sim[p] = s_i;
        __syncthreads();
        float y = 0.f;
#pragma unroll
        for (int pp = 0; pp < 16; ++pp) { const int P = q * 16 + pp; y += Cr[n][P] * sre[P] - Ci[n][P] * sim[P]; }
        y += __shfl_xor(y, 16); y += __shfl_xor(y, 32);
        if (q == 0) { const float yy = y + dn * un; z[(size_t)t * S5W + g * 16 + n] = 0.5f * yy * (1.0f + erff(yy * 0.70710678118654752f)); }
        __syncthreads();
    }
}
__global__ void k_glu_norm(const float* z, const float* t, const float* bg, const float* gain, float* ymix, int rows) {
    const int row = blockIdx.x * (blockDim.x >> 6) + (threadIdx.x >> 6), lane = threadIdx.x & 63;
    if (row >= rows) return;
    float v[8], s = 0.f;
#pragma unroll
    for (int j = 0; j < 8; ++j) { const int c = lane + 64 * j; const float zz = z[(size_t)row * S5W + c], tt = t[(size_t)row * S5W + c] + bg[c]; v[j] = zz / (1.0f + expf(-tt)); s += v[j] * v[j]; }
    const float r = rsqrtf(wsum(s) / 512.0f + EPS);
#pragma unroll
    for (int j = 0; j < 8; ++j) { const int c = lane + 64 * j; ymix[(size_t)row * D + c] = v[j] * r * gain[c]; }
}
__global__ void __launch_bounds__(128) k_ret(const float* proj, float* o, int rows) {
    const int h = blockIdx.x, e = threadIdx.x;
    __shared__ float qs[128], ks[128];
    float S[128];
#pragma unroll
    for (int d = 0; d < 128; ++d) S[d] = 0.f;
    const float gamma = 1.0f - exp2f(-5.0f - (float)h);
    float nq, nk, nv;
    { const float* pr = proj + S5W; nq = pr[h * RDK + e]; nk = pr[RW + h * RDK + e]; nv = pr[2 * RW + h * RDK + e]; }
    for (int t = 0; t < rows; ++t) {
        qs[e] = nq; ks[e] = nk; const float v = nv;
        if (t + 1 < rows) { const float* pr = proj + (size_t)(t + 1) * INW + S5W; nq = pr[h * RDK + e]; nk = pr[RW + h * RDK + e]; nv = pr[2 * RW + h * RDK + e]; }
        __syncthreads();
        float a0 = 0.f, a1 = 0.f, a2 = 0.f, a3 = 0.f;
#pragma unroll
        for (int d = 0; d < 128; d += 4) {
            S[d] = gamma * S[d] + ks[d] * v; S[d + 1] = gamma * S[d + 1] + ks[d + 1] * v; S[d + 2] = gamma * S[d + 2] + ks[d + 2] * v; S[d + 3] = gamma * S[d + 3] + ks[d + 3] * v;
            a0 += qs[d] * S[d]; a1 += qs[d + 1] * S[d + 1]; a2 += qs[d + 2] * S[d + 2]; a3 += qs[d + 3] * S[d + 3];
        }
        o[(size_t)t * RW + h * RDK + e] = (a0 + a1) + (a2 + a3);
        __syncthreads();
    }
}
__global__ void k_ret_norm(const float* o, const float* proj, const float* gain, float* ymix, int rows) {
    const int idx = blockIdx.x * (blockDim.x >> 6) + (threadIdx.x >> 6), lane = threadIdx.x & 63;
    if (idx >= rows * RH) return;
    const int row = idx >> 2, h = idx & 3;
    const float a = o[(size_t)row * RW + h * RDK + lane], b = o[(size_t)row * RW + h * RDK + lane + 64];
    const float mu = wsum(a + b) / 128.0f, da = a - mu, db = b - mu, var = wsum(da * da + db * db) / 128.0f, r = rsqrtf(var + EPS);
    const float* gp = proj + (size_t)row * INW + S5W + 3 * RW + h * RDK;
    const float g0 = gp[lane], g1 = gp[lane + 64];
    ymix[(size_t)row * D + S5W + h * RDK + lane] = da * r * gain[h * RDK + lane] * (g0 / (1.0f + expf(-g0)));
    ymix[(size_t)row * D + S5W + h * RDK + lane + 64] = db * r * gain[h * RDK + lane + 64] * (g1 / (1.0f + expf(-g1)));
}
__global__ void k_xattn(const float* q, const float* k, const float* v, float* o, int rows) {
    const int w = threadIdx.x >> 6, lane = threadIdx.x & 63, idx = blockIdx.x * (blockDim.x >> 6) + w;
    __shared__ float ps[4][256];
    if (idx >= rows * XH) return;
    const int row = idx >> 2, h = idx & 3;
    const float* qp = q + (size_t)row * D + h * XD;
    float sc[4];
#pragma unroll
    for (int j = 0; j < 4; ++j) {
        const float* kp = k + (size_t)(lane + 64 * j) * D + h * XD; float a = 0.f;
        for (int d = 0; d < XD; d += 4) { const float4 kk = *(const float4*)(kp + d), qq = *(const float4*)(qp + d); a += kk.x * qq.x + kk.y * qq.y + kk.z * qq.z + kk.w * qq.w; }
        sc[j] = a * 0.0625f;
    }
    float m = fmaxf(fmaxf(sc[0], sc[1]), fmaxf(sc[2], sc[3]));
#pragma unroll
    for (int of = 1; of < 64; of <<= 1) m = fmaxf(m, __shfl_xor(m, of));
    float s = 0.f;
#pragma unroll
    for (int j = 0; j < 4; ++j) { sc[j] = expf(sc[j] - m); s += sc[j]; }
    s = wsum(s);
#pragma unroll
    for (int j = 0; j < 4; ++j) ps[w][lane + 64 * j] = sc[j] / s;
    __syncthreads();
    float4 acc = {0.f, 0.f, 0.f, 0.f};
    for (int key = 0; key < MEM; ++key) { const float p = ps[w][key]; const float4 vv = *(const float4*)(v + (size_t)key * D + h * XD + lane * 4); acc.x += p * vv.x; acc.y += p * vv.y; acc.z += p * vv.z; acc.w += p * vv.w; }
    *(float4*)(o + (size_t)row * D + h * XD + lane * 4) = acc;
}
__global__ void k_swiglu(const float* g, const float* u, float* h, size_t n) { for (size_t i = (size_t)blockIdx.x * blockDim.x + threadIdx.x; i < n; i += (size_t)gridDim.x * blockDim.x) { const float a = g[i]; h[i] = a / (1.0f + expf(-a)) * u[i]; } }
}

extern "C" void kernel_launch(void* const* d_in, const int* in_sizes, int n_in, void* d_out, int out_size, void* d_ws, size_t ws_size, hipStream_t stream) {
    using namespace base;
    const float* x = (const float*)d_in[0]; const float* mem = (const float*)d_in[1]; const int* pos = (const int*)d_in[2];
    const float* norm_mix = (const float*)d_in[3]; const float* w_in = (const float*)d_in[4];
    const float* lre = (const float*)d_in[5]; const float* lim = (const float*)d_in[6]; const float* lstep = (const float*)d_in[7];
    const float* bre = (const float*)d_in[8]; const float* bim = (const float*)d_in[9]; const float* cre = (const float*)d_in[10]; const float* cim = (const float*)d_in[11];
    const float* s5d = (const float*)d_in[12]; const float* wglu = (const float*)d_in[13]; const float* bglu = (const float*)d_in[14]; const float* s5n = (const float*)d_in[15];
    const float* retn = (const float*)d_in[16]; const float* w_out = (const float*)d_in[17]; const float* norm_cross = (const float*)d_in[18]; const float* norm_mem = (const float*)d_in[19];
    const float* w_cq = (const float*)d_in[20]; const float* w_ck = (const float*)d_in[21]; const float* w_cv = (const float*)d_in[22]; const float* w_co = (const float*)d_in[23];
    const float* norm_ffn = (const float*)d_in[24]; const float* w_gate = (const float*)d_in[25]; const float* w_up = (const float*)d_in[26]; const float* w_down = (const float*)d_in[27];
    const float* norm_final = (const float*)d_in[28];
    float* out = (float*)d_out;
    const size_t MiB = 1u << 20;
    if (ws_size < 400 * MiB) { fprintf(stderr, "ws too small\n"); return; }
    float* xn = (float*)((char*)d_ws + 0);
    float* proj = (float*)((char*)d_ws + 32 * MiB);
    float* ymix = (float*)((char*)d_ws + 112 * MiB);
    float* zb = (float*)((char*)d_ws + 144 * MiB);
    float* tb = (float*)((char*)d_ws + 160 * MiB);
    float* ob = (float*)((char*)d_ws + 176 * MiB);
    float* hg = (float*)((char*)d_ws + 192 * MiB);
    float* hu = (float*)((char*)d_ws + 280 * MiB);
    float* mn = (float*)((char*)d_ws + 368 * MiB);
    float* kc = (float*)((char*)d_ws + 369 * MiB);
    float* vc = (float*)((char*)d_ws + 370 * MiB);
    hipLaunchKernelGGL(k_copy, dim3(2048), dim3(256), 0, stream, (const float4*)x, (float4*)out, (size_t)B * L * D / 4);
    for (int l = 0; l < DEPTH; ++l) {
        for (int b = 0; b < B; ++b) {
            float* xb = out + (size_t)b * L * D;
            const int* pb = pos + (size_t)b * L;
            hipLaunchKernelGGL(k_rmsnorm, dim3(L / 4), dim3(256), 0, stream, xb, D, norm_mix + l * D, xn, D, L, D);
            gemm(stream, xn, D, w_in + (size_t)l * D * INW, INW, proj, INW, L, INW, D, false);
            hipLaunchKernelGGL(k_rope, dim3((L * 2 * RH * 64) / 256), dim3(256), 0, stream, proj, pb, L);
            hipLaunchKernelGGL(k_s5, dim3(S5G), dim3(64), 0, stream, proj, lre + l * S5G * S5P, lim + l * S5G * S5P, lstep + l * S5G, bre + (size_t)l * S5G * S5P * 16, bim + (size_t)l * S5G * S5P * 16,
                               cre + (size_t)l * S5G * 16 * S5P, cim + (size_t)l * S5G * 16 * S5P, s5d + l * S5W, zb, L);
            gemm(stream, zb, S5W, wglu + (size_t)l * S5W * S5W, S5W, tb, S5W, L, S5W, S5W, false);
            hipLaunchKernelGGL(k_glu_norm, dim3(L / 4), dim3(256), 0, stream, zb, tb, bglu + l * S5W, s5n + l * S5W, ymix, L);
            hipLaunchKernelGGL(k_ret, dim3(RH), dim3(128), 0, stream, proj, ob, L);
            hipLaunchKernelGGL(k_ret_norm, dim3(L * RH / 4), dim3(256), 0, stream, ob, proj, retn + l * RW, ymix, L);
            gemm(stream, ymix, D, w_out + (size_t)l * D * D, D, xb, D, L, D, D, true);
            hipLaunchKernelGGL(k_rmsnorm, dim3(L / 4), dim3(256), 0, stream, xb, D, norm_cross + l * D, xn, D, L, D);
            hipLaunchKernelGGL(k_rmsnorm, dim3(MEM / 4), dim3(256), 0, stream, mem + (size_t)b * MEM * D, D, norm_mem + l * D, mn, D, MEM, D);
            gemm(stream, xn, D, w_cq + (size_t)l * D * D, D, ymix, D, L, D, D, false);
            gemm(stream, mn, D, w_ck + (size_t)l * D * D, D, kc, D, MEM, D, D, false);
            gemm(stream, mn, D, w_cv + (size_t)l * D * D, D, vc, D, MEM, D, D, false);
            hipLaunchKernelGGL(k_xattn, dim3(L * XH / 4), dim3(256), 0, stream, ymix, kc, vc, xn, L);
            gemm(stream, xn, D, w_co + (size_t)l * D * D, D, xb, D, L, D, D, true);
            hipLaunchKernelGGL(k_rmsnorm, dim3(L / 4), dim3(256), 0, stream, xb, D, norm_ffn + l * D, xn, D, L, D);
            gemm(stream, xn, D, w_gate + (size_t)l * D * FF, FF, hg, FF, L, FF, D, false);
            gemm(stream, xn, D, w_up + (size_t)l * D * FF, FF, hu, FF, L, FF, D, false);
            hipLaunchKernelGGL(k_swiglu, dim3(2048), dim3(256), 0, stream, hg, hu, hg, (size_t)L * FF);
            gemm(stream, hg, FF, w_down + (size_t)l * FF * D, D, xb, D, L, D, FF, true);
        }
    }
    hipLaunchKernelGGL(k_rmsnorm, dim3(B * L / 4), dim3(256), 0, stream, out, D, norm_final, out, D, B * L, D);
}
```

```cpp
#include <hip/hip_runtime.h>
#include <cstdio>
#include <cstdint>
#include <cmath>

namespace mk {
#define LAS __attribute__((address_space(3)))
#define GAS __attribute__((address_space(1)))
typedef unsigned short bf16_t;
typedef short bf16x8 __attribute__((ext_vector_type(8)));
typedef float f32x4 __attribute__((ext_vector_type(4)));
typedef float f32x2 __attribute__((ext_vector_type(2)));
typedef float f32x16 __attribute__((ext_vector_type(16)));
typedef unsigned u32x4 __attribute__((ext_vector_type(4)));
typedef unsigned u32x2 __attribute__((ext_vector_type(2)));
constexpr int M = 32768, D = 1024, NB = 4, SEQ = 8192, DEPTH = 4, MEML = 256, MROWS = NB * MEML;
constexpr int S5W = 512, S5G = 32, S5P = 64, RH = 4, RDK = 128, RW = 512, INW = 2560, XH = 4, XD = 256, FF = 2816;
constexpr float EPS = 1e-6f;
constexpr int BM = 256, BK = 64, HALF = 128, HTB = HALF * BK * 2, STAGE_BYTES = 8 * HTB, NXCD = 8, WGM = 8;
constexpr int NWAVES = 8, NTHR = 512;

constexpr int TAB_OFF = STAGE_BYTES;
constexpr int TAB2_OFF = TAB_OFF + 12288;
constexpr int MISC_OFF = TAB2_OFF + 2048;
constexpr int LDS_BYTES = 147456;
static_assert(MISC_OFF + 128 <= LDS_BYTES, "lds map");

constexpr size_t MiB = 1u << 20;
constexpr size_t WS_CTL = 0, CTL_ZERO_BYTES = 1 * MiB;
constexpr size_t WS_SSQ = 1 * MiB;
constexpr size_t WS_SSQS = 3 * MiB;
constexpr size_t WS_W = 4 * MiB, W_LAYER = 28 * MiB;
constexpr size_t W_IN = 0, W_GLU = 5 * MiB, W_OUT = W_GLU + MiB / 2, W_CQ = W_OUT + 2 * MiB, W_CO = W_CQ + 2 * MiB, W_GU = W_CO + 2 * MiB, W_DN = W_GU + 11 * MiB;
static_assert(W_DN + 11 * MiB / 2 == W_LAYER, "weights");
constexpr size_t WS_ROPE = 116 * MiB;
constexpr size_t WS_MEMK = 132 * MiB;
constexpr size_t WS_MEMVT = 140 * MiB;
constexpr size_t WS_S5M = 148 * MiB;
constexpr size_t WS_XB = 176 * MiB;
constexpr size_t WS_PROJ = 240 * MiB;
constexpr size_t WS_UG = WS_PROJ, WS_Q = WS_PROJ + 40 * MiB, WS_K = WS_Q + 32 * MiB, WS_V = WS_K + 32 * MiB, WS_GATE = WS_V + 32 * MiB;
constexpr size_t WS_Z = 408 * MiB;
constexpr size_t WS_YMIX = 440 * MiB;
constexpr size_t WS_SPARE = 504 * MiB;
constexpr size_t WS_QC = WS_PROJ, WS_OC = WS_PROJ + 64 * MiB, WS_HID = WS_PROJ;
constexpr size_t WS_WCK_TMP = WS_PROJ, WS_WCV_TMP = WS_PROJ + 8 * MiB, WS_MEMB = WS_PROJ + 16 * MiB;
constexpr size_t WS_END = 512 * MiB;
constexpr int CW_BAR = 4096, XB_WORDS = 3456, N_BAR_REGIONS = 64;
static_assert((CW_BAR + N_BAR_REGIONS * XB_WORDS) * 4 <= (int)CTL_ZERO_BYTES, "ctl");

__host__ __device__ __forceinline__ int lds_byte(int r, int c) { const int st = (r >> 4) * 2 + (c >> 5), rr = r & 15, cc = c & 31, ob = rr * 64 + cc * 2; return st * 1024 + (ob ^ (((ob >> 9) & 1) << 5)); }
__host__ __device__ __forceinline__ void stage_rc(int b, int& R, int& C) { const int st = b / 1024, sb = b % 1024, swz = sb ^ (((sb >> 9) & 1) << 5); R = (st >> 1) * 16 + swz / 64; C = (st & 1) * 32 + (swz % 64) / 2; }
__host__ __device__ __forceinline__ int perm32(int rho) { const int n = rho >> 4, i = rho & 15; return 8 * (i >> 2) + 4 * n + (i & 3); }

struct Unit { int pm, pn, g; };
struct Gemm { const bf16_t* A; const bf16_t* Bt; int lda, ldb, K; long a_gs, b_gs; };

struct StaticOrder {
    int nM, nN, nwg, G, c;
    __device__ void init(int nM_, int nN_, int G_, int c_) { nM = nM_; nN = nN_; nwg = nM * nN; G = G_; c = c_; }
    __device__ bool next(int i, Unit& u) const {
        const long L = (long)i * G + c; if (L >= nwg) return false;
        int wgid = (int)L; { const int q = nwg / NXCD, r = nwg % NXCD, xcd = wgid % NXCD, off = wgid / NXCD; wgid = (xcd < r ? xcd * (q + 1) : r * (q + 1) + (xcd - r) * q) + off; }
        const int nig = WGM * nN, gid = wgid / nig, fm = gid * WGM, gsz = (nM - fm) < WGM ? (nM - fm) : WGM;
        u.pm = fm + ((wgid % nig) % gsz); u.pn = (wgid % nig) / gsz; u.g = 0; return true;
    }
};
struct GroupOrder {
    int nM, nN, nG, G, c, first;
    __device__ void init(int nG_, int nM_, int nN_, int G_, int c_, int first_) { nG = nG_; nM = nM_; nN = nN_; G = G_; c = c_; first = first_; }
    __device__ bool next(int i, Unit& u) const {
        const long L = (long)i * G + c - first; if (L < 0 || L >= (long)nG * nM * nN) return false;
        u.pn = (int)(L % nN); const int r = (int)(L / nN); u.pm = r % nM; u.g = r / nM; return true;
    }
};

__device__ __forceinline__ unsigned f2bf(float f) { unsigned u = __builtin_bit_cast(unsigned, f); return (u + 0x7fffu + ((u >> 16) & 1u)) >> 16; }
__device__ __forceinline__ unsigned pk2(float lo, float hi) { return f2bf(lo) | (f2bf(hi) << 16); }
__device__ __forceinline__ unsigned cvt_pk(float lo, float hi) { unsigned r; asm volatile("v_cvt_pk_bf16_f32 %0, %1, %2" : "=v"(r) : "v"(lo), "v"(hi)); return r; }
__device__ __forceinline__ float bf2f(unsigned short b) { return __builtin_bit_cast(float, ((unsigned)b) << 16); }
__device__ __forceinline__ float bflo(unsigned w) { return __builtin_bit_cast(float, w << 16); }
__device__ __forceinline__ float bfhi(unsigned w) { return __builtin_bit_cast(float, w & 0xffff0000u); }
__device__ __forceinline__ float fast_sigmoid(float x) { return __builtin_amdgcn_rcpf(1.0f + __builtin_amdgcn_exp2f(-1.4426950408889634f * x)); }
template <int O> __device__ __forceinline__ float swz_xor(float v) { return __builtin_bit_cast(float, __builtin_amdgcn_ds_swizzle(__builtin_bit_cast(int, v), (O << 10) | 0x1f)); }
__device__ __forceinline__ float half_sum(float v) { const unsigned u = __builtin_bit_cast(unsigned, v); auto r = __builtin_amdgcn_permlane32_swap(u, u, false, false);
    return __builtin_bit_cast(float, (unsigned)r[0]) + __builtin_bit_cast(float, (unsigned)r[1]); }
__device__ __forceinline__ float half_max(float v) { const unsigned u = __builtin_bit_cast(unsigned, v); auto r = __builtin_amdgcn_permlane32_swap(u, u, false, false);
    return fmaxf(__builtin_bit_cast(float, (unsigned)r[0]), __builtin_bit_cast(float, (unsigned)r[1])); }
__device__ __forceinline__ float wave_sum(float v) { v += swz_xor<1>(v); v += swz_xor<2>(v); v += swz_xor<4>(v); v += swz_xor<8>(v); v += swz_xor<16>(v); return half_sum(v); }

__device__ __forceinline__ int lane_id() { unsigned z = 0u; asm volatile("" : "+v"(z)); return (int)__builtin_amdgcn_mbcnt_hi(~0u, __builtin_amdgcn_mbcnt_lo(~0u, z)); }
template <class Epi, class Sched, bool HOOK = false>
__device__ __forceinline__ void gemm_phase(LAS unsigned char* lds, const Gemm g, const Sched& S, const Epi& E, int wid) {
    const int lane = lane_id(), tid = wid * 64 + lane, wr = wid >> 2, wc = wid & 3, fr = lane & 15, fq = lane >> 4;
    const int nt = g.K / BK;
    unsigned voffA[2], voffB[2];
#pragma unroll
    for (int i = 0; i < 2; ++i) { int R, C; stage_rc(tid * 16 + i * 8192, R, C); const int Rb = Epi::PERM ? ((R & ~31) + perm32(R & 31)) : R;
        voffA[i] = (unsigned)(R * g.lda + C) * 2u; voffB[i] = (unsigned)(Rb * g.ldb + C) * 2u; }
    const size_t kstep = (size_t)(BK * 2);
    const size_t hstepA = (size_t)HALF * g.lda * 2, hstepB = (size_t)HALF * g.ldb * 2;
    const unsigned ldsw = (unsigned)wid * 1024u;
    const int aoff = lds_byte(wr * 64 + fr, fq * 8), boff = lds_byte(wc * 32 + fr, fq * 8);
#define PG8_SA(b, h) (((b) * 2 + (h)) * HTB)
#define PG8_SB(b, h) ((4 + (b) * 2 + (h)) * HTB)
#define PG8_STAGE(bufoff, gbase, voff) do { _Pragma("unroll") for (int _i = 0; _i < 2; ++_i) \
        __builtin_amdgcn_global_load_lds((const unsigned*)((const char*)(gbase) + (voff)[_i]), (LAS unsigned*)(lds + (bufoff) + ldsw + _i * 8192), 16, 0, 0); } while (0)
#define PG8_LDA(dst, b, h) do { _Pragma("unroll") for (int m = 0; m < 4; ++m) _Pragma("unroll") for (int k = 0; k < 2; ++k) dst[m][k] = *(const LAS bf16x8*)(lds + PG8_SA(b, h) + aoff + m * 2048 + k * 1024); } while (0)
#define PG8_LDB(dst, b, h) do { _Pragma("unroll") for (int n = 0; n < 2; ++n) _Pragma("unroll") for (int k = 0; k < 2; ++k) dst[n][k] = *(const LAS bf16x8*)(lds + PG8_SB(b, h) + boff + n * 2048 + k * 1024); } while (0)
#define PG8_MMA(ai, bj, At, Bt) do { __builtin_amdgcn_s_setprio(1); _Pragma("unroll") for (int m = 0; m < 4; ++m) _Pragma("unroll") for (int n = 0; n < 2; ++n) _Pragma("unroll") for (int k = 0; k < 2; ++k) \
        acc[ai][bj][m][n] = __builtin_amdgcn_mfma_f32_16x16x32_bf16(Bt[n][k], At[m][k], acc[ai][bj][m][n], 0, 0, 0); __builtin_amdgcn_s_setprio(0); } while (0)
#define PG8_WAIT_V(n) asm volatile("s_waitcnt vmcnt(" #n ")" ::: "memory")
#define PG8_WAIT_L(n) asm volatile("s_waitcnt lgkmcnt(" #n ")" ::: "memory")
#define PG8_BAR __builtin_amdgcn_s_barrier()
#define PG8_SCHED __builtin_amdgcn_sched_barrier(0)
#define PG8_ABASE(u) ((const char*)g.A + ((size_t)(u).g * g.a_gs + (size_t)(u).pm * BM * g.lda) * 2)
#define PG8_BBASE(u) ((const char*)g.Bt + ((size_t)(u).g * g.b_gs + (size_t)(u).pn * BM * g.ldb) * 2)
    Unit cur, nxt; int ui = 0;
    if (!S.next(0, cur)) return;
    f32x4 acc[2][2][4][2];
#pragma unroll
    for (int a = 0; a < 2; ++a)
#pragma unroll
        for (int b = 0; b < 2; ++b)
#pragma unroll
            for (int m = 0; m < 4; ++m)
#pragma unroll
                for (int n = 0; n < 2; ++n) acc[a][b][m][n] = (f32x4){0.f, 0.f, 0.f, 0.f};
    bf16x8 At[4][2], B0[2][2], B1[2][2];
    const char* cA = PG8_ABASE(cur); const char* cB = PG8_BBASE(cur);
    PG8_STAGE(PG8_SB(0, 0), cB, voffB); PG8_STAGE(PG8_SB(0, 1), cB + hstepB, voffB); PG8_STAGE(PG8_SA(0, 0), cA, voffA); PG8_STAGE(PG8_SA(0, 1), cA + hstepA, voffA);
    if (wr == 1) PG8_BAR;
    PG8_WAIT_V(2); PG8_BAR;
    PG8_STAGE(PG8_SB(1, 0), cB + kstep, voffB); PG8_STAGE(PG8_SA(1, 0), cA + kstep, voffA); PG8_STAGE(PG8_SB(1, 1), cB + hstepB + kstep, voffB);
    PG8_WAIT_V(6); PG8_BAR;
    for (;;) {
        const bool has_next = S.next(ui + 1, nxt);
        const char* nA = has_next ? PG8_ABASE(nxt) : cA; const char* nB = has_next ? PG8_BBASE(nxt) : cB;
        for (int t = 0; t < nt; t += 2) {
            const bool last = (t == nt - 2);
            const char* a1 = cA + (size_t)(t + 1) * kstep;
            const char* a2 = last ? nA : cA + (size_t)(t + 2) * kstep; const char* b2 = last ? nB : cB + (size_t)(t + 2) * kstep;
            const char* a3 = a2 + kstep; const char* b3 = b2 + kstep;
            if constexpr (HOOK) { if (t == E.hook_t) E.hook(acc, ui, wr, fr); }
            PG8_LDB(B0, 0, 0); PG8_LDB(B1, 0, 1); PG8_SCHED; PG8_LDA(At, 0, 0); PG8_STAGE(PG8_SA(1, 1), a1 + hstepA, voffA);
            PG8_WAIT_V(8); PG8_WAIT_L(0); PG8_BAR; PG8_MMA(0, 0, At, B0); PG8_MMA(0, 1, At, B1); PG8_BAR; PG8_SCHED;
            PG8_LDA(At, 0, 1); PG8_STAGE(PG8_SB(0, 0), b2, voffB); PG8_STAGE(PG8_SB(0, 1), b2 + hstepB, voffB); PG8_STAGE(PG8_SA(0, 0), a2, voffA);
            PG8_WAIT_V(8); PG8_WAIT_L(0); PG8_BAR; PG8_MMA(1, 0, At, B0); PG8_MMA(1, 1, At, B1); PG8_BAR; PG8_SCHED;
            PG8_LDB(B0, 1, 0); PG8_LDB(B1, 1, 1); PG8_SCHED; PG8_LDA(At, 1, 0); PG8_STAGE(PG8_SA(0, 1), a2 + hstepA, voffA);
            PG8_WAIT_V(8); PG8_WAIT_L(0); PG8_BAR; PG8_MMA(0, 0, At, B0); PG8_MMA(0, 1, At, B1); PG8_BAR; PG8_SCHED;
            PG8_LDA(At, 1, 1); PG8_STAGE(PG8_SB(1, 0), b3, voffB); PG8_STAGE(PG8_SB(1, 1), b3 + hstepB, voffB); PG8_STAGE(PG8_SA(1, 0), a3, voffA);
            PG8_WAIT_V(8); PG8_WAIT_L(0); PG8_BAR; PG8_MMA(1, 0, At, B0); PG8_MMA(1, 1, At, B1); PG8_BAR; PG8_SCHED;
        }
        if (wr == 0) PG8_BAR;
        E(acc, cur, ui, wr, wc, fr, fq);
        if (!has_next) break;
#pragma unroll
        for (int a = 0; a < 2; ++a)
#pragma unroll
            for (int b = 0; b < 2; ++b)
#pragma unroll
                for (int m = 0; m < 4; ++m)
#pragma unroll
                    for (int n = 0; n < 2; ++n) acc[a][b][m][n] = (f32x4){0.f, 0.f, 0.f, 0.f};
        cur = nxt; cA = nA; cB = nB; ++ui;
        if (wr == 1) PG8_BAR;
    }
    PG8_WAIT_V(0);
    PG8_BAR;
#undef PG8_SA
#undef PG8_SB
#undef PG8_STAGE
#undef PG8_LDA
#undef PG8_LDB
#undef PG8_MMA
#undef PG8_WAIT_V
#undef PG8_WAIT_L
#undef PG8_BAR
#undef PG8_SCHED
#undef PG8_ABASE
#undef PG8_BBASE
}
typedef GAS unsigned gu32;
#define VM_WAIT() asm volatile("s_waitcnt vmcnt(0)" ::: "memory")
#define LDS_WAIT() asm volatile("s_waitcnt lgkmcnt(0)" ::: "memory")
#define XB_TMO      128
#define XB_XCNT(j)  (256  + 64 * (j))
#define XB_XSUB(j)  (1280 + 64 * (j))
#define XB_XGEN(j)  (2304 + 64 * (j))
#define XB_TOP      3328
#define XB_TOPGEN   3392
#define XCD_BAR_WORDS 3456
#define XB_SPIN_CAP (1u << 18)

__device__ __forceinline__ unsigned xb_ld(unsigned* p)              { return __hip_atomic_load(p, __ATOMIC_RELAXED, __HIP_MEMORY_SCOPE_AGENT); }
__device__ __forceinline__ unsigned xb_add(unsigned* p, unsigned v) { return __hip_atomic_fetch_add(p, v, __ATOMIC_RELAXED, __HIP_MEMORY_SCOPE_AGENT); }
__device__ __forceinline__ unsigned xb_xcc_id() { return (unsigned)__builtin_amdgcn_s_getreg((3 << 11) | 20) & 0xFu; }
#define XB_SPIN(cond, bar) do { unsigned _sp = 0; while (cond) { __builtin_amdgcn_s_sleep(1); \
    if ((++_sp & 255u) == 0u) { if (xb_ld(&(bar)[XB_TMO])) break; if (_sp > XB_SPIN_CAP) { atomicAdd(&(bar)[XB_TMO], 1u); break; } } } } while (0)

struct XcdBarrier {
    unsigned* bar; unsigned x;
    bool t0; volatile LAS unsigned* st;
};

__device__ __forceinline__ XcdBarrier xcd_barrier_post(unsigned* bar, volatile LAS unsigned* st, bool t0) {
    XcdBarrier b; b.bar = bar; b.x = xb_xcc_id(); b.st = st; b.t0 = t0;
    if (t0) (void)xb_add(&bar[XB_XCNT(b.x)], 1u);
    return b;
}
__device__ __forceinline__ void xcd_barrier_complete(unsigned* bar, unsigned x, unsigned& nloc, unsigned& nx) {
    const unsigned G = gridDim.x * gridDim.y * gridDim.z;
    unsigned sum, cnt, mine, sp = 0u;
    for (;;) {
        sum = 0u; cnt = 0u; mine = 0u;
#pragma unroll
        for (unsigned j = 0; j < 16; ++j) { const unsigned c = xb_ld(&bar[XB_XCNT(j)]); sum += c; cnt += (c > 0u) ? 1u : 0u; mine = (j == x) ? c : mine; }
        if (sum == G) break;
        __builtin_amdgcn_s_sleep(1);
        if ((++sp & 255u) == 0u) { if (xb_ld(&bar[XB_TMO])) break; if (sp > XB_SPIN_CAP) { atomicAdd(&bar[XB_TMO], 1u); break; } }
    }
    nloc = mine > 0u ? mine : 1u; nx = cnt > 0u ? cnt : 1u;
}

__device__ __forceinline__ void xcd_barrier(const XcdBarrier& b) {
    asm volatile("s_waitcnt vmcnt(0)" ::: "memory");
    __syncthreads();
    if (b.t0) {
        unsigned* bar = b.bar;
        __builtin_amdgcn_s_waitcnt(0);
        unsigned nloc = b.st[0], nx = b.st[1];
        if (nloc == 0u) { xcd_barrier_complete(bar, b.x, nloc, nx); b.st[0] = nloc; b.st[1] = nx; }
        const unsigned old = xb_add(&bar[XB_XSUB(b.x)], 1u);
        const unsigned gen = old / nloc;
        if (old + 1u == (gen + 1u) * nloc) {
            __builtin_amdgcn_fence(__ATOMIC_RELEASE, "agent");
            asm volatile("s_waitcnt vmcnt(0)" ::: "memory");
            const unsigned og = xb_add(&bar[XB_TOP], 1u);
            const unsigned tg = og / nx;
            if (og + 1u == (tg + 1u) * nx) xb_add(&bar[XB_TOPGEN], 1u);
            else XB_SPIN(xb_ld(&bar[XB_TOPGEN]) == tg, bar);
            __builtin_amdgcn_fence(__ATOMIC_ACQUIRE, "agent");
            xb_add(&bar[XB_XGEN(b.x)], 1u);
            asm volatile("s_waitcnt vmcnt(0)" ::: "memory");
        } else {
            XB_SPIN(xb_ld(&bar[XB_XGEN(b.x)]) == gen, bar);
            __builtin_amdgcn_fence(__ATOMIC_ACQUIRE, "agent");
            asm volatile("s_waitcnt vmcnt(0)" ::: "memory");
        }
    }
    __syncthreads();
}
template <int MAPK>
__device__ __forceinline__ void tr_item(const float* W, int K, int N, bf16_t* WT, const float* gain, int gain_lim, float scale, LAS float* scr, int item, int lane) {
    const int nblk = N / 32, kb = item / nblk, nb = item % nblk, k0 = 64 * kb, n0 = 32 * nb;
    float cs = scale;
    if (MAPK == 1) { if (n0 >= 1024 && n0 < 1536) cs *= 0.08838834764831845f; }
#pragma unroll 8
    for (int i = 0; i < 32; ++i) { const int kk = 2 * i + (lane >> 5); const float gk = (k0 + kk < gain_lim) ? gain[k0 + kk] : 1.0f;
        scr[kk * 33 + (lane & 31)] = W[(size_t)(k0 + kk) * N + n0 + (lane & 31)] * gk * cs; }
    LDS_WAIT(); asm volatile("" ::: "memory");
    const int c = lane & 7;
#pragma unroll
    for (int j = 0; j < 4; ++j) { const int nl = (lane >> 3) + 8 * j, n = n0 + nl; const LAS float* s = scr + (8 * c) * 33 + nl;
        int nr = n;
        if (MAPK == 1) { if (n >= 512 && n < 1536) { const int jj = n - 512, blk = jj >> 7, e = jj & 127; nr = 512 + blk * 128 + 2 * (e & 63) + (e >> 6); } }
        if (MAPK == 2) nr = (n >> 7) * 256 + (n & 127);
        if (MAPK == 3) nr = (n >> 7) * 256 + 128 + (n & 127);
        u32x4 o; o.x = pk2(s[0 * 33], s[1 * 33]); o.y = pk2(s[2 * 33], s[3 * 33]); o.z = pk2(s[4 * 33], s[5 * 33]); o.w = pk2(s[6 * 33], s[7 * 33]);
        *(GAS u32x4*)(WT + (size_t)nr * K + k0 + 8 * c) = o; }
    LDS_WAIT(); asm volatile("" ::: "memory");
}
struct In {
    const float *x, *mem; const int* pos; const float *norm_mix, *w_in, *lre, *lim, *lstep, *bre, *bim, *cre, *cim, *s5d, *wglu, *bglu, *s5n, *retn, *w_out, *norm_cross, *norm_mem,
        *w_cq, *w_ck, *w_cv, *w_co, *norm_ffn, *w_gate, *w_up, *w_down, *norm_final;
};
__device__ __forceinline__ bf16_t* wl(unsigned char* ws, int l, size_t off) { return (bf16_t*)(ws + WS_W + (size_t)l * W_LAYER + off); }

__device__ __forceinline__ void pro_weights(const In& in, unsigned char* ws, LAS unsigned char* lds, int gw, int NGW, int wave, int lane) {
    LAS float* scr = (LAS float*)(lds + wave * 16384);
    constexpr int I_IN = 16 * 80, I_GLU = 8 * 16, I_SQ = 16 * 32, I_GU = 16 * 88, I_DN = 44 * 32;
    constexpr int PER_L = I_IN + I_GLU + 5 * I_SQ + 2 * I_GU + I_DN;
    static_assert(PER_L == 8192, "items");
    for (int it = gw; it < DEPTH * PER_L; it += NGW) {
        const int l = it / PER_L; int r = it % PER_L;
        if (r < I_IN) { tr_item<1>(in.w_in + (size_t)l * D * INW, D, INW, wl(ws, l, W_IN), in.norm_mix + l * D, D, 1.0f, scr, r, lane); continue; } r -= I_IN;
        if (r < I_GLU) { tr_item<0>(in.wglu + (size_t)l * S5W * S5W, S5W, S5W, wl(ws, l, W_GLU), nullptr, 0, 1.0f, scr, r, lane); continue; } r -= I_GLU;
        if (r < I_SQ) { tr_item<0>(in.w_out + (size_t)l * D * D, D, D, wl(ws, l, W_OUT), in.s5n + l * S5W, S5W, 1.0f, scr, r, lane); continue; } r -= I_SQ;
        if (r < I_SQ) { tr_item<0>(in.w_cq + (size_t)l * D * D, D, D, wl(ws, l, W_CQ), in.norm_cross + l * D, D, 0.0625f * 1.4426950408889634f, scr, r, lane); continue; } r -= I_SQ;
        if (r < I_SQ) { tr_item<0>(in.w_co + (size_t)l * D * D, D, D, wl(ws, l, W_CO), nullptr, 0, 1.0f, scr, r, lane); continue; } r -= I_SQ;
        if (r < I_SQ) { tr_item<0>(in.w_ck + (size_t)l * D * D, D, D, (bf16_t*)(ws + WS_WCK_TMP) + (size_t)l * D * D, in.norm_mem + l * D, D, 1.0f, scr, r, lane); continue; } r -= I_SQ;
        if (r < I_SQ) { tr_item<0>(in.w_cv + (size_t)l * D * D, D, D, (bf16_t*)(ws + WS_WCV_TMP) + (size_t)l * D * D, in.norm_mem + l * D, D, 1.0f, scr, r, lane); continue; } r -= I_SQ;
        if (r < I_GU) { tr_item<2>(in.w_gate + (size_t)l * D * FF, D, FF, wl(ws, l, W_GU), in.norm_ffn + l * D, D, 1.0f, scr, r, lane); continue; } r -= I_GU;
        if (r < I_GU) { tr_item<3>(in.w_up + (size_t)l * D * FF, D, FF, wl(ws, l, W_GU), in.norm_ffn + l * D, D, 1.0f, scr, r, lane); continue; } r -= I_GU;
        tr_item<0>(in.w_down + (size_t)l * FF * D, FF, D, wl(ws, l, W_DN), nullptr, 0, 1.0f, scr, r, lane);
    }
}
__device__ __forceinline__ void xprep_rows(const float* src, float* dst, bf16_t* xb, float* ssq, int gw, int NGW, int lane) {
    for (int m = gw; m < M; m += NGW) {
        const GAS f32x4* xr = (const GAS f32x4*)(src + (size_t)m * D) + lane;
        f32x4 v[4]; float s = 0.f;
#pragma unroll
        for (int j = 0; j < 4; ++j) { v[j] = xr[64 * j]; s += (v[j].x * v[j].x + v[j].y * v[j].y) + (v[j].z * v[j].z + v[j].w * v[j].w); }
        const float tot = wave_sum(s);
        if (dst != src) { GAS f32x4* o = (GAS f32x4*)(dst + (size_t)m * D) + lane;
#pragma unroll
            for (int j = 0; j < 4; ++j) o[64 * j] = v[j]; }
        GAS u32x2* o8 = (GAS u32x2*)(xb + (size_t)m * D) + lane;
#pragma unroll
        for (int j = 0; j < 4; ++j) { u32x2 w; w.x = pk2(v[j].x, v[j].y); w.y = pk2(v[j].z, v[j].w); o8[64 * j] = w; }
        if (lane < 16) ssq[(size_t)m * 16 + lane] = (lane == 0) ? tot : 0.f;
    }
}
__device__ __forceinline__ void final_norm_rows(float* x, const float* g, int gw, int NGW, int lane) {
    f32x4 gv[4];
#pragma unroll
    for (int j = 0; j < 4; ++j) gv[j] = ((const GAS f32x4*)g)[lane + 64 * j];
    for (int m = gw; m < M; m += NGW) {
        GAS f32x4* xr = (GAS f32x4*)(x + (size_t)m * D) + lane;
        f32x4 v[4]; float s = 0.f;
#pragma unroll
        for (int j = 0; j < 4; ++j) { v[j] = xr[64 * j]; s += (v[j].x * v[j].x + v[j].y * v[j].y) + (v[j].z * v[j].z + v[j].w * v[j].w); }
        const float r = 1.0f / sqrtf(wave_sum(s) * (1.0f / D) + EPS);
#pragma unroll
        for (int j = 0; j < 4; ++j) xr[64 * j] = v[j] * r * gv[j];
    }
}
template <class Sched>
__device__ __forceinline__ void rstd_table(LAS float* tab, const Sched& S, const float* ssq, int nslots, float inv_n, int wave) {
    Unit u; const int t = wave * 64 + lane_id();
    for (int i = 0; S.next(i, u); ++i) {
        if (wave < 4) { const float* p = ssq + (size_t)(u.pm * 256 + t) * nslots; float s = 0.f;
            for (int j = 0; j < nslots; j += 4) { const f32x4 v = *(const GAS f32x4*)(p + j); s += (v.x + v.y) + (v.z + v.w); }
            tab[i * 256 + t] = 1.0f / sqrtf(s * inv_n + EPS); }
    }
    __syncthreads();
}

struct EpiFfn1 {
    static constexpr bool PERM = true;
    bf16_t* H; LAS const float* tab;
    __device__ __forceinline__ void operator()(const f32x4 (&acc)[2][2][4][2], const Unit& u, int ui, int wr, int wc, int fr, int fq) const {
#pragma unroll
        for (int ai = 0; ai < 2; ++ai)
#pragma unroll
            for (int m = 0; m < 4; ++m) { const int rl = ai * HALF + wr * 64 + m * 16 + fr; const float rs = tab[ui * 256 + rl];
                float h[8];
#pragma unroll
                for (int n = 0; n < 2; ++n)
#pragma unroll
                    for (int j = 0; j < 4; ++j) { const float gg = acc[ai][0][m][n][j] * rs, uu = acc[ai][1][m][n][j] * rs; h[4 * n + j] = gg * fast_sigmoid(gg) * uu; }
                u32x4 w; w.x = cvt_pk(h[0], h[1]); w.y = cvt_pk(h[2], h[3]); w.z = cvt_pk(h[4], h[5]); w.w = cvt_pk(h[6], h[7]);
                *(GAS u32x4*)(H + (size_t)(u.pm * BM + rl) * FF + u.pn * 128 + wc * 32 + 8 * fq) = w; }
    }
};
struct EpiRes {
    static constexpr bool PERM = true;
    const float* xin; float* xout; bf16_t* xb; float* ssq;
    __device__ __forceinline__ void operator()(const f32x4 (&acc)[2][2][4][2], const Unit& u, int ui, int wr, int wc, int fr, int fq) const {
#pragma unroll
        for (int ai = 0; ai < 2; ++ai)
#pragma unroll
            for (int m = 0; m < 4; ++m) { const int row = u.pm * BM + ai * HALF + wr * 64 + m * 16 + fr; float ps = 0.f;
#pragma unroll
                for (int bj = 0; bj < 2; ++bj) { const size_t off = (size_t)row * D + u.pn * BM + bj * HALF + wc * 32 + 8 * fq;
                    const f32x4 v0 = *(const GAS f32x4*)(xin + off) + acc[ai][bj][m][0], v1 = *(const GAS f32x4*)(xin + off + 4) + acc[ai][bj][m][1];
                    *(GAS f32x4*)(xout + off) = v0; *(GAS f32x4*)(xout + off + 4) = v1;
                    u32x4 w; w.x = cvt_pk(v0.x, v0.y); w.y = cvt_pk(v0.z, v0.w); w.z = cvt_pk(v1.x, v1.y); w.w = cvt_pk(v1.z, v1.w);
                    *(GAS u32x4*)(xb + off) = w;
                    ps += (v0.x * v0.x + v0.y * v0.y) + (v0.z * v0.z + v0.w * v0.w) + (v1.x * v1.x + v1.y * v1.y) + (v1.z * v1.z + v1.w * v1.w); }
                ps += swz_xor<16>(ps); ps = half_sum(ps);
                if (fq == 0) ssq[(size_t)row * 16 + u.pn * 4 + wc] = ps;
                asm volatile("" ::: "memory"); }
    }
};
struct EpiScaleBf16 {
    static constexpr bool PERM = true;
    bf16_t* O; int ldo; LAS const float* tab;
    __device__ __forceinline__ void operator()(const f32x4 (&acc)[2][2][4][2], const Unit& u, int ui, int wr, int wc, int fr, int fq) const {
#pragma unroll
        for (int ai = 0; ai < 2; ++ai)
#pragma unroll
            for (int m = 0; m < 4; ++m) { const int rl = ai * HALF + wr * 64 + m * 16 + fr; const float rs = tab[ui * 256 + rl];
#pragma unroll
                for (int bj = 0; bj < 2; ++bj) { const f32x4 v0 = acc[ai][bj][m][0] * rs, v1 = acc[ai][bj][m][1] * rs;
                    u32x4 w; w.x = cvt_pk(v0.x, v0.y); w.y = cvt_pk(v0.z, v0.w); w.z = cvt_pk(v1.x, v1.y); w.w = cvt_pk(v1.z, v1.w);
                    *(GAS u32x4*)(O + (size_t)(u.pm * BM + rl) * ldo + u.pn * BM + bj * HALF + wc * 32 + 8 * fq) = w; } }
    }
};
struct EpiMemK {
    static constexpr bool PERM = true;
    bf16_t* O; const float* rsm;
    __device__ __forceinline__ void operator()(const f32x4 (&acc)[2][2][4][2], const Unit& u, int ui, int wr, int wc, int fr, int fq) const {
#pragma unroll
        for (int ai = 0; ai < 2; ++ai)
#pragma unroll
            for (int m = 0; m < 4; ++m) { const int row = u.pm * BM + ai * HALF + wr * 64 + m * 16 + fr; const float rs = rsm[row];
#pragma unroll
                for (int bj = 0; bj < 2; ++bj) { const f32x4 v0 = acc[ai][bj][m][0] * rs, v1 = acc[ai][bj][m][1] * rs;
                    u32x4 w; w.x = cvt_pk(v0.x, v0.y); w.y = cvt_pk(v0.z, v0.w); w.z = cvt_pk(v1.x, v1.y); w.w = cvt_pk(v1.z, v1.w);
                    *(GAS u32x4*)(O + ((size_t)u.g * MROWS + row) * D + u.pn * BM + bj * HALF + wc * 32 + 8 * fq) = w; } }
    }
};
struct EpiMemVT {
    static constexpr bool PERM = true;
    bf16_t* O; const float* rsm;
    __device__ __forceinline__ void operator()(const f32x4 (&acc)[2][2][4][2], const Unit& u, int ui, int wr, int wc, int fr, int fq) const {
#pragma unroll
        for (int bj = 0; bj < 2; ++bj) { const int c0 = u.pn * BM + bj * HALF + wc * 32 + 8 * fq;
            const f32x4 r0 = *(const GAS f32x4*)(rsm + c0), r1 = *(const GAS f32x4*)(rsm + c0 + 4);
            const int p0 = (c0 & ~15) + 4 * ((c0 >> 3) & 1), p1 = p0 + 8;
#pragma unroll
            for (int ai = 0; ai < 2; ++ai)
#pragma unroll
                for (int m = 0; m < 4; ++m) { const int row = u.pm * BM + ai * HALF + wr * 64 + m * 16 + fr;
                    const f32x4 v0 = acc[ai][bj][m][0] * r0, v1 = acc[ai][bj][m][1] * r1;
                    bf16_t* o = O + ((size_t)u.g * D + row) * MROWS;
                    u32x2 w0, w1; w0.x = cvt_pk(v0.x, v0.y); w0.y = cvt_pk(v0.z, v0.w); w1.x = cvt_pk(v1.x, v1.y); w1.y = cvt_pk(v1.z, v1.w);
                    *(GAS u32x2*)(o + p0) = w0; *(GAS u32x2*)(o + p1) = w1; } }
    }
};

__device__ __forceinline__ void xa_fill(LAS unsigned char* lds, const bf16_t* src  , int wave, int lane) {
#pragma unroll 1
    for (int j = 0; j < 16; ++j) { const int p = wave * 16 + j, row = 2 * p + (lane >> 5), ch = (lane & 31) ^ (row & 15);
        __builtin_amdgcn_global_load_lds((const unsigned*)((const char*)src + (size_t)row * 2048 + ch * 16), (LAS unsigned*)(lds + p * 1024), 16, 0, 0); }
}
__device__ __forceinline__ void xa_mma(f32x16 (&acc)[8], const bf16x8 (&bf)[16], LAS const unsigned char* lds, int r, int hh) {
    const int a = (r >> 1) & 7, b = hh ^ (r & 1); LAS const unsigned char* base = lds + r * 512 + b * 16;
#pragma unroll
    for (int s = 0; s < 16; ++s) { const int cp = ((s & 8) | ((s & 7) ^ a)) << 5;
        LAS const unsigned char* p0 = base + cp; LAS const unsigned char* p1 = p0 + 65536;
#pragma unroll
        for (int blk = 0; blk < 8; ++blk) {
            const bf16x8 av = (blk < 4) ? *(LAS const bf16x8*)(p0 + blk * 16384) : *(LAS const bf16x8*)(p1 + (blk - 4) * 16384);
            acc[blk] = __builtin_amdgcn_mfma_f32_32x32x16_bf16(av, bf[s], acc[blk], 0, 0, 0); }
#pragma unroll
        for (int blk = 0; blk < 8; ++blk) asm volatile("" : "+v"(acc[blk]));
    }
}
__device__ __forceinline__ void xa_mma_q(f32x16 (&acc)[8], const GAS bf16x8* qp, LAS const unsigned char* lds, int r, int hh) {
    const int a = (r >> 1) & 7, b = hh ^ (r & 1); LAS const unsigned char* base = lds + r * 512 + b * 16;
    bf16x8 q3[3];
#pragma unroll
    for (int s = 0; s < 3; ++s) q3[s] = qp[2 * s];
#pragma unroll
    for (int s = 0; s < 16; ++s) { const int cp = ((s & 8) | ((s & 7) ^ a)) << 5;
        LAS const unsigned char* p0 = base + cp; LAS const unsigned char* p1 = p0 + 65536;
        const bf16x8 bq = q3[s % 3];
        if (s + 3 < 16) q3[s % 3] = qp[2 * (s + 3)];
#pragma unroll
        for (int blk = 0; blk < 8; ++blk) {
            const bf16x8 av = (blk < 4) ? *(LAS const bf16x8*)(p0 + blk * 16384) : *(LAS const bf16x8*)(p1 + (blk - 4) * 16384);
            acc[blk] = __builtin_amdgcn_mfma_f32_32x32x16_bf16(av, bq, acc[blk], 0, 0, 0); }
#pragma unroll
        for (int blk = 0; blk < 8; ++blk) asm volatile("" : "+v"(acc[blk]));
    }
}
__device__ __forceinline__ void xattn_phase(LAS unsigned char* lds, const bf16_t* QC, const bf16_t* Kl, const bf16_t* VTl, bf16_t* OC, int G, int bx, int wave) {
    const int per = (NB * XH * (SEQ / 256) + G - 1) / G;
    for (int i = 0; i < per; ++i) {
        const int unit = bx * per + i; if (unit >= NB * XH * (SEQ / 256)) break;
        const int bh = unit >> 5, qt = unit & 31, b = bh >> 2, h = bh & 3;
        const size_t qrow0 = (size_t)b * SEQ + qt * 256 + wave * 32;
        xa_fill(lds, Kl + (size_t)b * MEML * D + h * XD, wave, lane_id());
        VM_WAIT(); __syncthreads();
        f32x16 acc[8];
#pragma unroll
        for (int k = 0; k < 8; ++k)
#pragma unroll
            for (int j = 0; j < 16; ++j) acc[k][j] = 0.f;
        { const int lane = lane_id(), r = lane & 31, hh = lane >> 5;
          xa_mma_q(acc, (const GAS bf16x8*)(QC + (qrow0 + r) * D + h * XD + 8 * hh), lds, r, hh); }
        __syncthreads();
        xa_fill(lds, VTl + (size_t)h * XD * MROWS + b * MEML, wave, lane_id());
        float mx = acc[0][0];
#pragma unroll
        for (int k = 0; k < 8; ++k)
#pragma unroll
            for (int j = 0; j < 16; ++j) mx = fmaxf(mx, acc[k][j]);
        mx = half_max(mx);
        float sum = 0.f;
#pragma unroll
        for (int k = 0; k < 8; ++k)
#pragma unroll
            for (int j = 0; j < 16; ++j) { const float p = __builtin_amdgcn_exp2f(acc[k][j] - mx); acc[k][j] = p; sum += p; }
        sum = half_sum(sum);
        const float inv = 1.0f / sum;
        bf16x8 bp[16];
#pragma unroll
        for (int k = 0; k < 8; ++k)
#pragma unroll
            for (int s = 0; s < 2; ++s) { u32x4 w; w.x = cvt_pk(acc[k][8 * s + 0], acc[k][8 * s + 1]); w.y = cvt_pk(acc[k][8 * s + 2], acc[k][8 * s + 3]);
                w.z = cvt_pk(acc[k][8 * s + 4], acc[k][8 * s + 5]); w.w = cvt_pk(acc[k][8 * s + 6], acc[k][8 * s + 7]); bp[2 * k + s] = __builtin_bit_cast(bf16x8, w); }
#pragma unroll
        for (int k = 0; k < 8; ++k)
#pragma unroll
            for (int j = 0; j < 16; ++j) acc[k][j] = 0.f;
        VM_WAIT(); __syncthreads();
        { const int lane = lane_id(); xa_mma(acc, bp, lds, lane & 31, lane >> 5); }
        __syncthreads();
        { const int lane = lane_id(), r = lane & 31, hh = lane >> 5;
          bf16_t* op = OC + (qrow0 + r) * D + h * XD + 4 * hh;
#pragma unroll
          for (int k = 0; k < 8; ++k)
#pragma unroll
            for (int g4 = 0; g4 < 4; ++g4) { u32x2 w; w.x = cvt_pk(acc[k][4 * g4] * inv, acc[k][4 * g4 + 1] * inv); w.y = cvt_pk(acc[k][4 * g4 + 2] * inv, acc[k][4 * g4 + 3] * inv);
                *(GAS u32x2*)(op + k * 32 + 8 * g4) = w; } }
    }
}
__device__ __forceinline__ void mem_prep_rows(const float* mem, bf16_t* memb, float* rsm, int gw, int NGW, int lane) {
    for (int m = gw; m < MROWS; m += NGW) {
        const GAS f32x4* xr = (const GAS f32x4*)(mem + (size_t)m * D) + lane;
        f32x4 v[4]; float s = 0.f;
#pragma unroll
        for (int j = 0; j < 4; ++j) { v[j] = xr[64 * j]; s += (v[j].x * v[j].x + v[j].y * v[j].y) + (v[j].z * v[j].z + v[j].w * v[j].w); }
        const float tot = wave_sum(s);
        GAS u32x2* o8 = (GAS u32x2*)(memb + (size_t)m * D) + lane;
#pragma unroll
        for (int j = 0; j < 4; ++j) { u32x2 w; w.x = pk2(v[j].x, v[j].y); w.y = pk2(v[j].z, v[j].w); o8[64 * j] = w; }
        if (lane == 0) rsm[m] = 1.0f / sqrtf(tot * (1.0f / D) + EPS);
    }
}

__device__ __forceinline__ float ret_lg2(int h) { return h == 0 ? -0.04580368961312479f : h == 1 ? -0.02272007650008353f : h == 2 ? -0.011315313227834146f : -0.005646563141142063f; }
struct EpiProj {
    static constexpr bool PERM = true;
    bf16_t *UG, *Q, *K, *V, *GT; const float* rope; LAS const float* tab;
    __device__ __forceinline__ void operator()(const f32x4 (&acc)[2][2][4][2], const Unit& u, int ui, int wr, int wc, int fr, int fq) const {
        const int kind = u.pn >> 1;
#pragma unroll
        for (int ai = 0; ai < 2; ++ai)
#pragma unroll
            for (int m = 0; m < 4; ++m) { const int rl = ai * HALF + wr * 64 + m * 16 + fr, row = u.pm * BM + rl; const float rs = tab[ui * 256 + rl];
#pragma unroll
                for (int bj = 0; bj < 2; ++bj) { f32x4 v0 = acc[ai][bj][m][0] * rs, v1 = acc[ai][bj][m][1] * rs;
                    const int cw = (u.pn & 1) * 256 + bj * HALF + wc * 32 + 8 * fq;
                    bf16_t* dst;
                    if (kind == 0) dst = UG + ((size_t)(cw >> 4) * (M / 32) + (row >> 5)) * 640 + (row & 31) * 16 + ((cw >> 3) & 1) * 8;
                    else if (kind == 1 || kind == 2) {
                        const int hd = cw >> 7, i0 = (cw & 127) >> 1;
                        const GAS f32x4* rp = (const GAS f32x4*)(rope + ((size_t)row * 64 + i0) * 2);
                        const f32x4 c0 = rp[0], c1 = rp[1];
                        const float e = (float)(row & 127) * ret_lg2(hd), sc = __builtin_amdgcn_exp2f(kind == 1 ? e : -e);
                        f32x4 o0, o1;
                        o0.x = (v0.x * c0.x - v0.y * c0.y) * sc; o0.y = (v0.y * c0.x + v0.x * c0.y) * sc; o0.z = (v0.z * c0.z - v0.w * c0.w) * sc; o0.w = (v0.w * c0.z + v0.z * c0.w) * sc;
                        o1.x = (v1.x * c1.x - v1.y * c1.y) * sc; o1.y = (v1.y * c1.x + v1.x * c1.y) * sc; o1.z = (v1.z * c1.z - v1.w * c1.w) * sc; o1.w = (v1.w * c1.z + v1.z * c1.w) * sc;
                        v0 = o0; v1 = o1;
                        dst = (kind == 1 ? Q : K) + (size_t)row * RW + cw;
                    } else dst = (kind == 3 ? V : GT) + (size_t)row * RW + cw;
                    u32x4 w; w.x = cvt_pk(v0.x, v0.y); w.y = cvt_pk(v0.z, v0.w); w.z = cvt_pk(v1.x, v1.y); w.w = cvt_pk(v1.z, v1.w);
                    *(GAS u32x4*)dst = w; }
                asm volatile("" ::: "memory"); }
    }
};
struct EpiGlu {
    static constexpr bool PERM = true;
    const bf16_t* Z; const float* bias; bf16_t* Y; float* ssqs;
    __device__ __forceinline__ void operator()(const f32x4 (&acc)[2][2][4][2], const Unit& u, int ui, int wr, int wc, int fr, int fq) const {
#pragma unroll
        for (int ai = 0; ai < 2; ++ai)
#pragma unroll
            for (int m = 0; m < 4; ++m) { const int row = u.pm * BM + ai * HALF + wr * 64 + m * 16 + fr; float ps = 0.f;
#pragma unroll
                for (int bj = 0; bj < 2; ++bj) { const int col = u.pn * BM + bj * HALF + wc * 32 + 8 * fq;
                    const u32x4 zw = *(const GAS u32x4*)(Z + (size_t)row * S5W + col);
                    const f32x4 b0 = *(const GAS f32x4*)(bias + col), b1 = *(const GAS f32x4*)(bias + col + 4);
                    const f32x4 t0 = acc[ai][bj][m][0] + b0, t1 = acc[ai][bj][m][1] + b1;
                    float o[8];
                    o[0] = bflo(zw.x) * fast_sigmoid(t0.x); o[1] = bfhi(zw.x) * fast_sigmoid(t0.y); o[2] = bflo(zw.y) * fast_sigmoid(t0.z); o[3] = bfhi(zw.y) * fast_sigmoid(t0.w);
                    o[4] = bflo(zw.z) * fast_sigmoid(t1.x); o[5] = bfhi(zw.z) * fast_sigmoid(t1.y); o[6] = bflo(zw.w) * fast_sigmoid(t1.z); o[7] = bfhi(zw.w) * fast_sigmoid(t1.w);
#pragma unroll
                    for (int j = 0; j < 8; ++j) ps += o[j] * o[j];
                    u32x4 w; w.x = cvt_pk(o[0], o[1]); w.y = cvt_pk(o[2], o[3]); w.z = cvt_pk(o[4], o[5]); w.w = cvt_pk(o[6], o[7]);
                    *(GAS u32x4*)(Y + (size_t)row * D + col) = w; }
                ps += swz_xor<16>(ps); ps = half_sum(ps);
                if (fq == 0) ssqs[(size_t)row * 8 + u.pn * 4 + wc] = ps;
                asm volatile("" ::: "memory"); }
    }
};
struct EpiResHook : EpiRes {
    LAS const float* tab2; int hook_t;
    __device__ __forceinline__ void hook(f32x4 (&acc)[2][2][4][2], int ui, int wr, int fr) const {
#pragma unroll
        for (int ai = 0; ai < 2; ++ai)
#pragma unroll
            for (int m = 0; m < 4; ++m) { const float rs = tab2[ui * 256 + ai * HALF + wr * 64 + m * 16 + fr];
#pragma unroll
                for (int bj = 0; bj < 2; ++bj)
#pragma unroll
                    for (int n = 0; n < 2; ++n) acc[ai][bj][m][n] *= rs; }
    }
};
__device__ __forceinline__ void rope_table(const int* pos, float* rope, int gtid, int nthr) {
    for (int idx = gtid; idx < M * 64; idx += nthr) { const int i = idx & 63, row = idx >> 6;
        const float inv = (float)(1.0 / pow(10000.0, (double)i / 64.0)); const float ang = (float)pos[row] * inv;
        f32x2 cs; cs.x = (float)cos((double)ang); cs.y = (float)sin((double)ang);
        *(GAS f32x2*)(rope + (size_t)idx * 2) = cs; }
}

constexpr size_t SP_RSM = 0, SP_KTAB = 64 * 1024, SP_APOW = SP_KTAB + 4 * MiB, SP_BBAR = 6 * MiB + 256 * 1024;
constexpr size_t APOW_LG = 33 * 64 * 2, KTAB_LG = 32 * 256, BBAR_LG = 64 * 16 * 2;
static_assert(SP_APOW + (size_t)DEPTH * S5G * APOW_LG * 4 <= SP_BBAR && SP_BBAR + (size_t)DEPTH * S5G * BBAR_LG * 4 <= 8 * MiB, "spare map");
constexpr size_t WS_SEND = WS_XB, WS_KVRUN = WS_XB + 16 * MiB, WS_RSTART = WS_XB + 32 * MiB;
constexpr size_t S5M_T = 0, S5M_WEND = 20 * MiB;
__device__ __forceinline__ void s5_tables_item(const In& in, unsigned char* ws, LAS unsigned char* lds, int item, int wave, int lane) {
    const int l = item >> 7, g = (item >> 2) & 31, tq = item & 3, p = lane;
    LAS float* Br = (LAS float*)lds; LAS float* Bi = Br + 1024; LAS float* Cr = Bi + 1024; LAS float* Ci = Cr + 1024;
    LAS float* CAr = Ci + 1024 + wave * 2048; LAS float* CAi = CAr + 1024;
    float* sp = (float*)(ws + WS_SPARE);
    const int lg = l * S5G + g;
    const double lr = (double)in.lre[lg * 64 + p], li = (double)in.lim[lg * 64 + p], step = (double)expf(in.lstep[lg]);
    if (wave == 0) {
        const double mag = exp(lr * step), ar = mag * cos(li * step), ai = mag * sin(li * step), den = lr * lr + li * li;
        const double fr = ((ar - 1.0) * lr + ai * li) / den, fi = (ai * lr - (ar - 1.0) * li) / den;
#pragma unroll 4
        for (int h = 0; h < 16; ++h) { const double br = (double)in.bre[((size_t)lg * 64 + p) * 16 + h], bi = (double)in.bim[((size_t)lg * 64 + p) * 16 + h];
            const float xr = (float)(fr * br - fi * bi), xi = (float)(fr * bi + fi * br); Br[p * 16 + h] = xr; Bi[p * 16 + h] = xi;
            if (tq == 0) { f32x2 w; w.x = xr; w.y = xi; *(GAS f32x2*)(sp + SP_BBAR / 4 + (size_t)lg * BBAR_LG + (p * 16 + h) * 2) = w; } }
    }
    if (wave == 1) { for (int n = 0; n < 16; ++n) { Cr[n * 64 + p] = in.cre[((size_t)lg * 16 + n) * 64 + p]; Ci[n * 64 + p] = in.cim[((size_t)lg * 16 + n) * 64 + p]; } }
    const int tau = 8 * tq + wave;
    const double mg = exp(lr * step * (double)tau), an = li * step * (double)tau;
    const float ar = (float)(mg * cos(an)), ai = (float)(mg * sin(an));
    { f32x2 w; w.x = ar; w.y = ai; *(GAS f32x2*)(sp + SP_APOW / 4 + (size_t)lg * APOW_LG + (tau * 64 + p) * 2) = w; }
    if (tq == 3 && wave == 7) { const double m2 = exp(lr * step * 32.0), a2 = li * step * 32.0; f32x2 w; w.x = (float)(m2 * cos(a2)); w.y = (float)(m2 * sin(a2));
        *(GAS f32x2*)(sp + SP_APOW / 4 + (size_t)lg * APOW_LG + (32 * 64 + p) * 2) = w; }
    __syncthreads();
#pragma unroll 4
    for (int n = 0; n < 16; ++n) { const float cr = Cr[n * 64 + p], ci = Ci[n * 64 + p]; CAr[n * 64 + p] = cr * ar - ci * ai; CAi[n * 64 + p] = cr * ai + ci * ar; }
    LDS_WAIT(); asm volatile("" ::: "memory");
    const int n = lane >> 2, h0 = 4 * (lane & 3);
    f32x4 acc = {0.f, 0.f, 0.f, 0.f};
    for (int pp = 0; pp < 64; ++pp) { const float cr = CAr[n * 64 + pp], ci = CAi[n * 64 + pp];
        const f32x4 br = *(LAS const f32x4*)(Br + pp * 16 + h0), bi = *(LAS const f32x4*)(Bi + pp * 16 + h0);
        acc += br * cr - bi * ci; }
    *(GAS f32x4*)(sp + SP_KTAB / 4 + (size_t)lg * KTAB_LG + tau * 256 + n * 16 + h0) = acc;
    __syncthreads();
}
__device__ __forceinline__ void s5_build_item(const In& in, unsigned char* ws, int l, int item, int tid) {
    const int g = item >> 3, part = item & 7, lg = l * S5G + g;
    const float* sp = (const float*)(ws + WS_SPARE);
    const float* ktab = sp + SP_KTAB / 4 + (size_t)lg * KTAB_LG; const float* apow = sp + SP_APOW / 4 + (size_t)lg * APOW_LG; const float* bbar = sp + SP_BBAR / 4 + (size_t)lg * BBAR_LG;
    bf16_t* T = (bf16_t*)(ws + WS_S5M + S5M_T) + (size_t)g * 512 * 640; bf16_t* WE = (bf16_t*)(ws + WS_S5M + S5M_WEND) + (size_t)g * 256 * 512;
    for (int q = tid; q < 64 * 80; q += NTHR) {
        const int rl = q / 80, pc = q % 80, t = 4 * part + (rl >> 4), n = rl & 15, col0 = 8 * pc; float v[8];
        if (col0 < 512) { const int s = col0 >> 4, h0 = col0 & 15;
            if (s <= t) { const f32x4 a = *(const GAS f32x4*)(ktab + (t - s) * 256 + n * 16 + h0), b = *(const GAS f32x4*)(ktab + (t - s) * 256 + n * 16 + h0 + 4);
                v[0] = a.x; v[1] = a.y; v[2] = a.z; v[3] = a.w; v[4] = b.x; v[5] = b.y; v[6] = b.z; v[7] = b.w;
                if (s == t) { const float dn = in.s5d[l * S5W + g * 16 + n];
#pragma unroll
                    for (int j = 0; j < 8; ++j) v[j] += (h0 + j == n) ? dn : 0.f; } }
            else {
#pragma unroll
                for (int j = 0; j < 8; ++j) v[j] = 0.f; } }
        else { const int q0 = col0 - 512, im = q0 >= 64, p0 = q0 & 63;
#pragma unroll
            for (int j = 0; j < 8; ++j) { const int p = p0 + j; const float cr = in.cre[((size_t)lg * 16 + n) * 64 + p], ci = in.cim[((size_t)lg * 16 + n) * 64 + p];
                const f32x2 a = *(const GAS f32x2*)(apow + ((t + 1) * 64 + p) * 2); v[j] = im ? -(cr * a.y + ci * a.x) : (cr * a.x - ci * a.y); } }
        u32x4 w; w.x = pk2(v[0], v[1]); w.y = pk2(v[2], v[3]); w.z = pk2(v[4], v[5]); w.w = pk2(v[6], v[7]);
        *(GAS u32x4*)(T + (size_t)(t * 16 + n) * 640 + col0) = w;
    }
    for (int q = tid; q < 32 * 64; q += NTHR) {
        const int r = 32 * part + (q >> 6), col0 = 8 * (q & 63), s = col0 >> 4, h0 = col0 & 15; float v[8];
        if (r < 128) { const int p = r & 63, im = r >= 64; const f32x2 a = *(const GAS f32x2*)(apow + ((31 - s) * 64 + p) * 2);
#pragma unroll
            for (int j = 0; j < 8; ++j) { const f32x2 b = *(const GAS f32x2*)(bbar + (p * 16 + h0 + j) * 2); v[j] = im ? (a.x * b.y + a.y * b.x) : (a.x * b.x - a.y * b.y); } }
        else {
#pragma unroll
            for (int j = 0; j < 8; ++j) v[j] = 0.f; }
        u32x4 w; w.x = pk2(v[0], v[1]); w.y = pk2(v[2], v[3]); w.z = pk2(v[4], v[5]); w.w = pk2(v[6], v[7]);
        *(GAS u32x4*)(WE + (size_t)r * 512 + col0) = w;
    }
}
struct EpiS5End {
    static constexpr bool PERM = false;
    float* SE;
    __device__ __forceinline__ void operator()(const f32x4 (&acc)[2][2][4][2], const Unit& u, int ui, int wr, int wc, int fr, int fq) const {
#pragma unroll
        for (int ai = 0; ai < 2; ++ai)
#pragma unroll
            for (int m = 0; m < 4; ++m) { const int row = u.pm * BM + ai * HALF + wr * 64 + m * 16 + fr; float* o = SE + ((size_t)u.g * (M / 32) + row) * 128 + wc * 32 + 4 * fq;
#pragma unroll
                for (int n = 0; n < 2; ++n) *(GAS f32x4*)(o + 16 * n) = acc[ai][0][m][n]; }
    }
};
__device__ __forceinline__ f32x2 gelu_pk(f32x2 v) {
    const f32x2 av = __builtin_elementwise_abs(v), d = av * 0.2316418882f + 1.0f;
    f32x2 t; t.x = __builtin_amdgcn_rcpf(d.x); t.y = __builtin_amdgcn_rcpf(d.y);
    f32x2 q = t * 0.5307027145f + (-0.7265760135f); q = q * t + 0.7107068705f; q = q * t + (-0.142248368f); q = q * t + 0.127414796f; q = q * t;
    const f32x2 s = (v * v) * (-0.72134752044f);
    f32x2 e; e.x = __builtin_amdgcn_exp2f(s.x); e.y = __builtin_amdgcn_exp2f(s.y);
    const f32x2 m = v * (q * e), r = v - m;
    f32x2 o; o.x = v.x < 0.f ? m.x : r.x; o.y = v.y < 0.f ? m.y : r.y; return o;
}
struct EpiS5Out {
    static constexpr bool PERM = true;
    bf16_t* Z;
    __device__ __forceinline__ void operator()(const f32x4 (&acc)[2][2][4][2], const Unit& u, int ui, int wr, int wc, int fr, int fq) const {
#pragma unroll
        for (int ai = 0; ai < 2; ++ai)
#pragma unroll
            for (int m = 0; m < 4; ++m) { const int crow = u.pm * BM + ai * HALF + wr * 64 + m * 16 + fr;
#pragma unroll
                for (int bj = 0; bj < 2; ++bj) { const int c = u.pn * BM + bj * HALF + wc * 32 + 8 * fq, t = c >> 4, hf = (c >> 3) & 1;
                    const f32x4 v0 = acc[ai][bj][m][0], v1 = acc[ai][bj][m][1];
                    const f32x2 a = gelu_pk((f32x2){v0.x, v0.y}), b = gelu_pk((f32x2){v0.z, v0.w}), cc = gelu_pk((f32x2){v1.x, v1.y}), dd = gelu_pk((f32x2){v1.z, v1.w});
                    u32x4 w; w.x = cvt_pk(a.x, a.y); w.y = cvt_pk(b.x, b.y); w.z = cvt_pk(cc.x, cc.y); w.w = cvt_pk(dd.x, dd.y);
                    *(GAS u32x4*)(Z + ((size_t)crow * 32 + t) * S5W + u.g * 16 + hf * 8) = w; } }
    }
};
__device__ __forceinline__ void s5_scan_unit(unsigned char* ws, LAS unsigned char* lds, int l, int unit, int wave, int lane) {
    const int b = unit >> 5, g = unit & 31, p = lane, seg = wave, lg = l * S5G + g;
    const float* sp = (const float*)(ws + WS_SPARE);
    const f32x2 a32 = *(const GAS f32x2*)(sp + SP_APOW / 4 + (size_t)lg * APOW_LG + (32 * 64 + p) * 2);
    const float* se = (const float*)(ws + WS_SEND) + ((size_t)g * (M / 32) + b * 256 + seg * 32) * 128;
    LAS f32x2* segT = (LAS f32x2*)lds;
    float tr = 0.f, ti = 0.f;
#pragma unroll 8
    for (int k = 0; k < 32; ++k) { const float xr = se[k * 128 + p], xi = se[k * 128 + 64 + p]; const float nr = a32.x * tr - a32.y * ti + xr, ni = a32.x * ti + a32.y * tr + xi; tr = nr; ti = ni; }
    segT[seg * 64 + p] = (f32x2){tr, ti};
    float Ar = a32.x, Ai = a32.y;
#pragma unroll
    for (int j = 0; j < 5; ++j) { const float nr = Ar * Ar - Ai * Ai, ni = 2.f * Ar * Ai; Ar = nr; Ai = ni; }
    __syncthreads();
    float cr = 0.f, ci = 0.f;
    for (int s = 0; s < seg; ++s) { const f32x2 t2 = segT[s * 64 + p]; const float nr = Ar * cr - Ai * ci + t2.x, ni = Ar * ci + Ai * cr + t2.y; cr = nr; ci = ni; }
    bf16_t* ug = (bf16_t*)(ws + WS_UG) + ((size_t)g * (M / 32) + b * 256 + seg * 32) * 640 + 512;
#pragma unroll 8
    for (int k = 0; k < 32; ++k) { ug[k * 640 + p] = (bf16_t)f2bf(cr); ug[k * 640 + 64 + p] = (bf16_t)f2bf(ci);
        const float xr = se[k * 128 + p], xi = se[k * 128 + 64 + p]; const float nr = a32.x * cr - a32.y * ci + xr, ni = a32.x * ci + a32.y * cr + xi; cr = nr; ci = ni; }
    __syncthreads();
}

typedef short s16x4 __attribute__((ext_vector_type(4)));
__device__ __forceinline__ unsigned rt_f(int row) { return (unsigned)(((row & 3) << 2) | ((row >> 2) & 3)); }
__device__ __forceinline__ unsigned rt_off(int row, int ch) { return 256u * (unsigned)row + 16u * ((unsigned)ch ^ rt_f(row)); }
__device__ __forceinline__ void rt_fill(LAS unsigned char* img, const bf16_t* src  , int wave, int lane) {
#pragma unroll 1
    for (int j = 0; j < 4; ++j) { const int p = wave * 4 + j, row = 4 * p + (lane >> 4), ch = (lane & 15) ^ (int)rt_f(row);
        __builtin_amdgcn_global_load_lds((const unsigned*)((const char*)src + (size_t)row * 1024 + ch * 16), (LAS unsigned*)(img + p * 1024), 16, 0, 0); }
}
__device__ __forceinline__ s16x4 rt_tr4(LAS const unsigned char* p) { typedef short v4i16_t __attribute__((ext_vector_type(4))); return __builtin_bit_cast(s16x4, __builtin_amdgcn_ds_read_tr16_b64_v4i16((LAS v4i16_t*)p)); }
template <bool KPERM> __device__ __forceinline__ bf16x8 rt_trfrag(LAS const unsigned char* img, int k0, int c, int lane) {
    const int hh = lane >> 5, blk = (lane >> 4) & 1, q = (lane & 15) >> 2, p = lane & 3;
    const int r0 = k0 + (KPERM ? 4 * hh : 8 * hh) + q, r1 = r0 + (KPERM ? 8 : 4), ch = 4 * c + 2 * blk + (p >> 1);
    const s16x4 lo = rt_tr4(img + rt_off(r0, ch) + 8 * (p & 1)), hi = rt_tr4(img + rt_off(r1, ch) + 8 * (p & 1));
    return __builtin_shufflevector(lo, hi, 0, 1, 2, 3, 4, 5, 6, 7);
}
__device__ __forceinline__ bf16x8 rt_rowfrag(LAS const unsigned char* img, int rb, int s, int lane) {
    return *(LAS const bf16x8*)(img + rt_off(32 * rb + (lane & 31), 2 * s + (lane >> 5)));
}
constexpr int RT_Q = 0, RT_K = 32768, RT_V = 65536, RT_R = 98304;
__device__ __forceinline__ float ret_g(int h) { return h == 0 ? 0.017183023570817902f : h == 1 ? 0.1332151628796484f : h == 2 ? 0.3664377159220373f : 0.6059370882290803f; }
__device__ __forceinline__ void rt_kv(f32x16 (&racc)[2], LAS const unsigned char* lds, int wave, int lane) {
    const int eb = wave & 3, db0 = 2 * (wave >> 2);
#pragma unroll
    for (int ks = 0; ks < 8; ++ks) {
        const bf16x8 bv = rt_trfrag<false>(lds + RT_V, 16 * ks, eb, lane);
        const bf16x8 a0 = rt_trfrag<false>(lds + RT_K, 16 * ks, db0, lane), a1 = rt_trfrag<false>(lds + RT_K, 16 * ks, db0 + 1, lane);
        racc[0] = __builtin_amdgcn_mfma_f32_32x32x16_bf16(a0, bv, racc[0], 0, 0, 0);
        racc[1] = __builtin_amdgcn_mfma_f32_32x32x16_bf16(a1, bv, racc[1], 0, 0, 0);
    }
}
__device__ __forceinline__ void ret_kvrun_unit(unsigned char* ws, LAS unsigned char* lds, int unit, int wave) {
    const int bh = unit >> 4, run = unit & 15, b = bh >> 2, h = bh & 3; const float g = ret_g(h);
    const size_t row0 = (size_t)b * SEQ + run * 512;
    f32x16 racc[2];
#pragma unroll
    for (int k = 0; k < 2; ++k)
#pragma unroll
        for (int j = 0; j < 16; ++j) racc[k][j] = 0.f;
#pragma unroll 1
    for (int c = 0; c < 4; ++c) {
        { const int lane = lane_id();
          rt_fill(lds + RT_K, (const bf16_t*)(ws + WS_K) + (row0 + c * 128) * RW + h * RDK, wave, lane);
          rt_fill(lds + RT_V, (const bf16_t*)(ws + WS_V) + (row0 + c * 128) * RW + h * RDK, wave, lane); }
#pragma unroll
        for (int k = 0; k < 2; ++k) racc[k] *= g;
        VM_WAIT(); __syncthreads();
        rt_kv(racc, lds, wave, lane_id());
        __syncthreads();
    }
    { const int lane = lane_id(); float* o = (float*)(ws + WS_KVRUN) + (size_t)unit * 16384 + (size_t)wave * 2048 + lane;
#pragma unroll
      for (int k = 0; k < 2; ++k)
#pragma unroll
        for (int j = 0; j < 16; ++j) o[(k * 16 + j) * 64] = racc[k][j]; }
}
__device__ __forceinline__ void ret_scan(unsigned char* ws, int bx, int G, int tid) {
    for (int e2 = bx * NTHR + tid; e2 < NB * RH * 8192; e2 += G * NTHR) {
        const int bh = e2 >> 13, el = (e2 & 8191) * 2, h = bh & 3; float g4 = ret_g(h); g4 *= g4; g4 *= g4;
        const float* kv = (const float*)(ws + WS_KVRUN) + (size_t)bh * 16 * 16384 + el; float* rs = (float*)(ws + WS_RSTART) + (size_t)bh * 16 * 16384 + el;
        f32x2 v[15];
#pragma unroll
        for (int r = 0; r < 15; ++r) v[r] = *(const GAS f32x2*)(kv + (size_t)r * 16384);
        float z0 = 0.f; asm volatile("" : "+v"(z0));
        f32x2 s = {z0, z0};
        *(GAS f32x2*)rs = s;
#pragma unroll
        for (int r = 0; r < 15; ++r) { s = s * g4 + v[r]; *(GAS f32x2*)(rs + (size_t)(r + 1) * 16384) = s; }
    }
}
__device__ __forceinline__ void ret_out_unit(unsigned char* ws, LAS unsigned char* lds, const float* gain  , int unit, int wave) {
    const int bh = unit >> 4, run = unit & 15, b = bh >> 2, h = bh & 3; const float g = ret_g(h);
    const size_t row0 = (size_t)b * SEQ + run * 512;
    const int qb = wave & 3, eh = wave >> 2;
    LAS f32x2* exch = (LAS f32x2*)(lds + TAB_OFF);
    f32x16 racc[2];
    { const int lane = lane_id(); const float* o = (const float*)(ws + WS_RSTART) + (size_t)unit * 16384 + (size_t)wave * 2048 + lane;
#pragma unroll
      for (int k = 0; k < 2; ++k)
#pragma unroll
        for (int j = 0; j < 16; ++j) racc[k][j] = o[(k * 16 + j) * 64]; }
#pragma unroll 1
    for (int c = 0; c < 4; ++c) {
        { const int lane = lane_id();
          rt_fill(lds + RT_Q, (const bf16_t*)(ws + WS_Q) + (row0 + c * 128) * RW + h * RDK, wave, lane);
          rt_fill(lds + RT_K, (const bf16_t*)(ws + WS_K) + (row0 + c * 128) * RW + h * RDK, wave, lane);
          rt_fill(lds + RT_V, (const bf16_t*)(ws + WS_V) + (row0 + c * 128) * RW + h * RDK, wave, lane);
          const int eb = wave & 3, db0 = 2 * (wave >> 2), r = lane & 31, hh = lane >> 5;
#pragma unroll
          for (int k = 0; k < 2; ++k)
#pragma unroll
            for (int q4 = 0; q4 < 4; ++q4) { u32x2 w; w.x = cvt_pk(racc[k][4 * q4] * g, racc[k][4 * q4 + 1] * g); w.y = cvt_pk(racc[k][4 * q4 + 2] * g, racc[k][4 * q4 + 3] * g);
                const int e = 32 * eb + r, d0 = 32 * (db0 + k) + 8 * q4 + 4 * hh;
                *(LAS u32x2*)(lds + RT_R + rt_off(e, d0 >> 3) + 2 * (d0 & 7)) = w; } }
        VM_WAIT(); __syncthreads();
        {   const int lane = lane_id(), r = lane & 31, hh = lane >> 5;
            bf16x8 bq[8];
#pragma unroll
            for (int s = 0; s < 8; ++s) bq[s] = rt_rowfrag(lds + RT_Q, qb, s, lane);
            f32x16 sacc[4];
#pragma unroll
            for (int kb = 0; kb < 4; ++kb) {
#pragma unroll
                for (int j = 0; j < 16; ++j) sacc[kb][j] = 0.f;
                if (kb <= qb) {
#pragma unroll
                    for (int s = 0; s < 8; ++s) sacc[kb] = __builtin_amdgcn_mfma_f32_32x32x16_bf16(rt_rowfrag(lds + RT_K, kb, s, lane), bq[s], sacc[kb], 0, 0, 0);
                }
            }
#pragma unroll
            for (int kb = 0; kb < 4; ++kb) if (kb == qb) {
#pragma unroll
                for (int j = 0; j < 16; ++j) { const int key = (j & 3) + 8 * (j >> 2) + 4 * hh; sacc[kb][j] = (key <= r) ? sacc[kb][j] : 0.f; } }
            f32x16 oacc[2];
#pragma unroll
            for (int k = 0; k < 2; ++k)
#pragma unroll
                for (int j = 0; j < 16; ++j) oacc[k][j] = 0.f;
#pragma unroll
            for (int kb = 0; kb < 4; ++kb) if (kb <= qb) {
#pragma unroll
                for (int s = 0; s < 2; ++s) { u32x4 w; w.x = cvt_pk(sacc[kb][8 * s + 0], sacc[kb][8 * s + 1]); w.y = cvt_pk(sacc[kb][8 * s + 2], sacc[kb][8 * s + 3]);
                    w.z = cvt_pk(sacc[kb][8 * s + 4], sacc[kb][8 * s + 5]); w.w = cvt_pk(sacc[kb][8 * s + 6], sacc[kb][8 * s + 7]); const bf16x8 bp = __builtin_bit_cast(bf16x8, w);
#pragma unroll
                    for (int k = 0; k < 2; ++k) oacc[k] = __builtin_amdgcn_mfma_f32_32x32x16_bf16(rt_trfrag<true>(lds + RT_V, 32 * kb + 16 * s, 2 * eh + k, lane), bp, oacc[k], 0, 0, 0); } }
#pragma unroll
            for (int s = 0; s < 8; ++s)
#pragma unroll
                for (int k = 0; k < 2; ++k) oacc[k] = __builtin_amdgcn_mfma_f32_32x32x16_bf16(rt_rowfrag(lds + RT_R, 2 * eh + k, s, lane), bq[s], oacc[k], 0, 0, 0);
            float s1 = 0.f, s2 = 0.f;
#pragma unroll
            for (int k = 0; k < 2; ++k)
#pragma unroll
                for (int j = 0; j < 16; ++j) { s1 += oacc[k][j]; s2 += oacc[k][j] * oacc[k][j]; }
            s1 = half_sum(s1); s2 = half_sum(s2);
            if (hh == 0) exch[eh * 128 + 32 * qb + r] = (f32x2){s1, s2};
            __syncthreads();
            const f32x2 e0 = exch[32 * qb + r], e1 = exch[128 + 32 * qb + r];
            const float mu = (e0.x + e1.x) * (1.0f / 128.0f), var = (e0.y + e1.y) * (1.0f / 128.0f) - mu * mu, rstd = 1.0f / sqrtf(var + EPS);
            const size_t tok = row0 + c * 128 + 32 * qb + r;
            const bf16_t* gp = (const bf16_t*)(ws + WS_GATE) + tok * RW + h * RDK; bf16_t* yp = (bf16_t*)(ws + WS_YMIX) + tok * D + S5W + h * RDK;
#pragma unroll
            for (int k = 0; k < 2; ++k)
#pragma unroll
                for (int q4 = 0; q4 < 4; ++q4) { const int e = 32 * (2 * eh + k) + 8 * q4 + 4 * hh;
                    const u32x2 gw = *(const GAS u32x2*)(gp + e); const f32x4 gn = *(const GAS f32x4*)(gain + h * RDK + e);
                    const float g0 = bflo(gw.x), g1 = bfhi(gw.x), g2 = bflo(gw.y), g3 = bfhi(gw.y);
                    const float y0 = (oacc[k][4 * q4] - mu) * rstd * gn.x * g0 * fast_sigmoid(g0), y1 = (oacc[k][4 * q4 + 1] - mu) * rstd * gn.y * g1 * fast_sigmoid(g1);
                    const float y2 = (oacc[k][4 * q4 + 2] - mu) * rstd * gn.z * g2 * fast_sigmoid(g2), y3 = (oacc[k][4 * q4 + 3] - mu) * rstd * gn.w * g3 * fast_sigmoid(g3);
                    u32x2 w; w.x = cvt_pk(y0, y1); w.y = cvt_pk(y2, y3); *(GAS u32x2*)(yp + e) = w; }
        }
        if (c < 3) {
#pragma unroll
            for (int k = 0; k < 2; ++k) racc[k] *= g;
            rt_kv(racc, lds, wave, lane_id());
        }
        __syncthreads();
    }
}

struct Args { In in; float* out; unsigned char* ws; int pro_lo, pro_hi, l_lo, l_hi, ph_lo, ph_hi, flags, region; };
enum { PH_PROJ = 0, PH_MIXA = 1, PH_SCAN = 2, PH_MIXC = 3, PH_GLU = 4, PH_WOUT = 5, PH_CQ = 6, PH_XATT = 7, PH_CO = 8, PH_FFN1 = 9, PH_FFN2 = 10, PH_N = 11 };
enum { FL_XPREP = 1, FL_FINAL = 2, FL_XIN = 4 };

__global__ void __launch_bounds__(NTHR, 2) fwd(Args a) {
    extern __shared__ __attribute__((aligned(16))) unsigned char lds_raw[];
    LAS unsigned char* lds = (LAS unsigned char*)lds_raw;
    const int wave = __builtin_amdgcn_readfirstlane(threadIdx.x >> 6); const bool t0 = (threadIdx.x == 0);
#define LANE lane_id()
    const int G = gridDim.x, bx = blockIdx.x, vcu = (G % 8 == 0) ? (bx % 8) * (G / 8) + bx / 8 : bx;
    volatile LAS unsigned* MISC = (volatile LAS unsigned*)(lds + MISC_OFF);
    if (threadIdx.x < 32) MISC[threadIdx.x] = 0u;
    __syncthreads();
    unsigned char* ws = a.ws;
    unsigned* ctl = (unsigned*)(ws + WS_CTL);
    XcdBarrier bar = xcd_barrier_post(ctl + CW_BAR + a.region * XCD_BAR_WORDS, MISC + 8, t0);
    bool need_bar = false;
#define SEAM() do { if (need_bar) xcd_barrier(bar); need_bar = true; } while (0)
    const int gw = vcu * NWAVES + wave, NGW = G * NWAVES;
    const In& in = a.in;
    float* ssq = (float*)(ws + WS_SSQ);
    bf16_t* xb = (bf16_t*)(ws + WS_XB);
    LAS float* tab = (LAS float*)(lds + TAB_OFF);
    float* rsm = (float*)(ws + WS_SPARE);

    if (a.pro_lo <= 0 && 0 < a.pro_hi) {
        SEAM();
        pro_weights(in, ws, lds, gw, NGW, wave, LANE);
        if (a.flags & FL_XIN) xprep_rows(in.x, a.out, xb, ssq, gw, NGW, LANE);
        mem_prep_rows(in.mem, (bf16_t*)(ws + WS_MEMB), rsm, gw, NGW, LANE);
        rope_table(in.pos, (float*)(ws + WS_ROPE), gw * 64 + LANE, NGW * 64);
        __syncthreads();
        for (int it = bx; it < DEPTH * S5G * 4; it += G) s5_tables_item(in, ws, lds, it, wave, LANE);
        __syncthreads();
    }
    if (a.pro_lo <= 1 && 1 < a.pro_hi) {
        SEAM();
        int bxo = bx; asm volatile("" : "+s"(bxo));
        { GroupOrder S; S.init(DEPTH, MROWS / BM, D / BM, G, bxo, 0);
          const Gemm g{(const bf16_t*)(ws + WS_MEMB), (const bf16_t*)(ws + WS_WCK_TMP), D, D, D, 0, (long)D * D};
          const EpiMemK E{(bf16_t*)(ws + WS_MEMK), rsm};
          gemm_phase<EpiMemK, GroupOrder>(lds, g, S, E, wave); }
        { GroupOrder S; S.init(DEPTH, D / BM, MROWS / BM, G, bxo, 64);
          const Gemm g{(const bf16_t*)(ws + WS_WCV_TMP), (const bf16_t*)(ws + WS_MEMB), D, D, D, (long)D * D, 0};
          const EpiMemVT E{(bf16_t*)(ws + WS_MEMVT), rsm};
          gemm_phase<EpiMemVT, GroupOrder>(lds, g, S, E, wave); }
    }
    for (int l = a.l_lo; l < a.l_hi; ++l) {
#define IN_PH(k) (a.ph_lo <= (k) && (k) < a.ph_hi)
        if (a.flags & FL_XPREP) { SEAM(); xprep_rows(a.out, a.out, xb, ssq, gw, NGW, LANE); }
        if (IN_PH(PH_PROJ)) {
            SEAM();
            int bxo = bx; asm volatile("" : "+s"(bxo));
            for (int it = bxo; it < S5G * 8; it += G) s5_build_item(in, ws, l, it, wave * 64 + LANE);
            StaticOrder S; S.init(M / BM, INW / BM, G, bxo);
            rstd_table(tab, S, ssq, 16, 1.0f / D, wave);
            const Gemm g{xb, wl(ws, l, W_IN), D, D, D, 0, 0};
            const EpiProj E{(bf16_t*)(ws + WS_UG), (bf16_t*)(ws + WS_Q), (bf16_t*)(ws + WS_K), (bf16_t*)(ws + WS_V), (bf16_t*)(ws + WS_GATE), (const float*)(ws + WS_ROPE), tab};
            gemm_phase<EpiProj, StaticOrder>(lds, g, S, E, wave);
        }
        if (IN_PH(PH_MIXA)) {
            SEAM();
            int bxo = bx; asm volatile("" : "+s"(bxo));
            { GroupOrder S; S.init(S5G, (M / 32) / BM, 1, G, bxo, 0);
              const Gemm g{(const bf16_t*)(ws + WS_UG), (const bf16_t*)(ws + WS_S5M + S5M_WEND), 640, 512, 512, (long)(M / 32) * 640, 256L * 512};
              const EpiS5End E{(float*)(ws + WS_SEND)};
              gemm_phase<EpiS5End, GroupOrder>(lds, g, S, E, wave); }
            __syncthreads();
            for (int u = (bxo + 128) % G; u < NB * RH * 16; u += G) ret_kvrun_unit(ws, lds, u, wave);
        }
        if (IN_PH(PH_SCAN)) {
            SEAM();
            for (int u = bx; u < NB * S5G; u += G) s5_scan_unit(ws, lds, l, u, wave, LANE);
            ret_scan(ws, bx, G, wave * 64 + LANE);
        }
        if (IN_PH(PH_MIXC)) {
            SEAM();
            int bxo = bx; asm volatile("" : "+s"(bxo));
            { GroupOrder S; S.init(S5G, (M / 32) / BM, 2, G, bxo, 0);
              const Gemm g{(const bf16_t*)(ws + WS_UG), (const bf16_t*)(ws + WS_S5M + S5M_T), 640, 640, 640, (long)(M / 32) * 640, 512L * 640};
              const EpiS5Out E{(bf16_t*)(ws + WS_Z)};
              gemm_phase<EpiS5Out, GroupOrder>(lds, g, S, E, wave); }
            __syncthreads();
            for (int u = bxo; u < NB * RH * 16; u += G) ret_out_unit(ws, lds, in.retn + l * RW, u, wave);
        }
        if (IN_PH(PH_GLU)) {
            SEAM();
            int bxo = bx; asm volatile("" : "+s"(bxo));
            StaticOrder S; S.init(M / BM, S5W / BM, G, bxo);
            const Gemm g{(const bf16_t*)(ws + WS_Z), wl(ws, l, W_GLU), S5W, S5W, S5W, 0, 0};
            const EpiGlu E{(const bf16_t*)(ws + WS_Z), in.bglu + l * S5W, (bf16_t*)(ws + WS_YMIX), (float*)(ws + WS_SSQS)};
            gemm_phase<EpiGlu, StaticOrder>(lds, g, S, E, wave);
        }
        if (IN_PH(PH_WOUT)) {
            SEAM();
            int bxo = bx; asm volatile("" : "+s"(bxo));
            StaticOrder S; S.init(M / BM, D / BM, G, bxo);
            LAS float* tab2 = (LAS float*)(lds + TAB2_OFF);
            rstd_table(tab2, S, (const float*)(ws + WS_SSQS), 8, 1.0f / S5W, wave);
            const Gemm g{(const bf16_t*)(ws + WS_YMIX), wl(ws, l, W_OUT), D, D, D, 0, 0};
            const EpiResHook E{{a.out, a.out, xb, ssq}, tab2, 8};
            gemm_phase<EpiResHook, StaticOrder, true>(lds, g, S, E, wave);
        }
        if (IN_PH(PH_CQ)) {
            SEAM();
            int bxo = bx; asm volatile("" : "+s"(bxo));
            StaticOrder S; S.init(M / BM, D / BM, G, bxo);
            rstd_table(tab, S, ssq, 16, 1.0f / D, wave);
            const Gemm g{xb, wl(ws, l, W_CQ), D, D, D, 0, 0};
            const EpiScaleBf16 E{(bf16_t*)(ws + WS_QC), D, tab};
            gemm_phase<EpiScaleBf16, StaticOrder>(lds, g, S, E, wave);
        }
        if (IN_PH(PH_XATT)) {
            SEAM();
            xattn_phase(lds, (const bf16_t*)(ws + WS_QC), (const bf16_t*)(ws + WS_MEMK) + (size_t)l * MROWS * D, (const bf16_t*)(ws + WS_MEMVT) + (size_t)l * D * MROWS, (bf16_t*)(ws + WS_OC), G, bx, wave);
        }
        if (IN_PH(PH_CO)) {
            SEAM();
            int bxo = bx; asm volatile("" : "+s"(bxo));
            StaticOrder S; S.init(M / BM, D / BM, G, bxo);
            const Gemm g{(const bf16_t*)(ws + WS_OC), wl(ws, l, W_CO), D, D, D, 0, 0};
            const EpiRes E{a.out, a.out, xb, ssq};
            gemm_phase<EpiRes, StaticOrder>(lds, g, S, E, wave);
        }
        if (IN_PH(PH_FFN1)) {
            SEAM();
            int bxo = bx; asm volatile("" : "+s"(bxo));
            StaticOrder S; S.init(M / BM, (2 * FF) / BM, G, bxo);
            rstd_table(tab, S, ssq, 16, 1.0f / D, wave);
            const Gemm g{xb, wl(ws, l, W_GU), D, D, D, 0, 0};
            const EpiFfn1 E{(bf16_t*)(ws + WS_HID), tab};
            gemm_phase<EpiFfn1, StaticOrder>(lds, g, S, E, wave);
        }
        if (IN_PH(PH_FFN2)) {
            SEAM();
            int bxo = bx; asm volatile("" : "+s"(bxo));
            StaticOrder S; S.init(M / BM, D / BM, G, bxo);
            const Gemm g{(const bf16_t*)(ws + WS_HID), wl(ws, l, W_DN), FF, FF, FF, 0, 0};
            const EpiRes E{a.out, a.out, xb, ssq};
            gemm_phase<EpiRes, StaticOrder>(lds, g, S, E, wave);
        }
    }
    if (a.flags & FL_FINAL) { SEAM(); final_norm_rows(a.out, in.norm_final, gw, NGW, LANE); }
#undef IN_PH
#undef SEAM
#undef LANE
}
}

extern "C" void kernel_launch(void* const* d_in, const int* in_sizes, int n_in, void* d_out, int out_size, void* d_ws, size_t ws_size, hipStream_t stream) {
    static int grid = 0;
    if (grid == 0) {
        if (n_in != 29 || out_size != mk::M * mk::D || ws_size < mk::WS_END) { fprintf(stderr, "kernel_launch: unexpected sizes (n_in %d out %d ws %zu)\n", n_in, out_size, ws_size); grid = -1; return; }
        int dev = 0, cus = 0, per_cu = 0;
        if (hipGetDevice(&dev) != hipSuccess || hipDeviceGetAttribute(&cus, hipDeviceAttributeMultiprocessorCount, dev) != hipSuccess) { grid = -1; return; }
        if (hipFuncSetAttribute((const void*)mk::fwd, hipFuncAttributeMaxDynamicSharedMemorySize, mk::LDS_BYTES) != hipSuccess) { fprintf(stderr, "kernel_launch: hipFuncSetAttribute failed\n"); grid = -1; return; }
        if (hipOccupancyMaxActiveBlocksPerMultiprocessor(&per_cu, (const void*)mk::fwd, mk::NTHR, mk::LDS_BYTES) != hipSuccess || per_cu < 1) fprintf(stderr, "kernel_launch: occupancy query says %d\n", per_cu);
        (void)hipGetLastError();
        grid = cus;
    }
    if (grid < 0) return;
    (void)in_sizes;
    if (hipMemsetAsync((char*)d_ws + mk::WS_CTL, 0, mk::CTL_ZERO_BYTES, stream) != hipSuccess) return;
    mk::Args a{};
    { const void** p = (const void**)&a.in; for (int i = 0; i < 29; ++i) p[i] = d_in[i]; }
    a.out = (float*)d_out; a.ws = (unsigned char*)d_ws;
    a.pro_lo = 0; a.pro_hi = 2; a.l_lo = 0; a.l_hi = mk::DEPTH; a.ph_lo = 0; a.ph_hi = mk::PH_N; a.flags = mk::FL_XIN | mk::FL_FINAL; a.region = 0;
    hipLaunchKernelGGL(mk::fwd, dim3(grid), dim3(mk::NTHR), mk::LDS_BYTES, stream, a);
    const hipError_t le = hipPeekAtLastError();
    if (le != hipSuccess) fprintf(stderr, "kernel_launch: launch failed: %s\n", hipGetErrorName(le));
}
```

```cpp
#include <hip/hip_runtime.h>
#include <cstdio>
#include <cstdint>
#include <cmath>

namespace mk {
#define LAS __attribute__((address_space(3)))
#define GAS __attribute__((address_space(1)))
typedef unsigned short bf16_t;
typedef short bf16x8 __attribute__((ext_vector_type(8)));
typedef float f32x4 __attribute__((ext_vector_type(4)));
typedef float f32x2 __attribute__((ext_vector_type(2)));
typedef float f32x16 __attribute__((ext_vector_type(16)));
typedef unsigned u32x4 __attribute__((ext_vector_type(4)));
typedef unsigned u32x2 __attribute__((ext_vector_type(2)));
constexpr int M = 32768, D = 1024, NB = 4, SEQ = 8192, DEPTH = 4, MEML = 256, MROWS = NB * MEML;
constexpr int S5W = 512, S5G = 32, S5P = 64, RH = 4, RDK = 128, RW = 512, INW = 2560, XH = 4, XD = 256, FF = 2816;
constexpr float EPS = 1e-6f;
constexpr int BM = 256, BK = 64, HALF = 128, HTB = HALF * BK * 2, STAGE_BYTES = 8 * HTB, NXCD = 8, WGM = 8;
constexpr int NWAVES = 8, NTHR = 512;

constexpr int TAB_OFF = STAGE_BYTES;
constexpr int TAB2_OFF = TAB_OFF + 12288;
constexpr int MISC_OFF = TAB2_OFF + 2048;
constexpr int LDS_BYTES = 147456;
static_assert(MISC_OFF + 128 <= LDS_BYTES, "lds map");

constexpr size_t MiB = 1u << 20;
constexpr size_t WS_CTL = 0, CTL_ZERO_BYTES = 1 * MiB;
constexpr size_t WS_SSQ = 1 * MiB;
constexpr size_t WS_SSQS = 3 * MiB;
constexpr size_t WS_W = 4 * MiB, W_LAYER = 28 * MiB;
constexpr size_t W_IN = 0, W_GLU = 5 * MiB, W_OUT = W_GLU + MiB / 2, W_CQ = W_OUT + 2 * MiB, W_CO = W_CQ + 2 * MiB, W_GU = W_CO + 2 * MiB, W_DN = W_GU + 11 * MiB;
static_assert(W_DN + 11 * MiB / 2 == W_LAYER, "weights");
constexpr size_t WS_ROPE = 116 * MiB;
constexpr size_t WS_MEMK = 132 * MiB;
constexpr size_t WS_MEMVT = 140 * MiB;
constexpr size_t WS_S5M = 148 * MiB;
constexpr size_t WS_XB = 176 * MiB;
constexpr size_t WS_PROJ = 240 * MiB;
constexpr size_t WS_UG = WS_PROJ, WS_Q = WS_PROJ + 40 * MiB, WS_K = WS_Q + 32 * MiB, WS_V = WS_K + 32 * MiB, WS_GATE = WS_V + 32 * MiB;
constexpr size_t WS_Z = 408 * MiB;
constexpr size_t WS_YMIX = 440 * MiB;
constexpr size_t WS_SPARE = 504 * MiB;
constexpr size_t WS_QC = WS_PROJ, WS_OC = WS_PROJ + 64 * MiB, WS_HID = WS_PROJ;
constexpr size_t WS_WCK_TMP = WS_PROJ, WS_WCV_TMP = WS_PROJ + 8 * MiB, WS_MEMB = WS_PROJ + 16 * MiB;
constexpr size_t WS_END = 512 * MiB;
constexpr int CW_BAR = 4096, XB_WORDS = 3456, N_BAR_REGIONS = 64;
static_assert((CW_BAR + N_BAR_REGIONS * XB_WORDS) * 4 <= (int)CTL_ZERO_BYTES, "ctl");

__host__ __device__ __forceinline__ int lds_byte(int r, int c) { const int st = (r >> 4) * 2 + (c >> 5), rr = r & 15, cc = c & 31, ob = rr * 64 + cc * 2; return st * 1024 + (ob ^ (((ob >> 9) & 1) << 5)); }
__host__ __device__ __forceinline__ void stage_rc(int b, int& R, int& C) { const int st = b / 1024, sb = b % 1024, swz = sb ^ (((sb >> 9) & 1) << 5); R = (st >> 1) * 16 + swz / 64; C = (st & 1) * 32 + (swz % 64) / 2; }
__host__ __device__ __forceinline__ int perm32(int rho) { const int n = rho >> 4, i = rho & 15; return 8 * (i >> 2) + 4 * n + (i & 3); }

struct Unit { int pm, pn, g; };
struct Gemm { const bf16_t* A; const bf16_t* Bt; int lda, ldb, K; long a_gs, b_gs; };

struct StaticOrder {
    int nM, nN, nwg, G, c;
    __device__ void init(int nM_, int nN_, int G_, int c_) { nM = nM_; nN = nN_; nwg = nM * nN; G = G_; c = c_; }
    __device__ bool next(int i, Unit& u) const {
        const long L = (long)i * G + c; if (L >= nwg) return false;
        int wgid = (int)L; { const int q = nwg / NXCD, r = nwg % NXCD, xcd = wgid % NXCD, off = wgid / NXCD; wgid = (xcd < r ? xcd * (q + 1) : r * (q + 1) + (xcd - r) * q) + off; }
        const int nig = WGM * nN, gid = wgid / nig, fm = gid * WGM, gsz = (nM - fm) < WGM ? (nM - fm) : WGM;
        u.pm = fm + ((wgid % nig) % gsz); u.pn = (wgid % nig) / gsz; u.g = 0; return true;
    }
};
struct GroupOrder {
    int nM, nN, nG, G, c, first;
    __device__ void init(int nG_, int nM_, int nN_, int G_, int c_, int first_) { nG = nG_; nM = nM_; nN = nN_; G = G_; c = c_; first = first_; }
    __device__ bool next(int i, Unit& u) const {
        const long L = (long)i * G + c - first; if (L < 0 || L >= (long)nG * nM * nN) return false;
        u.pn = (int)(L % nN); const int r = (int)(L / nN); u.pm = r % nM; u.g = r / nM; return true;
    }
};

__device__ __forceinline__ unsigned f2bf(float f) { unsigned u = __builtin_bit_cast(unsigned, f); return (u + 0x7fffu + ((u >> 16) & 1u)) >> 16; }
__device__ __forceinline__ unsigned pk2(float lo, float hi) { return f2bf(lo) | (f2bf(hi) << 16); }
__device__ __forceinline__ unsigned cvt_pk(float lo, float hi) { unsigned r; asm volatile("v_cvt_pk_bf16_f32 %0, %1, %2" : "=v"(r) : "v"(lo), "v"(hi)); return r; }
__device__ __forceinline__ float bf2f(unsigned short b) { return __builtin_bit_cast(float, ((unsigned)b) << 16); }
__device__ __forceinline__ float bflo(unsigned w) { return __builtin_bit_cast(float, w << 16); }
__device__ __forceinline__ float bfhi(unsigned w) { return __builtin_bit_cast(float, w & 0xffff0000u); }
__device__ __forceinline__ float fast_sigmoid(float x) { return __builtin_amdgcn_rcpf(1.0f + __builtin_amdgcn_exp2f(-1.4426950408889634f * x)); }
template <int O> __device__ __forceinline__ float swz_xor(float v) { return __builtin_bit_cast(float, __builtin_amdgcn_ds_swizzle(__builtin_bit_cast(int, v), (O << 10) | 0x1f)); }
__device__ __forceinline__ float half_sum(float v) { const unsigned u = __builtin_bit_cast(unsigned, v); auto r = __builtin_amdgcn_permlane32_swap(u, u, false, false);
    return __builtin_bit_cast(float, (unsigned)r[0]) + __builtin_bit_cast(float, (unsigned)r[1]); }
__device__ __forceinline__ float half_max(float v) { const unsigned u = __builtin_bit_cast(unsigned, v); auto r = __builtin_amdgcn_permlane32_swap(u, u, false, false);
    return fmaxf(__builtin_bit_cast(float, (unsigned)r[0]), __builtin_bit_cast(float, (unsigned)r[1])); }
__device__ __forceinline__ float wave_sum(float v) { v += swz_xor<1>(v); v += swz_xor<2>(v); v += swz_xor<4>(v); v += swz_xor<8>(v); v += swz_xor<16>(v); return half_sum(v); }

__device__ __forceinline__ int lane_id() { unsigned z = 0u; asm volatile("" : "+v"(z)); return (int)__builtin_amdgcn_mbcnt_hi(~0u, __builtin_amdgcn_mbcnt_lo(~0u, z)); }
template <class Epi, class Sched, bool HOOK = false>
__device__ __forceinline__ void gemm_phase(LAS unsigned char* lds, const Gemm g, const Sched& S, const Epi& E, int wid) {
    const int lane = lane_id(), tid = wid * 64 + lane, wr = wid >> 2, wc = wid & 3, fr = lane & 15, fq = lane >> 4;
    const int nt = g.K / BK;
    unsigned voffA[2], voffB[2];
#pragma unroll
    for (int i = 0; i < 2; ++i) { int R, C; stage_rc(tid * 16 + i * 8192, R, C); const int Rb = Epi::PERM ? ((R & ~31) + perm32(R & 31)) : R;
        voffA[i] = (unsigned)(R * g.lda + C) * 2u; voffB[i] = (unsigned)(Rb * g.ldb + C) * 2u; }
    const size_t kstep = (size_t)(BK * 2);
    const size_t hstepA = (size_t)HALF * g.lda * 2, hstepB = (size_t)HALF * g.ldb * 2;
    const unsigned ldsw = (unsigned)wid * 1024u;
    const int aoff = lds_byte(wr * 64 + fr, fq * 8), boff = lds_byte(wc * 32 + fr, fq * 8);
#define PG8_SA(b, h) (((b) * 2 + (h)) * HTB)
#define PG8_SB(b, h) ((4 + (b) * 2 + (h)) * HTB)
#define PG8_STAGE(bufoff, gbase, voff) do { _Pragma("unroll") for (int _i = 0; _i < 2; ++_i) \
        __builtin_amdgcn_global_load_lds((const unsigned*)((const char*)(gbase) + (voff)[_i]), (LAS unsigned*)(lds + (bufoff) + ldsw + _i * 8192), 16, 0, 0); } while (0)
#define PG8_LDA(dst, b, h) do { _Pragma("unroll") for (int m = 0; m < 4; ++m) _Pragma("unroll") for (int k = 0; k < 2; ++k) dst[m][k] = *(const LAS bf16x8*)(lds + PG8_SA(b, h) + aoff + m * 2048 + k * 1024); } while (0)
#define PG8_LDB(dst, b, h) do { _Pragma("unroll") for (int n = 0; n < 2; ++n) _Pragma("unroll") for (int k = 0; k < 2; ++k) dst[n][k] = *(const LAS bf16x8*)(lds + PG8_SB(b, h) + boff + n * 2048 + k * 1024); } while (0)
#define PG8_MMA(ai, bj, At, Bt) do { __builtin_amdgcn_s_setprio(1); _Pragma("unroll") for (int m = 0; m < 4; ++m) _Pragma("unroll") for (int n = 0; n < 2; ++n) _Pragma("unroll") for (int k = 0; k < 2; ++k) \
        acc[ai][bj][m][n] = __builtin_amdgcn_mfma_f32_16x16x32_bf16(Bt[n][k], At[m][k], acc[ai][bj][m][n], 0, 0, 0); __builtin_amdgcn_s_setprio(0); } while (0)
#define PG8_WAIT_V(n) asm volatile("s_waitcnt vmcnt(" #n ")" ::: "memory")
#define PG8_WAIT_L(n) asm volatile("s_waitcnt lgkmcnt(" #n ")" ::: "memory")
#define PG8_BAR __builtin_amdgcn_s_barrier()
#define PG8_SCHED __builtin_amdgcn_sched_barrier(0)
#define PG8_ABASE(u) ((const char*)g.A + ((size_t)(u).g * g.a_gs + (size_t)(u).pm * BM * g.lda) * 2)
#define PG8_BBASE(u) ((const char*)g.Bt + ((size_t)(u).g * g.b_gs + (size_t)(u).pn * BM * g.ldb) * 2)
    Unit cur, nxt; int ui = 0;
    if (!S.next(0, cur)) return;
    f32x4 acc[2][2][4][2];
#pragma unroll
    for (int a = 0; a < 2; ++a)
#pragma unroll
        for (int b = 0; b < 2; ++b)
#pragma unroll
            for (int m = 0; m < 4; ++m)
#pragma unroll
                for (int n = 0; n < 2; ++n) acc[a][b][m][n] = (f32x4){0.f, 0.f, 0.f, 0.f};
    bf16x8 At[4][2], B0[2][2], B1[2][2];
    const char* cA = PG8_ABASE(cur); const char* cB = PG8_BBASE(cur);
    PG8_STAGE(PG8_SB(0, 0), cB, voffB); PG8_STAGE(PG8_SB(0, 1), cB + hstepB, voffB); PG8_STAGE(PG8_SA(0, 0), cA, voffA); PG8_STAGE(PG8_SA(0, 1), cA + hstepA, voffA);
    if (wr == 1) PG8_BAR;
    PG8_WAIT_V(2); PG8_BAR;
    PG8_STAGE(PG8_SB(1, 0), cB + kstep, voffB); PG8_STAGE(PG8_SA(1, 0), cA + kstep, voffA); PG8_STAGE(PG8_SB(1, 1), cB + hstepB + kstep, voffB);
    PG8_WAIT_V(6); PG8_BAR;
    for (;;) {
        const bool has_next = S.next(ui + 1, nxt);
        const char* nA = has_next ? PG8_ABASE(nxt) : cA; const char* nB = has_next ? PG8_BBASE(nxt) : cB;
        for (int t = 0; t < nt; t += 2) {
            const bool last = (t == nt - 2);
            const char* a1 = cA + (size_t)(t + 1) * kstep;
            const char* a2 = last ? nA : cA + (size_t)(t + 2) * kstep; const char* b2 = last ? nB : cB + (size_t)(t + 2) * kstep;
            const char* a3 = a2 + kstep; const char* b3 = b2 + kstep;
            if constexpr (HOOK) { if (t == E.hook_t) E.hook(acc, ui, wr, fr); }
            PG8_LDB(B0, 0, 0); PG8_LDB(B1, 0, 1); PG8_SCHED; PG8_LDA(At, 0, 0); PG8_STAGE(PG8_SA(1, 1), a1 + hstepA, voffA);
            PG8_WAIT_V(8); PG8_WAIT_L(0); PG8_BAR; PG8_MMA(0, 0, At, B0); PG8_MMA(0, 1, At, B1); PG8_BAR; PG8_SCHED;
            PG8_LDA(At, 0, 1); PG8_STAGE(PG8_SB(0, 0), b2, voffB); PG8_STAGE(PG8_SB(0, 1), b2 + hstepB, voffB); PG8_STAGE(PG8_SA(0, 0), a2, voffA);
            PG8_WAIT_V(8); PG8_WAIT_L(0); PG8_BAR; PG8_MMA(1, 0, At, B0); PG8_MMA(1, 1, At, B1); PG8_BAR; PG8_SCHED;
            PG8_LDB(B0, 1, 0); PG8_LDB(B1, 1, 1); PG8_SCHED; PG8_LDA(At, 1, 0); PG8_STAGE(PG8_SA(0, 1), a2 + hstepA, voffA);
            PG8_WAIT_V(8); PG8_WAIT_L(0); PG8_BAR; PG8_MMA(0, 0, At, B0); PG8_MMA(0, 1, At, B1); PG8_BAR; PG8_SCHED;
            PG8_LDA(At, 1, 1); PG8_STAGE(PG8_SB(1, 0), b3, voffB); PG8_STAGE(PG8_SB(1, 1), b3 + hstepB, voffB); PG8_STAGE(PG8_SA(1, 0), a3, voffA);
            PG8_WAIT_V(8); PG8_WAIT_L(0); PG8_BAR; PG8_MMA(1, 0, At, B0); PG8_MMA(1, 1, At, B1); PG8_BAR; PG8_SCHED;
        }
        if (wr == 0) PG8_BAR;
#if defined(PROBE_DUP) && PROBE_DUP == 300
        E.probe(acc, cur, ui, wr, wc, fr, fq);
#endif
        E(acc, cur, ui, wr, wc, fr, fq);
        if (!has_next) break;
#pragma unroll
        for (int a = 0; a < 2; ++a)
#pragma unroll
            for (int b = 0; b < 2; ++b)
#pragma unroll
                for (int m = 0; m < 4; ++m)
#pragma unroll
                    for (int n = 0; n < 2; ++n) acc[a][b][m][n] = (f32x4){0.f, 0.f, 0.f, 0.f};
        cur = nxt; cA = nA; cB = nB; ++ui;
        if (wr == 1) PG8_BAR;
    }
    PG8_WAIT_V(0);
    PG8_BAR;
#undef PG8_SA
#undef PG8_SB
#undef PG8_STAGE
#undef PG8_LDA
#undef PG8_LDB
#undef PG8_MMA
#undef PG8_WAIT_V
#undef PG8_WAIT_L
#undef PG8_BAR
#undef PG8_SCHED
#undef PG8_ABASE
#undef PG8_BBASE
}
typedef GAS unsigned gu32;
#define VM_WAIT() asm volatile("s_waitcnt vmcnt(0)" ::: "memory")
#define LDS_WAIT() asm volatile("s_waitcnt lgkmcnt(0)" ::: "memory")
#define XB_TMO      128
#define XB_XCNT(j)  (256  + 64 * (j))
#define XB_XSUB(j)  (1280 + 64 * (j))
#define XB_XGEN(j)  (2304 + 64 * (j))
#define XB_TOP      3328
#define XB_TOPGEN   3392
#define XCD_BAR_WORDS 3456
#define XB_SPIN_CAP (1u << 18)

__device__ __forceinline__ unsigned xb_ld(unsigned* p)              { return __hip_atomic_load(p, __ATOMIC_RELAXED, __HIP_MEMORY_SCOPE_AGENT); }
__device__ __forceinline__ unsigned xb_add(unsigned* p, unsigned v) { return __hip_atomic_fetch_add(p, v, __ATOMIC_RELAXED, __HIP_MEMORY_SCOPE_AGENT); }
__device__ __forceinline__ unsigned xb_xcc_id() { return (unsigned)__builtin_amdgcn_s_getreg((3 << 11) | 20) & 0xFu; }
#define XB_SPIN(cond, bar) do { unsigned _sp = 0; while (cond) { __builtin_amdgcn_s_sleep(1); \
    if ((++_sp & 255u) == 0u) { if (xb_ld(&(bar)[XB_TMO])) break; if (_sp > XB_SPIN_CAP) { atomicAdd(&(bar)[XB_TMO], 1u); break; } } } } while (0)

struct XcdBarrier {
    unsigned* bar; unsigned x;
    bool t0; volatile LAS unsigned* st;
};

__device__ __forceinline__ XcdBarrier xcd_barrier_post(unsigned* bar, volatile LAS unsigned* st, bool t0) {
    XcdBarrier b; b.bar = bar; b.x = xb_xcc_id(); b.st = st; b.t0 = t0;
    if (t0) (void)xb_add(&bar[XB_XCNT(b.x)], 1u);
    return b;
}
__device__ __forceinline__ void xcd_barrier_complete(unsigned* bar, unsigned x, unsigned& nloc, unsigned& nx) {
    const unsigned G = gridDim.x * gridDim.y * gridDim.z;
    unsigned sum, cnt, mine, sp = 0u;
    for (;;) {
        sum = 0u; cnt = 0u; mine = 0u;
#pragma unroll
        for (unsigned j = 0; j < 16; ++j) { const unsigned c = xb_ld(&bar[XB_XCNT(j)]); sum += c; cnt += (c > 0u) ? 1u : 0u; mine = (j == x) ? c : mine; }
        if (sum == G) break;
        __builtin_amdgcn_s_sleep(1);
        if ((++sp & 255u) == 0u) { if (xb_ld(&bar[XB_TMO])) break; if (sp > XB_SPIN_CAP) { atomicAdd(&bar[XB_TMO], 1u); break; } }
    }
    nloc = mine > 0u ? mine : 1u; nx = cnt > 0u ? cnt : 1u;
}

__device__ __forceinline__ void xcd_barrier(const XcdBarrier& b) {
    asm volatile("s_waitcnt vmcnt(0)" ::: "memory");
    __syncthreads();
    if (b.t0) {
        unsigned* bar = b.bar;
        __builtin_amdgcn_s_waitcnt(0);
        unsigned nloc = b.st[0], nx = b.st[1];
        if (nloc == 0u) { xcd_barrier_complete(bar, b.x, nloc, nx); b.st[0] = nloc; b.st[1] = nx; }
        const unsigned old = xb_add(&bar[XB_XSUB(b.x)], 1u);
        const unsigned gen = old / nloc;
        if (old + 1u == (gen + 1u) * nloc) {
            __builtin_amdgcn_fence(__ATOMIC_RELEASE, "agent");
            asm volatile("s_waitcnt vmcnt(0)" ::: "memory");
            const unsigned og = xb_add(&bar[XB_TOP], 1u);
            const unsigned tg = og / nx;
            if (og + 1u == (tg + 1u) * nx) xb_add(&bar[XB_TOPGEN], 1u);
            else XB_SPIN(xb_ld(&bar[XB_TOPGEN]) == tg, bar);
            __builtin_amdgcn_fence(__ATOMIC_ACQUIRE, "agent");
            xb_add(&bar[XB_XGEN(b.x)], 1u);
            asm volatile("s_waitcnt vmcnt(0)" ::: "memory");
        } else {
            XB_SPIN(xb_ld(&bar[XB_XGEN(b.x)]) == gen, bar);
            __builtin_amdgcn_fence(__ATOMIC_ACQUIRE, "agent");
            asm volatile("s_waitcnt vmcnt(0)" ::: "memory");
        }
    }
    __syncthreads();
}
template <int MAPK>
__device__ __forceinline__ void tr_item(const float* W, int K, int N, bf16_t* WT, const float* gain, int gain_lim, float scale, LAS float* scr, int item, int lane) {
    const int nblk = N / 32, kb = item / nblk, nb = item % nblk, k0 = 64 * kb, n0 = 32 * nb;
    float cs = scale;
    if (MAPK == 1) { if (n0 >= 1024 && n0 < 1536) cs *= 0.08838834764831845f; }
    const float* wp = W + (size_t)(k0 + (lane >> 5)) * N + n0 + (lane & 31);
    float w[32];
#pragma unroll
    for (int i = 0; i < 32; ++i) w[i] = wp[(size_t)(2 * i) * N];
    const int c = lane & 7;
    f32x4 g0 = {cs, cs, cs, cs}, g1 = g0;
    if (k0 < gain_lim) { g0 = *(const GAS f32x4*)(gain + k0 + 8 * c) * cs; g1 = *(const GAS f32x4*)(gain + k0 + 8 * c + 4) * cs; }
#pragma unroll
    for (int i = 0; i < 32; ++i) scr[(2 * i + (lane >> 5)) * 33 + (lane & 31)] = w[i];
    LDS_WAIT(); asm volatile("" ::: "memory");
#pragma unroll
    for (int j = 0; j < 4; ++j) { const int nl = (lane >> 3) + 8 * j, n = n0 + nl; const LAS float* s = scr + (8 * c) * 33 + nl;
        int nr = n;
        if (MAPK == 1) { if (n >= 512 && n < 1536) { const int jj = n - 512, blk = jj >> 7, e = jj & 127; nr = 512 + blk * 128 + 2 * (e & 63) + (e >> 6); } }
        if (MAPK == 2) nr = (n >> 7) * 256 + (n & 127);
        if (MAPK == 3) nr = (n >> 7) * 256 + 128 + (n & 127);
        u32x4 o; o.x = pk2(s[0 * 33] * g0.x, s[1 * 33] * g0.y); o.y = pk2(s[2 * 33] * g0.z, s[3 * 33] * g0.w); o.z = pk2(s[4 * 33] * g1.x, s[5 * 33] * g1.y); o.w = pk2(s[6 * 33] * g1.z, s[7 * 33] * g1.w);
        *(GAS u32x4*)(WT + (size_t)nr * K + k0 + 8 * c) = o; }
    LDS_WAIT(); asm volatile("" ::: "memory");
}
struct In {
    const float *x, *mem; const int* pos; const float *norm_mix, *w_in, *lre, *lim, *lstep, *bre, *bim, *cre, *cim, *s5d, *wglu, *bglu, *s5n, *retn, *w_out, *norm_cross, *norm_mem,
        *w_cq, *w_ck, *w_cv, *w_co, *norm_ffn, *w_gate, *w_up, *w_down, *norm_final;
};
__device__ __forceinline__ bf16_t* wl(unsigned char* ws, int l, size_t off) { return (bf16_t*)(ws + WS_W + (size_t)l * W_LAYER + off); }

__device__ __forceinline__ void pro_weights(const In& in, unsigned char* ws, LAS unsigned char* lds, int gw, int NGW, int wave, int lane) {
    LAS float* scr = (LAS float*)(lds + wave * 16384);
    constexpr int I_IN = 16 * 80, I_GLU = 8 * 16, I_SQ = 16 * 32, I_GU = 16 * 88, I_DN = 44 * 32;
    constexpr int PER_L = I_IN + I_GLU + 5 * I_SQ + 2 * I_GU + I_DN;
    static_assert(PER_L == 8192, "items");
    for (int it = gw; it < DEPTH * PER_L; it += NGW) {
        const int l = it / PER_L; int r = it % PER_L;
        if (r < I_IN) { tr_item<1>(in.w_in + (size_t)l * D * INW, D, INW, wl(ws, l, W_IN), in.norm_mix + l * D, D, 1.0f, scr, r, lane); continue; } r -= I_IN;
        if (r < I_GLU) { tr_item<0>(in.wglu + (size_t)l * S5W * S5W, S5W, S5W, wl(ws, l, W_GLU), nullptr, 0, 1.0f, scr, r, lane); continue; } r -= I_GLU;
        if (r < I_SQ) { tr_item<0>(in.w_out + (size_t)l * D * D, D, D, wl(ws, l, W_OUT), in.s5n + l * S5W, S5W, 1.0f, scr, r, lane); continue; } r -= I_SQ;
        if (r < I_SQ) { tr_item<0>(in.w_cq + (size_t)l * D * D, D, D, wl(ws, l, W_CQ), in.norm_cross + l * D, D, 0.0625f * 1.4426950408889634f, scr, r, lane); continue; } r -= I_SQ;
        if (r < I_SQ) { tr_item<0>(in.w_co + (size_t)l * D * D, D, D, wl(ws, l, W_CO), nullptr, 0, 1.0f, scr, r, lane); continue; } r -= I_SQ;
        if (r < I_SQ) { tr_item<0>(in.w_ck + (size_t)l * D * D, D, D, (bf16_t*)(ws + WS_WCK_TMP) + (size_t)l * D * D, in.norm_mem + l * D, D, 1.0f, scr, r, lane); continue; } r -= I_SQ;
        if (r < I_SQ) { tr_item<0>(in.w_cv + (size_t)l * D * D, D, D, (bf16_t*)(ws + WS_WCV_TMP) + (size_t)l * D * D, in.norm_mem + l * D, D, 1.0f, scr, r, lane); continue; } r -= I_SQ;
        if (r < I_GU) { tr_item<2>(in.w_gate + (size_t)l * D * FF, D, FF, wl(ws, l, W_GU), in.norm_ffn + l * D, D, 1.0f, scr, r, lane); continue; } r -= I_GU;
        if (r < I_GU) { tr_item<3>(in.w_up + (size_t)l * D * FF, D, FF, wl(ws, l, W_GU), in.norm_ffn + l * D, D, 1.0f, scr, r, lane); continue; } r -= I_GU;
        tr_item<0>(in.w_down + (size_t)l * FF * D, FF, D, wl(ws, l, W_DN), nullptr, 0, 1.0f, scr, r, lane);
    }
}
__device__ __forceinline__ void xprep_rows(const float* src, bf16_t* xb, float* ssq, int gw, int NGW, int lane) {
    for (int m = gw; m < M; m += NGW) {
        const GAS f32x4* xr = (const GAS f32x4*)(src + (size_t)m * D) + lane;
        f32x4 v[4]; float s = 0.f;
#pragma unroll
        for (int j = 0; j < 4; ++j) { v[j] = xr[64 * j]; s += (v[j].x * v[j].x + v[j].y * v[j].y) + (v[j].z * v[j].z + v[j].w * v[j].w); }
        const float tot = wave_sum(s);
        GAS u32x2* o8 = (GAS u32x2*)(xb + (size_t)m * D) + lane;
#pragma unroll
        for (int j = 0; j < 4; ++j) { u32x2 w; w.x = pk2(v[j].x, v[j].y); w.y = pk2(v[j].z, v[j].w); o8[64 * j] = w; }
        if (lane < 16) ssq[(size_t)m * 16 + lane] = (lane == 0) ? tot : 0.f;
    }
}
__device__ __forceinline__ void final_norm_rows(const bf16_t* xb, float* out, const float* g, int gw, int NGW, int lane) {
    f32x4 gv[4];
#pragma unroll
    for (int j = 0; j < 4; ++j) gv[j] = ((const GAS f32x4*)g)[lane + 64 * j];
    for (int m = gw; m < M; m += NGW) {
        const GAS u32x2* xr = (const GAS u32x2*)(xb + (size_t)m * D) + lane;
        f32x4 v[4]; float s = 0.f;
#pragma unroll
        for (int j = 0; j < 4; ++j) { const u32x2 w = xr[64 * j]; v[j] = (f32x4){bflo(w.x), bfhi(w.x), bflo(w.y), bfhi(w.y)}; s += (v[j].x * v[j].x + v[j].y * v[j].y) + (v[j].z * v[j].z + v[j].w * v[j].w); }
        const float r = 1.0f / sqrtf(wave_sum(s) * (1.0f / D) + EPS);
        GAS f32x4* o = (GAS f32x4*)(out + (size_t)m * D) + lane;
#pragma unroll
        for (int j = 0; j < 4; ++j) o[64 * j] = v[j] * r * gv[j];
    }
}
template <class Sched>
__device__ __forceinline__ void rstd_table(LAS float* tab, const Sched& S, const float* ssq, int nslots, float inv_n, int wave) {
    Unit u; const int t = wave * 64 + lane_id();
    for (int i = 0; S.next(i, u); ++i) {
        if (wave < 4) { const float* p = ssq + (size_t)(u.pm * 256 + t) * nslots; float s = 0.f;
            for (int j = 0; j < nslots; j += 4) { const f32x4 v = *(const GAS f32x4*)(p + j); s += (v.x + v.y) + (v.z + v.w); }
            tab[i * 256 + t] = 1.0f / sqrtf(s * inv_n + EPS); }
    }
    __syncthreads();
}

struct EpiFfn1 {
    static constexpr bool PERM = true;
    bf16_t* H; LAS const float* tab;
    __device__ __forceinline__ void probe(const f32x4 (&acc)[2][2][4][2], const Unit& u, int ui, int wr, int wc, int fr, int fq) const { (*this)(acc, u, ui, wr, wc, fr, fq); }
    __device__ __forceinline__ void operator()(const f32x4 (&acc)[2][2][4][2], const Unit& u, int ui, int wr, int wc, int fr, int fq) const {
        asm volatile("" : "+v"(fr), "+v"(fq));
#pragma unroll
        for (int ai = 0; ai < 2; ++ai)
#pragma unroll
            for (int m = 0; m < 4; ++m) { const int rl = ai * HALF + wr * 64 + m * 16 + fr; const float rs = tab[ui * 256 + rl];
                float h[8];
#pragma unroll
                for (int n = 0; n < 2; ++n)
#pragma unroll
                    for (int j = 0; j < 4; ++j) { const float gg = acc[ai][0][m][n][j] * rs, uu = acc[ai][1][m][n][j] * rs; h[4 * n + j] = gg * fast_sigmoid(gg) * uu; }
                u32x4 w; w.x = cvt_pk(h[0], h[1]); w.y = cvt_pk(h[2], h[3]); w.z = cvt_pk(h[4], h[5]); w.w = cvt_pk(h[6], h[7]);
                *(GAS u32x4*)(H + (size_t)(u.pm * BM + rl) * FF + u.pn * 128 + wc * 32 + 8 * fq) = w; }
    }
};
struct EpiRes {
    static constexpr bool PERM = true;
    bf16_t* xb; float* ssq; float* fout; float scale;
    __device__ __forceinline__ void probe(const f32x4 (&acc)[2][2][4][2], const Unit& u, int ui, int wr, int wc, int fr, int fq) const { EpiRes t = *this; t.scale = 0.f; t(acc, u, ui, wr, wc, fr, fq); }
    __device__ __forceinline__ void operator()(const f32x4 (&acc)[2][2][4][2], const Unit& u, int ui, int wr, int wc, int fr, int fq) const {
        asm volatile("" : "+v"(fr), "+v"(fq));
#pragma unroll
        for (int ai = 0; ai < 2; ++ai) {
            u32x4 xv[4][2];
#pragma unroll
            for (int m = 0; m < 4; ++m)
#pragma unroll
                for (int bj = 0; bj < 2; ++bj) xv[m][bj] = *(const GAS u32x4*)(xb + (size_t)(u.pm * BM + ai * HALF + wr * 64 + m * 16 + fr) * D + u.pn * BM + bj * HALF + wc * 32 + 8 * fq);
#pragma unroll
            for (int m = 0; m < 4; ++m) { const int row = u.pm * BM + ai * HALF + wr * 64 + m * 16 + fr; float ps = 0.f;
#pragma unroll
                for (int bj = 0; bj < 2; ++bj) { const size_t off = (size_t)row * D + u.pn * BM + bj * HALF + wc * 32 + 8 * fq; const u32x4 xw = xv[m][bj];
                    f32x4 v0, v1;
                    v0.x = bflo(xw.x) + acc[ai][bj][m][0].x * scale; v0.y = bfhi(xw.x) + acc[ai][bj][m][0].y * scale; v0.z = bflo(xw.y) + acc[ai][bj][m][0].z * scale; v0.w = bfhi(xw.y) + acc[ai][bj][m][0].w * scale;
                    v1.x = bflo(xw.z) + acc[ai][bj][m][1].x * scale; v1.y = bfhi(xw.z) + acc[ai][bj][m][1].y * scale; v1.z = bflo(xw.w) + acc[ai][bj][m][1].z * scale; v1.w = bfhi(xw.w) + acc[ai][bj][m][1].w * scale;
                    if (fout) { *(GAS f32x4*)(fout + off) = v0; *(GAS f32x4*)(fout + off + 4) = v1; }
                    u32x4 w; w.x = cvt_pk(v0.x, v0.y); w.y = cvt_pk(v0.z, v0.w); w.z = cvt_pk(v1.x, v1.y); w.w = cvt_pk(v1.z, v1.w);
                    *(GAS u32x4*)(xb + off) = w;
                    ps += (v0.x * v0.x + v0.y * v0.y) + (v0.z * v0.z + v0.w * v0.w) + (v1.x * v1.x + v1.y * v1.y) + (v1.z * v1.z + v1.w * v1.w); }
                ps += swz_xor<16>(ps); ps = half_sum(ps);
                if (fq == 0) ssq[(size_t)row * 16 + u.pn * 4 + wc] = ps; }
            asm volatile("" ::: "memory"); }
    }
};
struct EpiScaleBf16 {
    static constexpr bool PERM = true;
    bf16_t* O; int ldo; LAS const float* tab;
    __device__ __forceinline__ void probe(const f32x4 (&acc)[2][2][4][2], const Unit& u, int ui, int wr, int wc, int fr, int fq) const { (*this)(acc, u, ui, wr, wc, fr, fq); }
    __device__ __forceinline__ void operator()(const f32x4 (&acc)[2][2][4][2], const Unit& u, int ui, int wr, int wc, int fr, int fq) const {
        asm volatile("" : "+v"(fr), "+v"(fq));
#pragma unroll
        for (int ai = 0; ai < 2; ++ai)
#pragma unroll
            for (int m = 0; m < 4; ++m) { const int rl = ai * HALF + wr * 64 + m * 16 + fr; const float rs = tab[ui * 256 + rl];
#pragma unroll
                for (int bj = 0; bj < 2; ++bj) { const f32x4 v0 = acc[ai][bj][m][0] * rs, v1 = acc[ai][bj][m][1] * rs;
                    u32x4 w; w.x = cvt_pk(v0.x, v0.y); w.y = cvt_pk(v0.z, v0.w); w.z = cvt_pk(v1.x, v1.y); w.w = cvt_pk(v1.z, v1.w);
                    *(GAS u32x4*)(O + (size_t)(u.pm * BM + rl) * ldo + u.pn * BM + bj * HALF + wc * 32 + 8 * fq) = w; } }
    }
};
struct EpiMemK {
    static constexpr bool PERM = true;
    bf16_t* O; const float* rsm;
    __device__ __forceinline__ void probe(const f32x4 (&acc)[2][2][4][2], const Unit& u, int ui, int wr, int wc, int fr, int fq) const { (*this)(acc, u, ui, wr, wc, fr, fq); }
    __device__ __forceinline__ void operator()(const f32x4 (&acc)[2][2][4][2], const Unit& u, int ui, int wr, int wc, int fr, int fq) const {
        asm volatile("" : "+v"(fr), "+v"(fq));
#pragma unroll
        for (int ai = 0; ai < 2; ++ai)
#pragma unroll
            for (int m = 0; m < 4; ++m) { const int row = u.pm * BM + ai * HALF + wr * 64 + m * 16 + fr; const float rs = rsm[row];
#pragma unroll
                for (int bj = 0; bj < 2; ++bj) { const f32x4 v0 = acc[ai][bj][m][0] * rs, v1 = acc[ai][bj][m][1] * rs;
                    u32x4 w; w.x = cvt_pk(v0.x, v0.y); w.y = cvt_pk(v0.z, v0.w); w.z = cvt_pk(v1.x, v1.y); w.w = cvt_pk(v1.z, v1.w);
                    *(GAS u32x4*)(O + ((size_t)u.g * MROWS + row) * D + u.pn * BM + bj * HALF + wc * 32 + 8 * fq) = w; } }
    }
};
struct EpiMemVT {
    static constexpr bool PERM = true;
    bf16_t* O; const float* rsm;
    __device__ __forceinline__ void probe(const f32x4 (&acc)[2][2][4][2], const Unit& u, int ui, int wr, int wc, int fr, int fq) const { (*this)(acc, u, ui, wr, wc, fr, fq); }
    __device__ __forceinline__ void operator()(const f32x4 (&acc)[2][2][4][2], const Unit& u, int ui, int wr, int wc, int fr, int fq) const {
        asm volatile("" : "+v"(fr), "+v"(fq));
#pragma unroll
        for (int bj = 0; bj < 2; ++bj) { const int c0 = u.pn * BM + bj * HALF + wc * 32 + 8 * fq;
            const f32x4 r0 = *(const GAS f32x4*)(rsm + c0), r1 = *(const GAS f32x4*)(rsm + c0 + 4);
            const int p0 = (c0 & ~15) + 4 * ((c0 >> 3) & 1), p1 = p0 + 8;
#pragma unroll
            for (int ai = 0; ai < 2; ++ai)
#pragma unroll
                for (int m = 0; m < 4; ++m) { const int row = u.pm * BM + ai * HALF + wr * 64 + m * 16 + fr;
                    const f32x4 v0 = acc[ai][bj][m][0] * r0, v1 = acc[ai][bj][m][1] * r1;
                    bf16_t* o = O + ((size_t)u.g * D + row) * MROWS;
                    u32x2 w0, w1; w0.x = cvt_pk(v0.x, v0.y); w0.y = cvt_pk(v0.z, v0.w); w1.x = cvt_pk(v1.x, v1.y); w1.y = cvt_pk(v1.z, v1.w);
                    *(GAS u32x2*)(o + p0) = w0; *(GAS u32x2*)(o + p1) = w1; } }
    }
};

__device__ __forceinline__ void xa_fill(LAS unsigned char* lds, const bf16_t* src  , int wave, int lane) {
#pragma unroll 1
    for (int j = 0; j < 16; ++j) { const int p = wave * 16 + j, row = 2 * p + (lane >> 5), ch = (lane & 31) ^ (row & 15);
        __builtin_amdgcn_global_load_lds((const unsigned*)((const char*)src + (size_t)row * 2048 + ch * 16), (LAS unsigned*)(lds + p * 1024), 16, 0, 0); }
}
__device__ __forceinline__ void xa_mma(f32x16 (&acc)[8], const bf16x8 (&bf)[16], LAS const unsigned char* lds, int r, int hh) {
    const int a = (r >> 1) & 7, b = hh ^ (r & 1); LAS const unsigned char* base = lds + r * 512 + b * 16;
#pragma unroll
    for (int s = 0; s < 16; ++s) { const int cp = ((s & 8) | ((s & 7) ^ a)) << 5;
        LAS const unsigned char* p0 = base + cp; LAS const unsigned char* p1 = p0 + 65536;
#pragma unroll
        for (int blk = 0; blk < 8; ++blk) {
            const bf16x8 av = (blk < 4) ? *(LAS const bf16x8*)(p0 + blk * 16384) : *(LAS const bf16x8*)(p1 + (blk - 4) * 16384);
            acc[blk] = __builtin_amdgcn_mfma_f32_32x32x16_bf16(av, bf[s], acc[blk], 0, 0, 0); }
#pragma unroll
        for (int blk = 0; blk < 8; ++blk) asm volatile("" : "+v"(acc[blk]));
    }
}
__device__ __forceinline__ void xa_mma_q(f32x16 (&acc)[8], const GAS bf16x8* qp, LAS const unsigned char* lds, int r, int hh) {
    const int a = (r >> 1) & 7, b = hh ^ (r & 1); LAS const unsigned char* base = lds + r * 512 + b * 16;
    bf16x8 q3[3];
#pragma unroll
    for (int s = 0; s < 3; ++s) q3[s] = qp[2 * s];
#pragma unroll
    for (int s = 0; s < 16; ++s) { const int cp = ((s & 8) | ((s & 7) ^ a)) << 5;
        LAS const unsigned char* p0 = base + cp; LAS const unsigned char* p1 = p0 + 65536;
        const bf16x8 bq = q3[s % 3];
        if (s + 3 < 16) q3[s % 3] = qp[2 * (s + 3)];
#pragma unroll
        for (int blk = 0; blk < 8; ++blk) {
            const bf16x8 av = (blk < 4) ? *(LAS const bf16x8*)(p0 + blk * 16384) : *(LAS const bf16x8*)(p1 + (blk - 4) * 16384);
            acc[blk] = __builtin_amdgcn_mfma_f32_32x32x16_bf16(av, bq, acc[blk], 0, 0, 0); }
#pragma unroll
        for (int blk = 0; blk < 8; ++blk) asm volatile("" : "+v"(acc[blk]));
    }
}
__device__ __forceinline__ void xattn_phase(LAS unsigned char* lds, const bf16_t* QC, const bf16_t* Kl, const bf16_t* VTl, bf16_t* OC, int G, int bx, int wave) {
    const int per = (NB * XH * (SEQ / 256) + G - 1) / G;
    for (int i = 0; i < per; ++i) {
        const int unit = bx * per + i; if (unit >= NB * XH * (SEQ / 256)) break;
        const int bh = unit >> 5, qt = unit & 31, b = bh >> 2, h = bh & 3;
        const size_t qrow0 = (size_t)b * SEQ + qt * 256 + wave * 32;
        bf16x8 bq[16];
        { const int lane = lane_id(), r = lane & 31, hh = lane >> 5; const GAS bf16x8* qp = (const GAS bf16x8*)(QC + (qrow0 + r) * D + h * XD + 8 * hh);
#pragma unroll
          for (int s = 0; s < 16; ++s) bq[s] = qp[2 * s]; }
        xa_fill(lds, Kl + (size_t)b * MEML * D + h * XD, wave, lane_id());
        VM_WAIT(); __syncthreads();
        f32x16 acc[8];
#pragma unroll
        for (int k = 0; k < 8; ++k)
#pragma unroll
            for (int j = 0; j < 16; ++j) acc[k][j] = 0.f;
        { const int lane = lane_id(); xa_mma(acc, bq, lds, lane & 31, lane >> 5); }
        __syncthreads();
        xa_fill(lds, VTl + (size_t)h * XD * MROWS + b * MEML, wave, lane_id());
        float mx = acc[0][0];
#pragma unroll
        for (int k = 0; k < 8; ++k)
#pragma unroll
            for (int j = 0; j < 16; ++j) mx = fmaxf(mx, acc[k][j]);
        mx = half_max(mx);
        float sum = 0.f;
#pragma unroll
        for (int k = 0; k < 8; ++k)
#pragma unroll
            for (int j = 0; j < 16; ++j) { const float p = __builtin_amdgcn_exp2f(acc[k][j] - mx); acc[k][j] = p; sum += p; }
        sum = half_sum(sum);
        const float inv = 1.0f / sum;
        bf16x8 bp[16];
#pragma unroll
        for (int k = 0; k < 8; ++k)
#pragma unroll
            for (int s = 0; s < 2; ++s) { u32x4 w; w.x = cvt_pk(acc[k][8 * s + 0], acc[k][8 * s + 1]); w.y = cvt_pk(acc[k][8 * s + 2], acc[k][8 * s + 3]);
                w.z = cvt_pk(acc[k][8 * s + 4], acc[k][8 * s + 5]); w.w = cvt_pk(acc[k][8 * s + 6], acc[k][8 * s + 7]); bp[2 * k + s] = __builtin_bit_cast(bf16x8, w); }
#pragma unroll
        for (int k = 0; k < 8; ++k)
#pragma unroll
            for (int j = 0; j < 16; ++j) acc[k][j] = 0.f;
        VM_WAIT(); __syncthreads();
        { const int lane = lane_id(); xa_mma(acc, bp, lds, lane & 31, lane >> 5); }
        __syncthreads();
        { const int lane = lane_id(), r = lane & 31, hh = lane >> 5;
          bf16_t* op = OC + (qrow0 + r) * D + h * XD + 4 * hh;
#pragma unroll
          for (int k = 0; k < 8; ++k)
#pragma unroll
            for (int g4 = 0; g4 < 4; ++g4) { u32x2 w; w.x = cvt_pk(acc[k][4 * g4] * inv, acc[k][4 * g4 + 1] * inv); w.y = cvt_pk(acc[k][4 * g4 + 2] * inv, acc[k][4 * g4 + 3] * inv);
                *(GAS u32x2*)(op + k * 32 + 8 * g4) = w; } }
    }
}
__device__ __forceinline__ void mem_prep_rows(const float* mem, bf16_t* memb, float* rsm, int gw, int NGW, int lane) {
    for (int m = gw; m < MROWS; m += NGW) {
        const GAS f32x4* xr = (const GAS f32x4*)(mem + (size_t)m * D) + lane;
        f32x4 v[4]; float s = 0.f;
#pragma unroll
        for (int j = 0; j < 4; ++j) { v[j] = xr[64 * j]; s += (v[j].x * v[j].x + v[j].y * v[j].y) + (v[j].z * v[j].z + v[j].w * v[j].w); }
        const float tot = wave_sum(s);
        GAS u32x2* o8 = (GAS u32x2*)(memb + (size_t)m * D) + lane;
#pragma unroll
        for (int j = 0; j < 4; ++j) { u32x2 w; w.x = pk2(v[j].x, v[j].y); w.y = pk2(v[j].z, v[j].w); o8[64 * j] = w; }
        if (lane == 0) rsm[m] = 1.0f / sqrtf(tot * (1.0f / D) + EPS);
    }
}

__device__ __forceinline__ float ret_lg2(int h) { return h == 0 ? -0.04580368961312479f : h == 1 ? -0.02272007650008353f : h == 2 ? -0.011315313227834146f : -0.005646563141142063f; }
struct EpiProj {
    static constexpr bool PERM = true;
    bf16_t *UG, *Q, *K, *V, *GT; const float* rope; LAS const float* tab;
    __device__ __forceinline__ void probe(const f32x4 (&acc)[2][2][4][2], const Unit& u, int ui, int wr, int wc, int fr, int fq) const { (*this)(acc, u, ui, wr, wc, fr, fq); }
    __device__ __forceinline__ void operator()(const f32x4 (&acc)[2][2][4][2], const Unit& u, int ui, int wr, int wc, int fr, int fq) const {
        asm volatile("" : "+v"(fr), "+v"(fq));
        const int kind = u.pn >> 1;
        if (kind == 1 || kind == 2) {
#pragma unroll
            for (int ai = 0; ai < 2; ++ai) {
                f32x4 cs[4][2][2];
#pragma unroll
                for (int m = 0; m < 4; ++m)
#pragma unroll
                    for (int bj = 0; bj < 2; ++bj) { const int row = u.pm * BM + ai * HALF + wr * 64 + m * 16 + fr, cw = (u.pn & 1) * 256 + bj * HALF + wc * 32 + 8 * fq;
                        const GAS f32x4* rp = (const GAS f32x4*)(rope + ((size_t)row * 64 + ((cw & 127) >> 1)) * 2); cs[m][bj][0] = rp[0]; cs[m][bj][1] = rp[1]; }
#pragma unroll
                for (int m = 0; m < 4; ++m) { const int rl = ai * HALF + wr * 64 + m * 16 + fr, row = u.pm * BM + rl; const float rs = tab[ui * 256 + rl];
#pragma unroll
                    for (int bj = 0; bj < 2; ++bj) { const f32x4 v0 = acc[ai][bj][m][0] * rs, v1 = acc[ai][bj][m][1] * rs, c0 = cs[m][bj][0], c1 = cs[m][bj][1];
                        const int cw = (u.pn & 1) * 256 + bj * HALF + wc * 32 + 8 * fq, hd = cw >> 7;
                        const float e = (float)(row & 127) * ret_lg2(hd), sc = __builtin_amdgcn_exp2f(kind == 1 ? e : -e);
                        f32x4 o0, o1;
                        o0.x = (v0.x * c0.x - v0.y * c0.y) * sc; o0.y = (v0.y * c0.x + v0.x * c0.y) * sc; o0.z = (v0.z * c0.z - v0.w * c0.w) * sc; o0.w = (v0.w * c0.z + v0.z * c0.w) * sc;
                        o1.x = (v1.x * c1.x - v1.y * c1.y) * sc; o1.y = (v1.y * c1.x + v1.x * c1.y) * sc; o1.z = (v1.z * c1.z - v1.w * c1.w) * sc; o1.w = (v1.w * c1.z + v1.z * c1.w) * sc;
                        u32x4 w; w.x = cvt_pk(o0.x, o0.y); w.y = cvt_pk(o0.z, o0.w); w.z = cvt_pk(o1.x, o1.y); w.w = cvt_pk(o1.z, o1.w);
                        *(GAS u32x4*)((kind == 1 ? Q : K) + (size_t)row * RW + cw) = w; } }
                asm volatile("" ::: "memory"); }
        } else {
#pragma unroll
            for (int ai = 0; ai < 2; ++ai)
#pragma unroll
                for (int m = 0; m < 4; ++m) { const int rl = ai * HALF + wr * 64 + m * 16 + fr, row = u.pm * BM + rl; const float rs = tab[ui * 256 + rl];
#pragma unroll
                    for (int bj = 0; bj < 2; ++bj) { const f32x4 v0 = acc[ai][bj][m][0] * rs, v1 = acc[ai][bj][m][1] * rs;
                        const int cw = (u.pn & 1) * 256 + bj * HALF + wc * 32 + 8 * fq;
                        bf16_t* dst = (kind == 0) ? UG + ((size_t)(cw >> 4) * (M / 32) + (row >> 5)) * 640 + (row & 31) * 16 + ((cw >> 3) & 1) * 8 : (kind == 3 ? V : GT) + (size_t)row * RW + cw;
                        u32x4 w; w.x = cvt_pk(v0.x, v0.y); w.y = cvt_pk(v0.z, v0.w); w.z = cvt_pk(v1.x, v1.y); w.w = cvt_pk(v1.z, v1.w);
                        *(GAS u32x4*)dst = w; } }
        }
    }
};
struct EpiGlu {
    static constexpr bool PERM = true;
    const bf16_t* Z; const float* bias; bf16_t* Y; float* ssqs;
    __device__ __forceinline__ void probe(const f32x4 (&acc)[2][2][4][2], const Unit& u, int ui, int wr, int wc, int fr, int fq) const { (*this)(acc, u, ui, wr, wc, fr, fq); }
    __device__ __forceinline__ void operator()(const f32x4 (&acc)[2][2][4][2], const Unit& u, int ui, int wr, int wc, int fr, int fq) const {
        asm volatile("" : "+v"(fr), "+v"(fq));
#pragma unroll
        for (int ai = 0; ai < 2; ++ai)
#pragma unroll
            for (int m = 0; m < 4; ++m) { const int row = u.pm * BM + ai * HALF + wr * 64 + m * 16 + fr; float ps = 0.f;
#pragma unroll
                for (int bj = 0; bj < 2; ++bj) { const int col = u.pn * BM + bj * HALF + wc * 32 + 8 * fq;
                    const u32x4 zw = *(const GAS u32x4*)(Z + (size_t)row * S5W + col);
                    const f32x4 b0 = *(const GAS f32x4*)(bias + col), b1 = *(const GAS f32x4*)(bias + col + 4);
                    const f32x4 t0 = acc[ai][bj][m][0] + b0, t1 = acc[ai][bj][m][1] + b1;
                    float o[8];
                    o[0] = bflo(zw.x) * fast_sigmoid(t0.x); o[1] = bfhi(zw.x) * fast_sigmoid(t0.y); o[2] = bflo(zw.y) * fast_sigmoid(t0.z); o[3] = bfhi(zw.y) * fast_sigmoid(t0.w);
                    o[4] = bflo(zw.z) * fast_sigmoid(t1.x); o[5] = bfhi(zw.z) * fast_sigmoid(t1.y); o[6] = bflo(zw.w) * fast_sigmoid(t1.z); o[7] = bfhi(zw.w) * fast_sigmoid(t1.w);
#pragma unroll
                    for (int j = 0; j < 8; ++j) ps += o[j] * o[j];
                    u32x4 w; w.x = cvt_pk(o[0], o[1]); w.y = cvt_pk(o[2], o[3]); w.z = cvt_pk(o[4], o[5]); w.w = cvt_pk(o[6], o[7]);
                    *(GAS u32x4*)(Y + (size_t)row * D + col) = w; }
                ps += swz_xor<16>(ps); ps = half_sum(ps);
                if (fq == 0) ssqs[(size_t)row * 8 + u.pn * 4 + wc] = ps;
                asm volatile("" ::: "memory"); }
    }
};
struct EpiResHook : EpiRes {
    LAS const float* tab2; int hook_t;
    __device__ __forceinline__ void hook(f32x4 (&acc)[2][2][4][2], int ui, int wr, int fr) const {
#pragma unroll
        for (int ai = 0; ai < 2; ++ai)
#pragma unroll
            for (int m = 0; m < 4; ++m) { const float rs = tab2[ui * 256 + ai * HALF + wr * 64 + m * 16 + fr];
#pragma unroll
                for (int bj = 0; bj < 2; ++bj)
#pragma unroll
                    for (int n = 0; n < 2; ++n) acc[ai][bj][m][n] *= rs; }
    }
};
__device__ __forceinline__ void rope_table(const int* pos, float* rope, int gtid, int nthr) {
    for (int idx = gtid; idx < M * 64; idx += nthr) { const int i = idx & 63, row = idx >> 6;
        const float inv = (float)(1.0 / pow(10000.0, (double)i / 64.0)); const float ang = (float)pos[row] * inv;
        f32x2 cs; cs.x = (float)cos((double)ang); cs.y = (float)sin((double)ang);
        *(GAS f32x2*)(rope + (size_t)idx * 2) = cs; }
}

constexpr size_t SP_RSM = 0, SP_KTAB = 64 * 1024, SP_APOW = SP_KTAB + 4 * MiB, SP_BBAR = 6 * MiB + 256 * 1024;
constexpr size_t APOW_LG = 33 * 64 * 2, KTAB_LG = 32 * 256, BBAR_LG = 64 * 16 * 2;
static_assert(SP_APOW + (size_t)DEPTH * S5G * APOW_LG * 4 <= SP_BBAR && SP_BBAR + (size_t)DEPTH * S5G * BBAR_LG * 4 <= 8 * MiB, "spare map");
constexpr size_t S5M_T = 0, S5M_WEND = 20 * MiB;
constexpr size_t WS_SEND = WS_Z, WS_KVRUN = WS_Z + 16 * MiB;
constexpr size_t WS_RSTART = WS_S5M + S5M_WEND;
__device__ __forceinline__ void s5_tables_item(const In& in, unsigned char* ws, LAS unsigned char* lds, int item, int wave, int lane) {
    const int l = item >> 7, g = (item >> 2) & 31, tq = item & 3, p = lane;
    LAS float* Br = (LAS float*)lds; LAS float* Bi = Br + 1024; LAS float* Cr = Bi + 1024; LAS float* Ci = Cr + 1024;
    LAS float* CAr = Ci + 1024 + wave * 2048; LAS float* CAi = CAr + 1024;
    float* sp = (float*)(ws + WS_SPARE);
    const int lg = l * S5G + g;
    const double lr = (double)in.lre[lg * 64 + p], li = (double)in.lim[lg * 64 + p], step = (double)expf(in.lstep[lg]);
    if (wave == 0) {
        const double mag = exp(lr * step), ar = mag * cos(li * step), ai = mag * sin(li * step), den = lr * lr + li * li;
        const double fr = ((ar - 1.0) * lr + ai * li) / den, fi = (ai * lr - (ar - 1.0) * li) / den;
#pragma unroll 4
        for (int h = 0; h < 16; ++h) { const double br = (double)in.bre[((size_t)lg * 64 + p) * 16 + h], bi = (double)in.bim[((size_t)lg * 64 + p) * 16 + h];
            const float xr = (float)(fr * br - fi * bi), xi = (float)(fr * bi + fi * br); Br[p * 16 + h] = xr; Bi[p * 16 + h] = xi;
            if (tq == 0) { f32x2 w; w.x = xr; w.y = xi; *(GAS f32x2*)(sp + SP_BBAR / 4 + (size_t)lg * BBAR_LG + (p * 16 + h) * 2) = w; } }
    }
    if (wave == 1) { for (int n = 0; n < 16; ++n) { Cr[n * 64 + p] = in.cre[((size_t)lg * 16 + n) * 64 + p]; Ci[n * 64 + p] = in.cim[((size_t)lg * 16 + n) * 64 + p]; } }
    const int tau = 8 * tq + wave;
    const double mg = exp(lr * step * (double)tau), an = li * step * (double)tau;
    const float ar = (float)(mg * cos(an)), ai = (float)(mg * sin(an));
    { f32x2 w; w.x = ar; w.y = ai; *(GAS f32x2*)(sp + SP_APOW / 4 + (size_t)lg * APOW_LG + (tau * 64 + p) * 2) = w; }
    if (tq == 3 && wave == 7) { const double m2 = exp(lr * step * 32.0), a2 = li * step * 32.0; f32x2 w; w.x = (float)(m2 * cos(a2)); w.y = (float)(m2 * sin(a2));
        *(GAS f32x2*)(sp + SP_APOW / 4 + (size_t)lg * APOW_LG + (32 * 64 + p) * 2) = w; }
    __syncthreads();
#pragma unroll 4
    for (int n = 0; n < 16; ++n) { const float cr = Cr[n * 64 + p], ci = Ci[n * 64 + p]; CAr[n * 64 + p] = cr * ar - ci * ai; CAi[n * 64 + p] = cr * ai + ci * ar; }
    LDS_WAIT(); asm volatile("" ::: "memory");
    const int n = lane >> 2, h0 = 4 * (lane & 3);
    f32x4 acc = {0.f, 0.f, 0.f, 0.f};
    for (int pp = 0; pp < 64; ++pp) { const float cr = CAr[n * 64 + pp], ci = CAi[n * 64 + pp];
        const f32x4 br = *(LAS const f32x4*)(Br + pp * 16 + h0), bi = *(LAS const f32x4*)(Bi + pp * 16 + h0);
        acc += br * cr - bi * ci; }
    *(GAS f32x4*)(sp + SP_KTAB / 4 + (size_t)lg * KTAB_LG + tau * 256 + n * 16 + h0) = acc;
    __syncthreads();
}
__device__ __forceinline__ void s5_build_item(const In& in, unsigned char* ws, int l, int item, int tid) {
    const int g = item >> 3, part = item & 7, lg = l * S5G + g;
    const float* sp = (const float*)(ws + WS_SPARE);
    const float* ktab = sp + SP_KTAB / 4 + (size_t)lg * KTAB_LG; const float* apow = sp + SP_APOW / 4 + (size_t)lg * APOW_LG; const float* bbar = sp + SP_BBAR / 4 + (size_t)lg * BBAR_LG;
    bf16_t* T = (bf16_t*)(ws + WS_S5M + S5M_T) + (size_t)g * 512 * 640; bf16_t* WE = (bf16_t*)(ws + WS_S5M + S5M_WEND) + (size_t)g * 256 * 512;
    for (int q = tid; q < 64 * 80; q += NTHR) {
        const int rl = q / 80, pc = q % 80, t = 4 * part + (rl >> 4), n = rl & 15, col0 = 8 * pc; float v[8];
        if (col0 < 512) { const int s = col0 >> 4, h0 = col0 & 15;
            if (s <= t) { const f32x4 a = *(const GAS f32x4*)(ktab + (t - s) * 256 + n * 16 + h0), b = *(const GAS f32x4*)(ktab + (t - s) * 256 + n * 16 + h0 + 4);
                v[0] = a.x; v[1] = a.y; v[2] = a.z; v[3] = a.w; v[4] = b.x; v[5] = b.y; v[6] = b.z; v[7] = b.w;
                if (s == t) { const float dn = in.s5d[l * S5W + g * 16 + n];
#pragma unroll
                    for (int j = 0; j < 8; ++j) v[j] += (h0 + j == n) ? dn : 0.f; } }
            else {
#pragma unroll
                for (int j = 0; j < 8; ++j) v[j] = 0.f; } }
        else { const int q0 = col0 - 512, im = q0 >= 64, p0 = q0 & 63;
#pragma unroll
            for (int j = 0; j < 8; ++j) { const int p = p0 + j; const float cr = in.cre[((size_t)lg * 16 + n) * 64 + p], ci = in.cim[((size_t)lg * 16 + n) * 64 + p];
                const f32x2 a = *(const GAS f32x2*)(apow + ((t + 1) * 64 + p) * 2); v[j] = im ? -(cr * a.y + ci * a.x) : (cr * a.x - ci * a.y); } }
        u32x4 w; w.x = pk2(v[0], v[1]); w.y = pk2(v[2], v[3]); w.z = pk2(v[4], v[5]); w.w = pk2(v[6], v[7]);
        *(GAS u32x4*)(T + (size_t)(t * 16 + n) * 640 + col0) = w;
    }
    for (int q = tid; q < 32 * 64; q += NTHR) {
        const int r = 32 * part + (q >> 6), col0 = 8 * (q & 63), s = col0 >> 4, h0 = col0 & 15; float v[8];
        if (r < 128) { const int p = r & 63, im = r >= 64; const f32x2 a = *(const GAS f32x2*)(apow + ((31 - s) * 64 + p) * 2);
#pragma unroll
            for (int j = 0; j < 8; ++j) { const f32x2 b = *(const GAS f32x2*)(bbar + (p * 16 + h0 + j) * 2); v[j] = im ? (a.x * b.y + a.y * b.x) : (a.x * b.x - a.y * b.y); } }
        else {
#pragma unroll
            for (int j = 0; j < 8; ++j) v[j] = 0.f; }
        u32x4 w; w.x = pk2(v[0], v[1]); w.y = pk2(v[2], v[3]); w.z = pk2(v[4], v[5]); w.w = pk2(v[6], v[7]);
        *(GAS u32x4*)(WE + (size_t)r * 512 + col0) = w;
    }
}
struct EpiS5End {
    static constexpr bool PERM = false;
    float* SE;
    __device__ __forceinline__ void probe(const f32x4 (&acc)[2][2][4][2], const Unit& u, int ui, int wr, int wc, int fr, int fq) const { (*this)(acc, u, ui, wr, wc, fr, fq); }
    __device__ __forceinline__ void operator()(const f32x4 (&acc)[2][2][4][2], const Unit& u, int ui, int wr, int wc, int fr, int fq) const {
        asm volatile("" : "+v"(fr), "+v"(fq));
#pragma unroll
        for (int ai = 0; ai < 2; ++ai)
#pragma unroll
            for (int m = 0; m < 4; ++m) { const int row = u.pm * BM + ai * HALF + wr * 64 + m * 16 + fr; float* o = SE + ((size_t)u.g * (M / 32) + row) * 128 + wc * 32 + 4 * fq;
#pragma unroll
                for (int n = 0; n < 2; ++n) *(GAS f32x4*)(o + 16 * n) = acc[ai][0][m][n]; }
    }
};
__device__ __forceinline__ f32x2 gelu_pk(f32x2 v) {
    const f32x2 av = __builtin_elementwise_abs(v), d = av * 0.2316418882f + 1.0f;
    f32x2 t; t.x = __builtin_amdgcn_rcpf(d.x); t.y = __builtin_amdgcn_rcpf(d.y);
    f32x2 q = t * 0.5307027145f + (-0.7265760135f); q = q * t + 0.7107068705f; q = q * t + (-0.142248368f); q = q * t + 0.127414796f; q = q * t;
    const f32x2 s = (v * v) * (-0.72134752044f);
    f32x2 e; e.x = __builtin_amdgcn_exp2f(s.x); e.y = __builtin_amdgcn_exp2f(s.y);
    const f32x2 m = v * (q * e), r = v - m;
    f32x2 o; o.x = v.x < 0.f ? m.x : r.x; o.y = v.y < 0.f ? m.y : r.y; return o;
}
struct EpiS5Out {
    static constexpr bool PERM = true;
    bf16_t* Z;
    __device__ __forceinline__ void probe(const f32x4 (&acc)[2][2][4][2], const Unit& u, int ui, int wr, int wc, int fr, int fq) const { (*this)(acc, u, ui, wr, wc, fr, fq); }
    __device__ __forceinline__ void operator()(const f32x4 (&acc)[2][2][4][2], const Unit& u, int ui, int wr, int wc, int fr, int fq) const {
        asm volatile("" : "+v"(fr), "+v"(fq));
#pragma unroll
        for (int ai = 0; ai < 2; ++ai)
#pragma unroll
            for (int m = 0; m < 4; ++m) { const int crow = u.pm * BM + ai * HALF + wr * 64 + m * 16 + fr;
#pragma unroll
                for (int bj = 0; bj < 2; ++bj) { const int c = u.pn * BM + bj * HALF + wc * 32 + 8 * fq, t = c >> 4, hf = (c >> 3) & 1;
                    const f32x4 v0 = acc[ai][bj][m][0], v1 = acc[ai][bj][m][1];
                    const f32x2 a = gelu_pk((f32x2){v0.x, v0.y}), b = gelu_pk((f32x2){v0.z, v0.w}), cc = gelu_pk((f32x2){v1.x, v1.y}), dd = gelu_pk((f32x2){v1.z, v1.w});
                    u32x4 w; w.x = cvt_pk(a.x, a.y); w.y = cvt_pk(b.x, b.y); w.z = cvt_pk(cc.x, cc.y); w.w = cvt_pk(dd.x, dd.y);
                    *(GAS u32x4*)(Z + ((size_t)crow * 32 + t) * S5W + u.g * 16 + hf * 8) = w; } }
    }
};
__device__ __forceinline__ void s5_scan_unit(unsigned char* ws, LAS unsigned char* lds, int l, int unit, int wave, int lane) {
    const int b = unit >> 5, g = unit & 31, p = lane, seg = wave, lg = l * S5G + g;
    const float* sp = (const float*)(ws + WS_SPARE);
    const f32x2 a32 = *(const GAS f32x2*)(sp + SP_APOW / 4 + (size_t)lg * APOW_LG + (32 * 64 + p) * 2);
    const float* se = (const float*)(ws + WS_SEND) + ((size_t)g * (M / 32) + b * 256 + seg * 32) * 128;
    LAS f32x2* segT = (LAS f32x2*)lds;
    float tr = 0.f, ti = 0.f;
#pragma unroll 8
    for (int k = 0; k < 32; ++k) { const float xr = se[k * 128 + p], xi = se[k * 128 + 64 + p]; const float nr = a32.x * tr - a32.y * ti + xr, ni = a32.x * ti + a32.y * tr + xi; tr = nr; ti = ni; }
    segT[seg * 64 + p] = (f32x2){tr, ti};
    float Ar = a32.x, Ai = a32.y;
#pragma unroll
    for (int j = 0; j < 5; ++j) { const float nr = Ar * Ar - Ai * Ai, ni = 2.f * Ar * Ai; Ar = nr; Ai = ni; }
    __syncthreads();
    float cr = 0.f, ci = 0.f;
    for (int s = 0; s < seg; ++s) { const f32x2 t2 = segT[s * 64 + p]; const float nr = Ar * cr - Ai * ci + t2.x, ni = Ar * ci + Ai * cr + t2.y; cr = nr; ci = ni; }
    bf16_t* ug = (bf16_t*)(ws + WS_UG) + ((size_t)g * (M / 32) + b * 256 + seg * 32) * 640 + 512;
#pragma unroll 8
    for (int k = 0; k < 32; ++k) { ug[k * 640 + p] = (bf16_t)f2bf(cr); ug[k * 640 + 64 + p] = (bf16_t)f2bf(ci);
        const float xr = se[k * 128 + p], xi = se[k * 128 + 64 + p]; const float nr = a32.x * cr - a32.y * ci + xr, ni = a32.x * ci + a32.y * cr + xi; cr = nr; ci = ni; }
    __syncthreads();
}

typedef short s16x4 __attribute__((ext_vector_type(4)));
__device__ __forceinline__ unsigned rt_f(int row) { return (unsigned)(((row & 3) << 2) | ((row >> 2) & 3)); }
__device__ __forceinline__ unsigned rt_off(int row, int ch) { return 256u * (unsigned)row + 16u * ((unsigned)ch ^ rt_f(row)); }
__device__ __forceinline__ void rt_fill(LAS unsigned char* img, const bf16_t* src  , int wave, int lane) {
#pragma unroll 1
    for (int j = 0; j < 4; ++j) { const int p = wave * 4 + j, row = 4 * p + (lane >> 4), ch = (lane & 15) ^ (int)rt_f(row);
        __builtin_amdgcn_global_load_lds((const unsigned*)((const char*)src + (size_t)row * 1024 + ch * 16), (LAS unsigned*)(img + p * 1024), 16, 0, 0); }
}
__device__ __forceinline__ s16x4 rt_tr4(LAS const unsigned char* p) { typedef short v4i16_t __attribute__((ext_vector_type(4))); return __builtin_bit_cast(s16x4, __builtin_amdgcn_ds_read_tr16_b64_v4i16((LAS v4i16_t*)p)); }
template <bool KPERM> __device__ __forceinline__ bf16x8 rt_trfrag(LAS const unsigned char* img, int k0, int c, int lane) {
    const int hh = lane >> 5, blk = (lane >> 4) & 1, q = (lane & 15) >> 2, p = lane & 3;
    const int r0 = k0 + (KPERM ? 4 * hh : 8 * hh) + q, r1 = r0 + (KPERM ? 8 : 4), ch = 4 * c + 2 * blk + (p >> 1);
    const s16x4 lo = rt_tr4(img + rt_off(r0, ch) + 8 * (p & 1)), hi = rt_tr4(img + rt_off(r1, ch) + 8 * (p & 1));
    return __builtin_shufflevector(lo, hi, 0, 1, 2, 3, 4, 5, 6, 7);
}
__device__ __forceinline__ bf16x8 rt_rowfrag(LAS const unsigned char* img, int rb, int s, int lane) {
    return *(LAS const bf16x8*)(img + rt_off(32 * rb + (lane & 31), 2 * s + (lane >> 5)));
}
constexpr int RT_Q = 0, RT_K = 32768, RT_V = 65536, RT_R = 98304;
__device__ __forceinline__ float ret_g(int h) { return h == 0 ? 0.017183023570817902f : h == 1 ? 0.1332151628796484f : h == 2 ? 0.3664377159220373f : 0.6059370882290803f; }
__device__ __forceinline__ void rt_kv(f32x16 (&racc)[2], LAS const unsigned char* lds, int wave, int lane) {
    const int eb = wave & 3, db0 = 2 * (wave >> 2);
#pragma unroll
    for (int ks = 0; ks < 8; ++ks) {
        const bf16x8 bv = rt_trfrag<false>(lds + RT_V, 16 * ks, eb, lane);
        const bf16x8 a0 = rt_trfrag<false>(lds + RT_K, 16 * ks, db0, lane), a1 = rt_trfrag<false>(lds + RT_K, 16 * ks, db0 + 1, lane);
        racc[0] = __builtin_amdgcn_mfma_f32_32x32x16_bf16(a0, bv, racc[0], 0, 0, 0);
        racc[1] = __builtin_amdgcn_mfma_f32_32x32x16_bf16(a1, bv, racc[1], 0, 0, 0);
    }
}
__device__ __forceinline__ void ret_kvrun_unit(unsigned char* ws, LAS unsigned char* lds, int unit, int wave) {
    const int bh = unit >> 4, run = unit & 15, b = bh >> 2, h = bh & 3; const float g = ret_g(h);
    const size_t row0 = (size_t)b * SEQ + run * 512;
    f32x16 racc[2];
#pragma unroll
    for (int k = 0; k < 2; ++k)
#pragma unroll
        for (int j = 0; j < 16; ++j) racc[k][j] = 0.f;
#pragma unroll 1
    for (int c = 0; c < 4; ++c) {
        { const int lane = lane_id();
          rt_fill(lds + RT_K, (const bf16_t*)(ws + WS_K) + (row0 + c * 128) * RW + h * RDK, wave, lane);
          rt_fill(lds + RT_V, (const bf16_t*)(ws + WS_V) + (row0 + c * 128) * RW + h * RDK, wave, lane); }
#pragma unroll
        for (int k = 0; k < 2; ++k) racc[k] *= g;
        VM_WAIT(); __syncthreads();
        rt_kv(racc, lds, wave, lane_id());
        __syncthreads();
    }
    { const int lane = lane_id(); float* o = (float*)(ws + WS_KVRUN) + (size_t)unit * 16384 + (size_t)wave * 2048 + lane;
#pragma unroll
      for (int k = 0; k < 2; ++k)
#pragma unroll
        for (int j = 0; j < 16; ++j) o[(k * 16 + j) * 64] = racc[k][j]; }
}
__device__ __forceinline__ void ret_scan(unsigned char* ws, int bx, int G, int tid) {
    for (int e2 = bx * NTHR + tid; e2 < NB * RH * 8192; e2 += G * NTHR) {
        const int bh = e2 >> 13, el = (e2 & 8191) * 2, h = bh & 3; float g4 = ret_g(h); g4 *= g4; g4 *= g4;
        const float* kv = (const float*)(ws + WS_KVRUN) + (size_t)bh * 16 * 16384 + el; bf16_t* rs = (bf16_t*)(ws + WS_RSTART) + (size_t)bh * 16 * 16384 + el;
        f32x2 v[15];
#pragma unroll
        for (int r = 0; r < 15; ++r) v[r] = *(const GAS f32x2*)(kv + (size_t)r * 16384);
        float z0 = 0.f; asm volatile("" : "+v"(z0));
        f32x2 s = {z0, z0};
        *(GAS unsigned*)rs = 0u;
#pragma unroll
        for (int r = 0; r < 15; ++r) { s = s * g4 + v[r]; *(GAS unsigned*)(rs + (size_t)(r + 1) * 16384) = pk2(s.x, s.y); }
    }
}
__device__ __forceinline__ void ret_out_unit(unsigned char* ws, LAS unsigned char* lds, const float* gain  , int unit, int wave) {
    const int bh = unit >> 4, run = unit & 15, b = bh >> 2, h = bh & 3; const float g = ret_g(h);
    const size_t row0 = (size_t)b * SEQ + run * 512;
    const int qb = wave & 3, eh = wave >> 2;
    LAS f32x2* exch = (LAS f32x2*)(lds + TAB_OFF);
    f32x16 racc[2];
    { const int lane = lane_id(); const bf16_t* o = (const bf16_t*)(ws + WS_RSTART) + (size_t)unit * 16384 + (size_t)wave * 2048 + lane;
#pragma unroll
      for (int k = 0; k < 2; ++k)
#pragma unroll
        for (int j = 0; j < 16; ++j) racc[k][j] = bf2f(o[(k * 16 + j) * 64]); }
#pragma unroll 1
    for (int c = 0; c < 4; ++c) {
        { const int lane = lane_id();
          rt_fill(lds + RT_Q, (const bf16_t*)(ws + WS_Q) + (row0 + c * 128) * RW + h * RDK, wave, lane);
          rt_fill(lds + RT_K, (const bf16_t*)(ws + WS_K) + (row0 + c * 128) * RW + h * RDK, wave, lane);
          rt_fill(lds + RT_V, (const bf16_t*)(ws + WS_V) + (row0 + c * 128) * RW + h * RDK, wave, lane);
          const int eb = wave & 3, db0 = 2 * (wave >> 2), r = lane & 31, hh = lane >> 5;
#pragma unroll
          for (int k = 0; k < 2; ++k)
#pragma unroll
            for (int q4 = 0; q4 < 4; ++q4) { u32x2 w; w.x = cvt_pk(racc[k][4 * q4] * g, racc[k][4 * q4 + 1] * g); w.y = cvt_pk(racc[k][4 * q4 + 2] * g, racc[k][4 * q4 + 3] * g);
                const int e = 32 * eb + r, d0 = 32 * (db0 + k) + 8 * q4 + 4 * hh;
                *(LAS u32x2*)(lds + RT_R + rt_off(e, d0 >> 3) + 2 * (d0 & 7)) = w; } }
        u32x2 gw[2][4];
        { const int lane = lane_id(), r = lane & 31, hh = lane >> 5;
          const bf16_t* gp = (const bf16_t*)(ws + WS_GATE) + (row0 + c * 128 + 32 * qb + r) * RW + h * RDK + 4 * hh;
#pragma unroll
          for (int k = 0; k < 2; ++k)
#pragma unroll
            for (int q4 = 0; q4 < 4; ++q4) gw[k][q4] = *(const GAS u32x2*)(gp + 32 * (2 * eh + k) + 8 * q4); }
        VM_WAIT(); __syncthreads();
        {   const int lane = lane_id(), r = lane & 31, hh = lane >> 5;
            bf16x8 bq[8];
#pragma unroll
            for (int s = 0; s < 8; ++s) bq[s] = rt_rowfrag(lds + RT_Q, qb, s, lane);
            f32x16 sacc[4];
#pragma unroll
            for (int kb = 0; kb < 4; ++kb) {
#pragma unroll
                for (int j = 0; j < 16; ++j) sacc[kb][j] = 0.f;
                if (kb <= qb) {
#pragma unroll
                    for (int s = 0; s < 8; ++s) sacc[kb] = __builtin_amdgcn_mfma_f32_32x32x16_bf16(rt_rowfrag(lds + RT_K, kb, s, lane), bq[s], sacc[kb], 0, 0, 0);
                }
            }
#pragma unroll
            for (int kb = 0; kb < 4; ++kb) if (kb == qb) {
#pragma unroll
                for (int j = 0; j < 16; ++j) { const int key = (j & 3) + 8 * (j >> 2) + 4 * hh; sacc[kb][j] = (key <= r) ? sacc[kb][j] : 0.f; } }
            f32x16 oacc[2];
#pragma unroll
            for (int k = 0; k < 2; ++k)
#pragma unroll
                for (int j = 0; j < 16; ++j) oacc[k][j] = 0.f;
#pragma unroll
            for (int kb = 0; kb < 4; ++kb) if (kb <= qb) {
#pragma unroll
                for (int s = 0; s < 2; ++s) { u32x4 w; w.x = cvt_pk(sacc[kb][8 * s + 0], sacc[kb][8 * s + 1]); w.y = cvt_pk(sacc[kb][8 * s + 2], sacc[kb][8 * s + 3]);
                    w.z = cvt_pk(sacc[kb][8 * s + 4], sacc[kb][8 * s + 5]); w.w = cvt_pk(sacc[kb][8 * s + 6], sacc[kb][8 * s + 7]); const bf16x8 bp = __builtin_bit_cast(bf16x8, w);
#pragma unroll
                    for (int k = 0; k < 2; ++k) oacc[k] = __builtin_amdgcn_mfma_f32_32x32x16_bf16(rt_trfrag<true>(lds + RT_V, 32 * kb + 16 * s, 2 * eh + k, lane), bp, oacc[k], 0, 0, 0); } }
#pragma unroll
            for (int s = 0; s < 8; ++s)
#pragma unroll
                for (int k = 0; k < 2; ++k) oacc[k] = __builtin_amdgcn_mfma_f32_32x32x16_bf16(rt_rowfrag(lds + RT_R, 2 * eh + k, s, lane), bq[s], oacc[k], 0, 0, 0);
            float s1 = 0.f, s2 = 0.f;
#pragma unroll
            for (int k = 0; k < 2; ++k)
#pragma unroll
                for (int j = 0; j < 16; ++j) { s1 += oacc[k][j]; s2 += oacc[k][j] * oacc[k][j]; }
            s1 = half_sum(s1); s2 = half_sum(s2);
            if (hh == 0) exch[eh * 128 + 32 * qb + r] = (f32x2){s1, s2};
            __syncthreads();
            const f32x2 e0 = exch[32 * qb + r], e1 = exch[128 + 32 * qb + r];
            const float mu = (e0.x + e1.x) * (1.0f / 128.0f), var = (e0.y + e1.y) * (1.0f / 128.0f) - mu * mu, rstd = 1.0f / sqrtf(var + EPS);
            const size_t tok = row0 + c * 128 + 32 * qb + r;
            bf16_t* yp = (bf16_t*)(ws + WS_YMIX) + tok * D + S5W + h * RDK;
#pragma unroll
            for (int k = 0; k < 2; ++k)
#pragma unroll
                for (int q4 = 0; q4 < 4; ++q4) { const int e = 32 * (2 * eh + k) + 8 * q4 + 4 * hh;
                    const f32x4 gn = *(const GAS f32x4*)(gain + h * RDK + e);
                    const float g0 = bflo(gw[k][q4].x), g1 = bfhi(gw[k][q4].x), g2 = bflo(gw[k][q4].y), g3 = bfhi(gw[k][q4].y);
                    const float y0 = (oacc[k][4 * q4] - mu) * rstd * gn.x * g0 * fast_sigmoid(g0), y1 = (oacc[k][4 * q4 + 1] - mu) * rstd * gn.y * g1 * fast_sigmoid(g1);
                    const float y2 = (oacc[k][4 * q4 + 2] - mu) * rstd * gn.z * g2 * fast_sigmoid(g2), y3 = (oacc[k][4 * q4 + 3] - mu) * rstd * gn.w * g3 * fast_sigmoid(g3);
                    u32x2 w; w.x = cvt_pk(y0, y1); w.y = cvt_pk(y2, y3); *(GAS u32x2*)(yp + e) = w; }
        }
        if (c < 3) {
#pragma unroll
            for (int k = 0; k < 2; ++k) racc[k] *= g;
            rt_kv(racc, lds, wave, lane_id());
        }
        __syncthreads();
    }
}

struct Args { In in; float* out; unsigned char* ws; int pro_lo, pro_hi, l_lo, l_hi, ph_lo, ph_hi, flags, region; };
enum { PH_PROJ = 0, PH_MIXA = 1, PH_SCAN = 2, PH_MIXC = 3, PH_GLU = 4, PH_WOUT = 5, PH_CQ = 6, PH_XATT = 7, PH_CO = 8, PH_FFN1 = 9, PH_FFN2 = 10, PH_N = 11 };
enum { FL_XPREP = 1, FL_FINAL = 2, FL_XIN = 4 };

__global__ void __launch_bounds__(NTHR, 2) fwd(Args a) {
    extern __shared__ __attribute__((aligned(16))) unsigned char lds_raw[];
    LAS unsigned char* lds = (LAS unsigned char*)lds_raw;
    const int wave = __builtin_amdgcn_readfirstlane(threadIdx.x >> 6); const bool t0 = (threadIdx.x == 0);
#define LANE lane_id()
    const int G = gridDim.x, bx = blockIdx.x, vcu = (G % 8 == 0) ? (bx % 8) * (G / 8) + bx / 8 : bx;
    volatile LAS unsigned* MISC = (volatile LAS unsigned*)(lds + MISC_OFF);
    if (threadIdx.x < 32) MISC[threadIdx.x] = 0u;
    __syncthreads();
    unsigned char* ws = a.ws;
    unsigned* ctl = (unsigned*)(ws + WS_CTL);
    XcdBarrier bar = xcd_barrier_post(ctl + CW_BAR + a.region * XCD_BAR_WORDS, MISC + 8, t0);
    bool need_bar = false;
#ifndef PROBE_DUP
#define PROBE_DUP -1
#endif
#define REPS(k) ((PROBE_DUP == (k)) ? 2 : 1)
#define SEAM() do { if (need_bar) { xcd_barrier(bar); if (PROBE_DUP == 100) xcd_barrier(bar); } need_bar = true; } while (0)
    const int gw = vcu * NWAVES + wave, NGW = G * NWAVES;
    const In& in = a.in;
    float* ssq = (float*)(ws + WS_SSQ);
    bf16_t* xb = (bf16_t*)(ws + WS_XB);
    LAS float* tab = (LAS float*)(lds + TAB_OFF);
    float* rsm = (float*)(ws + WS_SPARE);

#ifndef STAGGER_TICKS
#define STAGGER_TICKS 0
#endif
#define STAGGER(cond) do { if (STAGGER_TICKS > 0 && (cond)) { const unsigned long long t0_ = __builtin_amdgcn_s_memrealtime(); while (__builtin_amdgcn_s_memrealtime() - t0_ < (unsigned long long)STAGGER_TICKS) __builtin_amdgcn_s_sleep(16); } } while (0)
    for (int rep = 0; rep < REPS(200); ++rep) if (a.pro_lo <= 0 && 0 < a.pro_hi) {
        SEAM();
        pro_weights(in, ws, lds, gw, NGW, wave, LANE);
#if PROBE_DUP == 210
        __syncthreads(); pro_weights(in, ws, lds, gw + (int)(a.flags >> 8), NGW, wave, LANE);
#endif
        for (int r2 = 0; r2 < REPS(211); ++r2) if (a.flags & FL_XIN) xprep_rows(in.x, xb, ssq, gw, NGW, LANE);
        mem_prep_rows(in.mem, (bf16_t*)(ws + WS_MEMB), rsm, gw, NGW, LANE);
        for (int r2 = 0; r2 < REPS(212); ++r2) rope_table(in.pos, (float*)(ws + WS_ROPE), gw * 64 + LANE, NGW * 64);
        __syncthreads();
        for (int r2 = 0; r2 < REPS(213); ++r2) for (int it = bx; it < DEPTH * S5G * 4; it += G) s5_tables_item(in, ws, lds, it, wave, LANE);
        __syncthreads();
    }
    for (int rep = 0; rep < REPS(201); ++rep) if (a.pro_lo <= 1 && 1 < a.pro_hi) {
        SEAM();
        int bxo = bx; asm volatile("" : "+s"(bxo));
        { GroupOrder S; S.init(DEPTH, MROWS / BM, D / BM, G, bxo, 0);
          const Gemm g{(const bf16_t*)(ws + WS_MEMB), (const bf16_t*)(ws + WS_WCK_TMP), D, D, D, 0, (long)D * D};
          const EpiMemK E{(bf16_t*)(ws + WS_MEMK), rsm};
          gemm_phase<EpiMemK, GroupOrder>(lds, g, S, E, wave); }
        { GroupOrder S; S.init(DEPTH, D / BM, MROWS / BM, G, bxo, 64);
          const Gemm g{(const bf16_t*)(ws + WS_WCV_TMP), (const bf16_t*)(ws + WS_MEMB), D, D, D, (long)D * D, 0};
          const EpiMemVT E{(bf16_t*)(ws + WS_MEMVT), rsm};
          gemm_phase<EpiMemVT, GroupOrder>(lds, g, S, E, wave); }
    }
    for (int l = a.l_lo; l < a.l_hi; ++l) {
#define IN_PH(k) (a.ph_lo <= (k) && (k) < a.ph_hi)
        for (int rep = 0; rep < REPS(PH_PROJ); ++rep) if (IN_PH(PH_PROJ)) {
            SEAM();
            int bxo = bx; asm volatile("" : "+s"(bxo));
            for (int it = bxo; it < S5G * 8; it += G) s5_build_item(in, ws, l, it, wave * 64 + LANE);
            StaticOrder S; S.init(M / BM, INW / BM, G, bxo);
            rstd_table(tab, S, ssq, 16, 1.0f / D, wave);
            const Gemm g{xb, wl(ws, l, W_IN), D, D, D, 0, 0};
            const EpiProj E{(bf16_t*)(ws + WS_UG), (bf16_t*)(ws + WS_Q), (bf16_t*)(ws + WS_K), (bf16_t*)(ws + WS_V), (bf16_t*)(ws + WS_GATE), (const float*)(ws + WS_ROPE), tab};
            gemm_phase<EpiProj, StaticOrder>(lds, g, S, E, wave);
        }
        for (int rep = 0; rep < REPS(PH_MIXA); ++rep) if (IN_PH(PH_MIXA)) {
            SEAM();
            int bxo = bx; asm volatile("" : "+s"(bxo));
            { GroupOrder S; S.init(S5G, (M / 32) / BM, 1, G, bxo, 0);
              const Gemm g{(const bf16_t*)(ws + WS_UG), (const bf16_t*)(ws + WS_S5M + S5M_WEND), 640, 512, 512, (long)(M / 32) * 640, 256L * 512};
              const EpiS5End E{(float*)(ws + WS_SEND)};
              gemm_phase<EpiS5End, GroupOrder>(lds, g, S, E, wave); }
            __syncthreads();
            for (int u = (bxo + 128) % G; u < NB * RH * 16; u += G) ret_kvrun_unit(ws, lds, u, wave);
        }
        for (int rep = 0; rep < REPS(PH_SCAN); ++rep) if (IN_PH(PH_SCAN)) {
            SEAM();
            for (int u = bx; u < NB * S5G; u += G) s5_scan_unit(ws, lds, l, u, wave, LANE);
            ret_scan(ws, bx, G, wave * 64 + LANE);
        }
        for (int rep = 0; rep < REPS(PH_MIXC); ++rep) if (IN_PH(PH_MIXC)) {
            SEAM();
            int bxo = bx; asm volatile("" : "+s"(bxo));
            for (int r2 = 0; r2 < REPS(31); ++r2)
            { GroupOrder S; S.init(S5G, (M / 32) / BM, 2, G, bxo, 0);
              const Gemm g{(const bf16_t*)(ws + WS_UG), (const bf16_t*)(ws + WS_S5M + S5M_T), 640, 640, 640, (long)(M / 32) * 640, 512L * 640};
              const EpiS5Out E{(bf16_t*)(ws + WS_Z)};
              gemm_phase<EpiS5Out, GroupOrder>(lds, g, S, E, wave); }
            __syncthreads();
            for (int r2 = 0; r2 < REPS(32); ++r2)
            for (int u = bxo; u < NB * RH * 16; u += G) ret_out_unit(ws, lds, in.retn + l * RW, u, wave);
        }
        for (int rep = 0; rep < REPS(PH_GLU); ++rep) if (IN_PH(PH_GLU)) {
            SEAM();
            int bxo = bx; asm volatile("" : "+s"(bxo));
            StaticOrder S; S.init(M / BM, S5W / BM, G, bxo);
            const Gemm g{(const bf16_t*)(ws + WS_Z), wl(ws, l, W_GLU), S5W, S5W, S5W, 0, 0};
            const EpiGlu E{(const bf16_t*)(ws + WS_Z), in.bglu + l * S5W, (bf16_t*)(ws + WS_YMIX), (float*)(ws + WS_SSQS)};
            gemm_phase<EpiGlu, StaticOrder>(lds, g, S, E, wave);
        }
        for (int rep = 0; rep < REPS(PH_WOUT); ++rep) if (IN_PH(PH_WOUT)) {
            SEAM();
            int bxo = bx; asm volatile("" : "+s"(bxo));
            StaticOrder S; S.init(M / BM, D / BM, G, bxo);
            LAS float* tab2 = (LAS float*)(lds + TAB2_OFF);
            rstd_table(tab2, S, (const float*)(ws + WS_SSQS), 8, 1.0f / S5W, wave);
            const Gemm g{(const bf16_t*)(ws + WS_YMIX), wl(ws, l, W_OUT), D, D, D, 0, 0};
            const EpiResHook E{{xb, ssq, nullptr, (REPS(PH_WOUT) == 2 && rep == 0) ? 0.f : 1.f}, tab2, 8};
            gemm_phase<EpiResHook, StaticOrder, true>(lds, g, S, E, wave);
        }
        for (int rep = 0; rep < REPS(PH_CQ); ++rep) if (IN_PH(PH_CQ)) {
            SEAM();
            int bxo = bx; asm volatile("" : "+s"(bxo));
            StaticOrder S; S.init(M / BM, D / BM, G, bxo);
            rstd_table(tab, S, ssq, 16, 1.0f / D, wave);
            const Gemm g{xb, wl(ws, l, W_CQ), D, D, D, 0, 0};
            const EpiScaleBf16 E{(bf16_t*)(ws + WS_QC), D, tab};
            gemm_phase<EpiScaleBf16, StaticOrder>(lds, g, S, E, wave);
        }
        for (int rep = 0; rep < REPS(PH_XATT); ++rep) if (IN_PH(PH_XATT)) {
            SEAM();
            xattn_phase(lds, (const bf16_t*)(ws + WS_QC), (const bf16_t*)(ws + WS_MEMK) + (size_t)l * MROWS * D, (const bf16_t*)(ws + WS_MEMVT) + (size_t)l * D * MROWS, (bf16_t*)(ws + WS_OC), G, bx, wave);
        }
        for (int rep = 0; rep < REPS(PH_CO); ++rep) if (IN_PH(PH_CO)) {
            SEAM();
            int bxo = bx; asm volatile("" : "+s"(bxo));
            StaticOrder S; S.init(M / BM, D / BM, G, bxo);
            const Gemm g{(const bf16_t*)(ws + WS_OC), wl(ws, l, W_CO), D, D, D, 0, 0};
            const EpiRes E{xb, ssq, nullptr, (REPS(PH_CO) == 2 && rep == 0) ? 0.f : 1.f};
            gemm_phase<EpiRes, StaticOrder>(lds, g, S, E, wave);
        }
        for (int rep = 0; rep < REPS(PH_FFN1); ++rep) if (IN_PH(PH_FFN1)) {
            SEAM();
            int bxo = bx; asm volatile("" : "+s"(bxo));
            StaticOrder S; S.init(M / BM, (2 * FF) / BM, G, bxo);
            rstd_table(tab, S, ssq, 16, 1.0f / D, wave);
            const Gemm g{xb, wl(ws, l, W_GU), D, D, D, 0, 0};
            const EpiFfn1 E{(bf16_t*)(ws + WS_HID), tab};
            STAGGER((bx >> 3) & 1);
            gemm_phase<EpiFfn1, StaticOrder>(lds, g, S, E, wave);
        }
        for (int rep = 0; rep < REPS(PH_FFN2); ++rep) if (IN_PH(PH_FFN2)) {
            SEAM();
            int bxo = bx; asm volatile("" : "+s"(bxo));
            StaticOrder S; S.init(M / BM, D / BM, G, bxo);
            const Gemm g{(const bf16_t*)(ws + WS_HID), wl(ws, l, W_DN), FF, FF, FF, 0, 0};
            const EpiRes E{xb, ssq, nullptr, (REPS(PH_FFN2) == 2 && rep == 0) ? 0.f : 1.f};
            gemm_phase<EpiRes, StaticOrder>(lds, g, S, E, wave);
        }
    }
    if (a.flags & FL_FINAL) { SEAM(); final_norm_rows(xb, a.out, in.norm_final, gw, NGW, LANE); }
#undef IN_PH
#undef SEAM
#undef LANE
}
}

extern "C" void kernel_launch(void* const* d_in, const int* in_sizes, int n_in, void* d_out, int out_size, void* d_ws, size_t ws_size, hipStream_t stream) {
    static int grid = 0;
    if (grid == 0) {
        if (n_in != 29 || out_size != mk::M * mk::D || ws_size < mk::WS_END) { fprintf(stderr, "kernel_launch: unexpected sizes (n_in %d out %d ws %zu)\n", n_in, out_size, ws_size); grid = -1; return; }
        int dev = 0, cus = 0, per_cu = 0;
        if (hipGetDevice(&dev) != hipSuccess || hipDeviceGetAttribute(&cus, hipDeviceAttributeMultiprocessorCount, dev) != hipSuccess) { grid = -1; return; }
        if (hipFuncSetAttribute((const void*)mk::fwd, hipFuncAttributeMaxDynamicSharedMemorySize, mk::LDS_BYTES) != hipSuccess) { fprintf(stderr, "kernel_launch: hipFuncSetAttribute failed\n"); grid = -1; return; }
        if (hipOccupancyMaxActiveBlocksPerMultiprocessor(&per_cu, (const void*)mk::fwd, mk::NTHR, mk::LDS_BYTES) != hipSuccess || per_cu < 1) fprintf(stderr, "kernel_launch: occupancy query says %d\n", per_cu);
        (void)hipGetLastError();
        grid = cus;
    }
    if (grid < 0) return;
    (void)in_sizes;
    if (hipMemsetAsync((char*)d_ws + mk::WS_CTL, 0, mk::CTL_ZERO_BYTES, stream) != hipSuccess) return;
    mk::Args a{};
    { const void** p = (const void**)&a.in; for (int i = 0; i < 29; ++i) p[i] = d_in[i]; }
    a.out = (float*)d_out; a.ws = (unsigned char*)d_ws;
    a.pro_lo = 0; a.pro_hi = 2; a.l_lo = 0; a.l_hi = mk::DEPTH; a.ph_lo = 0; a.ph_hi = mk::PH_N; a.flags = mk::FL_XIN | mk::FL_FINAL; a.region = 0;
    hipLaunchKernelGGL(mk::fwd, dim3(grid), dim3(mk::NTHR), mk::LDS_BYTES, stream, a);
    const hipError_t le = hipPeekAtLastError();
    if (le != hipSuccess) fprintf(stderr, "kernel_launch: launch failed: %s\n", hipGetErrorName(le));
}
```

```cpp
#include <hip/hip_runtime.h>
#include <cstdio>
#include <cstdint>
#include <cmath>

namespace mk {
#define LAS __attribute__((address_space(3)))
#define GAS __attribute__((address_space(1)))
typedef unsigned short bf16_t;
typedef short bf16x8 __attribute__((ext_vector_type(8)));
typedef float f32x4 __attribute__((ext_vector_type(4)));
typedef float f32x2 __attribute__((ext_vector_type(2)));
typedef float f32x16 __attribute__((ext_vector_type(16)));
typedef unsigned u32x4 __attribute__((ext_vector_type(4)));
typedef unsigned u32x2 __attribute__((ext_vector_type(2)));
constexpr int M = 32768, D = 1024, NB = 4, SEQ = 8192, DEPTH = 4, MEML = 256, MROWS = NB * MEML;
constexpr int S5W = 512, S5G = 32, S5P = 64, RH = 4, RDK = 128, RW = 512, INW = 2560, XH = 4, XD = 256, FF = 2816;
constexpr float EPS = 1e-6f;
constexpr int BM = 256, BK = 64, HALF = 128, HTB = HALF * BK * 2, STAGE_BYTES = 8 * HTB, NXCD = 8, WGM = 8;
constexpr int NWAVES = 8, NTHR = 512;

constexpr int TAB_OFF = STAGE_BYTES;
constexpr int TAB2_OFF = TAB_OFF + 12288;
constexpr int MISC_OFF = TAB2_OFF + 2048;
constexpr int LDS_BYTES = 147456;
static_assert(MISC_OFF + 128 <= LDS_BYTES, "lds map");

constexpr size_t MiB = 1u << 20;
constexpr size_t WS_CTL = 0, CTL_ZERO_BYTES = 1 * MiB;
constexpr size_t WS_SSQ = 1 * MiB;
constexpr size_t WS_SSQS = 3 * MiB;
constexpr size_t WS_W = 4 * MiB, W_LAYER = 28 * MiB;
constexpr size_t W_IN = 0, W_GLU = 5 * MiB, W_OUT = W_GLU + MiB / 2, W_CQ = W_OUT + 2 * MiB, W_CO = W_CQ + 2 * MiB, W_GU = W_CO + 2 * MiB, W_DN = W_GU + 11 * MiB;
static_assert(W_DN + 11 * MiB / 2 == W_LAYER, "weights");
constexpr size_t WS_ROPE = 116 * MiB;
constexpr size_t WS_MEMK = 132 * MiB;
constexpr size_t WS_MEMVT = 140 * MiB;
constexpr size_t WS_S5M = 148 * MiB;
constexpr size_t WS_XB = 176 * MiB;
constexpr size_t WS_PROJ = 240 * MiB;
constexpr size_t WS_UG = WS_PROJ, WS_Q = WS_PROJ + 40 * MiB, WS_K = WS_Q + 32 * MiB, WS_V = WS_K + 32 * MiB, WS_GATE = WS_V + 32 * MiB;
constexpr size_t WS_Z = 408 * MiB;
constexpr size_t WS_YMIX = 440 * MiB;
constexpr size_t WS_SPARE = 504 * MiB;
constexpr size_t WS_QC = WS_PROJ, WS_OC = WS_PROJ + 64 * MiB, WS_HID = WS_PROJ;
constexpr size_t WS_WCK_TMP = WS_PROJ, WS_WCV_TMP = WS_PROJ + 8 * MiB, WS_MEMB = WS_PROJ + 16 * MiB;
constexpr size_t WS_END = 512 * MiB;
constexpr int CW_BAR = 4096, XB_WORDS = 3456, N_BAR_REGIONS = 64;
static_assert((CW_BAR + N_BAR_REGIONS * XB_WORDS) * 4 <= (int)CTL_ZERO_BYTES, "ctl");

__host__ __device__ __forceinline__ int lds_byte(int r, int c) { const int st = (r >> 4) * 2 + (c >> 5), rr = r & 15, cc = c & 31, ob = rr * 64 + cc * 2; return st * 1024 + (ob ^ (((ob >> 9) & 1) << 5)); }
__host__ __device__ __forceinline__ void stage_rc(int b, int& R, int& C) { const int st = b / 1024, sb = b % 1024, swz = sb ^ (((sb >> 9) & 1) << 5); R = (st >> 1) * 16 + swz / 64; C = (st & 1) * 32 + (swz % 64) / 2; }
__host__ __device__ __forceinline__ int perm32(int rho) { const int n = rho >> 4, i = rho & 15; return 8 * (i >> 2) + 4 * n + (i & 3); }

struct Unit { int pm, pn, g; };
struct Gemm { const bf16_t* A; const bf16_t* Bt; int lda, ldb, K; long a_gs, b_gs; int a_g16; };

struct StaticOrder {
    int nM, nN, nwg, G, c;
    __device__ __forceinline__ void init(int nM_, int nN_, int G_, int c_) { nM = nM_; nN = nN_; nwg = nM * nN; G = G_; c = c_; }
    __device__ __forceinline__ bool next(int i, Unit& u) const {
        const long L = (long)i * G + c; if (L >= nwg) return false;
        int wgid = (int)L; { const int q = nwg / NXCD, r = nwg % NXCD, xcd = wgid % NXCD, off = wgid / NXCD; wgid = (xcd < r ? xcd * (q + 1) : r * (q + 1) + (xcd - r) * q) + off; }
        const int nig = WGM * nN, gid = wgid / nig, fm = gid * WGM, gsz = (nM - fm) < WGM ? (nM - fm) : WGM;
        u.pm = fm + ((wgid % nig) % gsz); u.pn = (wgid % nig) / gsz; u.g = 0; return true;
    }
};
struct GroupOrder {
    int nM, nN, nG, G, c, first;
    __device__ __forceinline__ void init(int nG_, int nM_, int nN_, int G_, int c_, int first_) { nG = nG_; nM = nM_; nN = nN_; G = G_; c = c_; first = first_; }
    __device__ __forceinline__ bool next(int i, Unit& u) const {
        const long L = (long)i * G + c - first; if (L < 0 || L >= (long)nG * nM * nN) return false;
        u.pn = (int)(L % nN); const int r = (int)(L / nN); u.pm = r % nM; u.g = r / nM; return true;
    }
};

__device__ __forceinline__ unsigned f2bf(float f) { unsigned u = __builtin_bit_cast(unsigned, f); return (u + 0x7fffu + ((u >> 16) & 1u)) >> 16; }
__device__ __forceinline__ unsigned pk2(float lo, float hi) { return f2bf(lo) | (f2bf(hi) << 16); }
__device__ __forceinline__ unsigned cvt_pk(float lo, float hi) { unsigned r; asm volatile("v_cvt_pk_bf16_f32 %0, %1, %2" : "=v"(r) : "v"(lo), "v"(hi)); return r; }
__device__ __forceinline__ float bf2f(unsigned short b) { return __builtin_bit_cast(float, ((unsigned)b) << 16); }
__device__ __forceinline__ float bflo(unsigned w) { return __builtin_bit_cast(float, w << 16); }
__device__ __forceinline__ float bfhi(unsigned w) { return __builtin_bit_cast(float, w & 0xffff0000u); }
__device__ __forceinline__ float fast_sigmoid(float x) { return __builtin_amdgcn_rcpf(1.0f + __builtin_amdgcn_exp2f(-1.4426950408889634f * x)); }
template <int O> __device__ __forceinline__ float swz_xor(float v) { return __builtin_bit_cast(float, __builtin_amdgcn_ds_swizzle(__builtin_bit_cast(int, v), (O << 10) | 0x1f)); }
__device__ __forceinline__ float half_sum(float v) { const unsigned u = __builtin_bit_cast(unsigned, v); auto r = __builtin_amdgcn_permlane32_swap(u, u, false, false);
    return __builtin_bit_cast(float, (unsigned)r[0]) + __builtin_bit_cast(float, (unsigned)r[1]); }
__device__ __forceinline__ float half_max(float v) { const unsigned u = __builtin_bit_cast(unsigned, v); auto r = __builtin_amdgcn_permlane32_swap(u, u, false, false);
    return fmaxf(__builtin_bit_cast(float, (unsigned)r[0]), __builtin_bit_cast(float, (unsigned)r[1])); }
__device__ __forceinline__ float wave_sum(float v) { v += swz_xor<1>(v); v += swz_xor<2>(v); v += swz_xor<4>(v); v += swz_xor<8>(v); v += swz_xor<16>(v); return half_sum(v); }

__device__ __forceinline__ int lane_id() { unsigned z = 0u; asm volatile("" : "+v"(z)); return (int)__builtin_amdgcn_mbcnt_hi(~0u, __builtin_amdgcn_mbcnt_lo(~0u, z)); }
template <class Epi, class Sched, bool HOOK = false>
__device__ __forceinline__ void gemm_phase(LAS unsigned char* lds, const Gemm g, const Sched& S, const Epi& E, int wid) {
    const int lane = lane_id(), tid = wid * 64 + lane, wr = wid >> 2, wc = wid & 3, fr = lane & 15, fq = lane >> 4;
    const int nt = g.K / BK;
    unsigned voffA[2], voffB[2];
#pragma unroll
    for (int i = 0; i < 2; ++i) { int R, C; stage_rc(tid * 16 + i * 8192, R, C); const int Rb = Epi::PERM ? ((R & ~31) + perm32(R & 31)) : R;
        voffA[i] = g.a_g16 ? (unsigned)(((C >> 4) * g.a_g16 + R) * 16 + (C & 15)) * 2u : (unsigned)(R * g.lda + C) * 2u; voffB[i] = (unsigned)(Rb * g.ldb + C) * 2u; }
    const size_t kstep = (size_t)(BK * 2);
    const size_t kstepA = g.a_g16 ? (size_t)g.a_g16 * 128 : kstep;
    const size_t hstepA = g.a_g16 ? (size_t)HALF * 32 : (size_t)HALF * g.lda * 2, hstepB = (size_t)HALF * g.ldb * 2;
    const unsigned ldsw = (unsigned)wid * 1024u;
    const int aoff = lds_byte(wr * 64 + fr, fq * 8), boff = lds_byte(wc * 32 + fr, fq * 8);
#define PG8_SA(b, h) (((b) * 2 + (h)) * HTB)
#define PG8_SB(b, h) ((4 + (b) * 2 + (h)) * HTB)
#define PG8_STAGE(bufoff, gbase, voff) do { _Pragma("unroll") for (int _i = 0; _i < 2; ++_i) \
        __builtin_amdgcn_global_load_lds((const unsigned*)((const char*)(gbase) + (voff)[_i]), (LAS unsigned*)(lds + (bufoff) + ldsw + _i * 8192), 16, 0, 0); } while (0)
#define PG8_LDA(dst, b, h) do { _Pragma("unroll") for (int m = 0; m < 4; ++m) _Pragma("unroll") for (int k = 0; k < 2; ++k) dst[m][k] = *(const LAS bf16x8*)(lds + PG8_SA(b, h) + aoff + m * 2048 + k * 1024); } while (0)
#define PG8_LDB(dst, b, h) do { _Pragma("unroll") for (int n = 0; n < 2; ++n) _Pragma("unroll") for (int k = 0; k < 2; ++k) dst[n][k] = *(const LAS bf16x8*)(lds + PG8_SB(b, h) + boff + n * 2048 + k * 1024); } while (0)
#define PG8_MMA(ai, bj, At, Bt) do { __builtin_amdgcn_s_setprio(1); _Pragma("unroll") for (int m = 0; m < 4; ++m) _Pragma("unroll") for (int n = 0; n < 2; ++n) _Pragma("unroll") for (int k = 0; k < 2; ++k) \
        acc[ai][bj][m][n] = __builtin_amdgcn_mfma_f32_16x16x32_bf16(Bt[n][k], At[m][k], acc[ai][bj][m][n], 0, 0, 0); __builtin_amdgcn_s_setprio(0); } while (0)
#define PG8_WAIT_V(n) asm volatile("s_waitcnt vmcnt(" #n ")" ::: "memory")
#define PG8_WAIT_L(n) asm volatile("s_waitcnt lgkmcnt(" #n ")" ::: "memory")
#define PG8_BAR __builtin_amdgcn_s_barrier()
#define PG8_SCHED __builtin_amdgcn_sched_barrier(0)
#define PG8_ABASE(u) ((const char*)g.A + ((size_t)(u).g * g.a_gs + (size_t)(u).pm * BM * (g.a_g16 ? 16 : g.lda)) * 2)
#define PG8_BBASE(u) ((const char*)g.Bt + ((size_t)(u).g * g.b_gs + (size_t)(u).pn * BM * g.ldb) * 2)
    Unit cur, nxt; int ui = 0;
    if (!S.next(0, cur)) return;
    f32x4 acc[2][2][4][2];
#pragma unroll
    for (int a = 0; a < 2; ++a)
#pragma unroll
        for (int b = 0; b < 2; ++b)
#pragma unroll
            for (int m = 0; m < 4; ++m)
#pragma unroll
                for (int n = 0; n < 2; ++n) acc[a][b][m][n] = (f32x4){0.f, 0.f, 0.f, 0.f};
    bf16x8 At[4][2], B0[2][2], B1[2][2];
    const char* cA = PG8_ABASE(cur); const char* cB = PG8_BBASE(cur);
    PG8_STAGE(PG8_SB(0, 0), cB, voffB); PG8_STAGE(PG8_SB(0, 1), cB + hstepB, voffB); PG8_STAGE(PG8_SA(0, 0), cA, voffA); PG8_STAGE(PG8_SA(0, 1), cA + hstepA, voffA);
    if (wr == 1) PG8_BAR;
    PG8_WAIT_V(2); PG8_BAR;
    PG8_STAGE(PG8_SB(1, 0), cB + kstep, voffB); PG8_STAGE(PG8_SA(1, 0), cA + kstepA, voffA); PG8_STAGE(PG8_SB(1, 1), cB + hstepB + kstep, voffB);
    PG8_WAIT_V(6); PG8_BAR;
    for (;;) {
        const bool has_next = S.next(ui + 1, nxt);
        const char* nA = has_next ? PG8_ABASE(nxt) : cA; const char* nB = has_next ? PG8_BBASE(nxt) : cB;
        for (int t = 0; t < nt; t += 2) {
            const bool last = (t == nt - 2);
            const char* a1 = cA + (size_t)(t + 1) * kstepA;
            const char* a2 = last ? nA : cA + (size_t)(t + 2) * kstepA; const char* b2 = last ? nB : cB + (size_t)(t + 2) * kstep;
            const char* a3 = a2 + kstepA; const char* b3 = b2 + kstep;
            if constexpr (HOOK) { if (t == E.hook_t) E.hook(acc, ui, wr, fr); }
            PG8_LDB(B0, 0, 0); PG8_LDB(B1, 0, 1); PG8_SCHED; PG8_LDA(At, 0, 0); PG8_STAGE(PG8_SA(1, 1), a1 + hstepA, voffA);
            PG8_WAIT_V(8); PG8_WAIT_L(0); PG8_BAR; PG8_MMA(0, 0, At, B0); PG8_MMA(0, 1, At, B1); PG8_BAR; PG8_SCHED;
            PG8_LDA(At, 0, 1); PG8_STAGE(PG8_SB(0, 0), b2, voffB); PG8_STAGE(PG8_SB(0, 1), b2 + hstepB, voffB); PG8_STAGE(PG8_SA(0, 0), a2, voffA);
            PG8_WAIT_V(8); PG8_WAIT_L(0); PG8_BAR; PG8_MMA(1, 0, At, B0); PG8_MMA(1, 1, At, B1); PG8_BAR; PG8_SCHED;
            PG8_LDB(B0, 1, 0); PG8_LDB(B1, 1, 1); PG8_SCHED; PG8_LDA(At, 1, 0); PG8_STAGE(PG8_SA(0, 1), a2 + hstepA, voffA);
            PG8_WAIT_V(8); PG8_WAIT_L(0); PG8_BAR; PG8_MMA(0, 0, At, B0); PG8_MMA(0, 1, At, B1); PG8_BAR; PG8_SCHED;
            PG8_LDA(At, 1, 1); PG8_STAGE(PG8_SB(1, 0), b3, voffB); PG8_STAGE(PG8_SB(1, 1), b3 + hstepB, voffB); PG8_STAGE(PG8_SA(1, 0), a3, voffA);
            PG8_WAIT_V(8); PG8_WAIT_L(0); PG8_BAR; PG8_MMA(1, 0, At, B0); PG8_MMA(1, 1, At, B1); PG8_BAR; PG8_SCHED;
        }
#ifndef NO_ALIGN_EPI
        if (wr == 0) PG8_BAR;
#endif
#if defined(PROBE_DUP) && PROBE_DUP >= 300 && PROBE_DUP < 310
        if (PROBE_DUP == 300 || PROBE_DUP == Epi::PROBE_ID) E.probe(acc, cur, ui, wr, wc, fr, fq);
#endif
        E(acc, cur, ui, wr, wc, fr, fq);
        if (!has_next) break;
#pragma unroll
        for (int a = 0; a < 2; ++a)
#pragma unroll
            for (int b = 0; b < 2; ++b)
#pragma unroll
                for (int m = 0; m < 4; ++m)
#pragma unroll
                    for (int n = 0; n < 2; ++n) acc[a][b][m][n] = (f32x4){0.f, 0.f, 0.f, 0.f};
        cur = nxt; cA = nA; cB = nB; ++ui;
#ifndef NO_ALIGN_EPI
        if (wr == 1) PG8_BAR;
#endif
    }
    PG8_WAIT_V(0);
#ifdef NO_ALIGN_EPI
    if (wr == 0) PG8_BAR;
#endif
    PG8_BAR;
#undef PG8_SA
#undef PG8_SB
#undef PG8_STAGE
#undef PG8_LDA
#undef PG8_LDB
#undef PG8_MMA
#undef PG8_WAIT_V
#undef PG8_WAIT_L
#undef PG8_BAR
#undef PG8_SCHED
#undef PG8_ABASE
#undef PG8_BBASE
}
typedef GAS unsigned gu32;
#define VM_WAIT() asm volatile("s_waitcnt vmcnt(0)" ::: "memory")
#define LDS_WAIT() asm volatile("s_waitcnt lgkmcnt(0)" ::: "memory")
#define XB_TMO      128
#define XB_XCNT(j)  (256  + 64 * (j))
#define XB_XSUB(j)  (1280 + 64 * (j))
#define XB_XGEN(j)  (2304 + 64 * (j))
#define XB_TOP      3328
#define XB_TOPGEN   3392
#define XCD_BAR_WORDS 3456
#define XB_SPIN_CAP (1u << 18)

__device__ __forceinline__ unsigned xb_ld(unsigned* p)              { return __hip_atomic_load(p, __ATOMIC_RELAXED, __HIP_MEMORY_SCOPE_AGENT); }
__device__ __forceinline__ unsigned xb_add(unsigned* p, unsigned v) { return __hip_atomic_fetch_add(p, v, __ATOMIC_RELAXED, __HIP_MEMORY_SCOPE_AGENT); }
__device__ __forceinline__ unsigned xb_xcc_id() { return (unsigned)__builtin_amdgcn_s_getreg((3 << 11) | 20) & 0xFu; }
#define XB_SPIN(cond, bar) do { unsigned _sp = 0; while (cond) { __builtin_amdgcn_s_sleep(1); \
    if ((++_sp & 255u) == 0u) { if (xb_ld(&(bar)[XB_TMO])) break; if (_sp > XB_SPIN_CAP) { atomicAdd(&(bar)[XB_TMO], 1u); break; } } } } while (0)

struct XcdBarrier {
    unsigned* bar; unsigned x;
    bool t0; volatile LAS unsigned* st;
};

__device__ __forceinline__ XcdBarrier xcd_barrier_post(unsigned* bar, volatile LAS unsigned* st, bool t0) {
    XcdBarrier b; b.bar = bar; b.x = xb_xcc_id(); b.st = st; b.t0 = t0;
    if (t0) (void)xb_add(&bar[XB_XCNT(b.x)], 1u);
    return b;
}
__device__ __forceinline__ void xcd_barrier_complete(unsigned* bar, unsigned x, unsigned& nloc, unsigned& nx) {
    const unsigned G = gridDim.x * gridDim.y * gridDim.z;
    unsigned sum, cnt, mine, sp = 0u;
    for (;;) {
        sum = 0u; cnt = 0u; mine = 0u;
#pragma unroll
        for (unsigned j = 0; j < 16; ++j) { const unsigned c = xb_ld(&bar[XB_XCNT(j)]); sum += c; cnt += (c > 0u) ? 1u : 0u; mine = (j == x) ? c : mine; }
        if (sum == G) break;
        __builtin_amdgcn_s_sleep(1);
        if ((++sp & 255u) == 0u) { if (xb_ld(&bar[XB_TMO])) break; if (sp > XB_SPIN_CAP) { atomicAdd(&bar[XB_TMO], 1u); break; } }
    }
    nloc = mine > 0u ? mine : 1u; nx = cnt > 0u ? cnt : 1u;
}

__device__ __forceinline__ void xcd_barrier(const XcdBarrier& b) {
    asm volatile("s_waitcnt vmcnt(0)" ::: "memory");
    __syncthreads();
    if (b.t0) {
        unsigned* bar = b.bar;
        __builtin_amdgcn_s_waitcnt(0);
        unsigned nloc = b.st[0], nx = b.st[1];
        if (nloc == 0u) { xcd_barrier_complete(bar, b.x, nloc, nx); b.st[0] = nloc; b.st[1] = nx; }
        const unsigned old = xb_add(&bar[XB_XSUB(b.x)], 1u);
        const unsigned gen = old / nloc;
        if (old + 1u == (gen + 1u) * nloc) {
            __builtin_amdgcn_fence(__ATOMIC_RELEASE, "agent");
            asm volatile("s_waitcnt vmcnt(0)" ::: "memory");
            const unsigned og = xb_add(&bar[XB_TOP], 1u);
            const unsigned tg = og / nx;
            if (og + 1u == (tg + 1u) * nx) xb_add(&bar[XB_TOPGEN], 1u);
            else XB_SPIN(xb_ld(&bar[XB_TOPGEN]) == tg, bar);
            __builtin_amdgcn_fence(__ATOMIC_ACQUIRE, "agent");
            xb_add(&bar[XB_XGEN(b.x)], 1u);
            asm volatile("s_waitcnt vmcnt(0)" ::: "memory");
        } else {
            XB_SPIN(xb_ld(&bar[XB_XGEN(b.x)]) == gen, bar);
            __builtin_amdgcn_fence(__ATOMIC_ACQUIRE, "agent");
            asm volatile("s_waitcnt vmcnt(0)" ::: "memory");
        }
    }
    __syncthreads();
}
template <int MAPK>
__device__ __forceinline__ void tr_item(const float* W, int K, int N, bf16_t* WT, const float* gain, int gain_lim, float scale, LAS float* scr, int item, int lane) {
    const int nblk = N / 32, kb = item / nblk, nb = item % nblk, k0 = 64 * kb, n0 = 32 * nb;
    float cs = scale;
    if (MAPK == 1) { if (n0 >= 1024 && n0 < 1536) cs *= 0.08838834764831845f; }
    const float* wp = W + (size_t)(k0 + (lane >> 5)) * N + n0 + (lane & 31);
    float w[32];
#pragma unroll
    for (int i = 0; i < 32; ++i) w[i] = wp[(size_t)(2 * i) * N];
    const int c = lane & 7;
    f32x4 g0 = {cs, cs, cs, cs}, g1 = g0;
    if (k0 < gain_lim) { g0 = *(const GAS f32x4*)(gain + k0 + 8 * c) * cs; g1 = *(const GAS f32x4*)(gain + k0 + 8 * c + 4) * cs; }
#pragma unroll
    for (int i = 0; i < 32; ++i) scr[(2 * i + (lane >> 5)) * 33 + (lane & 31)] = w[i];
    LDS_WAIT(); asm volatile("" ::: "memory");
#pragma unroll
    for (int j = 0; j < 4; ++j) { const int nl = (lane >> 3) + 8 * j, n = n0 + nl; const LAS float* s = scr + (8 * c) * 33 + nl;
        int nr = n;
        if (MAPK == 1) { if (n >= 512 && n < 1536) { const int jj = n - 512, blk = jj >> 7, e = jj & 127; nr = 512 + blk * 128 + 2 * (e & 63) + (e >> 6); } }
        if (MAPK == 2) nr = (n >> 7) * 256 + (n & 127);
        if (MAPK == 3) nr = (n >> 7) * 256 + 128 + (n & 127);
        u32x4 o; o.x = pk2(s[0 * 33] * g0.x, s[1 * 33] * g0.y); o.y = pk2(s[2 * 33] * g0.z, s[3 * 33] * g0.w); o.z = pk2(s[4 * 33] * g1.x, s[5 * 33] * g1.y); o.w = pk2(s[6 * 33] * g1.z, s[7 * 33] * g1.w);
        *(GAS u32x4*)(WT + (size_t)nr * K + k0 + 8 * c) = o; }
    LDS_WAIT(); asm volatile("" ::: "memory");
}
struct In {
    const float *x, *mem; const int* pos; const float *norm_mix, *w_in, *lre, *lim, *lstep, *bre, *bim, *cre, *cim, *s5d, *wglu, *bglu, *s5n, *retn, *w_out, *norm_cross, *norm_mem,
        *w_cq, *w_ck, *w_cv, *w_co, *norm_ffn, *w_gate, *w_up, *w_down, *norm_final;
};
__device__ __forceinline__ bf16_t* wl(unsigned char* ws, int l, size_t off) { return (bf16_t*)(ws + WS_W + (size_t)l * W_LAYER + off); }

__device__ __forceinline__ void pro_weights(const In& in, unsigned char* ws, LAS unsigned char* lds, int gw, int NGW, int wave, int lane) {
    LAS float* scr = (LAS float*)(lds + wave * 16384);
    constexpr int I_IN = 16 * 80, I_GLU = 8 * 16, I_SQ = 16 * 32, I_GU = 16 * 88, I_DN = 44 * 32;
    constexpr int PER_L = I_IN + I_GLU + 5 * I_SQ + 2 * I_GU + I_DN;
    static_assert(PER_L == 8192, "items");
    for (int it = gw; it < DEPTH * PER_L; it += NGW) {
        const int l = it / PER_L; int r = it % PER_L;
        if (r < I_IN) { tr_item<1>(in.w_in + (size_t)l * D * INW, D, INW, wl(ws, l, W_IN), in.norm_mix + l * D, D, 1.0f, scr, r, lane); continue; } r -= I_IN;
        if (r < I_GLU) { tr_item<0>(in.wglu + (size_t)l * S5W * S5W, S5W, S5W, wl(ws, l, W_GLU), nullptr, 0, 1.0f, scr, r, lane); continue; } r -= I_GLU;
        if (r < I_SQ) { tr_item<0>(in.w_out + (size_t)l * D * D, D, D, wl(ws, l, W_OUT), in.s5n + l * S5W, S5W, 1.0f, scr, r, lane); continue; } r -= I_SQ;
        if (r < I_SQ) { tr_item<0>(in.w_cq + (size_t)l * D * D, D, D, wl(ws, l, W_CQ), in.norm_cross + l * D, D, 0.0625f * 1.4426950408889634f, scr, r, lane); continue; } r -= I_SQ;
        if (r < I_SQ) { tr_item<0>(in.w_co + (size_t)l * D * D, D, D, wl(ws, l, W_CO), nullptr, 0, 1.0f, scr, r, lane); continue; } r -= I_SQ;
        if (r < I_SQ) { tr_item<0>(in.w_ck + (size_t)l * D * D, D, D, (bf16_t*)(ws + WS_WCK_TMP) + (size_t)l * D * D, in.norm_mem + l * D, D, 1.0f, scr, r, lane); continue; } r -= I_SQ;
        if (r < I_SQ) { tr_item<0>(in.w_cv + (size_t)l * D * D, D, D, (bf16_t*)(ws + WS_WCV_TMP) + (size_t)l * D * D, in.norm_mem + l * D, D, 1.0f, scr, r, lane); continue; } r -= I_SQ;
        if (r < I_GU) { tr_item<2>(in.w_gate + (size_t)l * D * FF, D, FF, wl(ws, l, W_GU), in.norm_ffn + l * D, D, 1.0f, scr, r, lane); continue; } r -= I_GU;
        if (r < I_GU) { tr_item<3>(in.w_up + (size_t)l * D * FF, D, FF, wl(ws, l, W_GU), in.norm_ffn + l * D, D, 1.0f, scr, r, lane); continue; } r -= I_GU;
        tr_item<0>(in.w_down + (size_t)l * FF * D, FF, D, wl(ws, l, W_DN), nullptr, 0, 1.0f, scr, r, lane);
    }
}
__device__ __forceinline__ void xprep_rows(const float* src, bf16_t* xb, float* ssq, int gw, int NGW, int lane) {
    for (int m = gw; m < M; m += NGW) {
        const GAS f32x4* xr = (const GAS f32x4*)(src + (size_t)m * D) + lane;
        f32x4 v[4]; float s = 0.f;
#pragma unroll
        for (int j = 0; j < 4; ++j) { v[j] = xr[64 * j]; s += (v[j].x * v[j].x + v[j].y * v[j].y) + (v[j].z * v[j].z + v[j].w * v[j].w); }
        const float tot = wave_sum(s);
        GAS u32x2* o8 = (GAS u32x2*)(xb + (size_t)m * D) + lane;
#pragma unroll
        for (int j = 0; j < 4; ++j) { u32x2 w; w.x = pk2(v[j].x, v[j].y); w.y = pk2(v[j].z, v[j].w); o8[64 * j] = w; }
        if (lane < 16) ssq[(size_t)m * 16 + lane] = (lane == 0) ? tot : 0.f;
    }
}
__device__ __forceinline__ void final_norm_rows(const bf16_t* xb, float* out, const float* g, int gw, int NGW, int lane) {
    f32x4 gv[4];
#pragma unroll
    for (int j = 0; j < 4; ++j) gv[j] = ((const GAS f32x4*)g)[lane + 64 * j];
    for (int m = gw; m < M; m += NGW) {
        const GAS u32x2* xr = (const GAS u32x2*)(xb + (size_t)m * D) + lane;
        f32x4 v[4]; float s = 0.f;
#pragma unroll
        for (int j = 0; j < 4; ++j) { const u32x2 w = xr[64 * j]; v[j] = (f32x4){bflo(w.x), bfhi(w.x), bflo(w.y), bfhi(w.y)}; s += (v[j].x * v[j].x + v[j].y * v[j].y) + (v[j].z * v[j].z + v[j].w * v[j].w); }
        const float r = 1.0f / sqrtf(wave_sum(s) * (1.0f / D) + EPS);
        GAS f32x4* o = (GAS f32x4*)(out + (size_t)m * D) + lane;
#pragma unroll
        for (int j = 0; j < 4; ++j) o[64 * j] = v[j] * r * gv[j];
    }
}
template <class Sched>
__device__ __forceinline__ void rstd_table(LAS float* tab, const Sched& S, const float* ssq, int nslots, float inv_n, int wave) {
    Unit u; const int t = wave * 64 + lane_id(); int prev_pm = -1;
    for (int i = 0; S.next(i, u); ++i) {
        if (wave < 4) {
            if (u.pm == prev_pm) tab[i * 256 + t] = tab[(i - 1) * 256 + t];
            else { const float* p = ssq + (size_t)(u.pm * 256 + t) * nslots; float s = 0.f;
                for (int j = 0; j < nslots; j += 4) { const f32x4 v = *(const GAS f32x4*)(p + j); s += (v.x + v.y) + (v.z + v.w); }
                tab[i * 256 + t] = 1.0f / sqrtf(s * inv_n + EPS); } }
        prev_pm = u.pm;
    }
    __syncthreads();
}

struct EpiFfn1 {
    static constexpr int PROBE_ID = 302; static constexpr bool PERM = true;
    bf16_t* H; LAS const float* tab;
    __device__ __forceinline__ void probe(const f32x4 (&acc)[2][2][4][2], const Unit& u, int ui, int wr, int wc, int fr, int fq) const { (*this)(acc, u, ui, wr, wc, fr, fq); }
    __device__ __forceinline__ void operator()(const f32x4 (&acc)[2][2][4][2], const Unit& u, int ui, int wr, int wc, int fr, int fq) const {
        asm volatile("" : "+v"(fr), "+v"(fq));
#pragma unroll
        for (int ai = 0; ai < 2; ++ai)
#pragma unroll
            for (int m = 0; m < 4; ++m) { const int rl = ai * HALF + wr * 64 + m * 16 + fr; const float rs = tab[ui * 256 + rl], k1 = -1.4426950408889634f * rs, rs2 = rs * rs;
                float h[8];
#pragma unroll
                for (int n = 0; n < 2; ++n)
#pragma unroll
                    for (int j = 0; j < 4; ++j) { const float ag = acc[ai][0][m][n][j], au = acc[ai][1][m][n][j]; h[4 * n + j] = (ag * au) * (rs2 * __builtin_amdgcn_rcpf(1.0f + __builtin_amdgcn_exp2f(ag * k1))); }
                u32x4 w; w.x = cvt_pk(h[0], h[1]); w.y = cvt_pk(h[2], h[3]); w.z = cvt_pk(h[4], h[5]); w.w = cvt_pk(h[6], h[7]);
                *(GAS u32x4*)(H + (size_t)(u.pm * BM + rl) * FF + u.pn * 128 + wc * 32 + 8 * fq) = w; }
    }
};
struct EpiRes {
    static constexpr int PROBE_ID = 307; static constexpr bool PERM = true;
    bf16_t* xb; float* ssq; float* fout; float scale;
    __device__ __forceinline__ void probe(const f32x4 (&acc)[2][2][4][2], const Unit& u, int ui, int wr, int wc, int fr, int fq) const { EpiRes t = *this; t.scale = 0.f; t(acc, u, ui, wr, wc, fr, fq); }
    __device__ __forceinline__ void operator()(const f32x4 (&acc)[2][2][4][2], const Unit& u, int ui, int wr, int wc, int fr, int fq) const {
        asm volatile("" : "+v"(fr), "+v"(fq));
#pragma unroll
        for (int ai = 0; ai < 2; ++ai) {
            u32x4 xv[4][2];
#pragma unroll
            for (int m = 0; m < 4; ++m)
#pragma unroll
                for (int bj = 0; bj < 2; ++bj) xv[m][bj] = *(const GAS u32x4*)(xb + (size_t)(u.pm * BM + ai * HALF + wr * 64 + m * 16 + fr) * D + u.pn * BM + bj * HALF + wc * 32 + 8 * fq);
#pragma unroll
            for (int m = 0; m < 4; ++m) { const int row = u.pm * BM + ai * HALF + wr * 64 + m * 16 + fr; float ps = 0.f;
#pragma unroll
                for (int bj = 0; bj < 2; ++bj) { const size_t off = (size_t)row * D + u.pn * BM + bj * HALF + wc * 32 + 8 * fq; const u32x4 xw = xv[m][bj];
                    f32x4 v0, v1;
                    v0.x = bflo(xw.x) + acc[ai][bj][m][0].x * scale; v0.y = bfhi(xw.x) + acc[ai][bj][m][0].y * scale; v0.z = bflo(xw.y) + acc[ai][bj][m][0].z * scale; v0.w = bfhi(xw.y) + acc[ai][bj][m][0].w * scale;
                    v1.x = bflo(xw.z) + acc[ai][bj][m][1].x * scale; v1.y = bfhi(xw.z) + acc[ai][bj][m][1].y * scale; v1.z = bflo(xw.w) + acc[ai][bj][m][1].z * scale; v1.w = bfhi(xw.w) + acc[ai][bj][m][1].w * scale;
                    if (fout) { *(GAS f32x4*)(fout + off) = v0; *(GAS f32x4*)(fout + off + 4) = v1; }
                    u32x4 w; w.x = cvt_pk(v0.x, v0.y); w.y = cvt_pk(v0.z, v0.w); w.z = cvt_pk(v1.x, v1.y); w.w = cvt_pk(v1.z, v1.w);
                    *(GAS u32x4*)(xb + off) = w;
                    ps += (v0.x * v0.x + v0.y * v0.y) + (v0.z * v0.z + v0.w * v0.w) + (v1.x * v1.x + v1.y * v1.y) + (v1.z * v1.z + v1.w * v1.w); }
                ps += swz_xor<16>(ps); ps = half_sum(ps);
                if (fq == 0) ssq[(size_t)row * 16 + u.pn * 4 + wc] = ps; }
            asm volatile("" ::: "memory"); }
    }
};
struct EpiScaleBf16 {
    static constexpr int PROBE_ID = 303; static constexpr bool PERM = true;
    bf16_t* O; int ldo; LAS const float* tab;
    __device__ __forceinline__ void probe(const f32x4 (&acc)[2][2][4][2], const Unit& u, int ui, int wr, int wc, int fr, int fq) const { (*this)(acc, u, ui, wr, wc, fr, fq); }
    __device__ __forceinline__ void operator()(const f32x4 (&acc)[2][2][4][2], const Unit& u, int ui, int wr, int wc, int fr, int fq) const {
        asm volatile("" : "+v"(fr), "+v"(fq));
#pragma unroll
        for (int ai = 0; ai < 2; ++ai)
#pragma unroll
            for (int m = 0; m < 4; ++m) { const int rl = ai * HALF + wr * 64 + m * 16 + fr; const float rs = tab[ui * 256 + rl];
#pragma unroll
                for (int bj = 0; bj < 2; ++bj) { const f32x4 v0 = acc[ai][bj][m][0] * rs, v1 = acc[ai][bj][m][1] * rs;
                    u32x4 w; w.x = cvt_pk(v0.x, v0.y); w.y = cvt_pk(v0.z, v0.w); w.z = cvt_pk(v1.x, v1.y); w.w = cvt_pk(v1.z, v1.w);
                    *(GAS u32x4*)(O + (size_t)(u.pm * BM + rl) * ldo + u.pn * BM + bj * HALF + wc * 32 + 8 * fq) = w; } }
    }
};
struct EpiMemK {
    static constexpr int PROBE_ID = 309; static constexpr bool PERM = true;
    bf16_t* O; const float* rsm;
    __device__ __forceinline__ void probe(const f32x4 (&acc)[2][2][4][2], const Unit& u, int ui, int wr, int wc, int fr, int fq) const { (*this)(acc, u, ui, wr, wc, fr, fq); }
    __device__ __forceinline__ void operator()(const f32x4 (&acc)[2][2][4][2], const Unit& u, int ui, int wr, int wc, int fr, int fq) const {
        asm volatile("" : "+v"(fr), "+v"(fq));
#pragma unroll
        for (int ai = 0; ai < 2; ++ai)
#pragma unroll
            for (int m = 0; m < 4; ++m) { const int row = u.pm * BM + ai * HALF + wr * 64 + m * 16 + fr; const float rs = rsm[row];
#pragma unroll
                for (int bj = 0; bj < 2; ++bj) { const f32x4 v0 = acc[ai][bj][m][0] * rs, v1 = acc[ai][bj][m][1] * rs;
                    u32x4 w; w.x = cvt_pk(v0.x, v0.y); w.y = cvt_pk(v0.z, v0.w); w.z = cvt_pk(v1.x, v1.y); w.w = cvt_pk(v1.z, v1.w);
                    *(GAS u32x4*)(O + ((size_t)u.g * MROWS + row) * D + u.pn * BM + bj * HALF + wc * 32 + 8 * fq) = w; } }
    }
};
struct EpiMemVT {
    static constexpr int PROBE_ID = 309; static constexpr bool PERM = true;
    bf16_t* O; const float* rsm;
    __device__ __forceinline__ void probe(const f32x4 (&acc)[2][2][4][2], const Unit& u, int ui, int wr, int wc, int fr, int fq) const { (*this)(acc, u, ui, wr, wc, fr, fq); }
    __device__ __forceinline__ void operator()(const f32x4 (&acc)[2][2][4][2], const Unit& u, int ui, int wr, int wc, int fr, int fq) const {
        asm volatile("" : "+v"(fr), "+v"(fq));
#pragma unroll
        for (int bj = 0; bj < 2; ++bj) { const int c0 = u.pn * BM + bj * HALF + wc * 32 + 8 * fq;
            const f32x4 r0 = *(const GAS f32x4*)(rsm + c0), r1 = *(const GAS f32x4*)(rsm + c0 + 4);
            const int p0 = (c0 & ~15) + 4 * ((c0 >> 3) & 1), p1 = p0 + 8;
#pragma unroll
            for (int ai = 0; ai < 2; ++ai)
#pragma unroll
                for (int m = 0; m < 4; ++m) { const int row = u.pm * BM + ai * HALF + wr * 64 + m * 16 + fr;
                    const f32x4 v0 = acc[ai][bj][m][0] * r0, v1 = acc[ai][bj][m][1] * r1;
                    bf16_t* o = O + ((size_t)u.g * D + row) * MROWS;
                    u32x2 w0, w1; w0.x = cvt_pk(v0.x, v0.y); w0.y = cvt_pk(v0.z, v0.w); w1.x = cvt_pk(v1.x, v1.y); w1.y = cvt_pk(v1.z, v1.w);
                    *(GAS u32x2*)(o + p0) = w0; *(GAS u32x2*)(o + p1) = w1; } }
    }
};

__device__ __forceinline__ void xa_fill(LAS unsigned char* lds, const bf16_t* src  , int wave, int lane) {
#pragma unroll 1
    for (int j = 0; j < 16; ++j) { const int p = wave * 16 + j, row = 2 * p + (lane >> 5), ch = (lane & 31) ^ (row & 15);
        __builtin_amdgcn_global_load_lds((const unsigned*)((const char*)src + (size_t)row * 2048 + ch * 16), (LAS unsigned*)(lds + p * 1024), 16, 0, 0); }
}
__device__ __forceinline__ void xa_mma(f32x16 (&acc)[8], const bf16x8 (&bf)[16], LAS const unsigned char* lds, int r, int hh) {
    const int a = (r >> 1) & 7, b = hh ^ (r & 1); LAS const unsigned char* base = lds + r * 512 + b * 16;
#pragma unroll
    for (int s = 0; s < 16; ++s) { const int cp = ((s & 8) | ((s & 7) ^ a)) << 5;
        LAS const unsigned char* p0 = base + cp; LAS const unsigned char* p1 = p0 + 65536;
#pragma unroll
        for (int blk = 0; blk < 8; ++blk) {
            const bf16x8 av = (blk < 4) ? *(LAS const bf16x8*)(p0 + blk * 16384) : *(LAS const bf16x8*)(p1 + (blk - 4) * 16384);
            acc[blk] = __builtin_amdgcn_mfma_f32_32x32x16_bf16(av, bf[s], acc[blk], 0, 0, 0); }
#pragma unroll
        for (int blk = 0; blk < 8; ++blk) asm volatile("" : "+v"(acc[blk]));
    }
}
__device__ __forceinline__ void xa_mma_q(f32x16 (&acc)[8], const GAS bf16x8* qp, LAS const unsigned char* lds, int r, int hh) {
    const int a = (r >> 1) & 7, b = hh ^ (r & 1); LAS const unsigned char* base = lds + r * 512 + b * 16;
    bf16x8 q3[3];
#pragma unroll
    for (int s = 0; s < 3; ++s) q3[s] = qp[2 * s];
#pragma unroll
    for (int s = 0; s < 16; ++s) { const int cp = ((s & 8) | ((s & 7) ^ a)) << 5;
        LAS const unsigned char* p0 = base + cp; LAS const unsigned char* p1 = p0 + 65536;
        const bf16x8 bq = q3[s % 3];
        if (s + 3 < 16) q3[s % 3] = qp[2 * (s + 3)];
#pragma unroll
        for (int blk = 0; blk < 8; ++blk) {
            const bf16x8 av = (blk < 4) ? *(LAS const bf16x8*)(p0 + blk * 16384) : *(LAS const bf16x8*)(p1 + (blk - 4) * 16384);
            acc[blk] = __builtin_amdgcn_mfma_f32_32x32x16_bf16(av, bq, acc[blk], 0, 0, 0); }
#pragma unroll
        for (int blk = 0; blk < 8; ++blk) asm volatile("" : "+v"(acc[blk]));
    }
}
__device__ __forceinline__ void xattn_unit(LAS unsigned char* lds, const bf16_t* QC, const bf16_t* Kl, const bf16_t* VTl, bf16_t* OC, int b, int h, int qt, int wave) {
    {
        const size_t qrow0 = (size_t)b * SEQ + qt * 256 + wave * 32;
        bf16x8 bq[16];
        { const int lane = lane_id(), r = lane & 31, hh = lane >> 5; const GAS bf16x8* qp = (const GAS bf16x8*)(QC + (qrow0 + r) * D + h * XD + 8 * hh);
#pragma unroll
          for (int s = 0; s < 16; ++s) bq[s] = qp[2 * s]; }
        xa_fill(lds, Kl + (size_t)b * MEML * D + h * XD, wave, lane_id());
        VM_WAIT(); __syncthreads();
#if defined(PROBE_DUP) && PROBE_DUP == 71
        xa_fill(lds, Kl + (size_t)b * MEML * D + h * XD, wave, lane_id());
        VM_WAIT(); __syncthreads();
#endif
        f32x16 acc[8];
#pragma unroll
        for (int k = 0; k < 8; ++k)
#pragma unroll
            for (int j = 0; j < 16; ++j) acc[k][j] = 0.f;
        { const int lane = lane_id(); xa_mma(acc, bq, lds, lane & 31, lane >> 5); }
        __syncthreads();
        xa_fill(lds, VTl + (size_t)h * XD * MROWS + b * MEML, wave, lane_id());
        float mx = acc[0][0];
#pragma unroll
        for (int k = 0; k < 8; ++k)
#pragma unroll
            for (int j = 0; j < 16; ++j) mx = fmaxf(mx, acc[k][j]);
        mx = half_max(mx);
        float sum = 0.f;
#pragma unroll
        for (int k = 0; k < 8; ++k)
#pragma unroll
            for (int j = 0; j < 16; ++j) { const float p = __builtin_amdgcn_exp2f(acc[k][j] - mx); acc[k][j] = p; sum += p; }
        sum = half_sum(sum);
        const float inv = 1.0f / sum;
        bf16x8 bp[16];
#pragma unroll
        for (int k = 0; k < 8; ++k)
#pragma unroll
            for (int s = 0; s < 2; ++s) { u32x4 w; w.x = cvt_pk(acc[k][8 * s + 0], acc[k][8 * s + 1]); w.y = cvt_pk(acc[k][8 * s + 2], acc[k][8 * s + 3]);
                w.z = cvt_pk(acc[k][8 * s + 4], acc[k][8 * s + 5]); w.w = cvt_pk(acc[k][8 * s + 6], acc[k][8 * s + 7]); bp[2 * k + s] = __builtin_bit_cast(bf16x8, w); }
#pragma unroll
        for (int k = 0; k < 8; ++k)
#pragma unroll
            for (int j = 0; j < 16; ++j) acc[k][j] = 0.f;
        VM_WAIT(); __syncthreads();
        { const int lane = lane_id(); xa_mma(acc, bp, lds, lane & 31, lane >> 5); }
        __syncthreads();
        { const int lane = lane_id(), r = lane & 31, hh = lane >> 5; LAS unsigned char* wb = lds + wave * 16384;
#pragma unroll
          for (int k = 0; k < 8; ++k)
#pragma unroll
            for (int g4 = 0; g4 < 4; ++g4) { u32x2 w; w.x = cvt_pk(acc[k][4 * g4] * inv, acc[k][4 * g4 + 1] * inv); w.y = cvt_pk(acc[k][4 * g4 + 2] * inv, acc[k][4 * g4 + 3] * inv);
                *(LAS u32x2*)(wb + r * 512 + (((4 * k + g4) ^ r) << 4) + 8 * hh) = w; }
          asm volatile("s_waitcnt lgkmcnt(0)" ::: "memory");
#if defined(PROBE_DUP) && PROBE_DUP == 72
          for (int rp = 0; rp < 2; ++rp)
#endif
#pragma unroll
          for (int j = 0; j < 16; ++j) { const int row = 2 * j + hh, cp = lane & 31; const u32x4 v = *(LAS const u32x4*)(wb + row * 512 + cp * 16);
              *(GAS u32x4*)(OC + (qrow0 + row) * D + h * XD + 8 * (cp ^ row)) = v; }
          asm volatile("s_waitcnt lgkmcnt(0)" ::: "memory"); }
    }
}
__device__ __forceinline__ void mem_prep_rows(const float* mem, bf16_t* memb, float* rsm, int gw, int NGW, int lane) {
    for (int m = gw; m < MROWS; m += NGW) {
        const GAS f32x4* xr = (const GAS f32x4*)(mem + (size_t)m * D) + lane;
        f32x4 v[4]; float s = 0.f;
#pragma unroll
        for (int j = 0; j < 4; ++j) { v[j] = xr[64 * j]; s += (v[j].x * v[j].x + v[j].y * v[j].y) + (v[j].z * v[j].z + v[j].w * v[j].w); }
        const float tot = wave_sum(s);
        GAS u32x2* o8 = (GAS u32x2*)(memb + (size_t)m * D) + lane;
#pragma unroll
        for (int j = 0; j < 4; ++j) { u32x2 w; w.x = pk2(v[j].x, v[j].y); w.y = pk2(v[j].z, v[j].w); o8[64 * j] = w; }
        if (lane == 0) rsm[m] = 1.0f / sqrtf(tot * (1.0f / D) + EPS);
    }
}

__device__ __forceinline__ float ret_lg2(int h) { return h == 0 ? -0.04580368961312479f : h == 1 ? -0.02272007650008353f : h == 2 ? -0.011315313227834146f : -0.005646563141142063f; }
struct EpiProj {
    static constexpr int PROBE_ID = 301; static constexpr bool PERM = true;
    bf16_t *UG, *Q, *K, *V, *GT; const float* rope; LAS const float* tab;
    __device__ __forceinline__ void probe(const f32x4 (&acc)[2][2][4][2], const Unit& u, int ui, int wr, int wc, int fr, int fq) const { (*this)(acc, u, ui, wr, wc, fr, fq); }
    __device__ __forceinline__ void operator()(const f32x4 (&acc)[2][2][4][2], const Unit& u, int ui, int wr, int wc, int fr, int fq) const {
        asm volatile("" : "+v"(fr), "+v"(fq));
        const int kind = u.pn >> 1;
        if (kind == 1 || kind == 2) {
            f32x4 cs[2][4][2];
#pragma unroll
            for (int ai = 0; ai < 2; ++ai)
#pragma unroll
                for (int m = 0; m < 4; ++m) { const int row = u.pm * BM + ai * HALF + wr * 64 + m * 16 + fr;
                    const GAS f32x4* rp = (const GAS f32x4*)(rope + ((size_t)row * 64 + ((wc * 32 + 8 * fq) >> 1)) * 2); cs[ai][m][0] = rp[0]; cs[ai][m][1] = rp[1]; }
#pragma unroll
            for (int ai = 0; ai < 2; ++ai) {
#pragma unroll
                for (int m = 0; m < 4; ++m) { const int rl = ai * HALF + wr * 64 + m * 16 + fr, row = u.pm * BM + rl; const float rs = tab[ui * 256 + rl];
#pragma unroll
                    for (int bj = 0; bj < 2; ++bj) { const f32x4 v0 = acc[ai][bj][m][0] * rs, v1 = acc[ai][bj][m][1] * rs, c0 = cs[ai][m][0], c1 = cs[ai][m][1];
                        const int cw = (u.pn & 1) * 256 + bj * HALF + wc * 32 + 8 * fq, hd = cw >> 7;
                        const float e = (float)(row & 127) * ret_lg2(hd), sc = __builtin_amdgcn_exp2f(kind == 1 ? e : -e);
                        f32x4 o0, o1;
                        o0.x = (v0.x * c0.x - v0.y * c0.y) * sc; o0.y = (v0.y * c0.x + v0.x * c0.y) * sc; o0.z = (v0.z * c0.z - v0.w * c0.w) * sc; o0.w = (v0.w * c0.z + v0.z * c0.w) * sc;
                        o1.x = (v1.x * c1.x - v1.y * c1.y) * sc; o1.y = (v1.y * c1.x + v1.x * c1.y) * sc; o1.z = (v1.z * c1.z - v1.w * c1.w) * sc; o1.w = (v1.w * c1.z + v1.z * c1.w) * sc;
                        u32x4 w; w.x = cvt_pk(o0.x, o0.y); w.y = cvt_pk(o0.z, o0.w); w.z = cvt_pk(o1.x, o1.y); w.w = cvt_pk(o1.z, o1.w);
                        *(GAS u32x4*)((kind == 1 ? Q : K) + (size_t)row * RW + cw) = w; } } }
        } else {
#pragma unroll
            for (int ai = 0; ai < 2; ++ai)
#pragma unroll
                for (int m = 0; m < 4; ++m) { const int rl = ai * HALF + wr * 64 + m * 16 + fr, row = u.pm * BM + rl; const float rs = tab[ui * 256 + rl];
#pragma unroll
                    for (int bj = 0; bj < 2; ++bj) { const f32x4 v0 = acc[ai][bj][m][0] * rs, v1 = acc[ai][bj][m][1] * rs;
                        const int cw = (u.pn & 1) * 256 + bj * HALF + wc * 32 + 8 * fq;
                        bf16_t* dst = (kind == 0) ? UG + ((size_t)(cw >> 4) * (M / 32) + (row >> 5)) * 640 + (row & 31) * 16 + ((cw >> 3) & 1) * 8 : (kind == 3 ? V : GT) + (size_t)row * RW + cw;
                        u32x4 w; w.x = cvt_pk(v0.x, v0.y); w.y = cvt_pk(v0.z, v0.w); w.z = cvt_pk(v1.x, v1.y); w.w = cvt_pk(v1.z, v1.w);
                        *(GAS u32x4*)dst = w; } }
        }
    }
};
struct EpiGlu {
    static constexpr int PROBE_ID = 304; static constexpr bool PERM = true;
    const bf16_t* Z; const float* bias; bf16_t* Y; float* ssqs;
    __device__ __forceinline__ void probe(const f32x4 (&acc)[2][2][4][2], const Unit& u, int ui, int wr, int wc, int fr, int fq) const { (*this)(acc, u, ui, wr, wc, fr, fq); }
    __device__ __forceinline__ void operator()(const f32x4 (&acc)[2][2][4][2], const Unit& u, int ui, int wr, int wc, int fr, int fq) const {
        asm volatile("" : "+v"(fr), "+v"(fq));
#pragma unroll
        for (int ai = 0; ai < 2; ++ai)
#pragma unroll
            for (int m = 0; m < 4; ++m) { const int row = u.pm * BM + ai * HALF + wr * 64 + m * 16 + fr; float ps = 0.f;
#pragma unroll
                for (int bj = 0; bj < 2; ++bj) { const int col = u.pn * BM + bj * HALF + wc * 32 + 8 * fq;
                    const u32x4 zw = *(const GAS u32x4*)(Z + ((size_t)(col >> 4) * M + row) * 16 + (col & 15));
                    const f32x4 b0 = *(const GAS f32x4*)(bias + col), b1 = *(const GAS f32x4*)(bias + col + 4);
                    const f32x4 t0 = acc[ai][bj][m][0] + b0, t1 = acc[ai][bj][m][1] + b1;
                    float o[8];
                    o[0] = bflo(zw.x) * fast_sigmoid(t0.x); o[1] = bfhi(zw.x) * fast_sigmoid(t0.y); o[2] = bflo(zw.y) * fast_sigmoid(t0.z); o[3] = bfhi(zw.y) * fast_sigmoid(t0.w);
                    o[4] = bflo(zw.z) * fast_sigmoid(t1.x); o[5] = bfhi(zw.z) * fast_sigmoid(t1.y); o[6] = bflo(zw.w) * fast_sigmoid(t1.z); o[7] = bfhi(zw.w) * fast_sigmoid(t1.w);
#pragma unroll
                    for (int j = 0; j < 8; ++j) ps += o[j] * o[j];
                    u32x4 w; w.x = cvt_pk(o[0], o[1]); w.y = cvt_pk(o[2], o[3]); w.z = cvt_pk(o[4], o[5]); w.w = cvt_pk(o[6], o[7]);
                    *(GAS u32x4*)(Y + (size_t)row * D + col) = w; }
                ps += swz_xor<16>(ps); ps = half_sum(ps);
                if (fq == 0) ssqs[(size_t)row * 8 + u.pn * 4 + wc] = ps;
                asm volatile("" ::: "memory"); }
    }
};
struct EpiResHook : EpiRes {
    LAS const float* tab2; int hook_t;
    __device__ __forceinline__ void hook(f32x4 (&acc)[2][2][4][2], int ui, int wr, int fr) const {
#pragma unroll
        for (int ai = 0; ai < 2; ++ai)
#pragma unroll
            for (int m = 0; m < 4; ++m) { const float rs = tab2[ui * 256 + ai * HALF + wr * 64 + m * 16 + fr];
#pragma unroll
                for (int bj = 0; bj < 2; ++bj)
#pragma unroll
                    for (int n = 0; n < 2; ++n) acc[ai][bj][m][n] *= rs; }
    }
};
__device__ __forceinline__ void rope_table(const int* pos, float* rope, int gtid, int nthr) {
    for (int idx = gtid; idx < M * 64; idx += nthr) { const int i = idx & 63, row = idx >> 6;
        const float inv = (float)(1.0 / pow(10000.0, (double)i / 64.0)); const float ang = (float)pos[row] * inv;
        f32x2 cs; cs.x = (float)cos((double)ang); cs.y = (float)sin((double)ang);
        *(GAS f32x2*)(rope + (size_t)idx * 2) = cs; }
}

constexpr size_t SP_RSM = 0, SP_KTAB = 64 * 1024, SP_APOW = SP_KTAB + 4 * MiB, SP_BBAR = 6 * MiB + 256 * 1024;
constexpr size_t APOW_LG = 33 * 64 * 2, KTAB_LG = 32 * 256, BBAR_LG = 64 * 16 * 2;
static_assert(SP_APOW + (size_t)DEPTH * S5G * APOW_LG * 4 <= SP_BBAR && SP_BBAR + (size_t)DEPTH * S5G * BBAR_LG * 4 <= 8 * MiB, "spare map");
constexpr size_t S5M_T = 0, S5M_WEND = 20 * MiB;
constexpr size_t WS_SEND = WS_Z, WS_KVRUN = WS_Z + 16 * MiB;
constexpr size_t WS_RSTART = WS_S5M;
constexpr size_t S5M_LAYER = 28 * MiB;
__device__ __forceinline__ void s5_tables_item(const In& in, unsigned char* ws, LAS unsigned char* lds, int item, int wave, int lane) {
    const int l = item >> 7, g = (item >> 2) & 31, tq = item & 3, p = lane;
    LAS float* Br = (LAS float*)lds; LAS float* Bi = Br + 1024; LAS float* Cr = Bi + 1024; LAS float* Ci = Cr + 1024;
    LAS float* CAr = Ci + 1024 + wave * 2048; LAS float* CAi = CAr + 1024;
    float* sp = (float*)(ws + WS_SPARE);
    const int lg = l * S5G + g;
    const double lr = (double)in.lre[lg * 64 + p], li = (double)in.lim[lg * 64 + p], step = (double)expf(in.lstep[lg]);
    if (wave == 0) {
        const double mag = exp(lr * step), ar = mag * cos(li * step), ai = mag * sin(li * step), den = lr * lr + li * li;
        const double fr = ((ar - 1.0) * lr + ai * li) / den, fi = (ai * lr - (ar - 1.0) * li) / den;
#pragma unroll 4
        for (int h = 0; h < 16; ++h) { const double br = (double)in.bre[((size_t)lg * 64 + p) * 16 + h], bi = (double)in.bim[((size_t)lg * 64 + p) * 16 + h];
            const float xr = (float)(fr * br - fi * bi), xi = (float)(fr * bi + fi * br); Br[p * 16 + h] = xr; Bi[p * 16 + h] = xi;
            if (tq == 0) { f32x2 w; w.x = xr; w.y = xi; *(GAS f32x2*)(sp + SP_BBAR / 4 + (size_t)lg * BBAR_LG + (p * 16 + h) * 2) = w; } }
    }
    if (wave == 1) { for (int n = 0; n < 16; ++n) { Cr[n * 64 + p] = in.cre[((size_t)lg * 16 + n) * 64 + p]; Ci[n * 64 + p] = in.cim[((size_t)lg * 16 + n) * 64 + p]; } }
    const int tau = 8 * tq + wave;
    const double mg = exp(lr * step * (double)tau), an = li * step * (double)tau;
    const float ar = (float)(mg * cos(an)), ai = (float)(mg * sin(an));
    { f32x2 w; w.x = ar; w.y = ai; *(GAS f32x2*)(sp + SP_APOW / 4 + (size_t)lg * APOW_LG + (tau * 64 + p) * 2) = w; }
    if (tq == 3 && wave == 7) { const double m2 = exp(lr * step * 32.0), a2 = li * step * 32.0; f32x2 w; w.x = (float)(m2 * cos(a2)); w.y = (float)(m2 * sin(a2));
        *(GAS f32x2*)(sp + SP_APOW / 4 + (size_t)lg * APOW_LG + (32 * 64 + p) * 2) = w; }
    __syncthreads();
#pragma unroll 4
    for (int n = 0; n < 16; ++n) { const float cr = Cr[n * 64 + p], ci = Ci[n * 64 + p]; CAr[n * 64 + p] = cr * ar - ci * ai; CAi[n * 64 + p] = cr * ai + ci * ar; }
    LDS_WAIT(); asm volatile("" ::: "memory");
    const int n = lane >> 2, h0 = 4 * (lane & 3);
    f32x4 acc = {0.f, 0.f, 0.f, 0.f};
    for (int pp = 0; pp < 64; ++pp) { const float cr = CAr[n * 64 + pp], ci = CAi[n * 64 + pp];
        const f32x4 br = *(LAS const f32x4*)(Br + pp * 16 + h0), bi = *(LAS const f32x4*)(Bi + pp * 16 + h0);
        acc += br * cr - bi * ci; }
    *(GAS f32x4*)(sp + SP_KTAB / 4 + (size_t)lg * KTAB_LG + tau * 256 + n * 16 + h0) = acc;
    __syncthreads();
}
__device__ __forceinline__ void s5_build_item(const In& in, unsigned char* ws, unsigned char* s5m  , int l, int item, int tid) {
    const int g = item >> 3, part = item & 7, lg = l * S5G + g;
    const float* sp = (const float*)(ws + WS_SPARE);
    const float* ktab = sp + SP_KTAB / 4 + (size_t)lg * KTAB_LG; const float* apow = sp + SP_APOW / 4 + (size_t)lg * APOW_LG; const float* bbar = sp + SP_BBAR / 4 + (size_t)lg * BBAR_LG;
    bf16_t* T = (bf16_t*)(s5m + S5M_T) + (size_t)g * 512 * 640; bf16_t* WE = (bf16_t*)(s5m + S5M_WEND) + (size_t)g * 256 * 512;
    for (int q = tid; q < 64 * 80; q += NTHR) {
        const int rl = q / 80, pc = q % 80, t = 4 * part + (rl >> 4), n = rl & 15, col0 = 8 * pc; float v[8];
        if (col0 < 512) { const int s = col0 >> 4, h0 = col0 & 15;
            if (s <= t) { const f32x4 a = *(const GAS f32x4*)(ktab + (t - s) * 256 + n * 16 + h0), b = *(const GAS f32x4*)(ktab + (t - s) * 256 + n * 16 + h0 + 4);
                v[0] = a.x; v[1] = a.y; v[2] = a.z; v[3] = a.w; v[4] = b.x; v[5] = b.y; v[6] = b.z; v[7] = b.w;
                if (s == t) { const float dn = in.s5d[l * S5W + g * 16 + n];
#pragma unroll
                    for (int j = 0; j < 8; ++j) v[j] += (h0 + j == n) ? dn : 0.f; } }
            else {
#pragma unroll
                for (int j = 0; j < 8; ++j) v[j] = 0.f; } }
        else { const int q0 = col0 - 512, im = q0 >= 64, p0 = q0 & 63;
#pragma unroll
            for (int j = 0; j < 8; ++j) { const int p = p0 + j; const float cr = in.cre[((size_t)lg * 16 + n) * 64 + p], ci = in.cim[((size_t)lg * 16 + n) * 64 + p];
                const f32x2 a = *(const GAS f32x2*)(apow + ((t + 1) * 64 + p) * 2); v[j] = im ? -(cr * a.y + ci * a.x) : (cr * a.x - ci * a.y); } }
        u32x4 w; w.x = pk2(v[0], v[1]); w.y = pk2(v[2], v[3]); w.z = pk2(v[4], v[5]); w.w = pk2(v[6], v[7]);
        *(GAS u32x4*)(T + (size_t)(t * 16 + n) * 640 + col0) = w;
    }
    for (int q = tid; q < 32 * 64; q += NTHR) {
        const int r = 32 * part + (q >> 6), col0 = 8 * (q & 63), s = col0 >> 4, h0 = col0 & 15; float v[8];
        if (r < 128) { const int p = r & 63, im = r >= 64; const f32x2 a = *(const GAS f32x2*)(apow + ((31 - s) * 64 + p) * 2);
#pragma unroll
            for (int j = 0; j < 8; ++j) { const f32x2 b = *(const GAS f32x2*)(bbar + (p * 16 + h0 + j) * 2); v[j] = im ? (a.x * b.y + a.y * b.x) : (a.x * b.x - a.y * b.y); } }
        else {
#pragma unroll
            for (int j = 0; j < 8; ++j) v[j] = 0.f; }
        u32x4 w; w.x = pk2(v[0], v[1]); w.y = pk2(v[2], v[3]); w.z = pk2(v[4], v[5]); w.w = pk2(v[6], v[7]);
        *(GAS u32x4*)(WE + (size_t)r * 512 + col0) = w;
    }
}
struct EpiS5End {
    static constexpr int PROBE_ID = 305; static constexpr bool PERM = false;
    float* SE;
    __device__ __forceinline__ void probe(const f32x4 (&acc)[2][2][4][2], const Unit& u, int ui, int wr, int wc, int fr, int fq) const { (*this)(acc, u, ui, wr, wc, fr, fq); }
    __device__ __forceinline__ void operator()(const f32x4 (&acc)[2][2][4][2], const Unit& u, int ui, int wr, int wc, int fr, int fq) const {
        asm volatile("" : "+v"(fr), "+v"(fq));
#pragma unroll
        for (int ai = 0; ai < 2; ++ai)
#pragma unroll
            for (int m = 0; m < 4; ++m) { const int row = u.pm * BM + ai * HALF + wr * 64 + m * 16 + fr; float* o = SE + ((size_t)u.g * (M / 32) + row) * 128 + wc * 32 + 4 * fq;
#pragma unroll
                for (int n = 0; n < 2; ++n) *(GAS f32x4*)(o + 16 * n) = acc[ai][0][m][n]; }
    }
};
__device__ __forceinline__ f32x2 gelu_pk(f32x2 v) {
    const f32x2 av = __builtin_elementwise_abs(v), d = av * 0.2316418882f + 1.0f;
    f32x2 t; t.x = __builtin_amdgcn_rcpf(d.x); t.y = __builtin_amdgcn_rcpf(d.y);
    f32x2 q = t * 0.5307027145f + (-0.7265760135f); q = q * t + 0.7107068705f; q = q * t + (-0.142248368f); q = q * t + 0.127414796f; q = q * t;
    const f32x2 s = (v * v) * (-0.72134752044f);
    f32x2 e; e.x = __builtin_amdgcn_exp2f(s.x); e.y = __builtin_amdgcn_exp2f(s.y);
    const f32x2 m = v * (q * e), r = v - m;
    f32x2 o; o.x = v.x < 0.f ? m.x : r.x; o.y = v.y < 0.f ? m.y : r.y; return o;
}
struct EpiS5Out {
    static constexpr int PROBE_ID = 306; static constexpr bool PERM = true;
    bf16_t* Z;
    __device__ __forceinline__ void probe(const f32x4 (&acc)[2][2][4][2], const Unit& u, int ui, int wr, int wc, int fr, int fq) const { (*this)(acc, u, ui, wr, wc, fr, fq); }
    __device__ __forceinline__ void operator()(const f32x4 (&acc)[2][2][4][2], const Unit& u, int ui, int wr, int wc, int fr, int fq) const {
        asm volatile("" : "+v"(fr), "+v"(fq));
#pragma unroll
        for (int ai = 0; ai < 2; ++ai)
#pragma unroll
            for (int m = 0; m < 4; ++m) { const int crow = u.pm * BM + ai * HALF + wr * 64 + m * 16 + fr;
#pragma unroll
                for (int bj = 0; bj < 2; ++bj) { const int c = u.pn * BM + bj * HALF + wc * 32 + 8 * fq, t = c >> 4, hf = (c >> 3) & 1;
                    const f32x4 v0 = acc[ai][bj][m][0], v1 = acc[ai][bj][m][1];
                    const f32x2 a = gelu_pk((f32x2){v0.x, v0.y}), b = gelu_pk((f32x2){v0.z, v0.w}), cc = gelu_pk((f32x2){v1.x, v1.y}), dd = gelu_pk((f32x2){v1.z, v1.w});
                    u32x4 w; w.x = cvt_pk(a.x, a.y); w.y = cvt_pk(b.x, b.y); w.z = cvt_pk(cc.x, cc.y); w.w = cvt_pk(dd.x, dd.y);
                    *(GAS u32x4*)(Z + ((size_t)u.g * M + (size_t)crow * 32 + t) * 16 + hf * 8) = w; } }
    }
};
__device__ __forceinline__ void s5_scan_unit(unsigned char* ws, LAS unsigned char* lds, int l, int unit, int wave, int lane) {
    const int b = unit >> 5, g = unit & 31, p = lane, seg = wave, lg = l * S5G + g;
    const float* sp = (const float*)(ws + WS_SPARE);
    const f32x2 a32 = *(const GAS f32x2*)(sp + SP_APOW / 4 + (size_t)lg * APOW_LG + (32 * 64 + p) * 2);
    const float* se = (const float*)(ws + WS_SEND) + ((size_t)g * (M / 32) + b * 256 + seg * 32) * 128;
    LAS f32x2* segT = (LAS f32x2*)lds;
    float tr = 0.f, ti = 0.f;
#pragma unroll 8
    for (int k = 0; k < 32; ++k) { const float xr = se[k * 128 + p], xi = se[k * 128 + 64 + p]; const float nr = a32.x * tr - a32.y * ti + xr, ni = a32.x * ti + a32.y * tr + xi; tr = nr; ti = ni; }
    segT[seg * 64 + p] = (f32x2){tr, ti};
    float Ar = a32.x, Ai = a32.y;
#pragma unroll
    for (int j = 0; j < 5; ++j) { const float nr = Ar * Ar - Ai * Ai, ni = 2.f * Ar * Ai; Ar = nr; Ai = ni; }
    __syncthreads();
    float cr = 0.f, ci = 0.f;
    for (int s = 0; s < seg; ++s) { const f32x2 t2 = segT[s * 64 + p]; const float nr = Ar * cr - Ai * ci + t2.x, ni = Ar * ci + Ai * cr + t2.y; cr = nr; ci = ni; }
    bf16_t* ug = (bf16_t*)(ws + WS_UG) + ((size_t)g * (M / 32) + b * 256 + seg * 32) * 640 + 512;
#pragma unroll 8
    for (int k = 0; k < 32; ++k) { ug[k * 640 + p] = (bf16_t)f2bf(cr); ug[k * 640 + 64 + p] = (bf16_t)f2bf(ci);
        const float xr = se[k * 128 + p], xi = se[k * 128 + 64 + p]; const float nr = a32.x * cr - a32.y * ci + xr, ni = a32.x * ci + a32.y * cr + xi; cr = nr; ci = ni; }
    __syncthreads();
}

typedef short s16x4 __attribute__((ext_vector_type(4)));
__device__ __forceinline__ unsigned rt_f(int row) { return (unsigned)(((row & 3) << 2) | ((row >> 2) & 3)); }
__device__ __forceinline__ unsigned rt_off(int row, int ch) { return 256u * (unsigned)row + 16u * ((unsigned)ch ^ rt_f(row)); }
__device__ __forceinline__ void rt_fill(LAS unsigned char* img, const bf16_t* src  , int wave, int lane) {
#pragma unroll
    for (int j = 0; j < 4; ++j) { const int p = wave * 4 + j, row = 4 * p + (lane >> 4), ch = (lane & 15) ^ (int)rt_f(row);
        __builtin_amdgcn_global_load_lds((const unsigned*)((const char*)src + (size_t)row * 1024 + ch * 16), (LAS unsigned*)(img + p * 1024), 16, 0, 0); }
}
__device__ __forceinline__ s16x4 rt_tr4(LAS const unsigned char* p) { typedef short v4i16_t __attribute__((ext_vector_type(4))); return __builtin_bit_cast(s16x4, __builtin_amdgcn_ds_read_tr16_b64_v4i16((LAS v4i16_t*)p)); }
template <bool KPERM> __device__ __forceinline__ bf16x8 rt_trfrag(LAS const unsigned char* img, int k0, int c, int lane) {
    const int hh = lane >> 5, blk = (lane >> 4) & 1, q = (lane & 15) >> 2, p = lane & 3;
    const int r0 = k0 + (KPERM ? 4 * hh : 8 * hh) + q, r1 = r0 + (KPERM ? 8 : 4), ch = 4 * c + 2 * blk + (p >> 1);
    const s16x4 lo = rt_tr4(img + rt_off(r0, ch) + 8 * (p & 1)), hi = rt_tr4(img + rt_off(r1, ch) + 8 * (p & 1));
    return __builtin_shufflevector(lo, hi, 0, 1, 2, 3, 4, 5, 6, 7);
}
__device__ __forceinline__ bf16x8 rt_rowfrag(LAS const unsigned char* img, int rb, int s, int lane) {
    return *(LAS const bf16x8*)(img + rt_off(32 * rb + (lane & 31), 2 * s + (lane >> 5)));
}
constexpr int RT_Q = 0, RT_K = 32768, RT_V = 65536, RT_R = 98304;
__device__ __forceinline__ float ret_g(int h) { return h == 0 ? 0.017183023570817902f : h == 1 ? 0.1332151628796484f : h == 2 ? 0.3664377159220373f : 0.6059370882290803f; }
__device__ __forceinline__ void rt_kv(f32x16 (&racc)[2], LAS const unsigned char* lds, int wave, int lane) {
    const int eb = wave & 3, db0 = 2 * (wave >> 2);
#pragma unroll
    for (int ks = 0; ks < 8; ++ks) {
        const bf16x8 bv = rt_trfrag<false>(lds + RT_V, 16 * ks, eb, lane);
        const bf16x8 a0 = rt_trfrag<false>(lds + RT_K, 16 * ks, db0, lane), a1 = rt_trfrag<false>(lds + RT_K, 16 * ks, db0 + 1, lane);
        racc[0] = __builtin_amdgcn_mfma_f32_32x32x16_bf16(a0, bv, racc[0], 0, 0, 0);
        racc[1] = __builtin_amdgcn_mfma_f32_32x32x16_bf16(a1, bv, racc[1], 0, 0, 0);
    }
}
template <int KS> __device__ __forceinline__ void rt_kv_step(f32x16 (&racc)[2], unsigned av0, unsigned av1, unsigned ak0, unsigned ak1, unsigned ak2, unsigned ak3) {
    s16x4 v0, v1, k0, k1, k2, k3;
    asm volatile("ds_read_b64_tr_b16 %0, %6 offset:%12\n\tds_read_b64_tr_b16 %1, %7 offset:%12\n\tds_read_b64_tr_b16 %2, %8 offset:%12\n\tds_read_b64_tr_b16 %3, %9 offset:%12\n\t"
                 "ds_read_b64_tr_b16 %4, %10 offset:%12\n\tds_read_b64_tr_b16 %5, %11 offset:%12\n\ts_waitcnt lgkmcnt(0)"
                 : "=&v"(v0), "=&v"(v1), "=&v"(k0), "=&v"(k1), "=&v"(k2), "=&v"(k3) : "v"(av0), "v"(av1), "v"(ak0), "v"(ak1), "v"(ak2), "v"(ak3), "i"(KS * 4096) : "memory");
    const bf16x8 bv = __builtin_shufflevector(v0, v1, 0, 1, 2, 3, 4, 5, 6, 7), a0 = __builtin_shufflevector(k0, k1, 0, 1, 2, 3, 4, 5, 6, 7), a1 = __builtin_shufflevector(k2, k3, 0, 1, 2, 3, 4, 5, 6, 7);
    racc[0] = __builtin_amdgcn_mfma_f32_32x32x16_bf16(a0, bv, racc[0], 0, 0, 0);
    racc[1] = __builtin_amdgcn_mfma_f32_32x32x16_bf16(a1, bv, racc[1], 0, 0, 0);
}
__device__ __forceinline__ unsigned rt_traddr(LAS const unsigned char* img, int c, int t, int lane) {
    const int hh = lane >> 5, blk = (lane >> 4) & 1, q = (lane & 15) >> 2, p = lane & 3;
    return (unsigned)(size_t)img + rt_off(8 * hh + 4 * t + q, 4 * c + 2 * blk + (p >> 1)) + 8 * (p & 1);
}
__device__ __forceinline__ void ret_kvrun_steps(unsigned char* ws, LAS unsigned char* lds, int u0, int nu, int wave) {
    const int total = nu * 4;
#define RT_ISSUE(step) do { const int un_ = u0 + ((step) >> 2), c_ = (step) & 3, bh_ = un_ >> 4, run_ = un_ & 15, b_ = bh_ >> 2, h_ = bh_ & 3; \
        const size_t r_ = ((size_t)b_ * SEQ + run_ * 512 + c_ * 128) * RW + h_ * RDK; LAS unsigned char* bf_ = lds + ((step) & 1) * 65536; const int ln_ = lane_id(); \
        rt_fill(bf_, (const bf16_t*)(ws + WS_K) + r_, wave, ln_); rt_fill(bf_ + 32768, (const bf16_t*)(ws + WS_V) + r_, wave, ln_); } while (0)
    RT_ISSUE(0);
    f32x16 racc[2];
#pragma unroll 1
    for (int step = 0; step < total; ++step) {
        const int unit = u0 + (step >> 2), c = step & 3, h = (unit >> 4) & 3; const float g = (c == 0) ? 0.f : ret_g(h);
        if (step + 1 < total) { RT_ISSUE(step + 1); asm volatile("s_waitcnt vmcnt(8) lgkmcnt(0)\n\ts_barrier" ::: "memory"); }
        else asm volatile("s_waitcnt vmcnt(0) lgkmcnt(0)\n\ts_barrier" ::: "memory");
#pragma unroll
        for (int k = 0; k < 2; ++k)
#pragma unroll
            for (int j = 0; j < 16; ++j) racc[k][j] = (c == 0) ? 0.f : racc[k][j] * g;
        { const int lane = lane_id(); LAS const unsigned char* bf = lds + (step & 1) * 65536;
          const int eb = wave & 3, db0 = 2 * (wave >> 2);
          const unsigned av0 = rt_traddr(bf + 32768, eb, 0, lane), av1 = rt_traddr(bf + 32768, eb, 1, lane);
          const unsigned ak0 = rt_traddr(bf, db0, 0, lane), ak1 = rt_traddr(bf, db0, 1, lane), ak2 = rt_traddr(bf, db0 + 1, 0, lane), ak3 = rt_traddr(bf, db0 + 1, 1, lane);
          rt_kv_step<0>(racc, av0, av1, ak0, ak1, ak2, ak3); rt_kv_step<1>(racc, av0, av1, ak0, ak1, ak2, ak3); rt_kv_step<2>(racc, av0, av1, ak0, ak1, ak2, ak3); rt_kv_step<3>(racc, av0, av1, ak0, ak1, ak2, ak3);
          rt_kv_step<4>(racc, av0, av1, ak0, ak1, ak2, ak3); rt_kv_step<5>(racc, av0, av1, ak0, ak1, ak2, ak3); rt_kv_step<6>(racc, av0, av1, ak0, ak1, ak2, ak3); rt_kv_step<7>(racc, av0, av1, ak0, ak1, ak2, ak3);
          if (c == 3) { float* o = (float*)(ws + WS_KVRUN) + (size_t)unit * 16384 + (size_t)wave * 2048 + lane;
#pragma unroll
            for (int k = 0; k < 2; ++k)
#pragma unroll
                for (int j = 0; j < 16; ++j) o[(k * 16 + j) * 64] = racc[k][j]; } }
        asm volatile("s_waitcnt lgkmcnt(0)\n\ts_barrier" ::: "memory");
    }
    asm volatile("s_waitcnt vmcnt(0)" ::: "memory");
#undef RT_ISSUE
}
__device__ __forceinline__ void ret_scan(unsigned char* ws, int bx, int G, int tid) {
    for (int e2 = bx * NTHR + tid; e2 < NB * RH * 8192; e2 += G * NTHR) {
        const int bh = e2 >> 13, el = (e2 & 8191) * 2, h = bh & 3; float g4 = ret_g(h); g4 *= g4; g4 *= g4;
        const float* kv = (const float*)(ws + WS_KVRUN) + (size_t)bh * 16 * 16384 + el; bf16_t* rs = (bf16_t*)(ws + WS_RSTART) + (size_t)bh * 16 * 16384 + el;
        f32x2 v[15];
#pragma unroll
        for (int r = 0; r < 15; ++r) v[r] = *(const GAS f32x2*)(kv + (size_t)r * 16384);
        float z0 = 0.f; asm volatile("" : "+v"(z0));
        f32x2 s = {z0, z0};
        *(GAS unsigned*)rs = 0u;
#pragma unroll
        for (int r = 0; r < 15; ++r) { s = s * g4 + v[r]; *(GAS unsigned*)(rs + (size_t)(r + 1) * 16384) = pk2(s.x, s.y); }
    }
}
__device__ __forceinline__ void ret_out_unit(unsigned char* ws, LAS unsigned char* lds, const float* gain  , int unit, int wave) {
    const int bh = unit >> 4, run = unit & 15, b = bh >> 2, h = bh & 3; const float g = ret_g(h);
    const size_t row0 = (size_t)b * SEQ + run * 512;
    const int qb = wave & 3, eh = wave >> 2;
    LAS f32x2* exch = (LAS f32x2*)(lds + TAB_OFF);
    f32x16 racc[2];
    { const int lane = lane_id(); const bf16_t* o = (const bf16_t*)(ws + WS_RSTART) + (size_t)unit * 16384 + (size_t)wave * 2048 + lane;
#pragma unroll
      for (int k = 0; k < 2; ++k)
#pragma unroll
        for (int j = 0; j < 16; ++j) racc[k][j] = bf2f(o[(k * 16 + j) * 64]); }
#pragma unroll 1
    for (int c = 0; c < 4; ++c) {
        { const int lane = lane_id();
          rt_fill(lds + RT_Q, (const bf16_t*)(ws + WS_Q) + (row0 + c * 128) * RW + h * RDK, wave, lane);
          rt_fill(lds + RT_K, (const bf16_t*)(ws + WS_K) + (row0 + c * 128) * RW + h * RDK, wave, lane);
          rt_fill(lds + RT_V, (const bf16_t*)(ws + WS_V) + (row0 + c * 128) * RW + h * RDK, wave, lane);
          const int eb = wave & 3, db0 = 2 * (wave >> 2), r = lane & 31, hh = lane >> 5;
#pragma unroll
          for (int k = 0; k < 2; ++k)
#pragma unroll
            for (int q4 = 0; q4 < 4; ++q4) { u32x2 w; w.x = cvt_pk(racc[k][4 * q4] * g, racc[k][4 * q4 + 1] * g); w.y = cvt_pk(racc[k][4 * q4 + 2] * g, racc[k][4 * q4 + 3] * g);
                const int e = 32 * eb + r, d0 = 32 * (db0 + k) + 8 * q4 + 4 * hh;
                *(LAS u32x2*)(lds + RT_R + rt_off(e, d0 >> 3) + 2 * (d0 & 7)) = w; } }
#if defined(PROBE_DUP) && PROBE_DUP == 33
        VM_WAIT(); __syncthreads();
        { const int lane = lane_id();
          rt_fill(lds + RT_Q, (const bf16_t*)(ws + WS_Q) + (row0 + c * 128) * RW + h * RDK, wave, lane);
          rt_fill(lds + RT_K, (const bf16_t*)(ws + WS_K) + (row0 + c * 128) * RW + h * RDK, wave, lane);
          rt_fill(lds + RT_V, (const bf16_t*)(ws + WS_V) + (row0 + c * 128) * RW + h * RDK, wave, lane); }
#endif
        u32x4 gw[4];
        { const int lane = lane_id();
          const bf16_t* gp = (const bf16_t*)(ws + WS_GATE) + (row0 + c * 128 + 32 * qb + (lane >> 3)) * RW + h * RDK + 64 * eh;
#pragma unroll
          for (int j = 0; j < 4; ++j) { const int row = 8 * j + (lane >> 3); gw[j] = *(const GAS u32x4*)(gp + (size_t)(8 * j) * RW + 8 * ((lane & 7) ^ (row & 7))); } }
        VM_WAIT(); __syncthreads();
        {   const int lane = lane_id(), r = lane & 31, hh = lane >> 5;
            bf16x8 bq[8];
#pragma unroll
            for (int s = 0; s < 8; ++s) bq[s] = rt_rowfrag(lds + RT_Q, qb, s, lane);
            f32x16 sacc[4];
#pragma unroll
            for (int kb = 0; kb < 4; ++kb) {
#pragma unroll
                for (int j = 0; j < 16; ++j) sacc[kb][j] = 0.f;
                if (kb <= qb) {
#pragma unroll
                    for (int s = 0; s < 8; ++s) sacc[kb] = __builtin_amdgcn_mfma_f32_32x32x16_bf16(rt_rowfrag(lds + RT_K, kb, s, lane), bq[s], sacc[kb], 0, 0, 0);
                }
            }
#pragma unroll
            for (int kb = 0; kb < 4; ++kb) if (kb == qb) {
#pragma unroll
                for (int j = 0; j < 16; ++j) { const int key = (j & 3) + 8 * (j >> 2) + 4 * hh; sacc[kb][j] = (key <= r) ? sacc[kb][j] : 0.f; } }
            f32x16 oacc[2];
#pragma unroll
            for (int k = 0; k < 2; ++k)
#pragma unroll
                for (int j = 0; j < 16; ++j) oacc[k][j] = 0.f;
#pragma unroll
            for (int kb = 0; kb < 4; ++kb) if (kb <= qb) {
#pragma unroll
                for (int s = 0; s < 2; ++s) { u32x4 w; w.x = cvt_pk(sacc[kb][8 * s + 0], sacc[kb][8 * s + 1]); w.y = cvt_pk(sacc[kb][8 * s + 2], sacc[kb][8 * s + 3]);
                    w.z = cvt_pk(sacc[kb][8 * s + 4], sacc[kb][8 * s + 5]); w.w = cvt_pk(sacc[kb][8 * s + 6], sacc[kb][8 * s + 7]); const bf16x8 bp = __builtin_bit_cast(bf16x8, w);
#pragma unroll
                    for (int k = 0; k < 2; ++k) oacc[k] = __builtin_amdgcn_mfma_f32_32x32x16_bf16(rt_trfrag<true>(lds + RT_V, 32 * kb + 16 * s, 2 * eh + k, lane), bp, oacc[k], 0, 0, 0); } }
#pragma unroll
            for (int s = 0; s < 8; ++s)
#pragma unroll
                for (int k = 0; k < 2; ++k) oacc[k] = __builtin_amdgcn_mfma_f32_32x32x16_bf16(rt_rowfrag(lds + RT_R, 2 * eh + k, s, lane), bq[s], oacc[k], 0, 0, 0);
            float s1 = 0.f, s2 = 0.f;
#pragma unroll
            for (int k = 0; k < 2; ++k)
#pragma unroll
                for (int j = 0; j < 16; ++j) { s1 += oacc[k][j]; s2 += oacc[k][j] * oacc[k][j]; }
            s1 = half_sum(s1); s2 = half_sum(s2);
            if (hh == 0) exch[eh * 128 + 32 * qb + r] = (f32x2){s1, s2};
            __syncthreads();
            const f32x2 e0 = exch[32 * qb + r], e1 = exch[128 + 32 * qb + r];
            const float mu = (e0.x + e1.x) * (1.0f / 128.0f), var = (e0.y + e1.y) * (1.0f / 128.0f) - mu * mu, rstd = 1.0f / sqrtf(var + EPS);
            LAS unsigned char* wb = lds + RT_Q + wave * 4096;
#pragma unroll
            for (int k = 0; k < 2; ++k)
#pragma unroll
                for (int q4 = 0; q4 < 4; ++q4) { const int el = 32 * k + 8 * q4 + 4 * hh; const f32x4 gn = *(const GAS f32x4*)(gain + h * RDK + 64 * eh + el);
                    u32x2 w; w.x = cvt_pk((oacc[k][4 * q4] - mu) * rstd * gn.x, (oacc[k][4 * q4 + 1] - mu) * rstd * gn.y); w.y = cvt_pk((oacc[k][4 * q4 + 2] - mu) * rstd * gn.z, (oacc[k][4 * q4 + 3] - mu) * rstd * gn.w);
                    *(LAS u32x2*)(wb + r * 128 + (((el >> 3) ^ (r & 7)) << 4) + 8 * hh) = w; }
            asm volatile("s_waitcnt lgkmcnt(0)" ::: "memory");
            bf16_t* yp = (bf16_t*)(ws + WS_YMIX) + (row0 + c * 128 + 32 * qb) * D + S5W + h * RDK + 64 * eh;
#if defined(PROBE_DUP) && PROBE_DUP == 35
            for (int rp = 0; rp < 2; ++rp)
#endif
#pragma unroll
            for (int j = 0; j < 4; ++j) { const int row = 8 * j + (lane >> 3), cp = lane & 7; const u32x4 v = *(LAS const u32x4*)(wb + row * 128 + cp * 16), gv = gw[j];
                float y[8];
                y[0] = bflo(v.x) * bflo(gv.x) * fast_sigmoid(bflo(gv.x)); y[1] = bfhi(v.x) * bfhi(gv.x) * fast_sigmoid(bfhi(gv.x)); y[2] = bflo(v.y) * bflo(gv.y) * fast_sigmoid(bflo(gv.y)); y[3] = bfhi(v.y) * bfhi(gv.y) * fast_sigmoid(bfhi(gv.y));
                y[4] = bflo(v.z) * bflo(gv.z) * fast_sigmoid(bflo(gv.z)); y[5] = bfhi(v.z) * bfhi(gv.z) * fast_sigmoid(bfhi(gv.z)); y[6] = bflo(v.w) * bflo(gv.w) * fast_sigmoid(bflo(gv.w)); y[7] = bfhi(v.w) * bfhi(gv.w) * fast_sigmoid(bfhi(gv.w));
                u32x4 w; w.x = cvt_pk(y[0], y[1]); w.y = cvt_pk(y[2], y[3]); w.z = cvt_pk(y[4], y[5]); w.w = cvt_pk(y[6], y[7]);
                *(GAS u32x4*)(yp + (size_t)row * D + 8 * (cp ^ (row & 7))) = w; }
        }
#if defined(PROBE_DUP) && PROBE_DUP == 36
        if (c < 3) { f32x16 r2[2] = {racc[0], racc[1]}; asm volatile("" : "+v"(r2[0]), "+v"(r2[1])); rt_kv(r2, lds, wave, lane_id()); asm volatile("" :: "v"(r2[0]), "v"(r2[1])); }
#endif
        if (c < 3) {
#pragma unroll
            for (int k = 0; k < 2; ++k) racc[k] *= g;
            rt_kv(racc, lds, wave, lane_id());
        }
        __syncthreads();
    }
}

struct Args { In in; float* out; unsigned char* ws; int pro_lo, pro_hi, l_lo, l_hi, ph_lo, ph_hi, flags, region; };
enum { PH_PROJ = 0, PH_MIXA = 1, PH_SCAN = 2, PH_MIXC = 3, PH_GLU = 4, PH_WOUT = 5, PH_CQ = 6, PH_XATT = 7, PH_CO = 8, PH_FFN1 = 9, PH_FFN2 = 10, PH_N = 11 };
enum { FL_XPREP = 1, FL_FINAL = 2, FL_XIN = 4 };

__global__ void __launch_bounds__(NTHR, 2) fwd(Args a) {
    extern __shared__ __attribute__((aligned(16))) unsigned char lds_raw[];
    LAS unsigned char* lds = (LAS unsigned char*)lds_raw;
    const int wave = __builtin_amdgcn_readfirstlane(threadIdx.x >> 6); const bool t0 = (threadIdx.x == 0);
#define LANE lane_id()
    const int G = gridDim.x, bx = blockIdx.x, vcu = (G % 8 == 0) ? (bx % 8) * (G / 8) + bx / 8 : bx;
    volatile LAS unsigned* MISC = (volatile LAS unsigned*)(lds + MISC_OFF);
    if (threadIdx.x < 32) MISC[threadIdx.x] = 0u;
    __syncthreads();
    unsigned char* ws = a.ws;
    unsigned* ctl = (unsigned*)(ws + WS_CTL);
    XcdBarrier bar = xcd_barrier_post(ctl + CW_BAR + a.region * XCD_BAR_WORDS, MISC + 8, t0);
    bool need_bar = false;
#ifndef PROBE_DUP
#define PROBE_DUP -1
#endif
#define REPS(k) ((PROBE_DUP == (k)) ? 2 : 1)
#define SEAM() do { if (need_bar) { xcd_barrier(bar); if (PROBE_DUP == 100) xcd_barrier(bar); } need_bar = true; } while (0)
    const int gw = vcu * NWAVES + wave, NGW = G * NWAVES;
    const In& in = a.in;
    float* ssq = (float*)(ws + WS_SSQ);
    bf16_t* xb = (bf16_t*)(ws + WS_XB);
    LAS float* tab = (LAS float*)(lds + TAB_OFF);
    float* rsm = (float*)(ws + WS_SPARE);

#ifndef STAGGER_TICKS
#define STAGGER_TICKS 0
#endif
#define STAGGER(cond) do { if (STAGGER_TICKS > 0 && (cond)) { const unsigned long long t0_ = __builtin_amdgcn_s_memrealtime(); while (__builtin_amdgcn_s_memrealtime() - t0_ < (unsigned long long)STAGGER_TICKS) __builtin_amdgcn_s_sleep(16); } } while (0)
    for (int rep = 0; rep < REPS(200); ++rep) if (a.pro_lo <= 0 && 0 < a.pro_hi) {
        SEAM();
        pro_weights(in, ws, lds, gw, NGW, wave, LANE);
#if PROBE_DUP == 210
        __syncthreads(); pro_weights(in, ws, lds, gw + (int)(a.flags >> 8), NGW, wave, LANE);
#endif
        for (int r2 = 0; r2 < REPS(211); ++r2) if (a.flags & FL_XIN) xprep_rows(in.x, xb, ssq, gw, NGW, LANE);
        mem_prep_rows(in.mem, (bf16_t*)(ws + WS_MEMB), rsm, gw, NGW, LANE);
        for (int r2 = 0; r2 < REPS(212); ++r2) rope_table(in.pos, (float*)(ws + WS_ROPE), gw * 64 + LANE, NGW * 64);
        __syncthreads();
        for (int r2 = 0; r2 < REPS(213); ++r2) for (int it = bx; it < DEPTH * S5G * 4; it += G) s5_tables_item(in, ws, lds, it, wave, LANE);
        __syncthreads();
    }
    for (int rep = 0; rep < REPS(201); ++rep) if (a.pro_lo <= 1 && 1 < a.pro_hi) {
        SEAM();
        int bxo = bx; asm volatile("" : "+s"(bxo));
        { GroupOrder S; S.init(DEPTH, MROWS / BM, D / BM, G, bxo, 0);
          const Gemm g{(const bf16_t*)(ws + WS_MEMB), (const bf16_t*)(ws + WS_WCK_TMP), D, D, D, 0, (long)D * D};
          const EpiMemK E{(bf16_t*)(ws + WS_MEMK), rsm};
          gemm_phase<EpiMemK, GroupOrder>(lds, g, S, E, wave); }
        { GroupOrder S; S.init(DEPTH, D / BM, MROWS / BM, G, bxo, 64);
          const Gemm g{(const bf16_t*)(ws + WS_WCV_TMP), (const bf16_t*)(ws + WS_MEMB), D, D, D, (long)D * D, 0};
          const EpiMemVT E{(bf16_t*)(ws + WS_MEMVT), rsm};
          gemm_phase<EpiMemVT, GroupOrder>(lds, g, S, E, wave); }
        for (int it = bxo; it < DEPTH * S5G * 8; it += G) s5_build_item(in, ws, (unsigned char*)a.out + (size_t)(it >> 8) * S5M_LAYER, it >> 8, it & 255, wave * 64 + LANE);
    }
    for (int l = a.l_lo; l < a.l_hi; ++l) {
#define IN_PH(k) (a.ph_lo <= (k) && (k) < a.ph_hi)
        for (int rep = 0; rep < REPS(PH_PROJ); ++rep) if (IN_PH(PH_PROJ)) {
            SEAM();
            int bxo = bx; asm volatile("" : "+s"(bxo));
            StaticOrder S; S.init(M / BM, INW / BM, G, bxo);
            rstd_table(tab, S, ssq, 16, 1.0f / D, wave);
            const Gemm g{xb, wl(ws, l, W_IN), D, D, D, 0, 0};
            const EpiProj E{(bf16_t*)(ws + WS_UG), (bf16_t*)(ws + WS_Q), (bf16_t*)(ws + WS_K), (bf16_t*)(ws + WS_V), (bf16_t*)(ws + WS_GATE), (const float*)(ws + WS_ROPE), tab};
            gemm_phase<EpiProj, StaticOrder>(lds, g, S, E, wave);
        }
        for (int rep = 0; rep < REPS(PH_MIXA); ++rep) if (IN_PH(PH_MIXA)) {
            SEAM();
            int bxo = bx; asm volatile("" : "+s"(bxo));
            if (G == 256) {
                if (bxo < 128) { GroupOrder S; S.init(S5G, (M / 32) / BM, 1, G, bxo, 0);
                  const Gemm g{(const bf16_t*)(ws + WS_UG), (const bf16_t*)((unsigned char*)a.out + (size_t)l * S5M_LAYER + S5M_WEND), 640, 512, 512, (long)(M / 32) * 640, 256L * 512};
                  const EpiS5End E{(float*)(ws + WS_SEND)};
                  gemm_phase<EpiS5End, GroupOrder>(lds, g, S, E, wave); }
                else ret_kvrun_steps(ws, lds, 2 * (bxo - 128), 2, wave);
            } else {
                { GroupOrder S; S.init(S5G, (M / 32) / BM, 1, G, bxo, 0);
                  const Gemm g{(const bf16_t*)(ws + WS_UG), (const bf16_t*)((unsigned char*)a.out + (size_t)l * S5M_LAYER + S5M_WEND), 640, 512, 512, (long)(M / 32) * 640, 256L * 512};
                  const EpiS5End E{(float*)(ws + WS_SEND)};
                  gemm_phase<EpiS5End, GroupOrder>(lds, g, S, E, wave); }
                __syncthreads();
                for (int u = bxo; u < NB * RH * 16; u += G) ret_kvrun_steps(ws, lds, u, 1, wave);
            }
        }
        for (int rep = 0; rep < REPS(PH_SCAN); ++rep) if (IN_PH(PH_SCAN)) {
            SEAM();
            for (int u = bx; u < NB * S5G; u += G) s5_scan_unit(ws, lds, l, u, wave, LANE);
            ret_scan(ws, bx, G, wave * 64 + LANE);
        }
        for (int rep = 0; rep < REPS(PH_MIXC); ++rep) if (IN_PH(PH_MIXC)) {
            SEAM();
            int bxo = bx; asm volatile("" : "+s"(bxo));
            for (int r2 = 0; r2 < REPS(31); ++r2)
            { GroupOrder S; S.init(S5G, (M / 32) / BM, 2, G, bxo, 0);
              const Gemm g{(const bf16_t*)(ws + WS_UG), (const bf16_t*)((unsigned char*)a.out + (size_t)l * S5M_LAYER + S5M_T), 640, 640, 640, (long)(M / 32) * 640, 512L * 640};
              const EpiS5Out E{(bf16_t*)(ws + WS_Z)};
              gemm_phase<EpiS5Out, GroupOrder>(lds, g, S, E, wave); }
            __syncthreads();
            for (int r2 = 0; r2 < REPS(32); ++r2)
            for (int u = bxo; u < NB * RH * 16; u += G) ret_out_unit(ws, lds, in.retn + l * RW, u, wave);
        }
        for (int rep = 0; rep < REPS(PH_GLU); ++rep) if (IN_PH(PH_GLU)) {
            SEAM();
            int bxo = bx; asm volatile("" : "+s"(bxo));
            StaticOrder S; S.init(M / BM, S5W / BM, G, bxo);
            const Gemm g{(const bf16_t*)(ws + WS_Z), wl(ws, l, W_GLU), S5W, S5W, S5W, 0, 0, M};
            const EpiGlu E{(const bf16_t*)(ws + WS_Z), in.bglu + l * S5W, (bf16_t*)(ws + WS_YMIX), (float*)(ws + WS_SSQS)};
            gemm_phase<EpiGlu, StaticOrder>(lds, g, S, E, wave);
        }
        for (int rep = 0; rep < REPS(PH_WOUT); ++rep) if (IN_PH(PH_WOUT)) {
            SEAM();
            int bxo = bx; asm volatile("" : "+s"(bxo));
            StaticOrder S; S.init(M / BM, D / BM, G, bxo);
            LAS float* tab2 = (LAS float*)(lds + TAB2_OFF);
            rstd_table(tab2, S, (const float*)(ws + WS_SSQS), 8, 1.0f / S5W, wave);
            const Gemm g{(const bf16_t*)(ws + WS_YMIX), wl(ws, l, W_OUT), D, D, D, 0, 0};
            const EpiResHook E{{xb, ssq, nullptr, (REPS(PH_WOUT) == 2 && rep == 0) ? 0.f : 1.f}, tab2, 8};
            gemm_phase<EpiResHook, StaticOrder, true>(lds, g, S, E, wave);
        }
        for (int rep = 0; rep < REPS(PH_CQ); ++rep) if (IN_PH(PH_CQ)) {
            SEAM();
            int bxo = bx; asm volatile("" : "+s"(bxo));
            StaticOrder S; S.init(M / BM, D / BM, G, bxo);
            rstd_table(tab, S, ssq, 16, 1.0f / D, wave);
            const Gemm g{xb, wl(ws, l, W_CQ), D, D, D, 0, 0};
            const EpiScaleBf16 E{(bf16_t*)(ws + WS_QC), D, tab};
            gemm_phase<EpiScaleBf16, StaticOrder>(lds, g, S, E, wave);
#pragma unroll 1
            for (int i = 0; i < 2; ++i) { Unit u; if (!S.next(i, u)) break;
                const int upm = __builtin_amdgcn_readfirstlane(u.pm), upn = __builtin_amdgcn_readfirstlane(u.pn);
                xattn_unit(lds, (const bf16_t*)(ws + WS_QC), (const bf16_t*)(ws + WS_MEMK) + (size_t)l * MROWS * D, (const bf16_t*)(ws + WS_MEMVT) + (size_t)l * D * MROWS, (bf16_t*)(ws + WS_OC), upm >> 5, upn, upm & 31, wave); }
        }
        for (int rep = 0; rep < REPS(PH_CO); ++rep) if (IN_PH(PH_CO)) {
            SEAM();
            int bxo = bx; asm volatile("" : "+s"(bxo));
            StaticOrder S; S.init(M / BM, D / BM, G, bxo);
            const Gemm g{(const bf16_t*)(ws + WS_OC), wl(ws, l, W_CO), D, D, D, 0, 0};
            const EpiRes E{xb, ssq, nullptr, (REPS(PH_CO) == 2 && rep == 0) ? 0.f : 1.f};
            gemm_phase<EpiRes, StaticOrder>(lds, g, S, E, wave);
        }
        for (int rep = 0; rep < REPS(PH_FFN1); ++rep) if (IN_PH(PH_FFN1)) {
            SEAM();
            int bxo = bx; asm volatile("" : "+s"(bxo));
            StaticOrder S; S.init(M / BM, (2 * FF) / BM, G, bxo);
            rstd_table(tab, S, ssq, 16, 1.0f / D, wave);
            const Gemm g{xb, wl(ws, l, W_GU), D, D, D, 0, 0};
            const EpiFfn1 E{(bf16_t*)(ws + WS_HID), tab};
            STAGGER((bx >> 3) & 1);
            gemm_phase<EpiFfn1, StaticOrder>(lds, g, S, E, wave);
        }
        for (int rep = 0; rep < REPS(PH_FFN2); ++rep) if (IN_PH(PH_FFN2)) {
            SEAM();
            int bxo = bx; asm volatile("" : "+s"(bxo));
            StaticOrder S; S.init(M / BM, D / BM, G, bxo);
            const Gemm g{(const bf16_t*)(ws + WS_HID), wl(ws, l, W_DN), FF, FF, FF, 0, 0};
            const EpiRes E{xb, ssq, nullptr, (REPS(PH_FFN2) == 2 && rep == 0) ? 0.f : 1.f};
            gemm_phase<EpiRes, StaticOrder>(lds, g, S, E, wave);
        }
    }
    if (a.flags & FL_FINAL) { SEAM(); final_norm_rows(xb, a.out, in.norm_final, gw, NGW, LANE); }
#undef IN_PH
#undef SEAM
#undef LANE
}
}

extern "C" void kernel_launch(void* const* d_in, const int* in_sizes, int n_in, void* d_out, int out_size, void* d_ws, size_t ws_size, hipStream_t stream) {
    static int grid = 0;
    if (grid == 0) {
        if (n_in != 29 || out_size != mk::M * mk::D || ws_size < mk::WS_END) { fprintf(stderr, "kernel_launch: unexpected sizes (n_in %d out %d ws %zu)\n", n_in, out_size, ws_size); grid = -1; return; }
        int dev = 0, cus = 0, per_cu = 0;
        if (hipGetDevice(&dev) != hipSuccess || hipDeviceGetAttribute(&cus, hipDeviceAttributeMultiprocessorCount, dev) != hipSuccess) { grid = -1; return; }
        if (hipFuncSetAttribute((const void*)mk::fwd, hipFuncAttributeMaxDynamicSharedMemorySize, mk::LDS_BYTES) != hipSuccess) { fprintf(stderr, "kernel_launch: hipFuncSetAttribute failed\n"); grid = -1; return; }
        if (hipOccupancyMaxActiveBlocksPerMultiprocessor(&per_cu, (const void*)mk::fwd, mk::NTHR, mk::LDS_BYTES) != hipSuccess || per_cu < 1) fprintf(stderr, "kernel_launch: occupancy query says %d\n", per_cu);
        (void)hipGetLastError();
        grid = cus;
    }
    if (grid < 0) return;
    (void)in_sizes;
    if (hipMemsetAsync((char*)d_ws + mk::WS_CTL, 0, mk::CTL_ZERO_BYTES, stream) != hipSuccess) return;
    mk::Args a{};
    { const void** p = (const void**)&a.in; for (int i = 0; i < 29; ++i) p[i] = d_in[i]; }
    a.out = (float*)d_out; a.ws = (unsigned char*)d_ws;
    a.pro_lo = 0; a.pro_hi = 2; a.l_lo = 0; a.l_hi = mk::DEPTH; a.ph_lo = 0; a.ph_hi = mk::PH_N; a.flags = mk::FL_XIN | mk::FL_FINAL; a.region = 0;
    hipLaunchKernelGGL(mk::fwd, dim3(grid), dim3(mk::NTHR), mk::LDS_BYTES, stream, a);
    const hipError_t le = hipPeekAtLastError();
    if (le != hipSuccess) fprintf(stderr, "kernel_launch: launch failed: %s\n", hipGetErrorName(le));
}
```

```cpp
#include <hip/hip_runtime.h>
#include <cstdio>
#include <cstdint>
#include <cmath>

namespace mk {
#define LAS __attribute__((address_space(3)))
#define GAS __attribute__((address_space(1)))
typedef unsigned short bf16_t;
typedef short bf16x8 __attribute__((ext_vector_type(8)));
typedef float f32x4 __attribute__((ext_vector_type(4)));
typedef float f32x2 __attribute__((ext_vector_type(2)));
typedef float f32x16 __attribute__((ext_vector_type(16)));
typedef unsigned u32x4 __attribute__((ext_vector_type(4)));
typedef unsigned u32x2 __attribute__((ext_vector_type(2)));
constexpr int M = 32768, D = 1024, NB = 4, SEQ = 8192, DEPTH = 4, MEML = 256, MROWS = NB * MEML;
constexpr int S5W = 512, S5G = 32, S5P = 64, RH = 4, RDK = 128, RW = 512, INW = 2560, XH = 4, XD = 256, FF = 2816;
constexpr float EPS = 1e-6f;
constexpr int BM = 256, BK = 64, HALF = 128, HTB = HALF * BK * 2, STAGE_BYTES = 8 * HTB, NXCD = 8, WGM = 8;
constexpr int NWAVES = 8, NTHR = 512;

constexpr int TAB_OFF = STAGE_BYTES;
constexpr int TAB2_OFF = TAB_OFF + 12288;
constexpr int MISC_OFF = TAB2_OFF + 2048;
constexpr int LDS_BYTES = 147456;
static_assert(MISC_OFF + 128 <= LDS_BYTES, "lds map");

constexpr size_t MiB = 1u << 20;
constexpr size_t WS_CTL = 0, CTL_ZERO_BYTES = 1 * MiB;
constexpr size_t WS_SSQ = 1 * MiB;
constexpr size_t WS_SSQS = 3 * MiB;
constexpr size_t WS_W = 4 * MiB, W_LAYER = 28 * MiB;
constexpr size_t W_IN = 0, W_GLU = 5 * MiB, W_OUT = W_GLU + MiB / 2, W_CQ = W_OUT + 2 * MiB, W_CO = W_CQ + 2 * MiB, W_GU = W_CO + 2 * MiB, W_DN = W_GU + 11 * MiB;
static_assert(W_DN + 11 * MiB / 2 == W_LAYER, "weights");
constexpr size_t WS_ROPE = 116 * MiB;
constexpr size_t WS_MEMK = 132 * MiB;
constexpr size_t WS_MEMVT = 140 * MiB;
constexpr size_t WS_S5M = 148 * MiB;
constexpr size_t WS_XB = 176 * MiB;
constexpr size_t WS_PROJ = 240 * MiB;
constexpr size_t WS_UG = WS_PROJ, WS_Q = WS_PROJ + 40 * MiB, WS_K = WS_Q + 32 * MiB, WS_V = WS_K + 32 * MiB, WS_GATE = WS_V + 32 * MiB;
constexpr size_t WS_Z = 408 * MiB;
constexpr size_t WS_YMIX = 440 * MiB;
constexpr size_t WS_SPARE = 504 * MiB;
constexpr size_t WS_QC = WS_PROJ, WS_OC = WS_PROJ + 64 * MiB, WS_HID = WS_PROJ;
constexpr size_t WS_WCK_TMP = WS_PROJ, WS_WCV_TMP = WS_PROJ + 8 * MiB, WS_MEMB = WS_PROJ + 16 * MiB;
constexpr size_t WS_END = 512 * MiB;
constexpr int CW_BAR = 4096, XB_WORDS = 3456, N_BAR_REGIONS = 64;
static_assert((CW_BAR + N_BAR_REGIONS * XB_WORDS) * 4 <= (int)CTL_ZERO_BYTES, "ctl");

__host__ __device__ __forceinline__ int lds_byte(int r, int c) { const int st = (r >> 4) * 2 + (c >> 5), rr = r & 15, cc = c & 31, ob = rr * 64 + cc * 2; return st * 1024 + (ob ^ (((ob >> 9) & 1) << 5)); }
__host__ __device__ __forceinline__ void stage_rc(int b, int& R, int& C) { const int st = b / 1024, sb = b % 1024, swz = sb ^ (((sb >> 9) & 1) << 5); R = (st >> 1) * 16 + swz / 64; C = (st & 1) * 32 + (swz % 64) / 2; }
__host__ __device__ __forceinline__ int perm32(int rho) { const int n = rho >> 4, i = rho & 15; return 8 * (i >> 2) + 4 * n + (i & 3); }

struct Unit { int pm, pn, g; };
struct Gemm { const bf16_t* A; const bf16_t* Bt; int lda, ldb, K; long a_gs, b_gs; int a_g16; int probe_same; };

struct StaticOrder {
    int nM, nN, nwg, G, c;
    __device__ __forceinline__ void init(int nM_, int nN_, int G_, int c_) { nM = nM_; nN = nN_; nwg = nM * nN; G = G_; c = c_; }
    __device__ __forceinline__ bool next(int i, Unit& u) const {
        const long L = (long)i * G + c; if (L >= nwg) return false;
        int wgid = (int)L; { const int q = nwg / NXCD, r = nwg % NXCD, xcd = wgid % NXCD, off = wgid / NXCD; wgid = (xcd < r ? xcd * (q + 1) : r * (q + 1) + (xcd - r) * q) + off; }
        const int nig = WGM * nN, gid = wgid / nig, fm = gid * WGM, gsz = (nM - fm) < WGM ? (nM - fm) : WGM;
        u.pm = fm + ((wgid % nig) % gsz); u.pn = (wgid % nig) / gsz; u.g = 0; return true;
    }
};
struct GroupOrder {
    int nM, nN, nG, G, c, first;
    __device__ __forceinline__ void init(int nG_, int nM_, int nN_, int G_, int c_, int first_) { nG = nG_; nM = nM_; nN = nN_; G = G_; c = c_; first = first_; }
    __device__ __forceinline__ bool next(int i, Unit& u) const {
        const long L = (long)i * G + c - first; if (L < 0 || L >= (long)nG * nM * nN) return false;
        u.pn = (int)(L % nN); const int r = (int)(L / nN); u.pm = r % nM; u.g = r / nM; return true;
    }
};

__device__ __forceinline__ unsigned f2bf(float f) { unsigned u = __builtin_bit_cast(unsigned, f); return (u + 0x7fffu + ((u >> 16) & 1u)) >> 16; }
__device__ __forceinline__ unsigned pk2(float lo, float hi) { return f2bf(lo) | (f2bf(hi) << 16); }
__device__ __forceinline__ unsigned cvt_pk(float lo, float hi) { unsigned r; asm volatile("v_cvt_pk_bf16_f32 %0, %1, %2" : "=v"(r) : "v"(lo), "v"(hi)); return r; }
__device__ __forceinline__ float bf2f(unsigned short b) { return __builtin_bit_cast(float, ((unsigned)b) << 16); }
__device__ __forceinline__ float bflo(unsigned w) { return __builtin_bit_cast(float, w << 16); }
__device__ __forceinline__ float bfhi(unsigned w) { return __builtin_bit_cast(float, w & 0xffff0000u); }
__device__ __forceinline__ float fast_sigmoid(float x) { return __builtin_amdgcn_rcpf(1.0f + __builtin_amdgcn_exp2f(-1.4426950408889634f * x)); }
template <int O> __device__ __forceinline__ float swz_xor(float v) { return __builtin_bit_cast(float, __builtin_amdgcn_ds_swizzle(__builtin_bit_cast(int, v), (O << 10) | 0x1f)); }
__device__ __forceinline__ float half_sum(float v) { const unsigned u = __builtin_bit_cast(unsigned, v); auto r = __builtin_amdgcn_permlane32_swap(u, u, false, false);
    return __builtin_bit_cast(float, (unsigned)r[0]) + __builtin_bit_cast(float, (unsigned)r[1]); }
__device__ __forceinline__ float half_max(float v) { const unsigned u = __builtin_bit_cast(unsigned, v); auto r = __builtin_amdgcn_permlane32_swap(u, u, false, false);
    return fmaxf(__builtin_bit_cast(float, (unsigned)r[0]), __builtin_bit_cast(float, (unsigned)r[1])); }
__device__ __forceinline__ float wave_sum(float v) { v += swz_xor<1>(v); v += swz_xor<2>(v); v += swz_xor<4>(v); v += swz_xor<8>(v); v += swz_xor<16>(v); return half_sum(v); }

__device__ __forceinline__ int lane_id() { unsigned z = 0u; asm volatile("" : "+v"(z)); return (int)__builtin_amdgcn_mbcnt_hi(~0u, __builtin_amdgcn_mbcnt_lo(~0u, z)); }
template <class Epi, class Sched, bool HOOK = false>
__device__ __forceinline__ void gemm_phase(LAS unsigned char* lds, const Gemm g, const Sched& S, const Epi& E, int wid) {
    const int lane = lane_id(), tid = wid * 64 + lane, wr = wid >> 2, wc = wid & 3, fr = lane & 15, fq = lane >> 4;
    const int nt = g.K / BK;
    unsigned voffA[2], voffB[2];
#pragma unroll
    for (int i = 0; i < 2; ++i) { int R, C; stage_rc(tid * 16 + i * 8192, R, C); const int Rb = Epi::PERM ? ((R & ~31) + perm32(R & 31)) : R;
        voffA[i] = g.a_g16 ? (unsigned)(((C >> 4) * g.a_g16 + R) * 16 + (C & 15)) * 2u : (unsigned)(R * g.lda + C) * 2u; voffB[i] = (unsigned)(Rb * g.ldb + C) * 2u; }
    const size_t kstep = (size_t)(BK * 2);
    const size_t kstepA = g.a_g16 ? (size_t)g.a_g16 * 128 : kstep;
    const size_t hstepA = g.a_g16 ? (size_t)HALF * 32 : (size_t)HALF * g.lda * 2, hstepB = (size_t)HALF * g.ldb * 2;
    const unsigned ldsw = (unsigned)wid * 1024u;
    const int aoff = lds_byte(wr * 64 + fr, fq * 8), boff = lds_byte(wc * 32 + fr, fq * 8);
#define PG8_SA(b, h) (((b) * 2 + (h)) * HTB)
#define PG8_SB(b, h) ((4 + (b) * 2 + (h)) * HTB)
#define PG8_STAGE(bufoff, gbase, voff) do { _Pragma("unroll") for (int _i = 0; _i < 2; ++_i) \
        __builtin_amdgcn_global_load_lds((const unsigned*)((const char*)(gbase) + (voff)[_i]), (LAS unsigned*)(lds + (bufoff) + ldsw + _i * 8192), 16, 0, 0); } while (0)
#define PG8_LDA(dst, b, h) do { _Pragma("unroll") for (int m = 0; m < 4; ++m) _Pragma("unroll") for (int k = 0; k < 2; ++k) dst[m][k] = *(const LAS bf16x8*)(lds + PG8_SA(b, h) + aoff + m * 2048 + k * 1024); } while (0)
#define PG8_LDB(dst, b, h) do { _Pragma("unroll") for (int n = 0; n < 2; ++n) _Pragma("unroll") for (int k = 0; k < 2; ++k) dst[n][k] = *(const LAS bf16x8*)(lds + PG8_SB(b, h) + boff + n * 2048 + k * 1024); } while (0)
#define PG8_MMA(ai, bj, At, Bt) do { __builtin_amdgcn_s_setprio(1); _Pragma("unroll") for (int m = 0; m < 4; ++m) _Pragma("unroll") for (int n = 0; n < 2; ++n) _Pragma("unroll") for (int k = 0; k < 2; ++k) \
        acc[ai][bj][m][n] = __builtin_amdgcn_mfma_f32_16x16x32_bf16(Bt[n][k], At[m][k], acc[ai][bj][m][n], 0, 0, 0); __builtin_amdgcn_s_setprio(0); } while (0)
#define PG8_WAIT_V(n) asm volatile("s_waitcnt vmcnt(" #n ")" ::: "memory")
#define PG8_WAIT_L(n) asm volatile("s_waitcnt lgkmcnt(" #n ")" ::: "memory")
#define PG8_BAR __builtin_amdgcn_s_barrier()
#define PG8_SCHED __builtin_amdgcn_sched_barrier(0)
#define PG8_ABASE(u) ((const char*)g.A + ((size_t)(u).g * g.a_gs + (size_t)(g.probe_same ? 0 : (u).pm) * BM * (g.a_g16 ? 16 : g.lda)) * 2)
#define PG8_BBASE(u) ((const char*)g.Bt + ((size_t)(u).g * g.b_gs + (size_t)(g.probe_same ? 0 : (u).pn) * BM * g.ldb) * 2)
    Unit cur, nxt; int ui = 0;
    if (!S.next(0, cur)) return;
    f32x4 acc[2][2][4][2];
#pragma unroll
    for (int a = 0; a < 2; ++a)
#pragma unroll
        for (int b = 0; b < 2; ++b)
#pragma unroll
            for (int m = 0; m < 4; ++m)
#pragma unroll
                for (int n = 0; n < 2; ++n) acc[a][b][m][n] = (f32x4){0.f, 0.f, 0.f, 0.f};
    bf16x8 At[4][2], B0[2][2], B1[2][2];
    const char* cA = PG8_ABASE(cur); const char* cB = PG8_BBASE(cur);
    PG8_STAGE(PG8_SB(0, 0), cB, voffB); PG8_STAGE(PG8_SB(0, 1), cB + hstepB, voffB); PG8_STAGE(PG8_SA(0, 0), cA, voffA); PG8_STAGE(PG8_SA(0, 1), cA + hstepA, voffA);
    if (wr == 1) PG8_BAR;
    PG8_WAIT_V(2); PG8_BAR;
    PG8_STAGE(PG8_SB(1, 0), cB + kstep, voffB); PG8_STAGE(PG8_SA(1, 0), cA + kstepA, voffA); PG8_STAGE(PG8_SB(1, 1), cB + hstepB + kstep, voffB);
    PG8_WAIT_V(6); PG8_BAR;
    for (;;) {
        const bool has_next = S.next(ui + 1, nxt);
        const char* nA = has_next ? PG8_ABASE(nxt) : cA; const char* nB = has_next ? PG8_BBASE(nxt) : cB;
        for (int t = 0; t < nt; t += 2) {
            const bool last = (t == nt - 2);
            const char* a1 = cA + (size_t)(t + 1) * kstepA;
            const char* a2 = last ? nA : cA + (size_t)(t + 2) * kstepA; const char* b2 = last ? nB : cB + (size_t)(t + 2) * kstep;
            const char* a3 = a2 + kstepA; const char* b3 = b2 + kstep;
            if constexpr (HOOK) { if (t == E.hook_t) E.hook(acc, ui, wr, fr); }
            PG8_LDB(B0, 0, 0); PG8_LDB(B1, 0, 1); PG8_SCHED; PG8_LDA(At, 0, 0); PG8_STAGE(PG8_SA(1, 1), a1 + hstepA, voffA);
            PG8_WAIT_V(8); PG8_WAIT_L(0); PG8_BAR; PG8_MMA(0, 0, At, B0); PG8_MMA(0, 1, At, B1); PG8_BAR; PG8_SCHED;
            PG8_LDA(At, 0, 1); PG8_STAGE(PG8_SB(0, 0), b2, voffB); PG8_STAGE(PG8_SB(0, 1), b2 + hstepB, voffB); PG8_STAGE(PG8_SA(0, 0), a2, voffA);
            PG8_WAIT_V(8); PG8_WAIT_L(0); PG8_BAR; PG8_MMA(1, 0, At, B0); PG8_MMA(1, 1, At, B1); PG8_BAR; PG8_SCHED;
            PG8_LDB(B0, 1, 0); PG8_LDB(B1, 1, 1); PG8_SCHED; PG8_LDA(At, 1, 0); PG8_STAGE(PG8_SA(0, 1), a2 + hstepA, voffA);
            PG8_WAIT_V(8); PG8_WAIT_L(0); PG8_BAR; PG8_MMA(0, 0, At, B0); PG8_MMA(0, 1, At, B1); PG8_BAR; PG8_SCHED;
            PG8_LDA(At, 1, 1); PG8_STAGE(PG8_SB(1, 0), b3, voffB); PG8_STAGE(PG8_SB(1, 1), b3 + hstepB, voffB); PG8_STAGE(PG8_SA(1, 0), a3, voffA);
            PG8_WAIT_V(8); PG8_WAIT_L(0); PG8_BAR; PG8_MMA(1, 0, At, B0); PG8_MMA(1, 1, At, B1); PG8_BAR; PG8_SCHED;
        }
#ifndef NO_ALIGN_EPI
        if (wr == 0) PG8_BAR;
#endif
#if defined(PROBE_DUP) && PROBE_DUP >= 300 && PROBE_DUP < 310
        if (PROBE_DUP == 300 || PROBE_DUP == Epi::PROBE_ID) E.probe(acc, cur, ui, wr, wc, fr, fq);
#endif
        E(acc, cur, ui, wr, wc, fr, fq);
        if (!has_next) break;
#pragma unroll
        for (int a = 0; a < 2; ++a)
#pragma unroll
            for (int b = 0; b < 2; ++b)
#pragma unroll
                for (int m = 0; m < 4; ++m)
#pragma unroll
                    for (int n = 0; n < 2; ++n) acc[a][b][m][n] = (f32x4){0.f, 0.f, 0.f, 0.f};
        cur = nxt; cA = nA; cB = nB; ++ui;
#ifndef NO_ALIGN_EPI
        if (wr == 1) PG8_BAR;
#endif
    }
    PG8_WAIT_V(0);
#ifdef NO_ALIGN_EPI
    if (wr == 0) PG8_BAR;
#endif
    PG8_BAR;
#undef PG8_SA
#undef PG8_SB
#undef PG8_STAGE
#undef PG8_LDA
#undef PG8_LDB
#undef PG8_MMA
#undef PG8_WAIT_V
#undef PG8_WAIT_L
#undef PG8_BAR
#undef PG8_SCHED
#undef PG8_ABASE
#undef PG8_BBASE
}
typedef GAS unsigned gu32;
#define VM_WAIT() asm volatile("s_waitcnt vmcnt(0)" ::: "memory")
#define LDS_WAIT() asm volatile("s_waitcnt lgkmcnt(0)" ::: "memory")
#define XB_TMO      128
#define XB_XCNT(j)  (256  + 64 * (j))
#define XB_XSUB(j)  (1280 + 64 * (j))
#define XB_XGEN(j)  (2304 + 64 * (j))
#define XB_TOP      3328
#define XB_TOPGEN   3392
#define XCD_BAR_WORDS 3456
#define XB_SPIN_CAP (1u << 18)

__device__ __forceinline__ unsigned xb_ld(unsigned* p)              { return __hip_atomic_load(p, __ATOMIC_RELAXED, __HIP_MEMORY_SCOPE_AGENT); }
__device__ __forceinline__ unsigned xb_add(unsigned* p, unsigned v) { return __hip_atomic_fetch_add(p, v, __ATOMIC_RELAXED, __HIP_MEMORY_SCOPE_AGENT); }
__device__ __forceinline__ unsigned xb_xcc_id() { return (unsigned)__builtin_amdgcn_s_getreg((3 << 11) | 20) & 0xFu; }
#define XB_SPIN(cond, bar) do { unsigned _sp = 0; while (cond) { __builtin_amdgcn_s_sleep(1); \
    if ((++_sp & 255u) == 0u) { if (xb_ld(&(bar)[XB_TMO])) break; if (_sp > XB_SPIN_CAP) { atomicAdd(&(bar)[XB_TMO], 1u); break; } } } } while (0)

struct XcdBarrier {
    unsigned* bar; unsigned x;
    bool t0; volatile LAS unsigned* st;
};

__device__ __forceinline__ XcdBarrier xcd_barrier_post(unsigned* bar, volatile LAS unsigned* st, bool t0) {
    XcdBarrier b; b.bar = bar; b.x = xb_xcc_id(); b.st = st; b.t0 = t0;
    if (t0) (void)xb_add(&bar[XB_XCNT(b.x)], 1u);
    return b;
}
__device__ __forceinline__ void xcd_barrier_complete(unsigned* bar, unsigned x, unsigned& nloc, unsigned& nx) {
    const unsigned G = gridDim.x * gridDim.y * gridDim.z;
    unsigned sum, cnt, mine, sp = 0u;
    for (;;) {
        sum = 0u; cnt = 0u; mine = 0u;
#pragma unroll
        for (unsigned j = 0; j < 16; ++j) { const unsigned c = xb_ld(&bar[XB_XCNT(j)]); sum += c; cnt += (c > 0u) ? 1u : 0u; mine = (j == x) ? c : mine; }
        if (sum == G) break;
        __builtin_amdgcn_s_sleep(1);
        if ((++sp & 255u) == 0u) { if (xb_ld(&bar[XB_TMO])) break; if (sp > XB_SPIN_CAP) { atomicAdd(&bar[XB_TMO], 1u); break; } }
    }
    nloc = mine > 0u ? mine : 1u; nx = cnt > 0u ? cnt : 1u;
}

__device__ __forceinline__ void xcd_barrier(const XcdBarrier& b) {
    asm volatile("s_waitcnt vmcnt(0)" ::: "memory");
    __syncthreads();
    if (b.t0) {
        unsigned* bar = b.bar;
        __builtin_amdgcn_s_waitcnt(0);
        unsigned nloc = b.st[0], nx = b.st[1];
        if (nloc == 0u) { xcd_barrier_complete(bar, b.x, nloc, nx); b.st[0] = nloc; b.st[1] = nx; }
        const unsigned old = xb_add(&bar[XB_XSUB(b.x)], 1u);
        const unsigned gen = old / nloc;
        if (old + 1u == (gen + 1u) * nloc) {
            __builtin_amdgcn_fence(__ATOMIC_RELEASE, "agent");
            asm volatile("s_waitcnt vmcnt(0)" ::: "memory");
            const unsigned og = xb_add(&bar[XB_TOP], 1u);
            const unsigned tg = og / nx;
            if (og + 1u == (tg + 1u) * nx) xb_add(&bar[XB_TOPGEN], 1u);
            else XB_SPIN(xb_ld(&bar[XB_TOPGEN]) == tg, bar);
            __builtin_amdgcn_fence(__ATOMIC_ACQUIRE, "agent");
            xb_add(&bar[XB_XGEN(b.x)], 1u);
            asm volatile("s_waitcnt vmcnt(0)" ::: "memory");
        } else {
            XB_SPIN(xb_ld(&bar[XB_XGEN(b.x)]) == gen, bar);
            __builtin_amdgcn_fence(__ATOMIC_ACQUIRE, "agent");
            asm volatile("s_waitcnt vmcnt(0)" ::: "memory");
        }
    }
    __syncthreads();
}
template <int MAPK>
__device__ __forceinline__ void tr_item(const float* W, int K, int N, bf16_t* WT, const float* gain, int gain_lim, float scale, LAS float* scr, int item, int lane) {
    const int nblk = N / 32, kb = item / nblk, nb = item % nblk, k0 = 64 * kb, n0 = 32 * nb;
    float cs = scale;
    if (MAPK == 1) { if (n0 >= 1024 && n0 < 1536) cs *= 0.08838834764831845f; }
    const float* wp = W + (size_t)(k0 + (lane >> 5)) * N + n0 + (lane & 31);
    float w[32];
#pragma unroll
    for (int i = 0; i < 32; ++i) w[i] = wp[(size_t)(2 * i) * N];
    const int c = lane & 7;
    f32x4 g0 = {cs, cs, cs, cs}, g1 = g0;
    if (k0 < gain_lim) { g0 = *(const GAS f32x4*)(gain + k0 + 8 * c) * cs; g1 = *(const GAS f32x4*)(gain + k0 + 8 * c + 4) * cs; }
#pragma unroll
    for (int i = 0; i < 32; ++i) scr[(2 * i + (lane >> 5)) * 33 + (lane & 31)] = w[i];
    LDS_WAIT(); asm volatile("" ::: "memory");
#pragma unroll
    for (int j = 0; j < 4; ++j) { const int nl = (lane >> 3) + 8 * j, n = n0 + nl; const LAS float* s = scr + (8 * c) * 33 + nl;
        int nr = n;
        if (MAPK == 1) { if (n >= 512 && n < 1536) { const int jj = n - 512, blk = jj >> 7, e = jj & 127; nr = 512 + blk * 128 + 2 * (e & 63) + (e >> 6); } }
        if (MAPK == 2) nr = (n >> 7) * 256 + (n & 127);
        if (MAPK == 3) nr = (n >> 7) * 256 + 128 + (n & 127);
        u32x4 o; o.x = pk2(s[0 * 33] * g0.x, s[1 * 33] * g0.y); o.y = pk2(s[2 * 33] * g0.z, s[3 * 33] * g0.w); o.z = pk2(s[4 * 33] * g1.x, s[5 * 33] * g1.y); o.w = pk2(s[6 * 33] * g1.z, s[7 * 33] * g1.w);
        *(GAS u32x4*)(WT + (size_t)nr * K + k0 + 8 * c) = o; }
    LDS_WAIT(); asm volatile("" ::: "memory");
}
struct In {
    const float *x, *mem; const int* pos; const float *norm_mix, *w_in, *lre, *lim, *lstep, *bre, *bim, *cre, *cim, *s5d, *wglu, *bglu, *s5n, *retn, *w_out, *norm_cross, *norm_mem,
        *w_cq, *w_ck, *w_cv, *w_co, *norm_ffn, *w_gate, *w_up, *w_down, *norm_final;
};
__device__ __forceinline__ bf16_t* wl(unsigned char* ws, int l, size_t off) { return (bf16_t*)(ws + WS_W + (size_t)l * W_LAYER + off); }

__device__ __forceinline__ void pro_weights(const In& in, unsigned char* ws, LAS unsigned char* lds, int gw, int NGW, int wave, int lane) {
    LAS float* scr = (LAS float*)(lds + wave * 16384);
    constexpr int I_IN = 16 * 80, I_GLU = 8 * 16, I_SQ = 16 * 32, I_GU = 16 * 88, I_DN = 44 * 32;
    constexpr int PER_L = I_IN + I_GLU + 5 * I_SQ + 2 * I_GU + I_DN;
    static_assert(PER_L == 8192, "items");
    for (int it = gw; it < DEPTH * PER_L; it += NGW) {
        const int l = it / PER_L; int r = it % PER_L;
        if (r < I_IN) { tr_item<1>(in.w_in + (size_t)l * D * INW, D, INW, wl(ws, l, W_IN), in.norm_mix + l * D, D, 1.0f, scr, r, lane); continue; } r -= I_IN;
        if (r < I_GLU) { tr_item<0>(in.wglu + (size_t)l * S5W * S5W, S5W, S5W, wl(ws, l, W_GLU), nullptr, 0, 1.0f, scr, r, lane); continue; } r -= I_GLU;
        if (r < I_SQ) { tr_item<0>(in.w_out + (size_t)l * D * D, D, D, wl(ws, l, W_OUT), in.s5n + l * S5W, S5W, 1.0f, scr, r, lane); continue; } r -= I_SQ;
        if (r < I_SQ) { tr_item<0>(in.w_cq + (size_t)l * D * D, D, D, wl(ws, l, W_CQ), in.norm_cross + l * D, D, 0.0625f * 1.4426950408889634f, scr, r, lane); continue; } r -= I_SQ;
        if (r < I_SQ) { tr_item<0>(in.w_co + (size_t)l * D * D, D, D, wl(ws, l, W_CO), nullptr, 0, 1.0f, scr, r, lane); continue; } r -= I_SQ;
        if (r < I_SQ) { tr_item<0>(in.w_ck + (size_t)l * D * D, D, D, (bf16_t*)(ws + WS_WCK_TMP) + (size_t)l * D * D, in.norm_mem + l * D, D, 1.0f, scr, r, lane); continue; } r -= I_SQ;
        if (r < I_SQ) { tr_item<0>(in.w_cv + (size_t)l * D * D, D, D, (bf16_t*)(ws + WS_WCV_TMP) + (size_t)l * D * D, in.norm_mem + l * D, D, 1.0f, scr, r, lane); continue; } r -= I_SQ;
        if (r < I_GU) { tr_item<2>(in.w_gate + (size_t)l * D * FF, D, FF, wl(ws, l, W_GU), in.norm_ffn + l * D, D, 1.0f, scr, r, lane); continue; } r -= I_GU;
        if (r < I_GU) { tr_item<3>(in.w_up + (size_t)l * D * FF, D, FF, wl(ws, l, W_GU), in.norm_ffn + l * D, D, 1.0f, scr, r, lane); continue; } r -= I_GU;
        tr_item<0>(in.w_down + (size_t)l * FF * D, FF, D, wl(ws, l, W_DN), nullptr, 0, 1.0f, scr, r, lane);
    }
}
__device__ __forceinline__ void xprep_rows(const float* src, bf16_t* xb, float* ssq, int gw, int NGW, int lane) {
    for (int m = gw; m < M; m += NGW) {
        const GAS f32x4* xr = (const GAS f32x4*)(src + (size_t)m * D) + lane;
        f32x4 v[4]; float s = 0.f;
#pragma unroll
        for (int j = 0; j < 4; ++j) { v[j] = xr[64 * j]; s += (v[j].x * v[j].x + v[j].y * v[j].y) + (v[j].z * v[j].z + v[j].w * v[j].w); }
        const float tot = wave_sum(s);
        GAS u32x2* o8 = (GAS u32x2*)(xb + (size_t)m * D) + lane;
#pragma unroll
        for (int j = 0; j < 4; ++j) { u32x2 w; w.x = pk2(v[j].x, v[j].y); w.y = pk2(v[j].z, v[j].w); o8[64 * j] = w; }
        if (lane < 16) ssq[(size_t)m * 16 + lane] = (lane == 0) ? tot : 0.f;
    }
}
__device__ __forceinline__ void final_norm_rows(const bf16_t* xb, float* out, const float* g, int gw, int NGW, int lane) {
    f32x4 gv[4];
#pragma unroll
    for (int j = 0; j < 4; ++j) gv[j] = ((const GAS f32x4*)g)[lane + 64 * j];
    for (int m = gw; m < M; m += NGW) {
        const GAS u32x2* xr = (const GAS u32x2*)(xb + (size_t)m * D) + lane;
        f32x4 v[4]; float s = 0.f;
#pragma unroll
        for (int j = 0; j < 4; ++j) { const u32x2 w = xr[64 * j]; v[j] = (f32x4){bflo(w.x), bfhi(w.x), bflo(w.y), bfhi(w.y)}; s += (v[j].x * v[j].x + v[j].y * v[j].y) + (v[j].z * v[j].z + v[j].w * v[j].w); }
        const float r = 1.0f / sqrtf(wave_sum(s) * (1.0f / D) + EPS);
        GAS f32x4* o = (GAS f32x4*)(out + (size_t)m * D) + lane;
#pragma unroll
        for (int j = 0; j < 4; ++j) o[64 * j] = v[j] * r * gv[j];
    }
}
template <class Sched>
__device__ __forceinline__ void rstd_table(LAS float* tab, const Sched& S, const float* ssq, int nslots, float inv_n, int wave) {
    Unit u; const int t = wave * 64 + lane_id(); int prev_pm = -1;
    for (int i = 0; S.next(i, u); ++i) {
        if (wave < 4) {
            if (u.pm == prev_pm) tab[i * 256 + t] = tab[(i - 1) * 256 + t];
            else { const float* p = ssq + (size_t)(u.pm * 256 + t) * nslots; float s = 0.f;
                for (int j = 0; j < nslots; j += 4) { const f32x4 v = *(const GAS f32x4*)(p + j); s += (v.x + v.y) + (v.z + v.w); }
                tab[i * 256 + t] = 1.0f / sqrtf(s * inv_n + EPS); } }
        prev_pm = u.pm;
    }
    __syncthreads();
}

struct EpiFfn1 {
    static constexpr int PROBE_ID = 302; static constexpr bool PERM = true;
    bf16_t* H; LAS const float* tab;
    __device__ __forceinline__ void probe(const f32x4 (&acc)[2][2][4][2], const Unit& u, int ui, int wr, int wc, int fr, int fq) const { (*this)(acc, u, ui, wr, wc, fr, fq); }
    __device__ __forceinline__ void operator()(const f32x4 (&acc)[2][2][4][2], const Unit& u, int ui, int wr, int wc, int fr, int fq) const {
        asm volatile("" : "+v"(fr), "+v"(fq));
#pragma unroll
        for (int ai = 0; ai < 2; ++ai)
#pragma unroll
            for (int m = 0; m < 4; ++m) { const int rl = ai * HALF + wr * 64 + m * 16 + fr; const float rs = tab[ui * 256 + rl], k1 = -1.4426950408889634f * rs, rs2 = rs * rs;
                float h[8];
#pragma unroll
                for (int n = 0; n < 2; ++n)
#pragma unroll
                    for (int j = 0; j < 4; ++j) { const float ag = acc[ai][0][m][n][j], au = acc[ai][1][m][n][j]; h[4 * n + j] = (ag * au) * (rs2 * __builtin_amdgcn_rcpf(1.0f + __builtin_amdgcn_exp2f(ag * k1))); }
                u32x4 w; w.x = cvt_pk(h[0], h[1]); w.y = cvt_pk(h[2], h[3]); w.z = cvt_pk(h[4], h[5]); w.w = cvt_pk(h[6], h[7]);
                *(GAS u32x4*)(H + (size_t)(u.pm * BM + rl) * FF + u.pn * 128 + wc * 32 + 8 * fq) = w; }
    }
};
struct EpiRes {
    static constexpr int PROBE_ID = 307; static constexpr bool PERM = true;
    bf16_t* xb; float* ssq; float* fout; float scale;
    __device__ __forceinline__ void probe(const f32x4 (&acc)[2][2][4][2], const Unit& u, int ui, int wr, int wc, int fr, int fq) const { EpiRes t = *this; t.scale = 0.f; t(acc, u, ui, wr, wc, fr, fq); }
    __device__ __forceinline__ void operator()(const f32x4 (&acc)[2][2][4][2], const Unit& u, int ui, int wr, int wc, int fr, int fq) const {
        asm volatile("" : "+v"(fr), "+v"(fq));
        u32x4 xv[4][2][2];
#define ER_LOAD(b) do { _Pragma("unroll") for (int mm = 0; mm < 2; ++mm) _Pragma("unroll") for (int bj = 0; bj < 2; ++bj) \
            xv[b][mm][bj] = *(const GAS u32x4*)(xb + (size_t)(u.pm * BM + ((b) >> 1) * HALF + wr * 64 + (2 * ((b) & 1) + mm) * 16 + fr) * D + u.pn * BM + bj * HALF + wc * 32 + 8 * fq); } while (0)
#define ER_COMP(b) do { const int ai = (b) >> 1; _Pragma("unroll") for (int mm = 0; mm < 2; ++mm) { const int m = 2 * ((b) & 1) + mm; const int row = u.pm * BM + ai * HALF + wr * 64 + m * 16 + fr; float ps = 0.f; \
            _Pragma("unroll") for (int bj = 0; bj < 2; ++bj) { const size_t off = (size_t)row * D + u.pn * BM + bj * HALF + wc * 32 + 8 * fq; const u32x4 xw = xv[b][mm][bj]; f32x4 v0, v1; \
                v0.x = bflo(xw.x) + acc[ai][bj][m][0].x * scale; v0.y = bfhi(xw.x) + acc[ai][bj][m][0].y * scale; v0.z = bflo(xw.y) + acc[ai][bj][m][0].z * scale; v0.w = bfhi(xw.y) + acc[ai][bj][m][0].w * scale; \
                v1.x = bflo(xw.z) + acc[ai][bj][m][1].x * scale; v1.y = bfhi(xw.z) + acc[ai][bj][m][1].y * scale; v1.z = bflo(xw.w) + acc[ai][bj][m][1].z * scale; v1.w = bfhi(xw.w) + acc[ai][bj][m][1].w * scale; \
                if (fout) { *(GAS f32x4*)(fout + off) = v0; *(GAS f32x4*)(fout + off + 4) = v1; } \
                u32x4 w; w.x = cvt_pk(v0.x, v0.y); w.y = cvt_pk(v0.z, v0.w); w.z = cvt_pk(v1.x, v1.y); w.w = cvt_pk(v1.z, v1.w); \
                *(GAS u32x4*)(xb + off) = w; \
                ps += (v0.x * v0.x + v0.y * v0.y) + (v0.z * v0.z + v0.w * v0.w) + (v1.x * v1.x + v1.y * v1.y) + (v1.z * v1.z + v1.w * v1.w); } \
            ps += swz_xor<16>(ps); ps = half_sum(ps); \
            if (fq == 0) ssq[(size_t)row * 16 + u.pn * 4 + wc] = ps; } } while (0)
        ER_LOAD(0); ER_LOAD(1); asm volatile("" ::: "memory");
        ER_COMP(0); ER_LOAD(2); asm volatile("" ::: "memory");
        ER_COMP(1); ER_LOAD(3); asm volatile("" ::: "memory");
        ER_COMP(2); asm volatile("" ::: "memory");
        ER_COMP(3);
#undef ER_LOAD
#undef ER_COMP
    }
};
struct EpiScaleBf16 {
    static constexpr int PROBE_ID = 303; static constexpr bool PERM = true;
    bf16_t* O; int ldo; LAS const float* tab;
    __device__ __forceinline__ void probe(const f32x4 (&acc)[2][2][4][2], const Unit& u, int ui, int wr, int wc, int fr, int fq) const { (*this)(acc, u, ui, wr, wc, fr, fq); }
    __device__ __forceinline__ void operator()(const f32x4 (&acc)[2][2][4][2], const Unit& u, int ui, int wr, int wc, int fr, int fq) const {
        asm volatile("" : "+v"(fr), "+v"(fq));
#pragma unroll
        for (int ai = 0; ai < 2; ++ai)
#pragma unroll
            for (int m = 0; m < 4; ++m) { const int rl = ai * HALF + wr * 64 + m * 16 + fr; const float rs = tab[ui * 256 + rl];
#pragma unroll
                for (int bj = 0; bj < 2; ++bj) { const f32x4 v0 = acc[ai][bj][m][0] * rs, v1 = acc[ai][bj][m][1] * rs;
                    u32x4 w; w.x = cvt_pk(v0.x, v0.y); w.y = cvt_pk(v0.z, v0.w); w.z = cvt_pk(v1.x, v1.y); w.w = cvt_pk(v1.z, v1.w);
                    *(GAS u32x4*)(O + (size_t)(u.pm * BM + rl) * ldo + u.pn * BM + bj * HALF + wc * 32 + 8 * fq) = w; } }
    }
};
struct EpiMemK {
    static constexpr int PROBE_ID = 309; static constexpr bool PERM = true;
    bf16_t* O; const float* rsm;
    __device__ __forceinline__ void probe(const f32x4 (&acc)[2][2][4][2], const Unit& u, int ui, int wr, int wc, int fr, int fq) const { (*this)(acc, u, ui, wr, wc, fr, fq); }
    __device__ __forceinline__ void operator()(const f32x4 (&acc)[2][2][4][2], const Unit& u, int ui, int wr, int wc, int fr, int fq) const {
        asm volatile("" : "+v"(fr), "+v"(fq));
#pragma unroll
        for (int ai = 0; ai < 2; ++ai)
#pragma unroll
            for (int m = 0; m < 4; ++m) { const int row = u.pm * BM + ai * HALF + wr * 64 + m * 16 + fr; const float rs = rsm[row];
#pragma unroll
                for (int bj = 0; bj < 2; ++bj) { const f32x4 v0 = acc[ai][bj][m][0] * rs, v1 = acc[ai][bj][m][1] * rs;
                    u32x4 w; w.x = cvt_pk(v0.x, v0.y); w.y = cvt_pk(v0.z, v0.w); w.z = cvt_pk(v1.x, v1.y); w.w = cvt_pk(v1.z, v1.w);
                    *(GAS u32x4*)(O + ((size_t)u.g * MROWS + row) * D + u.pn * BM + bj * HALF + wc * 32 + 8 * fq) = w; } }
    }
};
struct EpiMemVT {
    static constexpr int PROBE_ID = 309; static constexpr bool PERM = true;
    bf16_t* O; const float* rsm;
    __device__ __forceinline__ void probe(const f32x4 (&acc)[2][2][4][2], const Unit& u, int ui, int wr, int wc, int fr, int fq) const { (*this)(acc, u, ui, wr, wc, fr, fq); }
    __device__ __forceinline__ void operator()(const f32x4 (&acc)[2][2][4][2], const Unit& u, int ui, int wr, int wc, int fr, int fq) const {
        asm volatile("" : "+v"(fr), "+v"(fq));
#pragma unroll
        for (int bj = 0; bj < 2; ++bj) { const int c0 = u.pn * BM + bj * HALF + wc * 32 + 8 * fq;
            const f32x4 r0 = *(const GAS f32x4*)(rsm + c0), r1 = *(const GAS f32x4*)(rsm + c0 + 4);
            const int p0 = (c0 & ~15) + 4 * ((c0 >> 3) & 1), p1 = p0 + 8;
#pragma unroll
            for (int ai = 0; ai < 2; ++ai)
#pragma unroll
                for (int m = 0; m < 4; ++m) { const int row = u.pm * BM + ai * HALF + wr * 64 + m * 16 + fr;
                    const f32x4 v0 = acc[ai][bj][m][0] * r0, v1 = acc[ai][bj][m][1] * r1;
                    bf16_t* o = O + ((size_t)u.g * D + row) * MROWS;
                    u32x2 w0, w1; w0.x = cvt_pk(v0.x, v0.y); w0.y = cvt_pk(v0.z, v0.w); w1.x = cvt_pk(v1.x, v1.y); w1.y = cvt_pk(v1.z, v1.w);
                    *(GAS u32x2*)(o + p0) = w0; *(GAS u32x2*)(o + p1) = w1; } }
    }
};

__device__ __forceinline__ void xa_fill(LAS unsigned char* lds, const bf16_t* src  , int wave, int lane) {
#pragma unroll 1
    for (int j = 0; j < 16; ++j) { const int p = wave * 16 + j, row = 2 * p + (lane >> 5), ch = (lane & 31) ^ (row & 15);
        __builtin_amdgcn_global_load_lds((const unsigned*)((const char*)src + (size_t)row * 2048 + ch * 16), (LAS unsigned*)(lds + p * 1024), 16, 0, 0); }
}
__device__ __forceinline__ void xa_mma(f32x16 (&acc)[8], const bf16x8 (&bf)[16], LAS const unsigned char* lds, int r, int hh) {
    const int a = (r >> 1) & 7, b = hh ^ (r & 1); LAS const unsigned char* base = lds + r * 512 + b * 16;
#pragma unroll
    for (int s = 0; s < 16; ++s) { const int cp = ((s & 8) | ((s & 7) ^ a)) << 5;
        LAS const unsigned char* p0 = base + cp; LAS const unsigned char* p1 = p0 + 65536;
#pragma unroll
        for (int blk = 0; blk < 8; ++blk) {
            const bf16x8 av = (blk < 4) ? *(LAS const bf16x8*)(p0 + blk * 16384) : *(LAS const bf16x8*)(p1 + (blk - 4) * 16384);
            acc[blk] = __builtin_amdgcn_mfma_f32_32x32x16_bf16(av, bf[s], acc[blk], 0, 0, 0); }
#pragma unroll
        for (int blk = 0; blk < 8; ++blk) asm volatile("" : "+v"(acc[blk]));
    }
}
__device__ __forceinline__ void xa_mma_q(f32x16 (&acc)[8], const GAS bf16x8* qp, LAS const unsigned char* lds, int r, int hh) {
    const int a = (r >> 1) & 7, b = hh ^ (r & 1); LAS const unsigned char* base = lds + r * 512 + b * 16;
    bf16x8 q3[3];
#pragma unroll
    for (int s = 0; s < 3; ++s) q3[s] = qp[2 * s];
#pragma unroll
    for (int s = 0; s < 16; ++s) { const int cp = ((s & 8) | ((s & 7) ^ a)) << 5;
        LAS const unsigned char* p0 = base + cp; LAS const unsigned char* p1 = p0 + 65536;
        const bf16x8 bq = q3[s % 3];
        if (s + 3 < 16) q3[s % 3] = qp[2 * (s + 3)];
#pragma unroll
        for (int blk = 0; blk < 8; ++blk) {
            const bf16x8 av = (blk < 4) ? *(LAS const bf16x8*)(p0 + blk * 16384) : *(LAS const bf16x8*)(p1 + (blk - 4) * 16384);
            acc[blk] = __builtin_amdgcn_mfma_f32_32x32x16_bf16(av, bq, acc[blk], 0, 0, 0); }
#pragma unroll
        for (int blk = 0; blk < 8; ++blk) asm volatile("" : "+v"(acc[blk]));
    }
}
__device__ __forceinline__ void xattn_unit(LAS unsigned char* lds, const bf16_t* QC, const bf16_t* Kl, const bf16_t* VTl, bf16_t* OC, int b, int h, int qt, int wave) {
    {
        const size_t qrow0 = (size_t)b * SEQ + qt * 256 + wave * 32;
        bf16x8 bq[16];
        { const int lane = lane_id(), r = lane & 31, hh = lane >> 5; const GAS bf16x8* qp = (const GAS bf16x8*)(QC + (qrow0 + r) * D + h * XD + 8 * hh);
#pragma unroll
          for (int s = 0; s < 16; ++s) bq[s] = qp[2 * s]; }
        xa_fill(lds, Kl + (size_t)b * MEML * D + h * XD, wave, lane_id());
        VM_WAIT(); __syncthreads();
#if defined(PROBE_DUP) && PROBE_DUP == 71
        xa_fill(lds, Kl + (size_t)b * MEML * D + h * XD, wave, lane_id());
        VM_WAIT(); __syncthreads();
#endif
        f32x16 acc[8];
#pragma unroll
        for (int k = 0; k < 8; ++k)
#pragma unroll
            for (int j = 0; j < 16; ++j) acc[k][j] = 0.f;
        { const int lane = lane_id(); xa_mma(acc, bq, lds, lane & 31, lane >> 5); }
        __syncthreads();
        xa_fill(lds, VTl + (size_t)h * XD * MROWS + b * MEML, wave, lane_id());
        float mx = acc[0][0];
#pragma unroll
        for (int k = 0; k < 8; ++k)
#pragma unroll
            for (int j = 0; j < 16; ++j) mx = fmaxf(mx, acc[k][j]);
        mx = half_max(mx);
        float sum = 0.f;
#pragma unroll
        for (int k = 0; k < 8; ++k)
#pragma unroll
            for (int j = 0; j < 16; ++j) { const float p = __builtin_amdgcn_exp2f(acc[k][j] - mx); acc[k][j] = p; sum += p; }
        sum = half_sum(sum);
        const float inv = 1.0f / sum;
        bf16x8 bp[16];
#pragma unroll
        for (int k = 0; k < 8; ++k)
#pragma unroll
            for (int s = 0; s < 2; ++s) { u32x4 w; w.x = cvt_pk(acc[k][8 * s + 0], acc[k][8 * s + 1]); w.y = cvt_pk(acc[k][8 * s + 2], acc[k][8 * s + 3]);
                w.z = cvt_pk(acc[k][8 * s + 4], acc[k][8 * s + 5]); w.w = cvt_pk(acc[k][8 * s + 6], acc[k][8 * s + 7]); bp[2 * k + s] = __builtin_bit_cast(bf16x8, w); }
#pragma unroll
        for (int k = 0; k < 8; ++k)
#pragma unroll
            for (int j = 0; j < 16; ++j) acc[k][j] = 0.f;
        VM_WAIT(); __syncthreads();
        { const int lane = lane_id(); xa_mma(acc, bp, lds, lane & 31, lane >> 5); }
        __syncthreads();
        { const int lane = lane_id(), r = lane & 31, hh = lane >> 5; LAS unsigned char* wb = lds + wave * 16384;
#pragma unroll
          for (int k = 0; k < 8; ++k)
#pragma unroll
            for (int g4 = 0; g4 < 4; ++g4) { u32x2 w; w.x = cvt_pk(acc[k][4 * g4] * inv, acc[k][4 * g4 + 1] * inv); w.y = cvt_pk(acc[k][4 * g4 + 2] * inv, acc[k][4 * g4 + 3] * inv);
                *(LAS u32x2*)(wb + r * 512 + (((4 * k + g4) ^ r) << 4) + 8 * hh) = w; }
          asm volatile("s_waitcnt lgkmcnt(0)" ::: "memory");
#if defined(PROBE_DUP) && PROBE_DUP == 72
          for (int rp = 0; rp < 2; ++rp)
#endif
#pragma unroll
          for (int j = 0; j < 16; ++j) { const int row = 2 * j + hh, cp = lane & 31; const u32x4 v = *(LAS const u32x4*)(wb + row * 512 + cp * 16);
              *(GAS u32x4*)(OC + (qrow0 + row) * D + h * XD + 8 * (cp ^ row)) = v; }
          asm volatile("s_waitcnt lgkmcnt(0)" ::: "memory"); }
    }
}
__device__ __forceinline__ void mem_prep_rows(const float* mem, bf16_t* memb, float* rsm, int gw, int NGW, int lane) {
    for (int m = gw; m < MROWS; m += NGW) {
        const GAS f32x4* xr = (const GAS f32x4*)(mem + (size_t)m * D) + lane;
        f32x4 v[4]; float s = 0.f;
#pragma unroll
        for (int j = 0; j < 4; ++j) { v[j] = xr[64 * j]; s += (v[j].x * v[j].x + v[j].y * v[j].y) + (v[j].z * v[j].z + v[j].w * v[j].w); }
        const float tot = wave_sum(s);
        GAS u32x2* o8 = (GAS u32x2*)(memb + (size_t)m * D) + lane;
#pragma unroll
        for (int j = 0; j < 4; ++j) { u32x2 w; w.x = pk2(v[j].x, v[j].y); w.y = pk2(v[j].z, v[j].w); o8[64 * j] = w; }
        if (lane == 0) rsm[m] = 1.0f / sqrtf(tot * (1.0f / D) + EPS);
    }
}

__device__ __forceinline__ float ret_lg2(int h) { return h == 0 ? -0.04580368961312479f : h == 1 ? -0.02272007650008353f : h == 2 ? -0.011315313227834146f : -0.005646563141142063f; }
struct EpiProj {
    static constexpr int PROBE_ID = 301; static constexpr bool PERM = true;
    bf16_t *UG, *Q, *K, *V, *GT; const float* rope; LAS const float* tab;
    __device__ __forceinline__ void probe(const f32x4 (&acc)[2][2][4][2], const Unit& u, int ui, int wr, int wc, int fr, int fq) const { (*this)(acc, u, ui, wr, wc, fr, fq); }
    __device__ __forceinline__ void operator()(const f32x4 (&acc)[2][2][4][2], const Unit& u, int ui, int wr, int wc, int fr, int fq) const {
        asm volatile("" : "+v"(fr), "+v"(fq));
        const int kind = u.pn >> 1;
        if (kind == 1 || kind == 2) {
            f32x4 cs[2][4][2];
#pragma unroll
            for (int ai = 0; ai < 2; ++ai)
#pragma unroll
                for (int m = 0; m < 4; ++m) { const int row = u.pm * BM + ai * HALF + wr * 64 + m * 16 + fr;
                    const GAS f32x4* rp = (const GAS f32x4*)(rope + ((size_t)row * 64 + ((wc * 32 + 8 * fq) >> 1)) * 2); cs[ai][m][0] = rp[0]; cs[ai][m][1] = rp[1]; }
#pragma unroll
            for (int ai = 0; ai < 2; ++ai) {
#pragma unroll
                for (int m = 0; m < 4; ++m) { const int rl = ai * HALF + wr * 64 + m * 16 + fr, row = u.pm * BM + rl; const float rs = tab[ui * 256 + rl];
#pragma unroll
                    for (int bj = 0; bj < 2; ++bj) { const f32x4 v0 = acc[ai][bj][m][0] * rs, v1 = acc[ai][bj][m][1] * rs, c0 = cs[ai][m][0], c1 = cs[ai][m][1];
                        const int cw = (u.pn & 1) * 256 + bj * HALF + wc * 32 + 8 * fq, hd = cw >> 7;
                        const float e = (float)(row & 127) * ret_lg2(hd), sc = __builtin_amdgcn_exp2f(kind == 1 ? e : -e);
                        f32x4 o0, o1;
                        o0.x = (v0.x * c0.x - v0.y * c0.y) * sc; o0.y = (v0.y * c0.x + v0.x * c0.y) * sc; o0.z = (v0.z * c0.z - v0.w * c0.w) * sc; o0.w = (v0.w * c0.z + v0.z * c0.w) * sc;
                        o1.x = (v1.x * c1.x - v1.y * c1.y) * sc; o1.y = (v1.y * c1.x + v1.x * c1.y) * sc; o1.z = (v1.z * c1.z - v1.w * c1.w) * sc; o1.w = (v1.w * c1.z + v1.z * c1.w) * sc;
                        u32x4 w; w.x = cvt_pk(o0.x, o0.y); w.y = cvt_pk(o0.z, o0.w); w.z = cvt_pk(o1.x, o1.y); w.w = cvt_pk(o1.z, o1.w);
                        *(GAS u32x4*)((kind == 1 ? Q : K) + (size_t)row * RW + cw) = w; } } }
        } else {
#pragma unroll
            for (int ai = 0; ai < 2; ++ai)
#pragma unroll
                for (int m = 0; m < 4; ++m) { const int rl = ai * HALF + wr * 64 + m * 16 + fr, row = u.pm * BM + rl; const float rs = tab[ui * 256 + rl];
#pragma unroll
                    for (int bj = 0; bj < 2; ++bj) { const f32x4 v0 = acc[ai][bj][m][0] * rs, v1 = acc[ai][bj][m][1] * rs;
                        const int cw = (u.pn & 1) * 256 + bj * HALF + wc * 32 + 8 * fq;
                        bf16_t* dst = (kind == 0) ? UG + ((size_t)(cw >> 4) * (M / 32) + (row >> 5)) * 640 + (row & 31) * 16 + ((cw >> 3) & 1) * 8 : (kind == 3 ? V : GT) + (size_t)row * RW + cw;
                        u32x4 w; w.x = cvt_pk(v0.x, v0.y); w.y = cvt_pk(v0.z, v0.w); w.z = cvt_pk(v1.x, v1.y); w.w = cvt_pk(v1.z, v1.w);
                        *(GAS u32x4*)dst = w; } }
        }
    }
};
struct EpiGlu {
    static constexpr int PROBE_ID = 304; static constexpr bool PERM = true;
    const bf16_t* Z; const float* bias; bf16_t* Y; float* ssqs;
    __device__ __forceinline__ void probe(const f32x4 (&acc)[2][2][4][2], const Unit& u, int ui, int wr, int wc, int fr, int fq) const { (*this)(acc, u, ui, wr, wc, fr, fq); }
    __device__ __forceinline__ void operator()(const f32x4 (&acc)[2][2][4][2], const Unit& u, int ui, int wr, int wc, int fr, int fq) const {
        asm volatile("" : "+v"(fr), "+v"(fq));
#pragma unroll
        for (int ai = 0; ai < 2; ++ai)
#pragma unroll
            for (int m = 0; m < 4; ++m) { const int row = u.pm * BM + ai * HALF + wr * 64 + m * 16 + fr; float ps = 0.f;
#pragma unroll
                for (int bj = 0; bj < 2; ++bj) { const int col = u.pn * BM + bj * HALF + wc * 32 + 8 * fq;
                    const u32x4 zw = *(const GAS u32x4*)(Z + ((size_t)(col >> 4) * M + row) * 16 + (col & 15));
                    const f32x4 b0 = *(const GAS f32x4*)(bias + col), b1 = *(const GAS f32x4*)(bias + col + 4);
                    const f32x4 t0 = acc[ai][bj][m][0] + b0, t1 = acc[ai][bj][m][1] + b1;
                    float o[8];
                    o[0] = bflo(zw.x) * fast_sigmoid(t0.x); o[1] = bfhi(zw.x) * fast_sigmoid(t0.y); o[2] = bflo(zw.y) * fast_sigmoid(t0.z); o[3] = bfhi(zw.y) * fast_sigmoid(t0.w);
                    o[4] = bflo(zw.z) * fast_sigmoid(t1.x); o[5] = bfhi(zw.z) * fast_sigmoid(t1.y); o[6] = bflo(zw.w) * fast_sigmoid(t1.z); o[7] = bfhi(zw.w) * fast_sigmoid(t1.w);
#pragma unroll
                    for (int j = 0; j < 8; ++j) ps += o[j] * o[j];
                    u32x4 w; w.x = cvt_pk(o[0], o[1]); w.y = cvt_pk(o[2], o[3]); w.z = cvt_pk(o[4], o[5]); w.w = cvt_pk(o[6], o[7]);
                    *(GAS u32x4*)(Y + (size_t)row * D + col) = w; }
                ps += swz_xor<16>(ps); ps = half_sum(ps);
                if (fq == 0) ssqs[(size_t)row * 8 + u.pn * 4 + wc] = ps;
                asm volatile("" ::: "memory"); }
    }
};
struct EpiResHook : EpiRes {
    LAS const float* tab2; int hook_t;
    __device__ __forceinline__ void hook(f32x4 (&acc)[2][2][4][2], int ui, int wr, int fr) const {
#pragma unroll
        for (int ai = 0; ai < 2; ++ai)
#pragma unroll
            for (int m = 0; m < 4; ++m) { const float rs = tab2[ui * 256 + ai * HALF + wr * 64 + m * 16 + fr];
#pragma unroll
                for (int bj = 0; bj < 2; ++bj)
#pragma unroll
                    for (int n = 0; n < 2; ++n) acc[ai][bj][m][n] *= rs; }
    }
};
__device__ __forceinline__ void rope_table(const int* pos, float* rope, int gtid, int nthr) {
    for (int idx = gtid; idx < M * 64; idx += nthr) { const int i = idx & 63, row = idx >> 6;
        const float inv = (float)(1.0 / pow(10000.0, (double)i / 64.0)); const float ang = (float)pos[row] * inv;
        f32x2 cs; cs.x = (float)cos((double)ang); cs.y = (float)sin((double)ang);
        *(GAS f32x2*)(rope + (size_t)idx * 2) = cs; }
}

constexpr size_t SP_RSM = 0, SP_KTAB = 64 * 1024, SP_APOW = SP_KTAB + 4 * MiB, SP_BBAR = 6 * MiB + 256 * 1024;
constexpr size_t APOW_LG = 33 * 64 * 2, KTAB_LG = 32 * 256, BBAR_LG = 64 * 16 * 2;
static_assert(SP_APOW + (size_t)DEPTH * S5G * APOW_LG * 4 <= SP_BBAR && SP_BBAR + (size_t)DEPTH * S5G * BBAR_LG * 4 <= 8 * MiB, "spare map");
constexpr size_t S5M_T = 0, S5M_WEND = 20 * MiB;
constexpr size_t WS_SEND = WS_Z, WS_KVRUN = WS_Z + 16 * MiB;
constexpr size_t WS_RSTART = WS_S5M;
constexpr size_t S5M_LAYER = 28 * MiB;
__device__ __forceinline__ void s5_tables_item(const In& in, unsigned char* ws, LAS unsigned char* lds, int item, int wave, int lane) {
    const int l = item >> 7, g = (item >> 2) & 31, tq = item & 3, p = lane;
    LAS float* Br = (LAS float*)lds; LAS float* Bi = Br + 1024; LAS float* Cr = Bi + 1024; LAS float* Ci = Cr + 1024;
    LAS float* CAr = Ci + 1024 + wave * 2048; LAS float* CAi = CAr + 1024;
    float* sp = (float*)(ws + WS_SPARE);
    const int lg = l * S5G + g;
    const double lr = (double)in.lre[lg * 64 + p], li = (double)in.lim[lg * 64 + p], step = (double)expf(in.lstep[lg]);
    if (wave == 0) {
        const double mag = exp(lr * step), ar = mag * cos(li * step), ai = mag * sin(li * step), den = lr * lr + li * li;
        const double fr = ((ar - 1.0) * lr + ai * li) / den, fi = (ai * lr - (ar - 1.0) * li) / den;
#pragma unroll 4
        for (int h = 0; h < 16; ++h) { const double br = (double)in.bre[((size_t)lg * 64 + p) * 16 + h], bi = (double)in.bim[((size_t)lg * 64 + p) * 16 + h];
            const float xr = (float)(fr * br - fi * bi), xi = (float)(fr * bi + fi * br); Br[p * 16 + h] = xr; Bi[p * 16 + h] = xi;
            if (tq == 0) { f32x2 w; w.x = xr; w.y = xi; *(GAS f32x2*)(sp + SP_BBAR / 4 + (size_t)lg * BBAR_LG + (p * 16 + h) * 2) = w; } }
    }
    if (wave == 1) { for (int n = 0; n < 16; ++n) { Cr[n * 64 + p] = in.cre[((size_t)lg * 16 + n) * 64 + p]; Ci[n * 64 + p] = in.cim[((size_t)lg * 16 + n) * 64 + p]; } }
    const int tau = 8 * tq + wave;
    const double mg = exp(lr * step * (double)tau), an = li * step * (double)tau;
    const float ar = (float)(mg * cos(an)), ai = (float)(mg * sin(an));
    { f32x2 w; w.x = ar; w.y = ai; *(GAS f32x2*)(sp + SP_APOW / 4 + (size_t)lg * APOW_LG + (tau * 64 + p) * 2) = w; }
    if (tq == 3 && wave == 7) { const double m2 = exp(lr * step * 32.0), a2 = li * step * 32.0; f32x2 w; w.x = (float)(m2 * cos(a2)); w.y = (float)(m2 * sin(a2));
        *(GAS f32x2*)(sp + SP_APOW / 4 + (size_t)lg * APOW_LG + (32 * 64 + p) * 2) = w; }
    __syncthreads();
#pragma unroll 4
    for (int n = 0; n < 16; ++n) { const float cr = Cr[n * 64 + p], ci = Ci[n * 64 + p]; CAr[n * 64 + p] = cr * ar - ci * ai; CAi[n * 64 + p] = cr * ai + ci * ar; }
    LDS_WAIT(); asm volatile("" ::: "memory");
    const int n = lane >> 2, h0 = 4 * (lane & 3);
    f32x4 acc = {0.f, 0.f, 0.f, 0.f};
    for (int pp = 0; pp < 64; ++pp) { const float cr = CAr[n * 64 + pp], ci = CAi[n * 64 + pp];
        const f32x4 br = *(LAS const f32x4*)(Br + pp * 16 + h0), bi = *(LAS const f32x4*)(Bi + pp * 16 + h0);
        acc += br * cr - bi * ci; }
    *(GAS f32x4*)(sp + SP_KTAB / 4 + (size_t)lg * KTAB_LG + tau * 256 + n * 16 + h0) = acc;
    __syncthreads();
}
__device__ __forceinline__ void s5_build_item(const In& in, unsigned char* ws, unsigned char* s5m  , int l, int item, int tid) {
    const int g = item >> 3, part = item & 7, lg = l * S5G + g;
    const float* sp = (const float*)(ws + WS_SPARE);
    const float* ktab = sp + SP_KTAB / 4 + (size_t)lg * KTAB_LG; const float* apow = sp + SP_APOW / 4 + (size_t)lg * APOW_LG; const float* bbar = sp + SP_BBAR / 4 + (size_t)lg * BBAR_LG;
    bf16_t* T = (bf16_t*)(s5m + S5M_T) + (size_t)g * 512 * 640; bf16_t* WE = (bf16_t*)(s5m + S5M_WEND) + (size_t)g * 256 * 512;
    for (int q = tid; q < 64 * 80; q += NTHR) {
        const int rl = q / 80, pc = q % 80, t = 4 * part + (rl >> 4), n = rl & 15, col0 = 8 * pc; float v[8];
        if (col0 < 512) { const int s = col0 >> 4, h0 = col0 & 15;
            if (s <= t) { const f32x4 a = *(const GAS f32x4*)(ktab + (t - s) * 256 + n * 16 + h0), b = *(const GAS f32x4*)(ktab + (t - s) * 256 + n * 16 + h0 + 4);
                v[0] = a.x; v[1] = a.y; v[2] = a.z; v[3] = a.w; v[4] = b.x; v[5] = b.y; v[6] = b.z; v[7] = b.w;
                if (s == t) { const float dn = in.s5d[l * S5W + g * 16 + n];
#pragma unroll
                    for (int j = 0; j < 8; ++j) v[j] += (h0 + j == n) ? dn : 0.f; } }
            else {
#pragma unroll
                for (int j = 0; j < 8; ++j) v[j] = 0.f; } }
        else { const int q0 = col0 - 512, im = q0 >= 64, p0 = q0 & 63;
#pragma unroll
            for (int j = 0; j < 8; ++j) { const int p = p0 + j; const float cr = in.cre[((size_t)lg * 16 + n) * 64 + p], ci = in.cim[((size_t)lg * 16 + n) * 64 + p];
                const f32x2 a = *(const GAS f32x2*)(apow + ((t + 1) * 64 + p) * 2); v[j] = im ? -(cr * a.y + ci * a.x) : (cr * a.x - ci * a.y); } }
        u32x4 w; w.x = pk2(v[0], v[1]); w.y = pk2(v[2], v[3]); w.z = pk2(v[4], v[5]); w.w = pk2(v[6], v[7]);
        *(GAS u32x4*)(T + (size_t)(t * 16 + n) * 640 + col0) = w;
    }
    for (int q = tid; q < 32 * 64; q += NTHR) {
        const int r = 32 * part + (q >> 6), col0 = 8 * (q & 63), s = col0 >> 4, h0 = col0 & 15; float v[8];
        if (r < 128) { const int p = r & 63, im = r >= 64; const f32x2 a = *(const GAS f32x2*)(apow + ((31 - s) * 64 + p) * 2);
#pragma unroll
            for (int j = 0; j < 8; ++j) { const f32x2 b = *(const GAS f32x2*)(bbar + (p * 16 + h0 + j) * 2); v[j] = im ? (a.x * b.y + a.y * b.x) : (a.x * b.x - a.y * b.y); } }
        else {
#pragma unroll
            for (int j = 0; j < 8; ++j) v[j] = 0.f; }
        u32x4 w; w.x = pk2(v[0], v[1]); w.y = pk2(v[2], v[3]); w.z = pk2(v[4], v[5]); w.w = pk2(v[6], v[7]);
        *(GAS u32x4*)(WE + (size_t)r * 512 + col0) = w;
    }
}
struct EpiS5End {
    static constexpr int PROBE_ID = 305; static constexpr bool PERM = false;
    float* SE;
    __device__ __forceinline__ void probe(const f32x4 (&acc)[2][2][4][2], const Unit& u, int ui, int wr, int wc, int fr, int fq) const { (*this)(acc, u, ui, wr, wc, fr, fq); }
    __device__ __forceinline__ void operator()(const f32x4 (&acc)[2][2][4][2], const Unit& u, int ui, int wr, int wc, int fr, int fq) const {
        asm volatile("" : "+v"(fr), "+v"(fq));
#pragma unroll
        for (int ai = 0; ai < 2; ++ai)
#pragma unroll
            for (int m = 0; m < 4; ++m) { const int row = u.pm * BM + ai * HALF + wr * 64 + m * 16 + fr; float* o = SE + ((size_t)u.g * (M / 32) + row) * 128 + wc * 32 + 4 * fq;
#pragma unroll
                for (int n = 0; n < 2; ++n) *(GAS f32x4*)(o + 16 * n) = acc[ai][0][m][n]; }
    }
};
__device__ __forceinline__ f32x2 gelu_pk(f32x2 v) {
    const f32x2 av = __builtin_elementwise_abs(v), d = av * 0.2316418882f + 1.0f;
    f32x2 t; t.x = __builtin_amdgcn_rcpf(d.x); t.y = __builtin_amdgcn_rcpf(d.y);
    f32x2 q = t * 0.5307027145f + (-0.7265760135f); q = q * t + 0.7107068705f; q = q * t + (-0.142248368f); q = q * t + 0.127414796f; q = q * t;
    const f32x2 s = (v * v) * (-0.72134752044f);
    f32x2 e; e.x = __builtin_amdgcn_exp2f(s.x); e.y = __builtin_amdgcn_exp2f(s.y);
    const f32x2 m = v * (q * e), r = v - m;
    f32x2 o; o.x = v.x < 0.f ? m.x : r.x; o.y = v.y < 0.f ? m.y : r.y; return o;
}
struct EpiS5Out {
    static constexpr int PROBE_ID = 306; static constexpr bool PERM = true;
    bf16_t* Z;
    __device__ __forceinline__ void probe(const f32x4 (&acc)[2][2][4][2], const Unit& u, int ui, int wr, int wc, int fr, int fq) const { (*this)(acc, u, ui, wr, wc, fr, fq); }
    __device__ __forceinline__ void operator()(const f32x4 (&acc)[2][2][4][2], const Unit& u, int ui, int wr, int wc, int fr, int fq) const {
        asm volatile("" : "+v"(fr), "+v"(fq));
#pragma unroll
        for (int ai = 0; ai < 2; ++ai)
#pragma unroll
            for (int m = 0; m < 4; ++m) { const int crow = u.pm * BM + ai * HALF + wr * 64 + m * 16 + fr;
#pragma unroll
                for (int bj = 0; bj < 2; ++bj) { const int c = u.pn * BM + bj * HALF + wc * 32 + 8 * fq, t = c >> 4, hf = (c >> 3) & 1;
                    const f32x4 v0 = acc[ai][bj][m][0], v1 = acc[ai][bj][m][1];
                    const f32x2 a = gelu_pk((f32x2){v0.x, v0.y}), b = gelu_pk((f32x2){v0.z, v0.w}), cc = gelu_pk((f32x2){v1.x, v1.y}), dd = gelu_pk((f32x2){v1.z, v1.w});
                    u32x4 w; w.x = cvt_pk(a.x, a.y); w.y = cvt_pk(b.x, b.y); w.z = cvt_pk(cc.x, cc.y); w.w = cvt_pk(dd.x, dd.y);
                    *(GAS u32x4*)(Z + ((size_t)u.g * M + (size_t)crow * 32 + t) * 16 + hf * 8) = w; } }
    }
};
__device__ __forceinline__ void s5_scan_unit(unsigned char* ws, LAS unsigned char* lds, int l, int unit, int wave, int lane) {
    const int b = unit >> 5, g = unit & 31, p = lane, seg = wave, lg = l * S5G + g;
    const float* sp = (const float*)(ws + WS_SPARE);
    const f32x2 a32 = *(const GAS f32x2*)(sp + SP_APOW / 4 + (size_t)lg * APOW_LG + (32 * 64 + p) * 2);
    const float* se = (const float*)(ws + WS_SEND) + ((size_t)g * (M / 32) + b * 256 + seg * 32) * 128;
    LAS f32x2* segT = (LAS f32x2*)lds;
    float tr = 0.f, ti = 0.f;
#pragma unroll 8
    for (int k = 0; k < 32; ++k) { const float xr = se[k * 128 + p], xi = se[k * 128 + 64 + p]; const float nr = a32.x * tr - a32.y * ti + xr, ni = a32.x * ti + a32.y * tr + xi; tr = nr; ti = ni; }
    segT[seg * 64 + p] = (f32x2){tr, ti};
    float Ar = a32.x, Ai = a32.y;
#pragma unroll
    for (int j = 0; j < 5; ++j) { const float nr = Ar * Ar - Ai * Ai, ni = 2.f * Ar * Ai; Ar = nr; Ai = ni; }
    __syncthreads();
    float cr = 0.f, ci = 0.f;
    for (int s = 0; s < seg; ++s) { const f32x2 t2 = segT[s * 64 + p]; const float nr = Ar * cr - Ai * ci + t2.x, ni = Ar * ci + Ai * cr + t2.y; cr = nr; ci = ni; }
    bf16_t* ug = (bf16_t*)(ws + WS_UG) + ((size_t)g * (M / 32) + b * 256 + seg * 32) * 640 + 512;
#pragma unroll 8
    for (int k = 0; k < 32; ++k) { ug[k * 640 + p] = (bf16_t)f2bf(cr); ug[k * 640 + 64 + p] = (bf16_t)f2bf(ci);
        const float xr = se[k * 128 + p], xi = se[k * 128 + 64 + p]; const float nr = a32.x * cr - a32.y * ci + xr, ni = a32.x * ci + a32.y * cr + xi; cr = nr; ci = ni; }
    __syncthreads();
}

typedef short s16x4 __attribute__((ext_vector_type(4)));
__device__ __forceinline__ unsigned rt_f(int row) { return (unsigned)(((row & 3) << 2) | ((row >> 2) & 3)); }
__device__ __forceinline__ unsigned rt_off(int row, int ch) { return 256u * (unsigned)row + 16u * ((unsigned)ch ^ rt_f(row)); }
__device__ __forceinline__ void rt_fill(LAS unsigned char* img, const bf16_t* src  , int wave, int lane) {
#pragma unroll
    for (int j = 0; j < 4; ++j) { const int p = wave * 4 + j, row = 4 * p + (lane >> 4), ch = (lane & 15) ^ (int)rt_f(row);
        __builtin_amdgcn_global_load_lds((const unsigned*)((const char*)src + (size_t)row * 1024 + ch * 16), (LAS unsigned*)(img + p * 1024), 16, 0, 0); }
}
__device__ __forceinline__ s16x4 rt_tr4(LAS const unsigned char* p) { typedef short v4i16_t __attribute__((ext_vector_type(4))); return __builtin_bit_cast(s16x4, __builtin_amdgcn_ds_read_tr16_b64_v4i16((LAS v4i16_t*)p)); }
template <bool KPERM> __device__ __forceinline__ bf16x8 rt_trfrag(LAS const unsigned char* img, int k0, int c, int lane) {
    const int hh = lane >> 5, blk = (lane >> 4) & 1, q = (lane & 15) >> 2, p = lane & 3;
    const int r0 = k0 + (KPERM ? 4 * hh : 8 * hh) + q, r1 = r0 + (KPERM ? 8 : 4), ch = 4 * c + 2 * blk + (p >> 1);
    const s16x4 lo = rt_tr4(img + rt_off(r0, ch) + 8 * (p & 1)), hi = rt_tr4(img + rt_off(r1, ch) + 8 * (p & 1));
    return __builtin_shufflevector(lo, hi, 0, 1, 2, 3, 4, 5, 6, 7);
}
__device__ __forceinline__ bf16x8 rt_rowfrag(LAS const unsigned char* img, int rb, int s, int lane) {
    return *(LAS const bf16x8*)(img + rt_off(32 * rb + (lane & 31), 2 * s + (lane >> 5)));
}
constexpr int RT_Q = 0, RT_K = 32768, RT_V = 65536, RT_R = 98304;
__device__ __forceinline__ float ret_g(int h) { return h == 0 ? 0.017183023570817902f : h == 1 ? 0.1332151628796484f : h == 2 ? 0.3664377159220373f : 0.6059370882290803f; }
__device__ __forceinline__ void rt_kv(f32x16 (&racc)[2], LAS const unsigned char* lds, int wave, int lane) {
    const int eb = wave & 3, db0 = 2 * (wave >> 2);
#pragma unroll
    for (int ks = 0; ks < 8; ++ks) {
        const bf16x8 bv = rt_trfrag<false>(lds + RT_V, 16 * ks, eb, lane);
        const bf16x8 a0 = rt_trfrag<false>(lds + RT_K, 16 * ks, db0, lane), a1 = rt_trfrag<false>(lds + RT_K, 16 * ks, db0 + 1, lane);
        racc[0] = __builtin_amdgcn_mfma_f32_32x32x16_bf16(a0, bv, racc[0], 0, 0, 0);
        racc[1] = __builtin_amdgcn_mfma_f32_32x32x16_bf16(a1, bv, racc[1], 0, 0, 0);
    }
}
template <int KS> __device__ __forceinline__ void rt_kv_step(f32x16 (&racc)[2], unsigned av0, unsigned av1, unsigned ak0, unsigned ak1, unsigned ak2, unsigned ak3) {
    s16x4 v0, v1, k0, k1, k2, k3;
    asm volatile("ds_read_b64_tr_b16 %0, %6 offset:%12\n\tds_read_b64_tr_b16 %1, %7 offset:%12\n\tds_read_b64_tr_b16 %2, %8 offset:%12\n\tds_read_b64_tr_b16 %3, %9 offset:%12\n\t"
                 "ds_read_b64_tr_b16 %4, %10 offset:%12\n\tds_read_b64_tr_b16 %5, %11 offset:%12\n\ts_waitcnt lgkmcnt(0)"
                 : "=&v"(v0), "=&v"(v1), "=&v"(k0), "=&v"(k1), "=&v"(k2), "=&v"(k3) : "v"(av0), "v"(av1), "v"(ak0), "v"(ak1), "v"(ak2), "v"(ak3), "i"(KS * 4096) : "memory");
    const bf16x8 bv = __builtin_shufflevector(v0, v1, 0, 1, 2, 3, 4, 5, 6, 7), a0 = __builtin_shufflevector(k0, k1, 0, 1, 2, 3, 4, 5, 6, 7), a1 = __builtin_shufflevector(k2, k3, 0, 1, 2, 3, 4, 5, 6, 7);
    racc[0] = __builtin_amdgcn_mfma_f32_32x32x16_bf16(a0, bv, racc[0], 0, 0, 0);
    racc[1] = __builtin_amdgcn_mfma_f32_32x32x16_bf16(a1, bv, racc[1], 0, 0, 0);
}
__device__ __forceinline__ unsigned rt_traddr(LAS const unsigned char* img, int c, int t, int lane) {
    const int hh = lane >> 5, blk = (lane >> 4) & 1, q = (lane & 15) >> 2, p = lane & 3;
    return (unsigned)(size_t)img + rt_off(8 * hh + 4 * t + q, 4 * c + 2 * blk + (p >> 1)) + 8 * (p & 1);
}
__device__ __forceinline__ void ret_kvrun_steps(unsigned char* ws, LAS unsigned char* lds, int u0, int nu, int wave) {
    const int total = nu * 4;
#define RT_ISSUE(step) do { const int un_ = u0 + ((step) >> 2), c_ = (step) & 3, bh_ = un_ >> 4, run_ = un_ & 15, b_ = bh_ >> 2, h_ = bh_ & 3; \
        const size_t r_ = ((size_t)b_ * SEQ + run_ * 512 + c_ * 128) * RW + h_ * RDK; LAS unsigned char* bf_ = lds + ((step) & 1) * 65536; const int ln_ = lane_id(); \
        rt_fill(bf_, (const bf16_t*)(ws + WS_K) + r_, wave, ln_); rt_fill(bf_ + 32768, (const bf16_t*)(ws + WS_V) + r_, wave, ln_); } while (0)
    RT_ISSUE(0);
    f32x16 racc[2];
#pragma unroll 1
    for (int step = 0; step < total; ++step) {
        const int unit = u0 + (step >> 2), c = step & 3, h = (unit >> 4) & 3; const float g = (c == 0) ? 0.f : ret_g(h);
        if (step + 1 < total) { RT_ISSUE(step + 1); asm volatile("s_waitcnt vmcnt(8) lgkmcnt(0)\n\ts_barrier" ::: "memory"); }
        else asm volatile("s_waitcnt vmcnt(0) lgkmcnt(0)\n\ts_barrier" ::: "memory");
#pragma unroll
        for (int k = 0; k < 2; ++k)
#pragma unroll
            for (int j = 0; j < 16; ++j) racc[k][j] = (c == 0) ? 0.f : racc[k][j] * g;
        { const int lane = lane_id(); LAS const unsigned char* bf = lds + (step & 1) * 65536;
          const int eb = wave & 3, db0 = 2 * (wave >> 2);
          const unsigned av0 = rt_traddr(bf + 32768, eb, 0, lane), av1 = rt_traddr(bf + 32768, eb, 1, lane);
          const unsigned ak0 = rt_traddr(bf, db0, 0, lane), ak1 = rt_traddr(bf, db0, 1, lane), ak2 = rt_traddr(bf, db0 + 1, 0, lane), ak3 = rt_traddr(bf, db0 + 1, 1, lane);
          rt_kv_step<0>(racc, av0, av1, ak0, ak1, ak2, ak3); rt_kv_step<1>(racc, av0, av1, ak0, ak1, ak2, ak3); rt_kv_step<2>(racc, av0, av1, ak0, ak1, ak2, ak3); rt_kv_step<3>(racc, av0, av1, ak0, ak1, ak2, ak3);
          rt_kv_step<4>(racc, av0, av1, ak0, ak1, ak2, ak3); rt_kv_step<5>(racc, av0, av1, ak0, ak1, ak2, ak3); rt_kv_step<6>(racc, av0, av1, ak0, ak1, ak2, ak3); rt_kv_step<7>(racc, av0, av1, ak0, ak1, ak2, ak3);
          if (c == 3) { float* o = (float*)(ws + WS_KVRUN) + (size_t)unit * 16384 + (size_t)wave * 2048 + lane;
#pragma unroll
            for (int k = 0; k < 2; ++k)
#pragma unroll
                for (int j = 0; j < 16; ++j) o[(k * 16 + j) * 64] = racc[k][j]; } }
        asm volatile("s_waitcnt lgkmcnt(0)\n\ts_barrier" ::: "memory");
    }
    asm volatile("s_waitcnt vmcnt(0)" ::: "memory");
#undef RT_ISSUE
}
__device__ __forceinline__ void ret_scan(unsigned char* ws, int bx, int G, int tid) {
    for (int e2 = bx * NTHR + tid; e2 < NB * RH * 8192; e2 += G * NTHR) {
        const int bh = e2 >> 13, el = (e2 & 8191) * 2, h = bh & 3; float g4 = ret_g(h); g4 *= g4; g4 *= g4;
        const float* kv = (const float*)(ws + WS_KVRUN) + (size_t)bh * 16 * 16384 + el; bf16_t* rs = (bf16_t*)(ws + WS_RSTART) + (size_t)bh * 16 * 16384 + el;
        f32x2 v[15];
#pragma unroll
        for (int r = 0; r < 15; ++r) v[r] = *(const GAS f32x2*)(kv + (size_t)r * 16384);
        float z0 = 0.f; asm volatile("" : "+v"(z0));
        f32x2 s = {z0, z0};
        *(GAS unsigned*)rs = 0u;
#pragma unroll
        for (int r = 0; r < 15; ++r) { s = s * g4 + v[r]; *(GAS unsigned*)(rs + (size_t)(r + 1) * 16384) = pk2(s.x, s.y); }
    }
}
__device__ __forceinline__ void ret_out_unit(unsigned char* ws, LAS unsigned char* lds, const float* gain  , int unit, int wave) {
    const int bh = unit >> 4, run = unit & 15, b = bh >> 2, h = bh & 3; const float g = ret_g(h);
    const size_t row0 = (size_t)b * SEQ + run * 512;
    const int qb = wave & 3, eh = wave >> 2;
    LAS f32x2* exch = (LAS f32x2*)(lds + TAB_OFF);
    f32x16 racc[2];
    { const int lane = lane_id(); const bf16_t* o = (const bf16_t*)(ws + WS_RSTART) + (size_t)unit * 16384 + (size_t)wave * 2048 + lane;
#pragma unroll
      for (int k = 0; k < 2; ++k)
#pragma unroll
        for (int j = 0; j < 16; ++j) racc[k][j] = bf2f(o[(k * 16 + j) * 64]); }
#pragma unroll 1
    for (int c = 0; c < 4; ++c) {
        { const int lane = lane_id();
          rt_fill(lds + RT_Q, (const bf16_t*)(ws + WS_Q) + (row0 + c * 128) * RW + h * RDK, wave, lane);
          rt_fill(lds + RT_K, (const bf16_t*)(ws + WS_K) + (row0 + c * 128) * RW + h * RDK, wave, lane);
          rt_fill(lds + RT_V, (const bf16_t*)(ws + WS_V) + (row0 + c * 128) * RW + h * RDK, wave, lane);
          const int eb = wave & 3, db0 = 2 * (wave >> 2), r = lane & 31, hh = lane >> 5;
#pragma unroll
          for (int k = 0; k < 2; ++k)
#pragma unroll
            for (int q4 = 0; q4 < 4; ++q4) { u32x2 w; w.x = cvt_pk(racc[k][4 * q4] * g, racc[k][4 * q4 + 1] * g); w.y = cvt_pk(racc[k][4 * q4 + 2] * g, racc[k][4 * q4 + 3] * g);
                const int e = 32 * eb + r, d0 = 32 * (db0 + k) + 8 * q4 + 4 * hh;
                *(LAS u32x2*)(lds + RT_R + rt_off(e, d0 >> 3) + 2 * (d0 & 7)) = w; } }
#if defined(PROBE_DUP) && PROBE_DUP == 33
        VM_WAIT(); __syncthreads();
        { const int lane = lane_id();
          rt_fill(lds + RT_Q, (const bf16_t*)(ws + WS_Q) + (row0 + c * 128) * RW + h * RDK, wave, lane);
          rt_fill(lds + RT_K, (const bf16_t*)(ws + WS_K) + (row0 + c * 128) * RW + h * RDK, wave, lane);
          rt_fill(lds + RT_V, (const bf16_t*)(ws + WS_V) + (row0 + c * 128) * RW + h * RDK, wave, lane); }
#endif
        u32x4 gw[4];
        { const int lane = lane_id();
          const bf16_t* gp = (const bf16_t*)(ws + WS_GATE) + (row0 + c * 128 + 32 * qb + (lane >> 3)) * RW + h * RDK + 64 * eh;
#pragma unroll
          for (int j = 0; j < 4; ++j) { const int row = 8 * j + (lane >> 3); gw[j] = *(const GAS u32x4*)(gp + (size_t)(8 * j) * RW + 8 * ((lane & 7) ^ (row & 7))); } }
        VM_WAIT(); __syncthreads();
        {   const int lane = lane_id(), r = lane & 31, hh = lane >> 5;
            bf16x8 bq[8];
#pragma unroll
            for (int s = 0; s < 8; ++s) bq[s] = rt_rowfrag(lds + RT_Q, qb, s, lane);
            f32x16 sacc[4];
#pragma unroll
            for (int kb = 0; kb < 4; ++kb) {
#pragma unroll
                for (int j = 0; j < 16; ++j) sacc[kb][j] = 0.f;
                if (kb <= qb) {
#pragma unroll
                    for (int s = 0; s < 8; ++s) sacc[kb] = __builtin_amdgcn_mfma_f32_32x32x16_bf16(rt_rowfrag(lds + RT_K, kb, s, lane), bq[s], sacc[kb], 0, 0, 0);
                }
            }
#pragma unroll
            for (int kb = 0; kb < 4; ++kb) if (kb == qb) {
#pragma unroll
                for (int j = 0; j < 16; ++j) { const int key = (j & 3) + 8 * (j >> 2) + 4 * hh; sacc[kb][j] = (key <= r) ? sacc[kb][j] : 0.f; } }
            f32x16 oacc[2];
#pragma unroll
            for (int k = 0; k < 2; ++k)
#pragma unroll
                for (int j = 0; j < 16; ++j) oacc[k][j] = 0.f;
#pragma unroll
            for (int kb = 0; kb < 4; ++kb) if (kb <= qb) {
#pragma unroll
                for (int s = 0; s < 2; ++s) { u32x4 w; w.x = cvt_pk(sacc[kb][8 * s + 0], sacc[kb][8 * s + 1]); w.y = cvt_pk(sacc[kb][8 * s + 2], sacc[kb][8 * s + 3]);
                    w.z = cvt_pk(sacc[kb][8 * s + 4], sacc[kb][8 * s + 5]); w.w = cvt_pk(sacc[kb][8 * s + 6], sacc[kb][8 * s + 7]); const bf16x8 bp = __builtin_bit_cast(bf16x8, w);
#pragma unroll
                    for (int k = 0; k < 2; ++k) oacc[k] = __builtin_amdgcn_mfma_f32_32x32x16_bf16(rt_trfrag<true>(lds + RT_V, 32 * kb + 16 * s, 2 * eh + k, lane), bp, oacc[k], 0, 0, 0); } }
#pragma unroll
            for (int s = 0; s < 8; ++s)
#pragma unroll
                for (int k = 0; k < 2; ++k) oacc[k] = __builtin_amdgcn_mfma_f32_32x32x16_bf16(rt_rowfrag(lds + RT_R, 2 * eh + k, s, lane), bq[s], oacc[k], 0, 0, 0);
            float s1 = 0.f, s2 = 0.f;
#pragma unroll
            for (int k = 0; k < 2; ++k)
#pragma unroll
                for (int j = 0; j < 16; ++j) { s1 += oacc[k][j]; s2 += oacc[k][j] * oacc[k][j]; }
            s1 = half_sum(s1); s2 = half_sum(s2);
            if (hh == 0) exch[eh * 128 + 32 * qb + r] = (f32x2){s1, s2};
            __syncthreads();
            const f32x2 e0 = exch[32 * qb + r], e1 = exch[128 + 32 * qb + r];
            const float mu = (e0.x + e1.x) * (1.0f / 128.0f), var = (e0.y + e1.y) * (1.0f / 128.0f) - mu * mu, rstd = 1.0f / sqrtf(var + EPS);
            LAS unsigned char* wb = lds + RT_Q + wave * 4096;
#pragma unroll
            for (int k = 0; k < 2; ++k)
#pragma unroll
                for (int q4 = 0; q4 < 4; ++q4) { const int el = 32 * k + 8 * q4 + 4 * hh; const f32x4 gn = *(const GAS f32x4*)(gain + h * RDK + 64 * eh + el);
                    u32x2 w; w.x = cvt_pk((oacc[k][4 * q4] - mu) * rstd * gn.x, (oacc[k][4 * q4 + 1] - mu) * rstd * gn.y); w.y = cvt_pk((oacc[k][4 * q4 + 2] - mu) * rstd * gn.z, (oacc[k][4 * q4 + 3] - mu) * rstd * gn.w);
                    *(LAS u32x2*)(wb + r * 128 + (((el >> 3) ^ (r & 7)) << 4) + 8 * hh) = w; }
            asm volatile("s_waitcnt lgkmcnt(0)" ::: "memory");
            bf16_t* yp = (bf16_t*)(ws + WS_YMIX) + (row0 + c * 128 + 32 * qb) * D + S5W + h * RDK + 64 * eh;
#if defined(PROBE_DUP) && PROBE_DUP == 35
            for (int rp = 0; rp < 2; ++rp)
#endif
#pragma unroll
            for (int j = 0; j < 4; ++j) { const int row = 8 * j + (lane >> 3), cp = lane & 7; const u32x4 v = *(LAS const u32x4*)(wb + row * 128 + cp * 16), gv = gw[j];
                float y[8];
                y[0] = bflo(v.x) * bflo(gv.x) * fast_sigmoid(bflo(gv.x)); y[1] = bfhi(v.x) * bfhi(gv.x) * fast_sigmoid(bfhi(gv.x)); y[2] = bflo(v.y) * bflo(gv.y) * fast_sigmoid(bflo(gv.y)); y[3] = bfhi(v.y) * bfhi(gv.y) * fast_sigmoid(bfhi(gv.y));
                y[4] = bflo(v.z) * bflo(gv.z) * fast_sigmoid(bflo(gv.z)); y[5] = bfhi(v.z) * bfhi(gv.z) * fast_sigmoid(bfhi(gv.z)); y[6] = bflo(v.w) * bflo(gv.w) * fast_sigmoid(bflo(gv.w)); y[7] = bfhi(v.w) * bfhi(gv.w) * fast_sigmoid(bfhi(gv.w));
                u32x4 w; w.x = cvt_pk(y[0], y[1]); w.y = cvt_pk(y[2], y[3]); w.z = cvt_pk(y[4], y[5]); w.w = cvt_pk(y[6], y[7]);
                *(GAS u32x4*)(yp + (size_t)row * D + 8 * (cp ^ (row & 7))) = w; }
        }
#if defined(PROBE_DUP) && PROBE_DUP == 36
        if (c < 3) { f32x16 r2[2] = {racc[0], racc[1]}; asm volatile("" : "+v"(r2[0]), "+v"(r2[1])); rt_kv(r2, lds, wave, lane_id()); asm volatile("" :: "v"(r2[0]), "v"(r2[1])); }
#endif
        if (c < 3) {
#pragma unroll
            for (int k = 0; k < 2; ++k) racc[k] *= g;
            rt_kv(racc, lds, wave, lane_id());
        }
        __syncthreads();
    }
}

struct Args { In in; float* out; unsigned char* ws; int pro_lo, pro_hi, l_lo, l_hi, ph_lo, ph_hi, flags, region; };
enum { PH_PROJ = 0, PH_MIXA = 1, PH_SCAN = 2, PH_MIXC = 3, PH_GLU = 4, PH_WOUT = 5, PH_CQ = 6, PH_XATT = 7, PH_CO = 8, PH_FFN1 = 9, PH_FFN2 = 10, PH_N = 11 };
enum { FL_XPREP = 1, FL_FINAL = 2, FL_XIN = 4 };

__global__ void __launch_bounds__(NTHR, 2) fwd(Args a) {
    extern __shared__ __attribute__((aligned(16))) unsigned char lds_raw[];
    LAS unsigned char* lds = (LAS unsigned char*)lds_raw;
    const int wave = __builtin_amdgcn_readfirstlane(threadIdx.x >> 6); const bool t0 = (threadIdx.x == 0);
#define LANE lane_id()
    const int G = gridDim.x, bx = blockIdx.x, vcu = (G % 8 == 0) ? (bx % 8) * (G / 8) + bx / 8 : bx;
    volatile LAS unsigned* MISC = (volatile LAS unsigned*)(lds + MISC_OFF);
    if (threadIdx.x < 32) MISC[threadIdx.x] = 0u;
    __syncthreads();
    unsigned char* ws = a.ws;
    unsigned* ctl = (unsigned*)(ws + WS_CTL);
    XcdBarrier bar = xcd_barrier_post(ctl + CW_BAR + a.region * XCD_BAR_WORDS, MISC + 8, t0);
    bool need_bar = false;
#ifndef PROBE_DUP
#define PROBE_DUP -1
#endif
#define REPS(k) ((PROBE_DUP == (k)) ? 2 : 1)
#define SEAM() do { if (need_bar) { xcd_barrier(bar); if (PROBE_DUP == 100) xcd_barrier(bar); } need_bar = true; } while (0)
    const int gw = vcu * NWAVES + wave, NGW = G * NWAVES;
    const In& in = a.in;
    float* ssq = (float*)(ws + WS_SSQ);
    bf16_t* xb = (bf16_t*)(ws + WS_XB);
    LAS float* tab = (LAS float*)(lds + TAB_OFF);
    float* rsm = (float*)(ws + WS_SPARE);

#ifndef STAGGER_TICKS
#define STAGGER_TICKS 0
#endif
#define STAGGER() do { if (STAGGER_TICKS > 0) { const unsigned long long t0_ = __builtin_amdgcn_s_memrealtime(), d_ = (unsigned long long)((bx & 7) * STAGGER_TICKS); \
        while (__builtin_amdgcn_s_memrealtime() - t0_ < d_) __builtin_amdgcn_s_sleep(2); } } while (0)
    for (int rep = 0; rep < REPS(200); ++rep) if (a.pro_lo <= 0 && 0 < a.pro_hi) {
        SEAM();
        pro_weights(in, ws, lds, gw, NGW, wave, LANE);
#if PROBE_DUP == 210
        __syncthreads(); pro_weights(in, ws, lds, gw + (int)(a.flags >> 8), NGW, wave, LANE);
#endif
        for (int r2 = 0; r2 < REPS(211); ++r2) if (a.flags & FL_XIN) xprep_rows(in.x, xb, ssq, gw, NGW, LANE);
        mem_prep_rows(in.mem, (bf16_t*)(ws + WS_MEMB), rsm, gw, NGW, LANE);
        for (int r2 = 0; r2 < REPS(212); ++r2) rope_table(in.pos, (float*)(ws + WS_ROPE), gw * 64 + LANE, NGW * 64);
        __syncthreads();
        for (int r2 = 0; r2 < REPS(213); ++r2) for (int it = bx; it < DEPTH * S5G * 4; it += G) s5_tables_item(in, ws, lds, it, wave, LANE);
        __syncthreads();
    }
    for (int rep = 0; rep < REPS(201); ++rep) if (a.pro_lo <= 1 && 1 < a.pro_hi) {
        SEAM();
        int bxo = bx; asm volatile("" : "+s"(bxo));
        { GroupOrder S; S.init(DEPTH, MROWS / BM, D / BM, G, bxo, 0);
          const Gemm g{(const bf16_t*)(ws + WS_MEMB), (const bf16_t*)(ws + WS_WCK_TMP), D, D, D, 0, (long)D * D};
          const EpiMemK E{(bf16_t*)(ws + WS_MEMK), rsm};
          gemm_phase<EpiMemK, GroupOrder>(lds, g, S, E, wave); }
        { GroupOrder S; S.init(DEPTH, D / BM, MROWS / BM, G, bxo, 64);
          const Gemm g{(const bf16_t*)(ws + WS_WCV_TMP), (const bf16_t*)(ws + WS_MEMB), D, D, D, (long)D * D, 0};
          const EpiMemVT E{(bf16_t*)(ws + WS_MEMVT), rsm};
          gemm_phase<EpiMemVT, GroupOrder>(lds, g, S, E, wave); }
        for (int it = bxo; it < DEPTH * S5G * 8; it += G) s5_build_item(in, ws, (unsigned char*)a.out + (size_t)(it >> 8) * S5M_LAYER, it >> 8, it & 255, wave * 64 + LANE);
    }
    for (int l = a.l_lo; l < a.l_hi; ++l) {
#define IN_PH(k) (a.ph_lo <= (k) && (k) < a.ph_hi)
        for (int rep = 0; rep < REPS(PH_PROJ); ++rep) if (IN_PH(PH_PROJ)) {
            SEAM();
            int bxo = bx; asm volatile("" : "+s"(bxo));
            StaticOrder S; S.init(M / BM, INW / BM, G, bxo);
            rstd_table(tab, S, ssq, 16, 1.0f / D, wave);
            const Gemm g{xb, wl(ws, l, W_IN), D, D, D, 0, 0};
            const EpiProj E{(bf16_t*)(ws + WS_UG), (bf16_t*)(ws + WS_Q), (bf16_t*)(ws + WS_K), (bf16_t*)(ws + WS_V), (bf16_t*)(ws + WS_GATE), (const float*)(ws + WS_ROPE), tab};
            STAGGER();
            gemm_phase<EpiProj, StaticOrder>(lds, g, S, E, wave);
        }
        for (int rep = 0; rep < REPS(PH_MIXA); ++rep) if (IN_PH(PH_MIXA)) {
            SEAM();
            int bxo = bx; asm volatile("" : "+s"(bxo));
            if (G == 256) {
                if (bxo < 128) { GroupOrder S; S.init(S5G, (M / 32) / BM, 1, G, bxo, 0);
                  const Gemm g{(const bf16_t*)(ws + WS_UG), (const bf16_t*)((unsigned char*)a.out + (size_t)l * S5M_LAYER + S5M_WEND), 640, 512, 512, (long)(M / 32) * 640, 256L * 512};
                  const EpiS5End E{(float*)(ws + WS_SEND)};
                  gemm_phase<EpiS5End, GroupOrder>(lds, g, S, E, wave); }
                else ret_kvrun_steps(ws, lds, 2 * (bxo - 128), 2, wave);
            } else {
                { GroupOrder S; S.init(S5G, (M / 32) / BM, 1, G, bxo, 0);
                  const Gemm g{(const bf16_t*)(ws + WS_UG), (const bf16_t*)((unsigned char*)a.out + (size_t)l * S5M_LAYER + S5M_WEND), 640, 512, 512, (long)(M / 32) * 640, 256L * 512};
                  const EpiS5End E{(float*)(ws + WS_SEND)};
                  gemm_phase<EpiS5End, GroupOrder>(lds, g, S, E, wave); }
                __syncthreads();
                for (int u = bxo; u < NB * RH * 16; u += G) ret_kvrun_steps(ws, lds, u, 1, wave);
            }
        }
        for (int rep = 0; rep < REPS(PH_SCAN); ++rep) if (IN_PH(PH_SCAN)) {
            SEAM();
            for (int u = bx; u < NB * S5G; u += G) s5_scan_unit(ws, lds, l, u, wave, LANE);
            ret_scan(ws, bx, G, wave * 64 + LANE);
        }
        for (int rep = 0; rep < REPS(PH_MIXC); ++rep) if (IN_PH(PH_MIXC)) {
            SEAM();
            int bxo = bx; asm volatile("" : "+s"(bxo));
            for (int r2 = 0; r2 < REPS(31); ++r2)
            { GroupOrder S; S.init(S5G, (M / 32) / BM, 2, G, bxo, 0);
              const Gemm g{(const bf16_t*)(ws + WS_UG), (const bf16_t*)((unsigned char*)a.out + (size_t)l * S5M_LAYER + S5M_T), 640, 640, 640, (long)(M / 32) * 640, 512L * 640};
              const EpiS5Out E{(bf16_t*)(ws + WS_Z)};
              gemm_phase<EpiS5Out, GroupOrder>(lds, g, S, E, wave); }
            __syncthreads();
            for (int r2 = 0; r2 < REPS(32); ++r2)
            for (int u = bxo; u < NB * RH * 16; u += G) ret_out_unit(ws, lds, in.retn + l * RW, u, wave);
        }
        for (int rep = 0; rep < REPS(PH_GLU); ++rep) if (IN_PH(PH_GLU)) {
            SEAM();
            int bxo = bx; asm volatile("" : "+s"(bxo));
            StaticOrder S; S.init(M / BM, S5W / BM, G, bxo);
            const Gemm g{(const bf16_t*)(ws + WS_Z), wl(ws, l, W_GLU), S5W, S5W, S5W, 0, 0, M};
            const EpiGlu E{(const bf16_t*)(ws + WS_Z), in.bglu + l * S5W, (bf16_t*)(ws + WS_YMIX), (float*)(ws + WS_SSQS)};
            gemm_phase<EpiGlu, StaticOrder>(lds, g, S, E, wave);
        }
        for (int rep = 0; rep < REPS(PH_WOUT); ++rep) if (IN_PH(PH_WOUT)) {
            SEAM();
            int bxo = bx; asm volatile("" : "+s"(bxo));
            StaticOrder S; S.init(M / BM, D / BM, G, bxo);
            LAS float* tab2 = (LAS float*)(lds + TAB2_OFF);
            rstd_table(tab2, S, (const float*)(ws + WS_SSQS), 8, 1.0f / S5W, wave);
            const Gemm g{(const bf16_t*)(ws + WS_YMIX), wl(ws, l, W_OUT), D, D, D, 0, 0};
            const EpiResHook E{{xb, ssq, nullptr, (REPS(PH_WOUT) == 2 && rep == 0) ? 0.f : 1.f}, tab2, 8};
            gemm_phase<EpiResHook, StaticOrder, true>(lds, g, S, E, wave);
        }
        for (int rep = 0; rep < REPS(PH_CQ); ++rep) if (IN_PH(PH_CQ)) {
            SEAM();
            int bxo = bx; asm volatile("" : "+s"(bxo));
            StaticOrder S; S.init(M / BM, D / BM, G, bxo);
            rstd_table(tab, S, ssq, 16, 1.0f / D, wave);
            const Gemm g{xb, wl(ws, l, W_CQ), D, D, D, 0, 0};
            const EpiScaleBf16 E{(bf16_t*)(ws + WS_QC), D, tab};
            gemm_phase<EpiScaleBf16, StaticOrder>(lds, g, S, E, wave);
#pragma unroll 1
            for (int i = 0; i < 2; ++i) { Unit u; if (!S.next(i, u)) break;
                const int upm = __builtin_amdgcn_readfirstlane(u.pm), upn = __builtin_amdgcn_readfirstlane(u.pn);
                xattn_unit(lds, (const bf16_t*)(ws + WS_QC), (const bf16_t*)(ws + WS_MEMK) + (size_t)l * MROWS * D, (const bf16_t*)(ws + WS_MEMVT) + (size_t)l * D * MROWS, (bf16_t*)(ws + WS_OC), upm >> 5, upn, upm & 31, wave); }
        }
        for (int rep = 0; rep < REPS(PH_CO); ++rep) if (IN_PH(PH_CO)) {
            SEAM();
            int bxo = bx; asm volatile("" : "+s"(bxo));
            StaticOrder S; S.init(M / BM, D / BM, G, bxo);
            const Gemm g{(const bf16_t*)(ws + WS_OC), wl(ws, l, W_CO), D, D, D, 0, 0};
            const EpiRes E{xb, ssq, nullptr, (REPS(PH_CO) == 2 && rep == 0) ? 0.f : 1.f};
            gemm_phase<EpiRes, StaticOrder>(lds, g, S, E, wave);
        }
        for (int rep = 0; rep < REPS(PH_FFN1); ++rep) if (IN_PH(PH_FFN1)) {
            SEAM();
            int bxo = bx; asm volatile("" : "+s"(bxo));
            StaticOrder S; S.init(M / BM, (2 * FF) / BM, G, bxo);
            rstd_table(tab, S, ssq, 16, 1.0f / D, wave);
#if defined(PROBE_DUP) && PROBE_DUP == 400
            { const Gemm g0{xb, wl(ws, l, W_GU), D, D, D, 0, 0, 0, 1}; const EpiFfn1 E0{(bf16_t*)(ws + WS_HID), tab}; gemm_phase<EpiFfn1, StaticOrder>(lds, g0, S, E0, wave); }
#endif
            const Gemm g{xb, wl(ws, l, W_GU), D, D, D, 0, 0};
            const EpiFfn1 E{(bf16_t*)(ws + WS_HID), tab};
            STAGGER();
            gemm_phase<EpiFfn1, StaticOrder>(lds, g, S, E, wave);
        }
        for (int rep = 0; rep < REPS(PH_FFN2); ++rep) if (IN_PH(PH_FFN2)) {
            SEAM();
            int bxo = bx; asm volatile("" : "+s"(bxo));
            StaticOrder S; S.init(M / BM, D / BM, G, bxo);
            const Gemm g{(const bf16_t*)(ws + WS_HID), wl(ws, l, W_DN), FF, FF, FF, 0, 0};
            const EpiRes E{xb, ssq, nullptr, (REPS(PH_FFN2) == 2 && rep == 0) ? 0.f : 1.f};
            gemm_phase<EpiRes, StaticOrder>(lds, g, S, E, wave);
        }
    }
    if (a.flags & FL_FINAL) { SEAM(); final_norm_rows(xb, a.out, in.norm_final, gw, NGW, LANE); }
#undef IN_PH
#undef SEAM
#undef LANE
}
}

extern "C" void kernel_launch(void* const* d_in, const int* in_sizes, int n_in, void* d_out, int out_size, void* d_ws, size_t ws_size, hipStream_t stream) {
    static int grid = 0;
    if (grid == 0) {
        if (n_in != 29 || out_size != mk::M * mk::D || ws_size < mk::WS_END) { fprintf(stderr, "kernel_launch: unexpected sizes (n_in %d out %d ws %zu)\n", n_in, out_size, ws_size); grid = -1; return; }
        int dev = 0, cus = 0, per_cu = 0;
        if (hipGetDevice(&dev) != hipSuccess || hipDeviceGetAttribute(&cus, hipDeviceAttributeMultiprocessorCount, dev) != hipSuccess) { grid = -1; return; }
        if (hipFuncSetAttribute((const void*)mk::fwd, hipFuncAttributeMaxDynamicSharedMemorySize, mk::LDS_BYTES) != hipSuccess) { fprintf(stderr, "kernel_launch: hipFuncSetAttribute failed\n"); grid = -1; return; }
        if (hipOccupancyMaxActiveBlocksPerMultiprocessor(&per_cu, (const void*)mk::fwd, mk::NTHR, mk::LDS_BYTES) != hipSuccess || per_cu < 1) fprintf(stderr, "kernel_launch: occupancy query says %d\n", per_cu);
        (void)hipGetLastError();
        grid = cus;
    }
    if (grid < 0) return;
    (void)in_sizes;
    if (hipMemsetAsync((char*)d_ws + mk::WS_CTL, 0, mk::CTL_ZERO_BYTES, stream) != hipSuccess) return;
    mk::Args a{};
    { const void** p = (const void**)&a.in; for (int i = 0; i < 29; ++i) p[i] = d_in[i]; }
    a.out = (float*)d_out; a.ws = (unsigned char*)d_ws;
    a.pro_lo = 0; a.pro_hi = 2; a.l_lo = 0; a.l_hi = mk::DEPTH; a.ph_lo = 0; a.ph_hi = mk::PH_N; a.flags = mk::FL_XIN | mk::FL_FINAL; a.region = 0;
    hipLaunchKernelGGL(mk::fwd, dim3(grid), dim3(mk::NTHR), mk::LDS_BYTES, stream, a);
    const hipError_t le = hipPeekAtLastError();
    if (le != hipSuccess) fprintf(stderr, "kernel_launch: launch failed: %s\n", hipGetErrorName(le));
}
```

```cpp
#include <hip/hip_runtime.h>
#include <cstdio>
#include <cstdint>
#include <cmath>

namespace mk {
#define LAS __attribute__((address_space(3)))
#define GAS __attribute__((address_space(1)))
typedef unsigned short bf16_t;
typedef short bf16x8 __attribute__((ext_vector_type(8)));
typedef float f32x4 __attribute__((ext_vector_type(4)));
typedef float f32x2 __attribute__((ext_vector_type(2)));
typedef float f32x16 __attribute__((ext_vector_type(16)));
typedef unsigned u32x4 __attribute__((ext_vector_type(4)));
typedef unsigned u32x2 __attribute__((ext_vector_type(2)));
constexpr int M = 32768, D = 1024, NB = 4, SEQ = 8192, DEPTH = 4, MEML = 256, MROWS = NB * MEML;
constexpr int S5W = 512, S5G = 32, S5P = 64, RH = 4, RDK = 128, RW = 512, INW = 2560, XH = 4, XD = 256, FF = 2816;
constexpr float EPS = 1e-6f;
constexpr int BM = 256, BK = 64, HALF = 128, HTB = HALF * BK * 2, STAGE_BYTES = 8 * HTB, NXCD = 8, WGM = 8;
constexpr int NWAVES = 8, NTHR = 512;

constexpr int TAB_OFF = STAGE_BYTES;
constexpr int TAB2_OFF = TAB_OFF + 12288;
constexpr int MISC_OFF = TAB2_OFF + 2048;
constexpr int LDS_BYTES = 147456;
static_assert(MISC_OFF + 128 <= LDS_BYTES, "lds map");

constexpr size_t MiB = 1u << 20;
constexpr size_t WS_CTL = 0, CTL_ZERO_BYTES = 1 * MiB;
constexpr size_t WS_SSQ = 1 * MiB;
constexpr size_t WS_SSQS = 3 * MiB;
constexpr size_t WS_W = 4 * MiB, W_LAYER = 28 * MiB;
constexpr size_t W_IN = 0, W_GLU = 5 * MiB, W_OUT = W_GLU + MiB / 2, W_CQ = W_OUT + 2 * MiB, W_CO = W_CQ + 2 * MiB, W_GU = W_CO + 2 * MiB, W_DN = W_GU + 11 * MiB;
static_assert(W_DN + 11 * MiB / 2 == W_LAYER, "weights");
constexpr size_t WS_ROPE = 116 * MiB;
constexpr size_t WS_MEMK = 132 * MiB;
constexpr size_t WS_MEMVT = 140 * MiB;
constexpr size_t WS_S5M = 148 * MiB;
constexpr size_t WS_XB = 176 * MiB;
constexpr size_t WS_PROJ = 240 * MiB;
constexpr size_t WS_UG = WS_PROJ, WS_Q = WS_PROJ + 40 * MiB, WS_K = WS_Q + 32 * MiB, WS_V = WS_K + 32 * MiB, WS_GATE = WS_V + 32 * MiB;
constexpr size_t WS_Z = 408 * MiB;
constexpr size_t WS_YMIX = 440 * MiB;
constexpr size_t WS_SPARE = 504 * MiB;
constexpr size_t WS_QC = WS_PROJ, WS_OC = WS_PROJ + 64 * MiB, WS_HID = WS_PROJ;
constexpr size_t WS_WCK_TMP = WS_PROJ, WS_WCV_TMP = WS_PROJ + 8 * MiB, WS_MEMB = WS_PROJ + 16 * MiB;
constexpr size_t WS_END = 512 * MiB;
constexpr int CW_BAR = 4096, XB_WORDS = 3456, N_BAR_REGIONS = 64;
static_assert((CW_BAR + N_BAR_REGIONS * XB_WORDS) * 4 <= (int)CTL_ZERO_BYTES, "ctl");

__host__ __device__ __forceinline__ int lds_byte(int r, int c) { const int st = (r >> 4) * 2 + (c >> 5), rr = r & 15, cc = c & 31, ob = rr * 64 + cc * 2; return st * 1024 + (ob ^ (((ob >> 9) & 1) << 5)); }
__host__ __device__ __forceinline__ void stage_rc(int b, int& R, int& C) { const int st = b / 1024, sb = b % 1024, swz = sb ^ (((sb >> 9) & 1) << 5); R = (st >> 1) * 16 + swz / 64; C = (st & 1) * 32 + (swz % 64) / 2; }
__host__ __device__ __forceinline__ int perm32(int rho) { const int n = rho >> 4, i = rho & 15; return 8 * (i >> 2) + 4 * n + (i & 3); }

struct Unit { int pm, pn, g; };
struct Gemm { const bf16_t* A; const bf16_t* Bt; int lda, ldb, K; long a_gs, b_gs; int a_g16; int probe_same; };

struct StaticOrder {
    int nM, nN, nwg, G, c;
    __device__ __forceinline__ void init(int nM_, int nN_, int G_, int c_) { nM = nM_; nN = nN_; nwg = nM * nN; G = G_; c = c_; }
    __device__ __forceinline__ bool next(int i, Unit& u) const {
        const long L = (long)i * G + c; if (L >= nwg) return false;
        int wgid = (int)L; { const int q = nwg / NXCD, r = nwg % NXCD, xcd = wgid % NXCD, off = wgid / NXCD; wgid = (xcd < r ? xcd * (q + 1) : r * (q + 1) + (xcd - r) * q) + off; }
        const int nig = WGM * nN, gid = wgid / nig, fm = gid * WGM, gsz = (nM - fm) < WGM ? (nM - fm) : WGM;
        u.pm = fm + ((wgid % nig) % gsz); u.pn = (wgid % nig) / gsz; u.g = 0; return true;
    }
};
struct GroupOrder {
    int nM, nN, nG, G, c, first;
    __device__ __forceinline__ void init(int nG_, int nM_, int nN_, int G_, int c_, int first_) { nG = nG_; nM = nM_; nN = nN_; G = G_; c = c_; first = first_; }
    __device__ __forceinline__ bool next(int i, Unit& u) const {
        const long L = (long)i * G + c - first; if (L < 0 || L >= (long)nG * nM * nN) return false;
        u.pn = (int)(L % nN); const int r = (int)(L / nN); u.pm = r % nM; u.g = r / nM; return true;
    }
};

__device__ __forceinline__ unsigned f2bf(float f) { unsigned u = __builtin_bit_cast(unsigned, f); return (u + 0x7fffu + ((u >> 16) & 1u)) >> 16; }
__device__ __forceinline__ unsigned pk2(float lo, float hi) { return f2bf(lo) | (f2bf(hi) << 16); }
__device__ __forceinline__ unsigned cvt_pk(float lo, float hi) { unsigned r; asm volatile("v_cvt_pk_bf16_f32 %0, %1, %2" : "=v"(r) : "v"(lo), "v"(hi)); return r; }
__device__ __forceinline__ float bf2f(unsigned short b) { return __builtin_bit_cast(float, ((unsigned)b) << 16); }
__device__ __forceinline__ float bflo(unsigned w) { return __builtin_bit_cast(float, w << 16); }
__device__ __forceinline__ float bfhi(unsigned w) { return __builtin_bit_cast(float, w & 0xffff0000u); }
__device__ __forceinline__ float fast_sigmoid(float x) { return __builtin_amdgcn_rcpf(1.0f + __builtin_amdgcn_exp2f(-1.4426950408889634f * x)); }
template <int O> __device__ __forceinline__ float swz_xor(float v) { return __builtin_bit_cast(float, __builtin_amdgcn_ds_swizzle(__builtin_bit_cast(int, v), (O << 10) | 0x1f)); }
__device__ __forceinline__ float row16_sum(float v) { const unsigned u = __builtin_bit_cast(unsigned, v); auto r = __builtin_amdgcn_permlane16_swap(u, u, false, false);
    return __builtin_bit_cast(float, (unsigned)r[0]) + __builtin_bit_cast(float, (unsigned)r[1]); }
__device__ __forceinline__ float half_sum(float v) { const unsigned u = __builtin_bit_cast(unsigned, v); auto r = __builtin_amdgcn_permlane32_swap(u, u, false, false);
    return __builtin_bit_cast(float, (unsigned)r[0]) + __builtin_bit_cast(float, (unsigned)r[1]); }
__device__ __forceinline__ float half_max(float v) { const unsigned u = __builtin_bit_cast(unsigned, v); auto r = __builtin_amdgcn_permlane32_swap(u, u, false, false);
    return fmaxf(__builtin_bit_cast(float, (unsigned)r[0]), __builtin_bit_cast(float, (unsigned)r[1])); }
__device__ __forceinline__ float wave_sum(float v) { v += swz_xor<1>(v); v += swz_xor<2>(v); v += swz_xor<4>(v); v += swz_xor<8>(v); v += swz_xor<16>(v); return half_sum(v); }

__device__ __forceinline__ int lane_id() { unsigned z = 0u; asm volatile("" : "+v"(z)); return (int)__builtin_amdgcn_mbcnt_hi(~0u, __builtin_amdgcn_mbcnt_lo(~0u, z)); }
struct NoPre { __device__ __forceinline__ void operator()(int) const {} };
template <class Epi, class Sched, bool HOOK = false, class Pre = NoPre>
__device__ __forceinline__ void gemm_phase(LAS unsigned char* lds, const Gemm g, const Sched& S, const Epi& E, int wid, const Pre& pre = Pre()) {
    const int lane = lane_id(), tid = wid * 64 + lane, wr = wid >> 2, wc = wid & 3, fr = lane & 15, fq = lane >> 4;
    const int nt = g.K / BK;
    unsigned voffA[2], voffB[2];
#pragma unroll
    for (int i = 0; i < 2; ++i) { int R, C; stage_rc(tid * 16 + i * 8192, R, C); const int Rb = Epi::PERM ? ((R & ~31) + perm32(R & 31)) : R;
        voffA[i] = g.a_g16 ? (unsigned)(((C >> 4) * g.a_g16 + R) * 16 + (C & 15)) * 2u : (unsigned)(R * g.lda + C) * 2u; voffB[i] = (unsigned)(Rb * g.ldb + C) * 2u; }
    const size_t kstep = (size_t)(BK * 2);
    const size_t kstepA = g.a_g16 ? (size_t)g.a_g16 * 128 : kstep;
    const size_t hstepA = g.a_g16 ? (size_t)HALF * 32 : (size_t)HALF * g.lda * 2, hstepB = (size_t)HALF * g.ldb * 2;
    const unsigned ldsw = (unsigned)wid * 1024u;
    const int aoff = lds_byte(wr * 64 + fr, fq * 8), boff = lds_byte(wc * 32 + fr, fq * 8);
#define PG8_SA(b, h) (((b) * 2 + (h)) * HTB)
#define PG8_SB(b, h) ((4 + (b) * 2 + (h)) * HTB)
#define PG8_STAGE(bufoff, gbase, voff) do { _Pragma("unroll") for (int _i = 0; _i < 2; ++_i) \
        __builtin_amdgcn_global_load_lds((const unsigned*)((const char*)(gbase) + (voff)[_i]), (LAS unsigned*)(lds + (bufoff) + ldsw + _i * 8192), 16, 0, 0); } while (0)
#define PG8_LDA(dst, b, h) do { _Pragma("unroll") for (int m = 0; m < 4; ++m) _Pragma("unroll") for (int k = 0; k < 2; ++k) dst[m][k] = *(const LAS bf16x8*)(lds + PG8_SA(b, h) + aoff + m * 2048 + k * 1024); } while (0)
#define PG8_LDB(dst, b, h) do { _Pragma("unroll") for (int n = 0; n < 2; ++n) _Pragma("unroll") for (int k = 0; k < 2; ++k) dst[n][k] = *(const LAS bf16x8*)(lds + PG8_SB(b, h) + boff + n * 2048 + k * 1024); } while (0)
#define PG8_MMA(ai, bj, At, Bt) do { __builtin_amdgcn_s_setprio(1); _Pragma("unroll") for (int m = 0; m < 4; ++m) _Pragma("unroll") for (int n = 0; n < 2; ++n) _Pragma("unroll") for (int k = 0; k < 2; ++k) \
        acc[ai][bj][m][n] = __builtin_amdgcn_mfma_f32_16x16x32_bf16(Bt[n][k], At[m][k], acc[ai][bj][m][n], 0, 0, 0); __builtin_amdgcn_s_setprio(0); } while (0)
#define PG8_WAIT_V(n) asm volatile("s_waitcnt vmcnt(" #n ")" ::: "memory")
#define PG8_WAIT_L(n) asm volatile("s_waitcnt lgkmcnt(" #n ")" ::: "memory")
#define PG8_BAR __builtin_amdgcn_s_barrier()
#define PG8_SCHED __builtin_amdgcn_sched_barrier(0)
#define PG8_ABASE(u) ((const char*)g.A + ((size_t)(u).g * g.a_gs + (size_t)(g.probe_same ? 0 : (u).pm) * BM * (g.a_g16 ? 16 : g.lda)) * 2)
#define PG8_BBASE(u) ((const char*)g.Bt + ((size_t)(u).g * g.b_gs + (size_t)(g.probe_same ? 0 : (u).pn) * BM * g.ldb) * 2)
    Unit cur, nxt; int ui = 0;
    if (!S.next(0, cur)) return;
    f32x4 acc[2][2][4][2];
#pragma unroll
    for (int a = 0; a < 2; ++a)
#pragma unroll
        for (int b = 0; b < 2; ++b)
#pragma unroll
            for (int m = 0; m < 4; ++m)
#pragma unroll
                for (int n = 0; n < 2; ++n) acc[a][b][m][n] = (f32x4){0.f, 0.f, 0.f, 0.f};
    bf16x8 At[4][2], B0[2][2], B1[2][2];
    const char* cA = PG8_ABASE(cur); const char* cB = PG8_BBASE(cur);
    PG8_STAGE(PG8_SB(0, 0), cB, voffB); PG8_STAGE(PG8_SB(0, 1), cB + hstepB, voffB); PG8_STAGE(PG8_SA(0, 0), cA, voffA); PG8_STAGE(PG8_SA(0, 1), cA + hstepA, voffA);
    pre(wid);
    if (wr == 1) PG8_BAR;
    PG8_WAIT_V(2); PG8_BAR;
    PG8_STAGE(PG8_SB(1, 0), cB + kstep, voffB); PG8_STAGE(PG8_SA(1, 0), cA + kstepA, voffA); PG8_STAGE(PG8_SB(1, 1), cB + hstepB + kstep, voffB);
    PG8_WAIT_V(6); PG8_BAR;
    for (;;) {
        const bool has_next = S.next(ui + 1, nxt);
        const char* nA = has_next ? PG8_ABASE(nxt) : cA; const char* nB = has_next ? PG8_BBASE(nxt) : cB;
        for (int t = 0; t < nt; t += 2) {
            const bool last = (t == nt - 2);
            const char* a1 = cA + (size_t)(t + 1) * kstepA;
            const char* a2 = last ? nA : cA + (size_t)(t + 2) * kstepA; const char* b2 = last ? nB : cB + (size_t)(t + 2) * kstep;
            const char* a3 = a2 + kstepA; const char* b3 = b2 + kstep;
            if constexpr (HOOK) { if (t == E.hook_t) E.hook(acc, ui, wr, fr); }
            PG8_LDB(B0, 0, 0); PG8_LDB(B1, 0, 1); PG8_SCHED; PG8_LDA(At, 0, 0); PG8_STAGE(PG8_SA(1, 1), a1 + hstepA, voffA);
            PG8_WAIT_V(8); PG8_WAIT_L(0); PG8_BAR; PG8_MMA(0, 0, At, B0); PG8_MMA(0, 1, At, B1); PG8_BAR; PG8_SCHED;
            PG8_LDA(At, 0, 1); PG8_STAGE(PG8_SB(0, 0), b2, voffB); PG8_STAGE(PG8_SB(0, 1), b2 + hstepB, voffB); PG8_STAGE(PG8_SA(0, 0), a2, voffA);
            PG8_WAIT_V(8); PG8_WAIT_L(0); PG8_BAR; PG8_MMA(1, 0, At, B0); PG8_MMA(1, 1, At, B1); PG8_BAR; PG8_SCHED;
            PG8_LDB(B0, 1, 0); PG8_LDB(B1, 1, 1); PG8_SCHED; PG8_LDA(At, 1, 0); PG8_STAGE(PG8_SA(0, 1), a2 + hstepA, voffA);
            PG8_WAIT_V(8); PG8_WAIT_L(0); PG8_BAR; PG8_MMA(0, 0, At, B0); PG8_MMA(0, 1, At, B1); PG8_BAR; PG8_SCHED;
            PG8_LDA(At, 1, 1); PG8_STAGE(PG8_SB(1, 0), b3, voffB); PG8_STAGE(PG8_SB(1, 1), b3 + hstepB, voffB); PG8_STAGE(PG8_SA(1, 0), a3, voffA);
            PG8_WAIT_V(8); PG8_WAIT_L(0); PG8_BAR; PG8_MMA(1, 0, At, B0); PG8_MMA(1, 1, At, B1); PG8_BAR; PG8_SCHED;
        }
#ifndef NO_ALIGN_EPI
        if (wr == 0) PG8_BAR;
#endif
#if defined(PROBE_DUP) && PROBE_DUP >= 300 && PROBE_DUP < 310
        if (PROBE_DUP == 300 || PROBE_DUP == Epi::PROBE_ID) E.probe(acc, cur, ui, wr, wc, fr, fq);
#endif
        E(acc, cur, ui, wr, wc, fr, fq);
        if (!has_next) break;
#pragma unroll
        for (int a = 0; a < 2; ++a)
#pragma unroll
            for (int b = 0; b < 2; ++b)
#pragma unroll
                for (int m = 0; m < 4; ++m)
#pragma unroll
                    for (int n = 0; n < 2; ++n) acc[a][b][m][n] = (f32x4){0.f, 0.f, 0.f, 0.f};
        cur = nxt; cA = nA; cB = nB; ++ui;
#ifndef NO_ALIGN_EPI
        if (wr == 1) PG8_BAR;
#endif
    }
    PG8_WAIT_V(0);
#ifdef NO_ALIGN_EPI
    if (wr == 0) PG8_BAR;
#endif
    PG8_BAR;
#undef PG8_SA
#undef PG8_SB
#undef PG8_STAGE
#undef PG8_LDA
#undef PG8_LDB
#undef PG8_MMA
#undef PG8_WAIT_V
#undef PG8_WAIT_L
#undef PG8_BAR
#undef PG8_SCHED
#undef PG8_ABASE
#undef PG8_BBASE
}
typedef GAS unsigned gu32;
#define VM_WAIT() asm volatile("s_waitcnt vmcnt(0)" ::: "memory")
#define LDS_WAIT() asm volatile("s_waitcnt lgkmcnt(0)" ::: "memory")
#define XB_TMO      128
#define XB_XCNT(j)  (256  + 64 * (j))
#define XB_XSUB(j)  (1280 + 64 * (j))
#define XB_XGEN(j)  (2304 + 64 * (j))
#define XB_TOP      3328
#define XB_TOPGEN   3392
#define XCD_BAR_WORDS 3456
#define XB_SPIN_CAP (1u << 18)

__device__ __forceinline__ unsigned xb_ld(unsigned* p)              { return __hip_atomic_load(p, __ATOMIC_RELAXED, __HIP_MEMORY_SCOPE_AGENT); }
__device__ __forceinline__ unsigned xb_add(unsigned* p, unsigned v) { return __hip_atomic_fetch_add(p, v, __ATOMIC_RELAXED, __HIP_MEMORY_SCOPE_AGENT); }
__device__ __forceinline__ unsigned xb_xcc_id() { return (unsigned)__builtin_amdgcn_s_getreg((3 << 11) | 20) & 0xFu; }
#define XB_SPIN(cond, bar) do { unsigned _sp = 0; while (cond) { __builtin_amdgcn_s_sleep(1); \
    if ((++_sp & 255u) == 0u) { if (xb_ld(&(bar)[XB_TMO])) break; if (_sp > XB_SPIN_CAP) { atomicAdd(&(bar)[XB_TMO], 1u); break; } } } } while (0)

struct XcdBarrier {
    unsigned* bar; unsigned x;
    bool t0; volatile LAS unsigned* st;
};

__device__ __forceinline__ XcdBarrier xcd_barrier_post(unsigned* bar, volatile LAS unsigned* st, bool t0) {
    XcdBarrier b; b.bar = bar; b.x = xb_xcc_id(); b.st = st; b.t0 = t0;
    if (t0) (void)xb_add(&bar[XB_XCNT(b.x)], 1u);
    return b;
}
__device__ __forceinline__ void xcd_barrier_complete(unsigned* bar, unsigned x, unsigned& nloc, unsigned& nx) {
    const unsigned G = gridDim.x * gridDim.y * gridDim.z;
    unsigned sum, cnt, mine, sp = 0u;
    for (;;) {
        sum = 0u; cnt = 0u; mine = 0u;
#pragma unroll
        for (unsigned j = 0; j < 16; ++j) { const unsigned c = xb_ld(&bar[XB_XCNT(j)]); sum += c; cnt += (c > 0u) ? 1u : 0u; mine = (j == x) ? c : mine; }
        if (sum == G) break;
        __builtin_amdgcn_s_sleep(1);
        if ((++sp & 255u) == 0u) { if (xb_ld(&bar[XB_TMO])) break; if (sp > XB_SPIN_CAP) { atomicAdd(&bar[XB_TMO], 1u); break; } }
    }
    nloc = mine > 0u ? mine : 1u; nx = cnt > 0u ? cnt : 1u;
}

__device__ __forceinline__ void xcd_barrier(const XcdBarrier& b) {
    asm volatile("s_waitcnt vmcnt(0)" ::: "memory");
    __syncthreads();
    if (b.t0) {
        unsigned* bar = b.bar;
        __builtin_amdgcn_s_waitcnt(0);
        unsigned nloc = b.st[0], nx = b.st[1];
        if (nloc == 0u) { xcd_barrier_complete(bar, b.x, nloc, nx); b.st[0] = nloc; b.st[1] = nx; }
        const unsigned old = xb_add(&bar[XB_XSUB(b.x)], 1u);
        const unsigned gen = old / nloc;
        if (old + 1u == (gen + 1u) * nloc) {
            __builtin_amdgcn_fence(__ATOMIC_RELEASE, "agent");
            asm volatile("s_waitcnt vmcnt(0)" ::: "memory");
            const unsigned og = xb_add(&bar[XB_TOP], 1u);
            const unsigned tg = og / nx;
            if (og + 1u == (tg + 1u) * nx) xb_add(&bar[XB_TOPGEN], 1u);
            else XB_SPIN(xb_ld(&bar[XB_TOPGEN]) == tg, bar);
            __builtin_amdgcn_fence(__ATOMIC_ACQUIRE, "agent");
            xb_add(&bar[XB_XGEN(b.x)], 1u);
            asm volatile("s_waitcnt vmcnt(0)" ::: "memory");
        } else {
            XB_SPIN(xb_ld(&bar[XB_XGEN(b.x)]) == gen, bar);
            __builtin_amdgcn_fence(__ATOMIC_ACQUIRE, "agent");
            asm volatile("s_waitcnt vmcnt(0)" ::: "memory");
        }
    }
    __syncthreads();
}
template <int MAPK>
__device__ __forceinline__ void tr_item(const float* W, int K, int N, bf16_t* WT, const float* gain, int gain_lim, float scale, LAS float* scr, int item, int lane) {
    const int nblk = N / 32, kb = item / nblk, nb = item % nblk, k0 = 64 * kb, n0 = 32 * nb;
    float cs = scale;
    if (MAPK == 1) { if (n0 >= 1024 && n0 < 1536) cs *= 0.08838834764831845f; }
    const float* wp = W + (size_t)(k0 + (lane >> 5)) * N + n0 + (lane & 31);
    float w[32];
#pragma unroll
    for (int i = 0; i < 32; ++i) w[i] = wp[(size_t)(2 * i) * N];
    const int c = lane & 7;
    f32x4 g0 = {cs, cs, cs, cs}, g1 = g0;
    if (k0 < gain_lim) { g0 = *(const GAS f32x4*)(gain + k0 + 8 * c) * cs; g1 = *(const GAS f32x4*)(gain + k0 + 8 * c + 4) * cs; }
#pragma unroll
    for (int i = 0; i < 32; ++i) scr[(2 * i + (lane >> 5)) * 33 + (lane & 31)] = w[i];
    LDS_WAIT(); asm volatile("" ::: "memory");
#pragma unroll
    for (int j = 0; j < 4; ++j) { const int nl = (lane >> 3) + 8 * j, n = n0 + nl; const LAS float* s = scr + (8 * c) * 33 + nl;
        int nr = n;
        if (MAPK == 1) { if (n >= 512 && n < 1536) { const int jj = n - 512, blk = jj >> 7, e = jj & 127; nr = 512 + blk * 128 + 2 * (e & 63) + (e >> 6); } }
        if (MAPK == 2) nr = (n >> 7) * 256 + (n & 127);
        if (MAPK == 3) nr = (n >> 7) * 256 + 128 + (n & 127);
        u32x4 o; o.x = pk2(s[0 * 33] * g0.x, s[1 * 33] * g0.y); o.y = pk2(s[2 * 33] * g0.z, s[3 * 33] * g0.w); o.z = pk2(s[4 * 33] * g1.x, s[5 * 33] * g1.y); o.w = pk2(s[6 * 33] * g1.z, s[7 * 33] * g1.w);
        *(GAS u32x4*)(WT + (size_t)nr * K + k0 + 8 * c) = o; }
    LDS_WAIT(); asm volatile("" ::: "memory");
}
struct In {
    const float *x, *mem; const int* pos; const float *norm_mix, *w_in, *lre, *lim, *lstep, *bre, *bim, *cre, *cim, *s5d, *wglu, *bglu, *s5n, *retn, *w_out, *norm_cross, *norm_mem,
        *w_cq, *w_ck, *w_cv, *w_co, *norm_ffn, *w_gate, *w_up, *w_down, *norm_final;
};
__device__ __forceinline__ bf16_t* wl(unsigned char* ws, int l, size_t off) { return (bf16_t*)(ws + WS_W + (size_t)l * W_LAYER + off); }

__device__ __forceinline__ void pro_weights(const In& in, unsigned char* ws, LAS unsigned char* lds, int gw, int NGW, int wave, int lane) {
    LAS float* scr = (LAS float*)(lds + wave * 16384);
    constexpr int I_IN = 16 * 80, I_GLU = 8 * 16, I_SQ = 16 * 32, I_GU = 16 * 88, I_DN = 44 * 32;
    constexpr int PER_L = I_IN + I_GLU + 5 * I_SQ + 2 * I_GU + I_DN;
    static_assert(PER_L == 8192, "items");
    for (int it = gw; it < DEPTH * PER_L; it += NGW) {
        const int l = it / PER_L; int r = it % PER_L;
        if (r < I_IN) { tr_item<1>(in.w_in + (size_t)l * D * INW, D, INW, wl(ws, l, W_IN), in.norm_mix + l * D, D, 1.0f, scr, r, lane); continue; } r -= I_IN;
        if (r < I_GLU) { tr_item<0>(in.wglu + (size_t)l * S5W * S5W, S5W, S5W, wl(ws, l, W_GLU), nullptr, 0, 1.0f, scr, r, lane); continue; } r -= I_GLU;
        if (r < I_SQ) { tr_item<0>(in.w_out + (size_t)l * D * D, D, D, wl(ws, l, W_OUT), in.s5n + l * S5W, S5W, 1.0f, scr, r, lane); continue; } r -= I_SQ;
        if (r < I_SQ) { tr_item<0>(in.w_cq + (size_t)l * D * D, D, D, wl(ws, l, W_CQ), in.norm_cross + l * D, D, 0.0625f * 1.4426950408889634f, scr, r, lane); continue; } r -= I_SQ;
        if (r < I_SQ) { tr_item<0>(in.w_co + (size_t)l * D * D, D, D, wl(ws, l, W_CO), nullptr, 0, 1.0f, scr, r, lane); continue; } r -= I_SQ;
        if (r < I_SQ) { tr_item<0>(in.w_ck + (size_t)l * D * D, D, D, (bf16_t*)(ws + WS_WCK_TMP) + (size_t)l * D * D, in.norm_mem + l * D, D, 1.0f, scr, r, lane); continue; } r -= I_SQ;
        if (r < I_SQ) { tr_item<0>(in.w_cv + (size_t)l * D * D, D, D, (bf16_t*)(ws + WS_WCV_TMP) + (size_t)l * D * D, in.norm_mem + l * D, D, 1.0f, scr, r, lane); continue; } r -= I_SQ;
        if (r < I_GU) { tr_item<2>(in.w_gate + (size_t)l * D * FF, D, FF, wl(ws, l, W_GU), in.norm_ffn + l * D, D, 1.0f, scr, r, lane); continue; } r -= I_GU;
        if (r < I_GU) { tr_item<3>(in.w_up + (size_t)l * D * FF, D, FF, wl(ws, l, W_GU), in.norm_ffn + l * D, D, 1.0f, scr, r, lane); continue; } r -= I_GU;
        tr_item<0>(in.w_down + (size_t)l * FF * D, FF, D, wl(ws, l, W_DN), nullptr, 0, 1.0f, scr, r, lane);
    }
}
__device__ __forceinline__ void xprep_rows(const float* src, bf16_t* xb, float* ssq, int gw, int NGW, int lane) {
    for (int m = gw; m < M; m += NGW) {
        const GAS f32x4* xr = (const GAS f32x4*)(src + (size_t)m * D) + lane;
        f32x4 v[4]; float s = 0.f;
#pragma unroll
        for (int j = 0; j < 4; ++j) { v[j] = xr[64 * j]; s += (v[j].x * v[j].x + v[j].y * v[j].y) + (v[j].z * v[j].z + v[j].w * v[j].w); }
        const float tot = wave_sum(s);
        GAS u32x2* o8 = (GAS u32x2*)(xb + (size_t)m * D) + lane;
#pragma unroll
        for (int j = 0; j < 4; ++j) { u32x2 w; w.x = pk2(v[j].x, v[j].y); w.y = pk2(v[j].z, v[j].w); o8[64 * j] = w; }
        if (lane < 16) ssq[(size_t)m * 16 + lane] = (lane == 0) ? tot : 0.f;
    }
}
__device__ __forceinline__ void final_norm_rows(const bf16_t* xb, float* out, const float* g, int gw, int NGW, int lane) {
    f32x4 gv[4];
#pragma unroll
    for (int j = 0; j < 4; ++j) gv[j] = ((const GAS f32x4*)g)[lane + 64 * j];
    for (int m = gw; m < M; m += NGW) {
        const GAS u32x2* xr = (const GAS u32x2*)(xb + (size_t)m * D) + lane;
        f32x4 v[4]; float s = 0.f;
#pragma unroll
        for (int j = 0; j < 4; ++j) { const u32x2 w = xr[64 * j]; v[j] = (f32x4){bflo(w.x), bfhi(w.x), bflo(w.y), bfhi(w.y)}; s += (v[j].x * v[j].x + v[j].y * v[j].y) + (v[j].z * v[j].z + v[j].w * v[j].w); }
        const float r = 1.0f / sqrtf(wave_sum(s) * (1.0f / D) + EPS);
        GAS f32x4* o = (GAS f32x4*)(out + (size_t)m * D) + lane;
#pragma unroll
        for (int j = 0; j < 4; ++j) o[64 * j] = v[j] * r * gv[j];
    }
}
template <class Sched>
struct RstdPre {
    LAS float* tab; const Sched* S; const float* ssq; int nslots; float inv_n;
    __device__ __forceinline__ void operator()(int wave) const {
        if (wave < 4) { Unit u; const int t = wave * 64 + lane_id(); int prev_pm = -1;
            for (int i = 0; S->next(i, u); ++i) {
                if (u.pm == prev_pm) tab[i * 256 + t] = tab[(i - 1) * 256 + t];
                else { const float* p = ssq + (size_t)(u.pm * 256 + t) * nslots; float s = 0.f;
                    for (int j = 0; j < nslots; j += 4) { const f32x4 v = *(const GAS f32x4*)(p + j); s += (v.x + v.y) + (v.z + v.w); }
                    tab[i * 256 + t] = 1.0f / sqrtf(s * inv_n + EPS); }
                prev_pm = u.pm; } }
    }
};

struct EpiFfn1 {
    static constexpr int PROBE_ID = 302; static constexpr bool PERM = true;
    bf16_t* H; LAS const float* tab;
    __device__ __forceinline__ void probe(const f32x4 (&acc)[2][2][4][2], const Unit& u, int ui, int wr, int wc, int fr, int fq) const { (*this)(acc, u, ui, wr, wc, fr, fq); }
    __device__ __forceinline__ void operator()(const f32x4 (&acc)[2][2][4][2], const Unit& u, int ui, int wr, int wc, int fr, int fq) const {
        asm volatile("" : "+v"(fr), "+v"(fq));
#pragma unroll
        for (int ai = 0; ai < 2; ++ai)
#pragma unroll
            for (int m = 0; m < 4; ++m) { const int rl = ai * HALF + wr * 64 + m * 16 + fr; const float rs = tab[ui * 256 + rl], k1 = -1.4426950408889634f * rs, rs2 = rs * rs;
                float h[8];
#pragma unroll
                for (int n = 0; n < 2; ++n)
#pragma unroll
                    for (int j = 0; j < 4; ++j) { const float ag = acc[ai][0][m][n][j], au = acc[ai][1][m][n][j]; h[4 * n + j] = (ag * au) * (rs2 * __builtin_amdgcn_rcpf(1.0f + __builtin_amdgcn_exp2f(ag * k1))); }
                u32x4 w; w.x = cvt_pk(h[0], h[1]); w.y = cvt_pk(h[2], h[3]); w.z = cvt_pk(h[4], h[5]); w.w = cvt_pk(h[6], h[7]);
                *(GAS u32x4*)(H + (size_t)(u.pm * BM + rl) * FF + u.pn * 128 + wc * 32 + 8 * fq) = w; }
    }
};
struct EpiRes {
    static constexpr int PROBE_ID = 307; static constexpr bool PERM = true;
    bf16_t* xb; float* ssq; float* fout; float scale; LAS float* sst;
    __device__ __forceinline__ void probe(const f32x4 (&acc)[2][2][4][2], const Unit& u, int ui, int wr, int wc, int fr, int fq) const { EpiRes t = *this; t.scale = 0.f; t(acc, u, ui, wr, wc, fr, fq); }
    __device__ __forceinline__ void operator()(const f32x4 (&acc)[2][2][4][2], const Unit& u, int ui, int wr, int wc, int fr, int fq) const {
        asm volatile("" : "+v"(fr), "+v"(fq));
        u32x4 xv[4][2][2];
#define ER_LOAD(b) do { _Pragma("unroll") for (int mm = 0; mm < 2; ++mm) _Pragma("unroll") for (int bj = 0; bj < 2; ++bj) \
            xv[b][mm][bj] = *(const GAS u32x4*)(xb + (size_t)(u.pm * BM + ((b) >> 1) * HALF + wr * 64 + (2 * ((b) & 1) + mm) * 16 + fr) * D + u.pn * BM + bj * HALF + wc * 32 + 8 * fq); } while (0)
#define ER_COMP(b) do { const int ai = (b) >> 1; _Pragma("unroll") for (int mm = 0; mm < 2; ++mm) { const int m = 2 * ((b) & 1) + mm; const int row = u.pm * BM + ai * HALF + wr * 64 + m * 16 + fr; float ps = 0.f; \
            _Pragma("unroll") for (int bj = 0; bj < 2; ++bj) { const size_t off = (size_t)row * D + u.pn * BM + bj * HALF + wc * 32 + 8 * fq; const u32x4 xw = xv[b][mm][bj]; f32x4 v0, v1; \
                v0.x = bflo(xw.x) + acc[ai][bj][m][0].x * scale; v0.y = bfhi(xw.x) + acc[ai][bj][m][0].y * scale; v0.z = bflo(xw.y) + acc[ai][bj][m][0].z * scale; v0.w = bfhi(xw.y) + acc[ai][bj][m][0].w * scale; \
                v1.x = bflo(xw.z) + acc[ai][bj][m][1].x * scale; v1.y = bfhi(xw.z) + acc[ai][bj][m][1].y * scale; v1.z = bflo(xw.w) + acc[ai][bj][m][1].z * scale; v1.w = bfhi(xw.w) + acc[ai][bj][m][1].w * scale; \
                if (fout) { *(GAS f32x4*)(fout + off) = v0; *(GAS f32x4*)(fout + off + 4) = v1; } \
                u32x4 w; w.x = cvt_pk(v0.x, v0.y); w.y = cvt_pk(v0.z, v0.w); w.z = cvt_pk(v1.x, v1.y); w.w = cvt_pk(v1.z, v1.w); \
                *(GAS u32x4*)(xb + off) = w; \
                ps += (v0.x * v0.x + v0.y * v0.y) + (v0.z * v0.z + v0.w * v0.w) + (v1.x * v1.x + v1.y * v1.y) + (v1.z * v1.z + v1.w * v1.w); } \
            ps = row16_sum(ps); ps = half_sum(ps); \
            if (fq == 0) sst[(ai * HALF + wr * 64 + m * 16 + fr) * 4 + wc] = ps; } } while (0)
        ER_LOAD(0); ER_LOAD(1); asm volatile("" ::: "memory");
        ER_COMP(0); ER_LOAD(2); asm volatile("" ::: "memory");
        ER_COMP(1); ER_LOAD(3); asm volatile("" ::: "memory");
        ER_COMP(2); asm volatile("" ::: "memory");
        ER_COMP(3);
#undef ER_LOAD
#undef ER_COMP
        asm volatile("s_waitcnt lgkmcnt(0)" ::: "memory"); __builtin_amdgcn_s_barrier(); asm volatile("" ::: "memory");
        { const int t = (wr * 4 + wc) * 64 + fq * 16 + fr; if (t < 256) *(GAS f32x4*)(ssq + (size_t)(u.pm * BM + t) * 16 + u.pn * 4) = *(LAS const f32x4*)(sst + t * 4); }
    }
};
struct EpiScaleBf16 {
    static constexpr int PROBE_ID = 303; static constexpr bool PERM = true;
    bf16_t* O; int ldo; LAS const float* tab;
    __device__ __forceinline__ void probe(const f32x4 (&acc)[2][2][4][2], const Unit& u, int ui, int wr, int wc, int fr, int fq) const { (*this)(acc, u, ui, wr, wc, fr, fq); }
    __device__ __forceinline__ void operator()(const f32x4 (&acc)[2][2][4][2], const Unit& u, int ui, int wr, int wc, int fr, int fq) const {
        asm volatile("" : "+v"(fr), "+v"(fq));
#pragma unroll
        for (int ai = 0; ai < 2; ++ai)
#pragma unroll
            for (int m = 0; m < 4; ++m) { const int rl = ai * HALF + wr * 64 + m * 16 + fr; const float rs = tab[ui * 256 + rl];
#pragma unroll
                for (int bj = 0; bj < 2; ++bj) { const f32x4 v0 = acc[ai][bj][m][0] * rs, v1 = acc[ai][bj][m][1] * rs;
                    u32x4 w; w.x = cvt_pk(v0.x, v0.y); w.y = cvt_pk(v0.z, v0.w); w.z = cvt_pk(v1.x, v1.y); w.w = cvt_pk(v1.z, v1.w);
                    *(GAS u32x4*)(O + (size_t)(u.pm * BM + rl) * ldo + u.pn * BM + bj * HALF + wc * 32 + 8 * fq) = w; } }
    }
};
struct EpiMemK {
    static constexpr int PROBE_ID = 309; static constexpr bool PERM = true;
    bf16_t* O; const float* rsm;
    __device__ __forceinline__ void probe(const f32x4 (&acc)[2][2][4][2], const Unit& u, int ui, int wr, int wc, int fr, int fq) const { (*this)(acc, u, ui, wr, wc, fr, fq); }
    __device__ __forceinline__ void operator()(const f32x4 (&acc)[2][2][4][2], const Unit& u, int ui, int wr, int wc, int fr, int fq) const {
        asm volatile("" : "+v"(fr), "+v"(fq));
#pragma unroll
        for (int ai = 0; ai < 2; ++ai)
#pragma unroll
            for (int m = 0; m < 4; ++m) { const int row = u.pm * BM + ai * HALF + wr * 64 + m * 16 + fr; const float rs = rsm[row];
#pragma unroll
                for (int bj = 0; bj < 2; ++bj) { const f32x4 v0 = acc[ai][bj][m][0] * rs, v1 = acc[ai][bj][m][1] * rs;
                    u32x4 w; w.x = cvt_pk(v0.x, v0.y); w.y = cvt_pk(v0.z, v0.w); w.z = cvt_pk(v1.x, v1.y); w.w = cvt_pk(v1.z, v1.w);
                    *(GAS u32x4*)(O + ((size_t)u.g * MROWS + row) * D + u.pn * BM + bj * HALF + wc * 32 + 8 * fq) = w; } }
    }
};
struct EpiMemVT {
    static constexpr int PROBE_ID = 309; static constexpr bool PERM = true;
    bf16_t* O; const float* rsm;
    __device__ __forceinline__ void probe(const f32x4 (&acc)[2][2][4][2], const Unit& u, int ui, int wr, int wc, int fr, int fq) const { (*this)(acc, u, ui, wr, wc, fr, fq); }
    __device__ __forceinline__ void operator()(const f32x4 (&acc)[2][2][4][2], const Unit& u, int ui, int wr, int wc, int fr, int fq) const {
        asm volatile("" : "+v"(fr), "+v"(fq));
#pragma unroll
        for (int bj = 0; bj < 2; ++bj) { const int c0 = u.pn * BM + bj * HALF + wc * 32 + 8 * fq;
            const f32x4 r0 = *(const GAS f32x4*)(rsm + c0), r1 = *(const GAS f32x4*)(rsm + c0 + 4);
            const int p0 = (c0 & ~15) + 4 * ((c0 >> 3) & 1), p1 = p0 + 8;
#pragma unroll
            for (int ai = 0; ai < 2; ++ai)
#pragma unroll
                for (int m = 0; m < 4; ++m) { const int row = u.pm * BM + ai * HALF + wr * 64 + m * 16 + fr;
                    const f32x4 v0 = acc[ai][bj][m][0] * r0, v1 = acc[ai][bj][m][1] * r1;
                    bf16_t* o = O + ((size_t)u.g * D + row) * MROWS;
                    u32x2 w0, w1; w0.x = cvt_pk(v0.x, v0.y); w0.y = cvt_pk(v0.z, v0.w); w1.x = cvt_pk(v1.x, v1.y); w1.y = cvt_pk(v1.z, v1.w);
                    *(GAS u32x2*)(o + p0) = w0; *(GAS u32x2*)(o + p1) = w1; } }
    }
};

__device__ __forceinline__ void xa_fill(LAS unsigned char* lds, const bf16_t* src  , int wave, int lane) {
#pragma unroll 1
    for (int j = 0; j < 16; ++j) { const int p = wave * 16 + j, row = 2 * p + (lane >> 5), ch = (lane & 31) ^ (row & 15);
        __builtin_amdgcn_global_load_lds((const unsigned*)((const char*)src + (size_t)row * 2048 + ch * 16), (LAS unsigned*)(lds + p * 1024), 16, 0, 0); }
}
__device__ __forceinline__ void xa_mma(f32x16 (&acc)[8], const bf16x8 (&bf)[16], LAS const unsigned char* lds, int r, int hh) {
    const int a = (r >> 1) & 7, b = hh ^ (r & 1); LAS const unsigned char* base = lds + r * 512 + b * 16;
#pragma unroll
    for (int s = 0; s < 16; ++s) { const int cp = ((s & 8) | ((s & 7) ^ a)) << 5;
        LAS const unsigned char* p0 = base + cp; LAS const unsigned char* p1 = p0 + 65536;
#pragma unroll
        for (int blk = 0; blk < 8; ++blk) {
            const bf16x8 av = (blk < 4) ? *(LAS const bf16x8*)(p0 + blk * 16384) : *(LAS const bf16x8*)(p1 + (blk - 4) * 16384);
            acc[blk] = __builtin_amdgcn_mfma_f32_32x32x16_bf16(av, bf[s], acc[blk], 0, 0, 0); }
#pragma unroll
        for (int blk = 0; blk < 8; ++blk) asm volatile("" : "+v"(acc[blk]));
    }
}
__device__ __forceinline__ void xa_mma_q(f32x16 (&acc)[8], const GAS bf16x8* qp, LAS const unsigned char* lds, int r, int hh) {
    const int a = (r >> 1) & 7, b = hh ^ (r & 1); LAS const unsigned char* base = lds + r * 512 + b * 16;
    bf16x8 q3[3];
#pragma unroll
    for (int s = 0; s < 3; ++s) q3[s] = qp[2 * s];
#pragma unroll
    for (int s = 0; s < 16; ++s) { const int cp = ((s & 8) | ((s & 7) ^ a)) << 5;
        LAS const unsigned char* p0 = base + cp; LAS const unsigned char* p1 = p0 + 65536;
        const bf16x8 bq = q3[s % 3];
        if (s + 3 < 16) q3[s % 3] = qp[2 * (s + 3)];
#pragma unroll
        for (int blk = 0; blk < 8; ++blk) {
            const bf16x8 av = (blk < 4) ? *(LAS const bf16x8*)(p0 + blk * 16384) : *(LAS const bf16x8*)(p1 + (blk - 4) * 16384);
            acc[blk] = __builtin_amdgcn_mfma_f32_32x32x16_bf16(av, bq, acc[blk], 0, 0, 0); }
#pragma unroll
        for (int blk = 0; blk < 8; ++blk) asm volatile("" : "+v"(acc[blk]));
    }
}
__device__ __forceinline__ void xattn_unit(LAS unsigned char* lds, const bf16_t* QC, const bf16_t* Kl, const bf16_t* VTl, bf16_t* OC, int b, int h, int qt, int wave) {
    {
        const size_t qrow0 = (size_t)b * SEQ + qt * 256 + wave * 32;
        bf16x8 bq[16];
        { const int lane = lane_id(), r = lane & 31, hh = lane >> 5; const GAS bf16x8* qp = (const GAS bf16x8*)(QC + (qrow0 + r) * D + h * XD + 8 * hh);
#pragma unroll
          for (int s = 0; s < 16; ++s) bq[s] = qp[2 * s]; }
        xa_fill(lds, Kl + (size_t)b * MEML * D + h * XD, wave, lane_id());
        VM_WAIT(); __syncthreads();
#if defined(PROBE_DUP) && PROBE_DUP == 71
        xa_fill(lds, Kl + (size_t)b * MEML * D + h * XD, wave, lane_id());
        VM_WAIT(); __syncthreads();
#endif
        f32x16 acc[8];
#pragma unroll
        for (int k = 0; k < 8; ++k)
#pragma unroll
            for (int j = 0; j < 16; ++j) acc[k][j] = 0.f;
        { const int lane = lane_id(); xa_mma(acc, bq, lds, lane & 31, lane >> 5); }
        __syncthreads();
        xa_fill(lds, VTl + (size_t)h * XD * MROWS + b * MEML, wave, lane_id());
        float mx = acc[0][0];
#pragma unroll
        for (int k = 0; k < 8; ++k)
#pragma unroll
            for (int j = 0; j < 16; ++j) mx = fmaxf(mx, acc[k][j]);
        mx = half_max(mx);
        float sum = 0.f;
#pragma unroll
        for (int k = 0; k < 8; ++k)
#pragma unroll
            for (int j = 0; j < 16; ++j) { const float p = __builtin_amdgcn_exp2f(acc[k][j] - mx); acc[k][j] = p; sum += p; }
        sum = half_sum(sum);
        const float inv = 1.0f / sum;
        bf16x8 bp[16];
#pragma unroll
        for (int k = 0; k < 8; ++k)
#pragma unroll
            for (int s = 0; s < 2; ++s) { u32x4 w; w.x = cvt_pk(acc[k][8 * s + 0], acc[k][8 * s + 1]); w.y = cvt_pk(acc[k][8 * s + 2], acc[k][8 * s + 3]);
                w.z = cvt_pk(acc[k][8 * s + 4], acc[k][8 * s + 5]); w.w = cvt_pk(acc[k][8 * s + 6], acc[k][8 * s + 7]); bp[2 * k + s] = __builtin_bit_cast(bf16x8, w); }
#pragma unroll
        for (int k = 0; k < 8; ++k)
#pragma unroll
            for (int j = 0; j < 16; ++j) acc[k][j] = 0.f;
        VM_WAIT(); __syncthreads();
        { const int lane = lane_id(); xa_mma(acc, bp, lds, lane & 31, lane >> 5); }
        __syncthreads();
        { const int lane = lane_id(), r = lane & 31, hh = lane >> 5; LAS unsigned char* wb = lds + wave * 16384;
#pragma unroll
          for (int k = 0; k < 8; ++k)
#pragma unroll
            for (int g4 = 0; g4 < 4; ++g4) { u32x2 w; w.x = cvt_pk(acc[k][4 * g4] * inv, acc[k][4 * g4 + 1] * inv); w.y = cvt_pk(acc[k][4 * g4 + 2] * inv, acc[k][4 * g4 + 3] * inv);
                *(LAS u32x2*)(wb + r * 512 + (((4 * k + g4) ^ r) << 4) + 8 * hh) = w; }
          asm volatile("s_waitcnt lgkmcnt(0)" ::: "memory");
#if defined(PROBE_DUP) && PROBE_DUP == 72
          for (int rp = 0; rp < 2; ++rp)
#endif
#pragma unroll
          for (int j = 0; j < 16; ++j) { const int row = 2 * j + hh, cp = lane & 31; const u32x4 v = *(LAS const u32x4*)(wb + row * 512 + cp * 16);
              *(GAS u32x4*)(OC + (qrow0 + row) * D + h * XD + 8 * (cp ^ row)) = v; }
          asm volatile("s_waitcnt lgkmcnt(0)" ::: "memory"); }
    }
}
__device__ __forceinline__ void mem_prep_rows(const float* mem, bf16_t* memb, float* rsm, int gw, int NGW, int lane) {
    for (int m = gw; m < MROWS; m += NGW) {
        const GAS f32x4* xr = (const GAS f32x4*)(mem + (size_t)m * D) + lane;
        f32x4 v[4]; float s = 0.f;
#pragma unroll
        for (int j = 0; j < 4; ++j) { v[j] = xr[64 * j]; s += (v[j].x * v[j].x + v[j].y * v[j].y) + (v[j].z * v[j].z + v[j].w * v[j].w); }
        const float tot = wave_sum(s);
        GAS u32x2* o8 = (GAS u32x2*)(memb + (size_t)m * D) + lane;
#pragma unroll
        for (int j = 0; j < 4; ++j) { u32x2 w; w.x = pk2(v[j].x, v[j].y); w.y = pk2(v[j].z, v[j].w); o8[64 * j] = w; }
        if (lane == 0) rsm[m] = 1.0f / sqrtf(tot * (1.0f / D) + EPS);
    }
}

__device__ __forceinline__ float ret_lg2(int h) { return h == 0 ? -0.04580368961312479f : h == 1 ? -0.02272007650008353f : h == 2 ? -0.011315313227834146f : -0.005646563141142063f; }
struct EpiProj {
    static constexpr int PROBE_ID = 301; static constexpr bool PERM = true;
    bf16_t *UG, *Q, *K, *V, *GT; const float* rope; LAS const float* tab;
    __device__ __forceinline__ void probe(const f32x4 (&acc)[2][2][4][2], const Unit& u, int ui, int wr, int wc, int fr, int fq) const { (*this)(acc, u, ui, wr, wc, fr, fq); }
    __device__ __forceinline__ void operator()(const f32x4 (&acc)[2][2][4][2], const Unit& u, int ui, int wr, int wc, int fr, int fq) const {
        asm volatile("" : "+v"(fr), "+v"(fq));
        const int kind = u.pn >> 1;
        if (kind == 1 || kind == 2) {
            f32x4 cs[2][4][2];
#pragma unroll
            for (int ai = 0; ai < 2; ++ai)
#pragma unroll
                for (int m = 0; m < 4; ++m) { const int row = u.pm * BM + ai * HALF + wr * 64 + m * 16 + fr;
                    const GAS f32x4* rp = (const GAS f32x4*)(rope + ((size_t)row * 64 + ((wc * 32 + 8 * fq) >> 1)) * 2); cs[ai][m][0] = rp[0]; cs[ai][m][1] = rp[1]; }
#pragma unroll
            for (int ai = 0; ai < 2; ++ai) {
#pragma unroll
                for (int m = 0; m < 4; ++m) { const int rl = ai * HALF + wr * 64 + m * 16 + fr, row = u.pm * BM + rl; const float rs = tab[ui * 256 + rl];
#pragma unroll
                    for (int bj = 0; bj < 2; ++bj) { const f32x4 v0 = acc[ai][bj][m][0] * rs, v1 = acc[ai][bj][m][1] * rs, c0 = cs[ai][m][0], c1 = cs[ai][m][1];
                        const int cw = (u.pn & 1) * 256 + bj * HALF + wc * 32 + 8 * fq, hd = cw >> 7;
                        const float e = (float)(row & 127) * ret_lg2(hd), sc = __builtin_amdgcn_exp2f(kind == 1 ? e : -e);
                        f32x4 o0, o1;
                        o0.x = (v0.x * c0.x - v0.y * c0.y) * sc; o0.y = (v0.y * c0.x + v0.x * c0.y) * sc; o0.z = (v0.z * c0.z - v0.w * c0.w) * sc; o0.w = (v0.w * c0.z + v0.z * c0.w) * sc;
                        o1.x = (v1.x * c1.x - v1.y * c1.y) * sc; o1.y = (v1.y * c1.x + v1.x * c1.y) * sc; o1.z = (v1.z * c1.z - v1.w * c1.w) * sc; o1.w = (v1.w * c1.z + v1.z * c1.w) * sc;
                        u32x4 w; w.x = cvt_pk(o0.x, o0.y); w.y = cvt_pk(o0.z, o0.w); w.z = cvt_pk(o1.x, o1.y); w.w = cvt_pk(o1.z, o1.w);
                        *(GAS u32x4*)((kind == 1 ? Q : K) + (size_t)row * RW + cw) = w; } } }
        } else {
#pragma unroll
            for (int ai = 0; ai < 2; ++ai)
#pragma unroll
                for (int m = 0; m < 4; ++m) { const int rl = ai * HALF + wr * 64 + m * 16 + fr, row = u.pm * BM + rl; const float rs = tab[ui * 256 + rl];
#pragma unroll
                    for (int bj = 0; bj < 2; ++bj) { const f32x4 v0 = acc[ai][bj][m][0] * rs, v1 = acc[ai][bj][m][1] * rs;
                        const int cw = (u.pn & 1) * 256 + bj * HALF + wc * 32 + 8 * fq;
                        bf16_t* dst = (kind == 0) ? UG + ((size_t)(cw >> 4) * (M / 32) + (row >> 5)) * 640 + (row & 31) * 16 + ((cw >> 3) & 1) * 8 : (kind == 3 ? V : GT) + (size_t)row * RW + cw;
                        u32x4 w; w.x = cvt_pk(v0.x, v0.y); w.y = cvt_pk(v0.z, v0.w); w.z = cvt_pk(v1.x, v1.y); w.w = cvt_pk(v1.z, v1.w);
                        *(GAS u32x4*)dst = w; } }
        }
    }
};
struct EpiGlu {
    static constexpr int PROBE_ID = 304; static constexpr bool PERM = true;
    const bf16_t* Z; const float* bias; bf16_t* Y; float* ssqs;
    __device__ __forceinline__ void probe(const f32x4 (&acc)[2][2][4][2], const Unit& u, int ui, int wr, int wc, int fr, int fq) const { (*this)(acc, u, ui, wr, wc, fr, fq); }
    __device__ __forceinline__ void operator()(const f32x4 (&acc)[2][2][4][2], const Unit& u, int ui, int wr, int wc, int fr, int fq) const {
        asm volatile("" : "+v"(fr), "+v"(fq));
#pragma unroll
        for (int ai = 0; ai < 2; ++ai)
#pragma unroll
            for (int m = 0; m < 4; ++m) { const int row = u.pm * BM + ai * HALF + wr * 64 + m * 16 + fr; float ps = 0.f;
#pragma unroll
                for (int bj = 0; bj < 2; ++bj) { const int col = u.pn * BM + bj * HALF + wc * 32 + 8 * fq;
                    const u32x4 zw = *(const GAS u32x4*)(Z + ((size_t)(col >> 4) * M + row) * 16 + (col & 15));
                    const f32x4 b0 = *(const GAS f32x4*)(bias + col), b1 = *(const GAS f32x4*)(bias + col + 4);
                    const f32x4 t0 = acc[ai][bj][m][0] + b0, t1 = acc[ai][bj][m][1] + b1;
                    float o[8];
                    o[0] = bflo(zw.x) * fast_sigmoid(t0.x); o[1] = bfhi(zw.x) * fast_sigmoid(t0.y); o[2] = bflo(zw.y) * fast_sigmoid(t0.z); o[3] = bfhi(zw.y) * fast_sigmoid(t0.w);
                    o[4] = bflo(zw.z) * fast_sigmoid(t1.x); o[5] = bfhi(zw.z) * fast_sigmoid(t1.y); o[6] = bflo(zw.w) * fast_sigmoid(t1.z); o[7] = bfhi(zw.w) * fast_sigmoid(t1.w);
#pragma unroll
                    for (int j = 0; j < 8; ++j) ps += o[j] * o[j];
                    u32x4 w; w.x = cvt_pk(o[0], o[1]); w.y = cvt_pk(o[2], o[3]); w.z = cvt_pk(o[4], o[5]); w.w = cvt_pk(o[6], o[7]);
                    *(GAS u32x4*)(Y + (size_t)row * D + col) = w; }
                ps = row16_sum(ps); ps = half_sum(ps);
                if (fq == 0) ssqs[(size_t)row * 8 + u.pn * 4 + wc] = ps;
                asm volatile("" ::: "memory"); }
    }
};
struct EpiResHook : EpiRes {
    LAS const float* tab2; int hook_t;
    __device__ __forceinline__ void hook(f32x4 (&acc)[2][2][4][2], int ui, int wr, int fr) const {
#pragma unroll
        for (int ai = 0; ai < 2; ++ai)
#pragma unroll
            for (int m = 0; m < 4; ++m) { const float rs = tab2[ui * 256 + ai * HALF + wr * 64 + m * 16 + fr];
#pragma unroll
                for (int bj = 0; bj < 2; ++bj)
#pragma unroll
                    for (int n = 0; n < 2; ++n) acc[ai][bj][m][n] *= rs; }
    }
};
__device__ __forceinline__ void rope_table(const int* pos, float* rope, int gtid, int nthr) {
    for (int idx = gtid; idx < M * 64; idx += nthr) { const int i = idx & 63, row = idx >> 6;
        const float inv = (float)(1.0 / pow(10000.0, (double)i / 64.0)); const float ang = (float)pos[row] * inv;
        f32x2 cs; cs.x = (float)cos((double)ang); cs.y = (float)sin((double)ang);
        *(GAS f32x2*)(rope + (size_t)idx * 2) = cs; }
}

constexpr size_t SP_RSM = 0, SP_KTAB = 64 * 1024, SP_APOW = SP_KTAB + 4 * MiB, SP_BBAR = 6 * MiB + 256 * 1024;
constexpr size_t APOW_LG = 33 * 64 * 2, KTAB_LG = 32 * 256, BBAR_LG = 64 * 16 * 2;
static_assert(SP_APOW + (size_t)DEPTH * S5G * APOW_LG * 4 <= SP_BBAR && SP_BBAR + (size_t)DEPTH * S5G * BBAR_LG * 4 <= 8 * MiB, "spare map");
constexpr size_t S5M_T = 0, S5M_WEND = 20 * MiB;
constexpr size_t WS_SEND = WS_Z, WS_KVRUN = WS_Z + 16 * MiB;
constexpr size_t WS_RSTART = WS_S5M;
constexpr size_t S5M_LAYER = 28 * MiB;
__device__ __forceinline__ void s5_tables_item(const In& in, unsigned char* ws, LAS unsigned char* lds, int item, int wave, int lane) {
    const int l = item >> 7, g = (item >> 2) & 31, tq = item & 3, p = lane;
    LAS float* Br = (LAS float*)lds; LAS float* Bi = Br + 1024; LAS float* Cr = Bi + 1024; LAS float* Ci = Cr + 1024;
    LAS float* CAr = Ci + 1024 + wave * 2048; LAS float* CAi = CAr + 1024;
    float* sp = (float*)(ws + WS_SPARE);
    const int lg = l * S5G + g;
    const double lr = (double)in.lre[lg * 64 + p], li = (double)in.lim[lg * 64 + p], step = (double)expf(in.lstep[lg]);
    if (wave == 0) {
        const double mag = exp(lr * step), ar = mag * cos(li * step), ai = mag * sin(li * step), den = lr * lr + li * li;
        const double fr = ((ar - 1.0) * lr + ai * li) / den, fi = (ai * lr - (ar - 1.0) * li) / den;
#pragma unroll 4
        for (int h = 0; h < 16; ++h) { const double br = (double)in.bre[((size_t)lg * 64 + p) * 16 + h], bi = (double)in.bim[((size_t)lg * 64 + p) * 16 + h];
            const float xr = (float)(fr * br - fi * bi), xi = (float)(fr * bi + fi * br); Br[p * 16 + h] = xr; Bi[p * 16 + h] = xi;
            if (tq == 0) { f32x2 w; w.x = xr; w.y = xi; *(GAS f32x2*)(sp + SP_BBAR / 4 + (size_t)lg * BBAR_LG + (p * 16 + h) * 2) = w; } }
    }
    if (wave == 1) { for (int n = 0; n < 16; ++n) { Cr[n * 64 + p] = in.cre[((size_t)lg * 16 + n) * 64 + p]; Ci[n * 64 + p] = in.cim[((size_t)lg * 16 + n) * 64 + p]; } }
    const int tau = 8 * tq + wave;
    const double mg = exp(lr * step * (double)tau), an = li * step * (double)tau;
    const float ar = (float)(mg * cos(an)), ai = (float)(mg * sin(an));
    { f32x2 w; w.x = ar; w.y = ai; *(GAS f32x2*)(sp + SP_APOW / 4 + (size_t)lg * APOW_LG + (tau * 64 + p) * 2) = w; }
    if (tq == 3 && wave == 7) { const double m2 = exp(lr * step * 32.0), a2 = li * step * 32.0; f32x2 w; w.x = (float)(m2 * cos(a2)); w.y = (float)(m2 * sin(a2));
        *(GAS f32x2*)(sp + SP_APOW / 4 + (size_t)lg * APOW_LG + (32 * 64 + p) * 2) = w; }
    __syncthreads();
#pragma unroll 4
    for (int n = 0; n < 16; ++n) { const float cr = Cr[n * 64 + p], ci = Ci[n * 64 + p]; CAr[n * 64 + p] = cr * ar - ci * ai; CAi[n * 64 + p] = cr * ai + ci * ar; }
    LDS_WAIT(); asm volatile("" ::: "memory");
    const int n = lane >> 2, h0 = 4 * (lane & 3);
    f32x4 acc = {0.f, 0.f, 0.f, 0.f};
    for (int pp = 0; pp < 64; ++pp) { const float cr = CAr[n * 64 + pp], ci = CAi[n * 64 + pp];
        const f32x4 br = *(LAS const f32x4*)(Br + pp * 16 + h0), bi = *(LAS const f32x4*)(Bi + pp * 16 + h0);
        acc += br * cr - bi * ci; }
    *(GAS f32x4*)(sp + SP_KTAB / 4 + (size_t)lg * KTAB_LG + tau * 256 + n * 16 + h0) = acc;
    __syncthreads();
}
__device__ __forceinline__ void s5_build_item(const In& in, unsigned char* ws, unsigned char* s5m  , int l, int item, int tid) {
    const int g = item >> 3, part = item & 7, lg = l * S5G + g;
    const float* sp = (const float*)(ws + WS_SPARE);
    const float* ktab = sp + SP_KTAB / 4 + (size_t)lg * KTAB_LG; const float* apow = sp + SP_APOW / 4 + (size_t)lg * APOW_LG; const float* bbar = sp + SP_BBAR / 4 + (size_t)lg * BBAR_LG;
    bf16_t* T = (bf16_t*)(s5m + S5M_T) + (size_t)g * 512 * 640; bf16_t* WE = (bf16_t*)(s5m + S5M_WEND) + (size_t)g * 256 * 512;
    const int my_n = tid & 15;
    (void)my_n;
#pragma unroll 4
    for (int k = 0; k < 8; ++k) { const int q = tid + k * NTHR, rl = q >> 6, pc = q & 63, t = 4 * part + (rl >> 4), n = rl & 15, col0 = 8 * pc, s = col0 >> 4, h0 = col0 & 15;
        const int tau = (t - s) < 0 ? 0 : (t - s); const bool live = s <= t;
        const f32x4 a = *(const GAS f32x4*)(ktab + tau * 256 + n * 16 + h0), b = *(const GAS f32x4*)(ktab + tau * 256 + n * 16 + h0 + 4);
        const float dn = (s == t) ? in.s5d[l * S5W + g * 16 + n] : 0.f;
        float v[8] = {a.x, a.y, a.z, a.w, b.x, b.y, b.z, b.w};
#pragma unroll
        for (int j = 0; j < 8; ++j) v[j] = live ? v[j] + ((h0 + j == n) ? dn : 0.f) : 0.f;
        u32x4 w; w.x = pk2(v[0], v[1]); w.y = pk2(v[2], v[3]); w.z = pk2(v[4], v[5]); w.w = pk2(v[6], v[7]);
        *(GAS u32x4*)(T + (size_t)(t * 16 + n) * 640 + col0) = w; }
#pragma unroll 2
    for (int k = 0; k < 2; ++k) { const int q = tid + k * NTHR, rl = q >> 4, pc = q & 15, t = 4 * part + (rl >> 4), n = rl & 15, q0 = 8 * pc, im = q0 >= 64, p0 = q0 & 63; float v[8];
#pragma unroll
        for (int j = 0; j < 8; ++j) { const int p = p0 + j; const float cr = in.cre[((size_t)lg * 16 + n) * 64 + p], ci = in.cim[((size_t)lg * 16 + n) * 64 + p];
            const f32x2 a = *(const GAS f32x2*)(apow + ((t + 1) * 64 + p) * 2); v[j] = im ? -(cr * a.y + ci * a.x) : (cr * a.x - ci * a.y); }
        u32x4 w; w.x = pk2(v[0], v[1]); w.y = pk2(v[2], v[3]); w.z = pk2(v[4], v[5]); w.w = pk2(v[6], v[7]);
        *(GAS u32x4*)(T + (size_t)(t * 16 + n) * 640 + 512 + q0) = w; }
#pragma unroll 2
    for (int q = tid; q < 32 * 64; q += NTHR) {
        const int r = 32 * part + (q >> 6), col0 = 8 * (q & 63), s = col0 >> 4, h0 = col0 & 15; float v[8];
        if (r < 128) { const int p = r & 63, im = r >= 64; const f32x2 a = *(const GAS f32x2*)(apow + ((31 - s) * 64 + p) * 2);
#pragma unroll
            for (int j = 0; j < 8; ++j) { const f32x2 b = *(const GAS f32x2*)(bbar + (p * 16 + h0 + j) * 2); v[j] = im ? (a.x * b.y + a.y * b.x) : (a.x * b.x - a.y * b.y); } }
        else {
#pragma unroll
            for (int j = 0; j < 8; ++j) v[j] = 0.f; }
        u32x4 w; w.x = pk2(v[0], v[1]); w.y = pk2(v[2], v[3]); w.z = pk2(v[4], v[5]); w.w = pk2(v[6], v[7]);
        *(GAS u32x4*)(WE + (size_t)r * 512 + col0) = w;
    }
}
struct EpiS5End {
    static constexpr int PROBE_ID = 305; static constexpr bool PERM = false;
    float* SE;
    __device__ __forceinline__ void probe(const f32x4 (&acc)[2][2][4][2], const Unit& u, int ui, int wr, int wc, int fr, int fq) const { (*this)(acc, u, ui, wr, wc, fr, fq); }
    __device__ __forceinline__ void operator()(const f32x4 (&acc)[2][2][4][2], const Unit& u, int ui, int wr, int wc, int fr, int fq) const {
        asm volatile("" : "+v"(fr), "+v"(fq));
#pragma unroll
        for (int ai = 0; ai < 2; ++ai)
#pragma unroll
            for (int m = 0; m < 4; ++m) { const int row = u.pm * BM + ai * HALF + wr * 64 + m * 16 + fr; float* o = SE + ((size_t)u.g * (M / 32) + row) * 128 + wc * 32 + 4 * fq;
#pragma unroll
                for (int n = 0; n < 2; ++n) *(GAS f32x4*)(o + 16 * n) = acc[ai][0][m][n]; }
    }
};
__device__ __forceinline__ f32x2 gelu_pk(f32x2 v) {
    const f32x2 av = __builtin_elementwise_abs(v), d = av * 0.2316418882f + 1.0f;
    f32x2 t; t.x = __builtin_amdgcn_rcpf(d.x); t.y = __builtin_amdgcn_rcpf(d.y);
    f32x2 q = t * 0.5307027145f + (-0.7265760135f); q = q * t + 0.7107068705f; q = q * t + (-0.142248368f); q = q * t + 0.127414796f; q = q * t;
    const f32x2 s = (v * v) * (-0.72134752044f);
    f32x2 e; e.x = __builtin_amdgcn_exp2f(s.x); e.y = __builtin_amdgcn_exp2f(s.y);
    const f32x2 m = v * (q * e), r = v - m;
    f32x2 o; o.x = v.x < 0.f ? m.x : r.x; o.y = v.y < 0.f ? m.y : r.y; return o;
}
struct EpiS5Out {
    static constexpr int PROBE_ID = 306; static constexpr bool PERM = true;
    bf16_t* Z;
    __device__ __forceinline__ void probe(const f32x4 (&acc)[2][2][4][2], const Unit& u, int ui, int wr, int wc, int fr, int fq) const { (*this)(acc, u, ui, wr, wc, fr, fq); }
    __device__ __forceinline__ void operator()(const f32x4 (&acc)[2][2][4][2], const Unit& u, int ui, int wr, int wc, int fr, int fq) const {
        asm volatile("" : "+v"(fr), "+v"(fq));
#pragma unroll
        for (int ai = 0; ai < 2; ++ai)
#pragma unroll
            for (int m = 0; m < 4; ++m) { const int crow = u.pm * BM + ai * HALF + wr * 64 + m * 16 + fr;
#pragma unroll
                for (int bj = 0; bj < 2; ++bj) { const int c = u.pn * BM + bj * HALF + wc * 32 + 8 * fq, t = c >> 4, hf = (c >> 3) & 1;
                    const f32x4 v0 = acc[ai][bj][m][0], v1 = acc[ai][bj][m][1];
                    const f32x2 a = gelu_pk((f32x2){v0.x, v0.y}), b = gelu_pk((f32x2){v0.z, v0.w}), cc = gelu_pk((f32x2){v1.x, v1.y}), dd = gelu_pk((f32x2){v1.z, v1.w});
                    u32x4 w; w.x = cvt_pk(a.x, a.y); w.y = cvt_pk(b.x, b.y); w.z = cvt_pk(cc.x, cc.y); w.w = cvt_pk(dd.x, dd.y);
                    *(GAS u32x4*)(Z + ((size_t)u.g * M + (size_t)crow * 32 + t) * 16 + hf * 8) = w; } }
    }
};
__device__ __forceinline__ void s5_scan_unit(unsigned char* ws, LAS unsigned char* lds, int l, int unit, int wave, int lane) {
    const int b = unit >> 5, g = unit & 31, p = lane, seg = wave, lg = l * S5G + g;
    const float* sp = (const float*)(ws + WS_SPARE);
    const f32x2 a32 = *(const GAS f32x2*)(sp + SP_APOW / 4 + (size_t)lg * APOW_LG + (32 * 64 + p) * 2);
    const float* se = (const float*)(ws + WS_SEND) + ((size_t)g * (M / 32) + b * 256 + seg * 32) * 128;
    LAS f32x2* segT = (LAS f32x2*)lds;
    float tr = 0.f, ti = 0.f;
#pragma unroll 8
    for (int k = 0; k < 32; ++k) { const float xr = se[k * 128 + p], xi = se[k * 128 + 64 + p]; const float nr = a32.x * tr - a32.y * ti + xr, ni = a32.x * ti + a32.y * tr + xi; tr = nr; ti = ni; }
    segT[seg * 64 + p] = (f32x2){tr, ti};
    float Ar = a32.x, Ai = a32.y;
#pragma unroll
    for (int j = 0; j < 5; ++j) { const float nr = Ar * Ar - Ai * Ai, ni = 2.f * Ar * Ai; Ar = nr; Ai = ni; }
    __syncthreads();
    float cr = 0.f, ci = 0.f;
    for (int s = 0; s < seg; ++s) { const f32x2 t2 = segT[s * 64 + p]; const float nr = Ar * cr - Ai * ci + t2.x, ni = Ar * ci + Ai * cr + t2.y; cr = nr; ci = ni; }
    bf16_t* ug = (bf16_t*)(ws + WS_UG) + ((size_t)g * (M / 32) + b * 256 + seg * 32) * 640 + 512;
#pragma unroll 8
    for (int k = 0; k < 32; ++k) { ug[k * 640 + p] = (bf16_t)f2bf(cr); ug[k * 640 + 64 + p] = (bf16_t)f2bf(ci);
        const float xr = se[k * 128 + p], xi = se[k * 128 + 64 + p]; const float nr = a32.x * cr - a32.y * ci + xr, ni = a32.x * ci + a32.y * cr + xi; cr = nr; ci = ni; }
    __syncthreads();
}

typedef short s16x4 __attribute__((ext_vector_type(4)));
__device__ __forceinline__ unsigned rt_f(int row) { return (unsigned)(((row & 3) << 2) | ((row >> 2) & 3)); }
__device__ __forceinline__ unsigned rt_off(int row, int ch) { return 256u * (unsigned)row + 16u * ((unsigned)ch ^ rt_f(row)); }
__device__ __forceinline__ void rt_fill(LAS unsigned char* img, const bf16_t* src  , int wave, int lane) {
#pragma unroll
    for (int j = 0; j < 4; ++j) { const int p = wave * 4 + j, row = 4 * p + (lane >> 4), ch = (lane & 15) ^ (int)rt_f(row);
        __builtin_amdgcn_global_load_lds((const unsigned*)((const char*)src + (size_t)row * 1024 + ch * 16), (LAS unsigned*)(img + p * 1024), 16, 0, 0); }
}
__device__ __forceinline__ s16x4 rt_tr4(LAS const unsigned char* p) { typedef short v4i16_t __attribute__((ext_vector_type(4))); return __builtin_bit_cast(s16x4, __builtin_amdgcn_ds_read_tr16_b64_v4i16((LAS v4i16_t*)p)); }
template <bool KPERM> __device__ __forceinline__ bf16x8 rt_trfrag(LAS const unsigned char* img, int k0, int c, int lane) {
    const int hh = lane >> 5, blk = (lane >> 4) & 1, q = (lane & 15) >> 2, p = lane & 3;
    const int r0 = k0 + (KPERM ? 4 * hh : 8 * hh) + q, r1 = r0 + (KPERM ? 8 : 4), ch = 4 * c + 2 * blk + (p >> 1);
    const s16x4 lo = rt_tr4(img + rt_off(r0, ch) + 8 * (p & 1)), hi = rt_tr4(img + rt_off(r1, ch) + 8 * (p & 1));
    return __builtin_shufflevector(lo, hi, 0, 1, 2, 3, 4, 5, 6, 7);
}
__device__ __forceinline__ bf16x8 rt_rowfrag(LAS const unsigned char* img, int rb, int s, int lane) {
    return *(LAS const bf16x8*)(img + rt_off(32 * rb + (lane & 31), 2 * s + (lane >> 5)));
}
constexpr int RT_Q = 0, RT_K = 32768, RT_V = 65536, RT_R = 98304;
__device__ __forceinline__ float ret_g(int h) { return h == 0 ? 0.017183023570817902f : h == 1 ? 0.1332151628796484f : h == 2 ? 0.3664377159220373f : 0.6059370882290803f; }
__device__ __forceinline__ void rt_kv(f32x16 (&racc)[2], LAS const unsigned char* lds, int wave, int lane) {
    const int eb = wave & 3, db0 = 2 * (wave >> 2);
#pragma unroll
    for (int ks = 0; ks < 8; ++ks) {
        const bf16x8 bv = rt_trfrag<false>(lds + RT_V, 16 * ks, eb, lane);
        const bf16x8 a0 = rt_trfrag<false>(lds + RT_K, 16 * ks, db0, lane), a1 = rt_trfrag<false>(lds + RT_K, 16 * ks, db0 + 1, lane);
        racc[0] = __builtin_amdgcn_mfma_f32_32x32x16_bf16(a0, bv, racc[0], 0, 0, 0);
        racc[1] = __builtin_amdgcn_mfma_f32_32x32x16_bf16(a1, bv, racc[1], 0, 0, 0);
    }
}
template <int KS> __device__ __forceinline__ void rt_kv_step(f32x16 (&racc)[2], unsigned av0, unsigned av1, unsigned ak0, unsigned ak1, unsigned ak2, unsigned ak3) {
    s16x4 v0, v1, k0, k1, k2, k3;
    asm volatile("ds_read_b64_tr_b16 %0, %6 offset:%12\n\tds_read_b64_tr_b16 %1, %7 offset:%12\n\tds_read_b64_tr_b16 %2, %8 offset:%12\n\tds_read_b64_tr_b16 %3, %9 offset:%12\n\t"
                 "ds_read_b64_tr_b16 %4, %10 offset:%12\n\tds_read_b64_tr_b16 %5, %11 offset:%12\n\ts_waitcnt lgkmcnt(0)"
                 : "=&v"(v0), "=&v"(v1), "=&v"(k0), "=&v"(k1), "=&v"(k2), "=&v"(k3) : "v"(av0), "v"(av1), "v"(ak0), "v"(ak1), "v"(ak2), "v"(ak3), "i"(KS * 4096) : "memory");
    const bf16x8 bv = __builtin_shufflevector(v0, v1, 0, 1, 2, 3, 4, 5, 6, 7), a0 = __builtin_shufflevector(k0, k1, 0, 1, 2, 3, 4, 5, 6, 7), a1 = __builtin_shufflevector(k2, k3, 0, 1, 2, 3, 4, 5, 6, 7);
    racc[0] = __builtin_amdgcn_mfma_f32_32x32x16_bf16(a0, bv, racc[0], 0, 0, 0);
    racc[1] = __builtin_amdgcn_mfma_f32_32x32x16_bf16(a1, bv, racc[1], 0, 0, 0);
}
__device__ __forceinline__ unsigned rt_traddr(LAS const unsigned char* img, int c, int t, int lane) {
    const int hh = lane >> 5, blk = (lane >> 4) & 1, q = (lane & 15) >> 2, p = lane & 3;
    return (unsigned)(size_t)img + rt_off(8 * hh + 4 * t + q, 4 * c + 2 * blk + (p >> 1)) + 8 * (p & 1);
}
__device__ __forceinline__ void ret_kvrun_steps(unsigned char* ws, LAS unsigned char* lds, int u0, int nu, int wave) {
    const int total = nu * 4;
#define RT_ISSUE(step) do { const int un_ = u0 + ((step) >> 2), c_ = (step) & 3, bh_ = un_ >> 4, run_ = un_ & 15, b_ = bh_ >> 2, h_ = bh_ & 3; \
        const size_t r_ = ((size_t)b_ * SEQ + run_ * 512 + c_ * 128) * RW + h_ * RDK; LAS unsigned char* bf_ = lds + ((step) & 1) * 65536; const int ln_ = lane_id(); \
        rt_fill(bf_, (const bf16_t*)(ws + WS_K) + r_, wave, ln_); rt_fill(bf_ + 32768, (const bf16_t*)(ws + WS_V) + r_, wave, ln_); } while (0)
    RT_ISSUE(0);
    f32x16 racc[2];
#pragma unroll 1
    for (int step = 0; step < total; ++step) {
        const int unit = u0 + (step >> 2), c = step & 3, h = (unit >> 4) & 3; const float g = (c == 0) ? 0.f : ret_g(h);
        if (step + 1 < total) { RT_ISSUE(step + 1); asm volatile("s_waitcnt vmcnt(8) lgkmcnt(0)\n\ts_barrier" ::: "memory"); }
        else asm volatile("s_waitcnt vmcnt(0) lgkmcnt(0)\n\ts_barrier" ::: "memory");
#pragma unroll
        for (int k = 0; k < 2; ++k)
#pragma unroll
            for (int j = 0; j < 16; ++j) racc[k][j] = (c == 0) ? 0.f : racc[k][j] * g;
        { const int lane = lane_id(); LAS const unsigned char* bf = lds + (step & 1) * 65536;
          const int eb = wave & 3, db0 = 2 * (wave >> 2);
          const unsigned av0 = rt_traddr(bf + 32768, eb, 0, lane), av1 = rt_traddr(bf + 32768, eb, 1, lane);
          const unsigned ak0 = rt_traddr(bf, db0, 0, lane), ak1 = rt_traddr(bf, db0, 1, lane), ak2 = rt_traddr(bf, db0 + 1, 0, lane), ak3 = rt_traddr(bf, db0 + 1, 1, lane);
          rt_kv_step<0>(racc, av0, av1, ak0, ak1, ak2, ak3); rt_kv_step<1>(racc, av0, av1, ak0, ak1, ak2, ak3); rt_kv_step<2>(racc, av0, av1, ak0, ak1, ak2, ak3); rt_kv_step<3>(racc, av0, av1, ak0, ak1, ak2, ak3);
          rt_kv_step<4>(racc, av0, av1, ak0, ak1, ak2, ak3); rt_kv_step<5>(racc, av0, av1, ak0, ak1, ak2, ak3); rt_kv_step<6>(racc, av0, av1, ak0, ak1, ak2, ak3); rt_kv_step<7>(racc, av0, av1, ak0, ak1, ak2, ak3);
          if (c == 3) { float* o = (float*)(ws + WS_KVRUN) + (size_t)unit * 16384 + (size_t)wave * 2048 + lane * 32;
#pragma unroll
            for (int k = 0; k < 2; ++k)
#pragma unroll
                for (int q4 = 0; q4 < 4; ++q4) *(GAS f32x4*)(o + k * 16 + 4 * q4) = (f32x4){racc[k][4 * q4], racc[k][4 * q4 + 1], racc[k][4 * q4 + 2], racc[k][4 * q4 + 3]}; } }
        asm volatile("s_waitcnt lgkmcnt(0)\n\ts_barrier" ::: "memory");
    }
    asm volatile("s_waitcnt vmcnt(0)" ::: "memory");
#undef RT_ISSUE
}
__device__ __forceinline__ void ret_scan(unsigned char* ws, int bx, int G, int tid) {
    for (int e2 = bx * NTHR + tid; e2 < NB * RH * 8192; e2 += G * NTHR) {
        const int bh = e2 >> 13, el = (e2 & 8191) * 2, h = bh & 3; float g4 = ret_g(h); g4 *= g4; g4 *= g4;
        const float* kv = (const float*)(ws + WS_KVRUN) + (size_t)bh * 16 * 16384 + el; bf16_t* rs = (bf16_t*)(ws + WS_RSTART) + (size_t)bh * 16 * 16384 + el;
        f32x2 v[15];
#pragma unroll
        for (int r = 0; r < 15; ++r) v[r] = *(const GAS f32x2*)(kv + (size_t)r * 16384);
        float z0 = 0.f; asm volatile("" : "+v"(z0));
        f32x2 s = {z0, z0};
        *(GAS unsigned*)rs = 0u;
#pragma unroll
        for (int r = 0; r < 15; ++r) { s = s * g4 + v[r]; *(GAS unsigned*)(rs + (size_t)(r + 1) * 16384) = pk2(s.x, s.y); }
    }
}
__device__ __forceinline__ void ret_out_unit(unsigned char* ws, LAS unsigned char* lds, const float* gain  , int unit, int wave) {
    const int bh = unit >> 4, run = unit & 15, b = bh >> 2, h = bh & 3; const float g = ret_g(h);
    const size_t row0 = (size_t)b * SEQ + run * 512;
    const int qb = wave & 3, eh = wave >> 2;
    LAS f32x2* exch = (LAS f32x2*)(lds + TAB_OFF);
    LAS float* gtab = (LAS float*)(lds + TAB_OFF + 2048);
    { const int lane = lane_id();
      rt_fill(lds + RT_Q, (const bf16_t*)(ws + WS_Q) + row0 * RW + h * RDK, wave, lane);
      rt_fill(lds + RT_K, (const bf16_t*)(ws + WS_K) + row0 * RW + h * RDK, wave, lane);
      rt_fill(lds + RT_V, (const bf16_t*)(ws + WS_V) + row0 * RW + h * RDK, wave, lane);
      if (wave < 2) gtab[wave * 64 + lane] = gain[h * RDK + wave * 64 + lane]; }
    f32x16 racc[2];
    { const int lane = lane_id(); const bf16_t* o = (const bf16_t*)(ws + WS_RSTART) + (size_t)unit * 16384 + (size_t)wave * 2048 + lane * 32;
      u32x4 rw[4];
#pragma unroll
      for (int i = 0; i < 4; ++i) rw[i] = *(const GAS u32x4*)(o + 8 * i);
#pragma unroll
      for (int k = 0; k < 2; ++k)
#pragma unroll
        for (int i = 0; i < 2; ++i) { const u32x4 v = rw[2 * k + i];
            racc[k][8 * i + 0] = bflo(v.x); racc[k][8 * i + 1] = bfhi(v.x); racc[k][8 * i + 2] = bflo(v.y); racc[k][8 * i + 3] = bfhi(v.y);
            racc[k][8 * i + 4] = bflo(v.z); racc[k][8 * i + 5] = bfhi(v.z); racc[k][8 * i + 6] = bflo(v.w); racc[k][8 * i + 7] = bfhi(v.w); } }
#pragma unroll 1
    for (int c = 0; c < 4; ++c) {
        __builtin_amdgcn_s_waitcnt(0x0F70); __syncthreads();
        u32x4 gw[4];
        { const int lane = lane_id();
          const bf16_t* gp = (const bf16_t*)(ws + WS_GATE) + (row0 + c * 128 + 32 * qb + (lane >> 3)) * RW + h * RDK + 64 * eh;
#pragma unroll
          for (int j = 0; j < 4; ++j) { const int row = 8 * j + (lane >> 3); gw[j] = *(const GAS u32x4*)(gp + (size_t)(8 * j) * RW + 8 * ((lane & 7) ^ (row & 7))); } }
        {
          const int lane = lane_id(), eb = wave & 3, db0 = 2 * (wave >> 2), r = lane & 31, hh = lane >> 5;
#pragma unroll
          for (int k = 0; k < 2; ++k)
#pragma unroll
            for (int q4 = 0; q4 < 4; ++q4) { u32x2 w; w.x = cvt_pk(racc[k][4 * q4] * g, racc[k][4 * q4 + 1] * g); w.y = cvt_pk(racc[k][4 * q4 + 2] * g, racc[k][4 * q4 + 3] * g);
                const int e = 32 * eb + r, d0 = 32 * (db0 + k) + 8 * q4 + 4 * hh;
                *(LAS u32x2*)(lds + RT_R + rt_off(e, d0 >> 3) + 2 * (d0 & 7)) = w; } }
        if (c < 3) {
#pragma unroll
            for (int k = 0; k < 2; ++k) racc[k] *= g;
            rt_kv(racc, lds, wave, lane_id());
        }
        f32x16 oacc[2]; bf16x8 bq[8]; float sg[4][8];
        {   const int lane = lane_id(), r = lane & 31, hh = lane >> 5;
#pragma unroll
            for (int s = 0; s < 8; ++s) bq[s] = rt_rowfrag(lds + RT_Q, qb, s, lane);
            f32x16 sacc[4];
#pragma unroll
            for (int kb = 0; kb < 4; ++kb) {
#pragma unroll
                for (int j = 0; j < 16; ++j) sacc[kb][j] = 0.f;
                if (kb <= qb) {
#pragma unroll
                    for (int s = 0; s < 8; ++s) sacc[kb] = __builtin_amdgcn_mfma_f32_32x32x16_bf16(rt_rowfrag(lds + RT_K, kb, s, lane), bq[s], sacc[kb], 0, 0, 0);
                }
            }
#pragma unroll
            for (int kb = 0; kb < 4; ++kb) if (kb == qb) {
#pragma unroll
                for (int j = 0; j < 16; ++j) { const int key = (j & 3) + 8 * (j >> 2) + 4 * hh; sacc[kb][j] = (key <= r) ? sacc[kb][j] : 0.f; } }
#pragma unroll
            for (int k = 0; k < 2; ++k)
#pragma unroll
                for (int j = 0; j < 16; ++j) oacc[k][j] = 0.f;
#pragma unroll
            for (int kb = 0; kb < 4; ++kb) if (kb <= qb) {
#pragma unroll
                for (int s = 0; s < 2; ++s) { u32x4 w; w.x = cvt_pk(sacc[kb][8 * s + 0], sacc[kb][8 * s + 1]); w.y = cvt_pk(sacc[kb][8 * s + 2], sacc[kb][8 * s + 3]);
                    w.z = cvt_pk(sacc[kb][8 * s + 4], sacc[kb][8 * s + 5]); w.w = cvt_pk(sacc[kb][8 * s + 6], sacc[kb][8 * s + 7]); const bf16x8 bp = __builtin_bit_cast(bf16x8, w);
#pragma unroll
                    for (int k = 0; k < 2; ++k) oacc[k] = __builtin_amdgcn_mfma_f32_32x32x16_bf16(rt_trfrag<true>(lds + RT_V, 32 * kb + 16 * s, 2 * eh + k, lane), bp, oacc[k], 0, 0, 0); } }
#pragma unroll
            for (int j = 0; j < 4; ++j) { const u32x4 gv = gw[j];
                sg[j][0] = bflo(gv.x) * fast_sigmoid(bflo(gv.x)); sg[j][1] = bfhi(gv.x) * fast_sigmoid(bfhi(gv.x)); sg[j][2] = bflo(gv.y) * fast_sigmoid(bflo(gv.y)); sg[j][3] = bfhi(gv.y) * fast_sigmoid(bfhi(gv.y));
                sg[j][4] = bflo(gv.z) * fast_sigmoid(bflo(gv.z)); sg[j][5] = bfhi(gv.z) * fast_sigmoid(bfhi(gv.z)); sg[j][6] = bflo(gv.w) * fast_sigmoid(bflo(gv.w)); sg[j][7] = bfhi(gv.w) * fast_sigmoid(bfhi(gv.w));
#pragma unroll
                for (int i = 0; i < 8; ++i) asm volatile("" : "+v"(sg[j][i])); }
        }
        __syncthreads();
        if (c < 3) { const int lane = lane_id(); const size_t nr = (row0 + (c + 1) * 128) * RW + h * RDK;
            rt_fill(lds + RT_Q, (const bf16_t*)(ws + WS_Q) + nr, wave, lane); rt_fill(lds + RT_K, (const bf16_t*)(ws + WS_K) + nr, wave, lane); rt_fill(lds + RT_V, (const bf16_t*)(ws + WS_V) + nr, wave, lane); }
        {   const int lane = lane_id(), r = lane & 31, hh = lane >> 5;
#pragma unroll
            for (int s = 0; s < 8; ++s)
#pragma unroll
                for (int k = 0; k < 2; ++k) oacc[k] = __builtin_amdgcn_mfma_f32_32x32x16_bf16(rt_rowfrag(lds + RT_R, 2 * eh + k, s, lane), bq[s], oacc[k], 0, 0, 0);
            float s1 = 0.f, s2 = 0.f;
#pragma unroll
            for (int k = 0; k < 2; ++k)
#pragma unroll
                for (int j = 0; j < 16; ++j) { s1 += oacc[k][j]; s2 += oacc[k][j] * oacc[k][j]; }
            s1 = half_sum(s1); s2 = half_sum(s2);
            if (hh == 0) exch[eh * 128 + 32 * qb + r] = (f32x2){s1, s2};
            asm volatile("s_waitcnt lgkmcnt(0)\n\ts_barrier" ::: "memory");
            const f32x2 e0 = exch[32 * qb + r], e1 = exch[128 + 32 * qb + r];
            const float mu = (e0.x + e1.x) * (1.0f / 128.0f), var = (e0.y + e1.y) * (1.0f / 128.0f) - mu * mu, rstd = 1.0f / sqrtf(var + EPS);
            LAS unsigned char* wb = lds + RT_R + wave * 4096;
#pragma unroll
            for (int k = 0; k < 2; ++k)
#pragma unroll
                for (int q4 = 0; q4 < 4; ++q4) { const int el = 32 * k + 8 * q4 + 4 * hh; const f32x4 gn = *(LAS const f32x4*)(gtab + 64 * eh + el);
                    u32x2 w; w.x = cvt_pk((oacc[k][4 * q4] - mu) * rstd * gn.x, (oacc[k][4 * q4 + 1] - mu) * rstd * gn.y); w.y = cvt_pk((oacc[k][4 * q4 + 2] - mu) * rstd * gn.z, (oacc[k][4 * q4 + 3] - mu) * rstd * gn.w);
                    *(LAS u32x2*)(wb + r * 128 + (((el >> 3) ^ (r & 7)) << 4) + 8 * hh) = w; }
            asm volatile("s_waitcnt lgkmcnt(0)" ::: "memory");
            bf16_t* yp = (bf16_t*)(ws + WS_YMIX) + (row0 + c * 128 + 32 * qb) * D + S5W + h * RDK + 64 * eh;
#pragma unroll
            for (int j = 0; j < 4; ++j) { const int row = 8 * j + (lane >> 3), cp = lane & 7; const u32x4 v = *(LAS const u32x4*)(wb + row * 128 + cp * 16);
                u32x4 w; w.x = cvt_pk(bflo(v.x) * sg[j][0], bfhi(v.x) * sg[j][1]); w.y = cvt_pk(bflo(v.y) * sg[j][2], bfhi(v.y) * sg[j][3]);
                w.z = cvt_pk(bflo(v.z) * sg[j][4], bfhi(v.z) * sg[j][5]); w.w = cvt_pk(bflo(v.w) * sg[j][6], bfhi(v.w) * sg[j][7]);
                *(GAS u32x4*)(yp + (size_t)row * D + 8 * (cp ^ (row & 7))) = w; }
        }
    }
    __syncthreads();
}

struct Args { In in; float* out; unsigned char* ws; int pro_lo, pro_hi, l_lo, l_hi, ph_lo, ph_hi, flags, region; };
enum { PH_PROJ = 0, PH_MIXA = 1, PH_SCAN = 2, PH_MIXC = 3, PH_GLU = 4, PH_WOUT = 5, PH_CQ = 6, PH_XATT = 7, PH_CO = 8, PH_FFN1 = 9, PH_FFN2 = 10, PH_N = 11 };
enum { FL_XPREP = 1, FL_FINAL = 2, FL_XIN = 4 };

__global__ void __launch_bounds__(NTHR, 2) fwd(Args a) {
    extern __shared__ __attribute__((aligned(16))) unsigned char lds_raw[];
    LAS unsigned char* lds = (LAS unsigned char*)lds_raw;
    const int wave = __builtin_amdgcn_readfirstlane(threadIdx.x >> 6); const bool t0 = (threadIdx.x == 0);
#define LANE lane_id()
    const int G = gridDim.x, bx = blockIdx.x, vcu = (G % 8 == 0) ? (bx % 8) * (G / 8) + bx / 8 : bx;
    volatile LAS unsigned* MISC = (volatile LAS unsigned*)(lds + MISC_OFF);
    if (threadIdx.x < 32) MISC[threadIdx.x] = 0u;
    __syncthreads();
    unsigned char* ws = a.ws;
    unsigned* ctl = (unsigned*)(ws + WS_CTL);
    XcdBarrier bar = xcd_barrier_post(ctl + CW_BAR + a.region * XCD_BAR_WORDS, MISC + 8, t0);
    bool need_bar = false;
#ifndef PROBE_DUP
#define PROBE_DUP -1
#endif
#define REPS(k) ((PROBE_DUP == (k)) ? 2 : 1)
#define SEAM() do { if (need_bar) { xcd_barrier(bar); if (PROBE_DUP == 100) xcd_barrier(bar); } need_bar = true; } while (0)
    const int gw = vcu * NWAVES + wave, NGW = G * NWAVES;
    const In& in = a.in;
    float* ssq = (float*)(ws + WS_SSQ);
    bf16_t* xb = (bf16_t*)(ws + WS_XB);
    LAS float* tab = (LAS float*)(lds + TAB_OFF);
    float* rsm = (float*)(ws + WS_SPARE);

#ifndef STAGGER_TICKS
#define STAGGER_TICKS 0
#endif
#define STAGGER() do { if (STAGGER_TICKS > 0) { const unsigned long long t0_ = __builtin_amdgcn_s_memrealtime(), d_ = (unsigned long long)((bx & 7) * STAGGER_TICKS); \
        while (__builtin_amdgcn_s_memrealtime() - t0_ < d_) __builtin_amdgcn_s_sleep(2); } } while (0)
    for (int rep = 0; rep < REPS(200); ++rep) if (a.pro_lo <= 0 && 0 < a.pro_hi) {
        SEAM();
        pro_weights(in, ws, lds, gw, NGW, wave, LANE);
#if PROBE_DUP == 210
        __syncthreads(); pro_weights(in, ws, lds, gw + (int)(a.flags >> 8), NGW, wave, LANE);
#endif
        for (int r2 = 0; r2 < REPS(211); ++r2) if (a.flags & FL_XIN) xprep_rows(in.x, xb, ssq, gw, NGW, LANE);
        mem_prep_rows(in.mem, (bf16_t*)(ws + WS_MEMB), rsm, gw, NGW, LANE);
        for (int r2 = 0; r2 < REPS(212); ++r2) rope_table(in.pos, (float*)(ws + WS_ROPE), gw * 64 + LANE, NGW * 64);
        __syncthreads();
        for (int r2 = 0; r2 < REPS(213); ++r2) for (int it = bx; it < DEPTH * S5G * 4; it += G) s5_tables_item(in, ws, lds, it, wave, LANE);
        __syncthreads();
    }
    for (int rep = 0; rep < REPS(201); ++rep) if (a.pro_lo <= 1 && 1 < a.pro_hi) {
        SEAM();
        int bxo = bx; asm volatile("" : "+s"(bxo));
        { GroupOrder S; S.init(DEPTH, MROWS / BM, D / BM, G, bxo, 0);
          const Gemm g{(const bf16_t*)(ws + WS_MEMB), (const bf16_t*)(ws + WS_WCK_TMP), D, D, D, 0, (long)D * D};
          const EpiMemK E{(bf16_t*)(ws + WS_MEMK), rsm};
          gemm_phase<EpiMemK, GroupOrder>(lds, g, S, E, wave); }
        { GroupOrder S; S.init(DEPTH, D / BM, MROWS / BM, G, bxo, 64);
          const Gemm g{(const bf16_t*)(ws + WS_WCV_TMP), (const bf16_t*)(ws + WS_MEMB), D, D, D, (long)D * D, 0};
          const EpiMemVT E{(bf16_t*)(ws + WS_MEMVT), rsm};
          gemm_phase<EpiMemVT, GroupOrder>(lds, g, S, E, wave); }
        if (G == 256) { const int n_it = bxo < 128 ? 2 : 6, it0 = bxo < 128 ? bxo : 256 + (bxo - 128);
            for (int k = 0; k < n_it; ++k) { const int it = it0 + 128 * k; s5_build_item(in, ws, (unsigned char*)a.out + (size_t)(it >> 8) * S5M_LAYER, it >> 8, it & 255, wave * 64 + LANE); } }
        else for (int it = bxo; it < DEPTH * S5G * 8; it += G) s5_build_item(in, ws, (unsigned char*)a.out + (size_t)(it >> 8) * S5M_LAYER, it >> 8, it & 255, wave * 64 + LANE);
    }
    for (int l = a.l_lo; l < a.l_hi; ++l) {
#define IN_PH(k) (a.ph_lo <= (k) && (k) < a.ph_hi)
        for (int rep = 0; rep < REPS(PH_PROJ); ++rep) if (IN_PH(PH_PROJ)) {
            SEAM();
            int bxo = bx; asm volatile("" : "+s"(bxo));
            StaticOrder S; S.init(M / BM, INW / BM, G, bxo);
            const RstdPre<StaticOrder> pre{tab, &S, ssq, 16, 1.0f / D};
            const Gemm g{xb, wl(ws, l, W_IN), D, D, D, 0, 0};
            const EpiProj E{(bf16_t*)(ws + WS_UG), (bf16_t*)(ws + WS_Q), (bf16_t*)(ws + WS_K), (bf16_t*)(ws + WS_V), (bf16_t*)(ws + WS_GATE), (const float*)(ws + WS_ROPE), tab};
            gemm_phase<EpiProj, StaticOrder, false, RstdPre<StaticOrder>>(lds, g, S, E, wave, pre);
        }
        for (int rep = 0; rep < REPS(PH_MIXA); ++rep) if (IN_PH(PH_MIXA)) {
            SEAM();
            int bxo = bx; asm volatile("" : "+s"(bxo));
            if (G == 256) {
                if (bxo < 128) { GroupOrder S; S.init(S5G, (M / 32) / BM, 1, G, bxo, 0);
                  const Gemm g{(const bf16_t*)(ws + WS_UG), (const bf16_t*)((unsigned char*)a.out + (size_t)l * S5M_LAYER + S5M_WEND), 640, 512, 512, (long)(M / 32) * 640, 256L * 512};
                  const EpiS5End E{(float*)(ws + WS_SEND)};
                  gemm_phase<EpiS5End, GroupOrder>(lds, g, S, E, wave); }
                else ret_kvrun_steps(ws, lds, 2 * (bxo - 128), 2, wave);
            } else {
                { GroupOrder S; S.init(S5G, (M / 32) / BM, 1, G, bxo, 0);
                  const Gemm g{(const bf16_t*)(ws + WS_UG), (const bf16_t*)((unsigned char*)a.out + (size_t)l * S5M_LAYER + S5M_WEND), 640, 512, 512, (long)(M / 32) * 640, 256L * 512};
                  const EpiS5End E{(float*)(ws + WS_SEND)};
                  gemm_phase<EpiS5End, GroupOrder>(lds, g, S, E, wave); }
                __syncthreads();
                for (int u = bxo; u < NB * RH * 16; u += G) ret_kvrun_steps(ws, lds, u, 1, wave);
            }
        }
        for (int rep = 0; rep < REPS(PH_SCAN); ++rep) if (IN_PH(PH_SCAN)) {
            SEAM();
            for (int u = bx; u < NB * S5G; u += G) s5_scan_unit(ws, lds, l, u, wave, LANE);
            ret_scan(ws, bx, G, wave * 64 + LANE);
        }
        for (int rep = 0; rep < REPS(PH_MIXC); ++rep) if (IN_PH(PH_MIXC)) {
            SEAM();
            int bxo = bx; asm volatile("" : "+s"(bxo));
            for (int r2 = 0; r2 < REPS(31); ++r2)
            { GroupOrder S; S.init(S5G, (M / 32) / BM, 2, G, bxo, 0);
              const Gemm g{(const bf16_t*)(ws + WS_UG), (const bf16_t*)((unsigned char*)a.out + (size_t)l * S5M_LAYER + S5M_T), 640, 640, 640, (long)(M / 32) * 640, 512L * 640};
              const EpiS5Out E{(bf16_t*)(ws + WS_Z)};
              gemm_phase<EpiS5Out, GroupOrder>(lds, g, S, E, wave); }
            __syncthreads();
            for (int r2 = 0; r2 < REPS(32); ++r2)
            for (int u = bxo; u < NB * RH * 16; u += G) ret_out_unit(ws, lds, in.retn + l * RW, u, wave);
        }
        for (int rep = 0; rep < REPS(PH_GLU); ++rep) if (IN_PH(PH_GLU)) {
            SEAM();
            int bxo = bx; asm volatile("" : "+s"(bxo));
            StaticOrder S; S.init(M / BM, S5W / BM, G, bxo);
            const Gemm g{(const bf16_t*)(ws + WS_Z), wl(ws, l, W_GLU), S5W, S5W, S5W, 0, 0, M};
            const EpiGlu E{(const bf16_t*)(ws + WS_Z), in.bglu + l * S5W, (bf16_t*)(ws + WS_YMIX), (float*)(ws + WS_SSQS)};
            gemm_phase<EpiGlu, StaticOrder>(lds, g, S, E, wave);
        }
        for (int rep = 0; rep < REPS(PH_WOUT); ++rep) if (IN_PH(PH_WOUT)) {
            SEAM();
            int bxo = bx; asm volatile("" : "+s"(bxo));
            StaticOrder S; S.init(M / BM, D / BM, G, bxo);
            LAS float* tab2 = (LAS float*)(lds + TAB2_OFF);
            const RstdPre<StaticOrder> pre{tab2, &S, (const float*)(ws + WS_SSQS), 8, 1.0f / S5W};
            const Gemm g{(const bf16_t*)(ws + WS_YMIX), wl(ws, l, W_OUT), D, D, D, 0, 0};
            const EpiResHook E{{xb, ssq, nullptr, (REPS(PH_WOUT) == 2 && rep == 0) ? 0.f : 1.f, tab}, tab2, 8};
            gemm_phase<EpiResHook, StaticOrder, true, RstdPre<StaticOrder>>(lds, g, S, E, wave, pre);
        }
        for (int rep = 0; rep < REPS(PH_CQ); ++rep) if (IN_PH(PH_CQ)) {
            SEAM();
            int bxo = bx; asm volatile("" : "+s"(bxo));
            StaticOrder S; S.init(M / BM, D / BM, G, bxo);
            const RstdPre<StaticOrder> pre{tab, &S, ssq, 16, 1.0f / D};
            const Gemm g{xb, wl(ws, l, W_CQ), D, D, D, 0, 0};
            const EpiScaleBf16 E{(bf16_t*)(ws + WS_QC), D, tab};
            gemm_phase<EpiScaleBf16, StaticOrder, false, RstdPre<StaticOrder>>(lds, g, S, E, wave, pre);
#pragma unroll 1
            for (int i = 0; i < 2; ++i) { Unit u; if (!S.next(i, u)) break;
                const int upm = __builtin_amdgcn_readfirstlane(u.pm), upn = __builtin_amdgcn_readfirstlane(u.pn);
                xattn_unit(lds, (const bf16_t*)(ws + WS_QC), (const bf16_t*)(ws + WS_MEMK) + (size_t)l * MROWS * D, (const bf16_t*)(ws + WS_MEMVT) + (size_t)l * D * MROWS, (bf16_t*)(ws + WS_OC), upm >> 5, upn, upm & 31, wave); }
        }
        for (int rep = 0; rep < REPS(PH_CO); ++rep) if (IN_PH(PH_CO)) {
            SEAM();
            int bxo = bx; asm volatile("" : "+s"(bxo));
            StaticOrder S; S.init(M / BM, D / BM, G, bxo);
            const Gemm g{(const bf16_t*)(ws + WS_OC), wl(ws, l, W_CO), D, D, D, 0, 0};
            const EpiRes E{xb, ssq, nullptr, (REPS(PH_CO) == 2 && rep == 0) ? 0.f : 1.f, tab};
            gemm_phase<EpiRes, StaticOrder>(lds, g, S, E, wave);
        }
        for (int rep = 0; rep < REPS(PH_FFN1); ++rep) if (IN_PH(PH_FFN1)) {
            SEAM();
            int bxo = bx; asm volatile("" : "+s"(bxo));
            StaticOrder S; S.init(M / BM, (2 * FF) / BM, G, bxo);
            const RstdPre<StaticOrder> pre{tab, &S, ssq, 16, 1.0f / D};
            const Gemm g{xb, wl(ws, l, W_GU), D, D, D, 0, 0};
            const EpiFfn1 E{(bf16_t*)(ws + WS_HID), tab};
            gemm_phase<EpiFfn1, StaticOrder, false, RstdPre<StaticOrder>>(lds, g, S, E, wave, pre);
        }
        for (int rep = 0; rep < REPS(PH_FFN2); ++rep) if (IN_PH(PH_FFN2)) {
            SEAM();
            int bxo = bx; asm volatile("" : "+s"(bxo));
            StaticOrder S; S.init(M / BM, D / BM, G, bxo);
            const Gemm g{(const bf16_t*)(ws + WS_HID), wl(ws, l, W_DN), FF, FF, FF, 0, 0};
            const EpiRes E{xb, ssq, nullptr, (REPS(PH_FFN2) == 2 && rep == 0) ? 0.f : 1.f, tab};
            gemm_phase<EpiRes, StaticOrder>(lds, g, S, E, wave);
        }
    }
    if (a.flags & FL_FINAL) { SEAM(); final_norm_rows(xb, a.out, in.norm_final, gw, NGW, LANE); }
#undef IN_PH
#undef SEAM
#undef LANE
}
}

extern "C" void kernel_launch(void* const* d_in, const int* in_sizes, int n_in, void* d_out, int out_size, void* d_ws, size_t ws_size, hipStream_t stream) {
    static int grid = 0;
    if (grid == 0) {
        if (n_in != 29 || out_size != mk::M * mk::D || ws_size < mk::WS_END) { fprintf(stderr, "kernel_launch: unexpected sizes (n_in %d out %d ws %zu)\n", n_in, out_size, ws_size); grid = -1; return; }
        int dev = 0, cus = 0, per_cu = 0;
        if (hipGetDevice(&dev) != hipSuccess || hipDeviceGetAttribute(&cus, hipDeviceAttributeMultiprocessorCount, dev) != hipSuccess) { grid = -1; return; }
        if (hipFuncSetAttribute((const void*)mk::fwd, hipFuncAttributeMaxDynamicSharedMemorySize, mk::LDS_BYTES) != hipSuccess) { fprintf(stderr, "kernel_launch: hipFuncSetAttribute failed\n"); grid = -1; return; }
        if (hipOccupancyMaxActiveBlocksPerMultiprocessor(&per_cu, (const void*)mk::fwd, mk::NTHR, mk::LDS_BYTES) != hipSuccess || per_cu < 1) fprintf(stderr, "kernel_launch: occupancy query says %d\n", per_cu);
        (void)hipGetLastError();
        grid = cus;
    }
    if (grid < 0) return;
    (void)in_sizes;
    if (hipMemsetAsync((char*)d_ws + mk::WS_CTL, 0, mk::CTL_ZERO_BYTES, stream) != hipSuccess) return;
    mk::Args a{};
    { const void** p = (const void**)&a.in; for (int i = 0; i < 29; ++i) p[i] = d_in[i]; }
    a.out = (float*)d_out; a.ws = (unsigned char*)d_ws;
    a.pro_lo = 0; a.pro_hi = 2; a.l_lo = 0; a.l_hi = mk::DEPTH; a.ph_lo = 0; a.ph_hi = mk::PH_N; a.flags = mk::FL_XIN | mk::FL_FINAL; a.region = 0;
    hipLaunchKernelGGL(mk::fwd, dim3(grid), dim3(mk::NTHR), mk::LDS_BYTES, stream, a);
    const hipError_t le = hipPeekAtLastError();
    if (le != hipSuccess) fprintf(stderr, "kernel_launch: launch failed: %s\n", hipGetErrorName(le));
}
```

```cpp
#include <hip/hip_runtime.h>
#include <cstdio>
#include <cstdint>
#include <cmath>

namespace mk {
#define LAS __attribute__((address_space(3)))
#define GAS __attribute__((address_space(1)))
typedef unsigned short bf16_t;
typedef short bf16x8 __attribute__((ext_vector_type(8)));
typedef float f32x4 __attribute__((ext_vector_type(4)));
typedef float f32x2 __attribute__((ext_vector_type(2)));
typedef float f32x16 __attribute__((ext_vector_type(16)));
typedef unsigned u32x4 __attribute__((ext_vector_type(4)));
typedef unsigned u32x2 __attribute__((ext_vector_type(2)));
constexpr int M = 32768, D = 1024, NB = 4, SEQ = 8192, DEPTH = 4, MEML = 256, MROWS = NB * MEML;
constexpr int S5W = 512, S5G = 32, S5P = 64, RH = 4, RDK = 128, RW = 512, INW = 2560, XH = 4, XD = 256, FF = 2816;
constexpr float EPS = 1e-6f;
constexpr int BM = 256, BK = 64, HALF = 128, HTB = HALF * BK * 2, STAGE_BYTES = 8 * HTB, NXCD = 8, WGM = 8;
constexpr int NWAVES = 8, NTHR = 512;

constexpr int TAB_OFF = STAGE_BYTES;
constexpr int TAB2_OFF = TAB_OFF + 12288;
constexpr int MISC_OFF = TAB2_OFF + 2048;
constexpr int LDS_BYTES = 147456;
static_assert(MISC_OFF + 128 <= LDS_BYTES, "lds map");

constexpr size_t MiB = 1u << 20;
constexpr size_t WS_CTL = 0, CTL_ZERO_BYTES = 1 * MiB;
constexpr size_t WS_SSQ = 1 * MiB;
constexpr size_t WS_SSQS = 3 * MiB;
constexpr size_t WS_W = 4 * MiB, W_LAYER = 28 * MiB;
constexpr size_t W_IN = 0, W_GLU = 5 * MiB, W_OUT = W_GLU + MiB / 2, W_CQ = W_OUT + 2 * MiB, W_CO = W_CQ + 2 * MiB, W_GU = W_CO + 2 * MiB, W_DN = W_GU + 11 * MiB;
static_assert(W_DN + 11 * MiB / 2 == W_LAYER, "weights");
constexpr size_t WS_ROPE = 116 * MiB;
constexpr size_t WS_MEMK = 132 * MiB;
constexpr size_t WS_MEMVT = 140 * MiB;
constexpr size_t WS_S5M = 148 * MiB;
constexpr size_t WS_XB = 176 * MiB;
constexpr size_t WS_PROJ = 240 * MiB;
constexpr size_t WS_UG = WS_PROJ, WS_Q = WS_PROJ + 40 * MiB, WS_K = WS_Q + 32 * MiB, WS_V = WS_K + 32 * MiB, WS_GATE = WS_V + 32 * MiB;
constexpr size_t WS_Z = 408 * MiB;
constexpr size_t WS_YMIX = 440 * MiB;
constexpr size_t WS_SPARE = 504 * MiB;
constexpr size_t WS_QC = WS_PROJ, WS_OC = WS_PROJ + 64 * MiB, WS_HID = WS_PROJ;
constexpr size_t WS_WCK_TMP = WS_PROJ, WS_WCV_TMP = WS_PROJ + 8 * MiB, WS_MEMB = WS_PROJ + 16 * MiB;
constexpr size_t WS_END = 512 * MiB;
constexpr int CW_BAR = 4096, XB_WORDS = 3456, N_BAR_REGIONS = 64;
static_assert((CW_BAR + N_BAR_REGIONS * XB_WORDS) * 4 <= (int)CTL_ZERO_BYTES, "ctl");

__host__ __device__ __forceinline__ int lds_byte(int r, int c) { const int st = (r >> 4) * 2 + (c >> 5), rr = r & 15, cc = c & 31, ob = rr * 64 + cc * 2; return st * 1024 + (ob ^ (((ob >> 9) & 1) << 5)); }
__host__ __device__ __forceinline__ void stage_rc(int b, int& R, int& C) { const int st = b / 1024, sb = b % 1024, swz = sb ^ (((sb >> 9) & 1) << 5); R = (st >> 1) * 16 + swz / 64; C = (st & 1) * 32 + (swz % 64) / 2; }
__host__ __device__ __forceinline__ int perm32(int rho) { const int n = rho >> 4, i = rho & 15; return 8 * (i >> 2) + 4 * n + (i & 3); }

struct Unit { int pm, pn, g; };
struct Gemm { const bf16_t* A; const bf16_t* Bt; int lda, ldb, K; long a_gs, b_gs; int a_g16; int probe_same; };

struct StaticOrder {
    int nM, nN, nwg, G, c;
    __device__ __forceinline__ void init(int nM_, int nN_, int G_, int c_) { nM = nM_; nN = nN_; nwg = nM * nN; G = G_; c = c_; }
    __device__ __forceinline__ bool next(int i, Unit& u) const {
        const long L = (long)i * G + c; if (L >= nwg) return false;
        int wgid = (int)L; { const int q = nwg / NXCD, r = nwg % NXCD, xcd = wgid % NXCD, off = wgid / NXCD; wgid = (xcd < r ? xcd * (q + 1) : r * (q + 1) + (xcd - r) * q) + off; }
        const int nig = WGM * nN, gid = wgid / nig, fm = gid * WGM, gsz = (nM - fm) < WGM ? (nM - fm) : WGM;
        u.pm = fm + ((wgid % nig) % gsz); u.pn = (wgid % nig) / gsz; u.g = 0; return true;
    }
};
struct GroupOrder {
    int nM, nN, nG, G, c, first;
    __device__ __forceinline__ void init(int nG_, int nM_, int nN_, int G_, int c_, int first_) { nG = nG_; nM = nM_; nN = nN_; G = G_; c = c_; first = first_; }
    __device__ __forceinline__ bool next(int i, Unit& u) const {
        const long L = (long)i * G + c - first; if (L < 0 || L >= (long)nG * nM * nN) return false;
        u.pn = (int)(L % nN); const int r = (int)(L / nN); u.pm = r % nM; u.g = r / nM; return true;
    }
};
struct XcdGroupOrder {
    int nM, nN, nG, G, c;
    __device__ __forceinline__ void init(int nG_, int nM_, int nN_, int G_, int c_) { nG = nG_; nM = nM_; nN = nN_; G = G_; c = c_; }
    __device__ __forceinline__ bool next(int i, Unit& u) const {
        const int total = nG * nM * nN; const long L = (long)i * G + c; if (L >= total) return false;
        int id = (int)L; if (((total | G) & (NXCD - 1)) == 0) id = (id & (NXCD - 1)) * (total / NXCD) + (id >> 3);
        u.pn = id % nN; const int r = id / nN; u.pm = r % nM; u.g = r / nM; return true;
    }
};

__device__ __forceinline__ unsigned f2bf(float f) { unsigned u = __builtin_bit_cast(unsigned, f); return (u + 0x7fffu + ((u >> 16) & 1u)) >> 16; }
__device__ __forceinline__ unsigned pk2(float lo, float hi) { return f2bf(lo) | (f2bf(hi) << 16); }
__device__ __forceinline__ unsigned cvt_pk(float lo, float hi) { unsigned r; asm volatile("v_cvt_pk_bf16_f32 %0, %1, %2" : "=v"(r) : "v"(lo), "v"(hi)); return r; }
__device__ __forceinline__ float bf2f(unsigned short b) { return __builtin_bit_cast(float, ((unsigned)b) << 16); }
__device__ __forceinline__ float bflo(unsigned w) { return __builtin_bit_cast(float, w << 16); }
__device__ __forceinline__ float bfhi(unsigned w) { return __builtin_bit_cast(float, w & 0xffff0000u); }
__device__ __forceinline__ float fast_sigmoid(float x) { return __builtin_amdgcn_rcpf(1.0f + __builtin_amdgcn_exp2f(-1.4426950408889634f * x)); }
template <int O> __device__ __forceinline__ float swz_xor(float v) { return __builtin_bit_cast(float, __builtin_amdgcn_ds_swizzle(__builtin_bit_cast(int, v), (O << 10) | 0x1f)); }
__device__ __forceinline__ float row16_sum(float v) { const unsigned u = __builtin_bit_cast(unsigned, v); auto r = __builtin_amdgcn_permlane16_swap(u, u, false, false);
    return __builtin_bit_cast(float, (unsigned)r[0]) + __builtin_bit_cast(float, (unsigned)r[1]); }
__device__ __forceinline__ float half_sum(float v) { const unsigned u = __builtin_bit_cast(unsigned, v); auto r = __builtin_amdgcn_permlane32_swap(u, u, false, false);
    return __builtin_bit_cast(float, (unsigned)r[0]) + __builtin_bit_cast(float, (unsigned)r[1]); }
__device__ __forceinline__ float half_max(float v) { const unsigned u = __builtin_bit_cast(unsigned, v); auto r = __builtin_amdgcn_permlane32_swap(u, u, false, false);
    return fmaxf(__builtin_bit_cast(float, (unsigned)r[0]), __builtin_bit_cast(float, (unsigned)r[1])); }
__device__ __forceinline__ float wave_sum(float v) { v += swz_xor<1>(v); v += swz_xor<2>(v); v += swz_xor<4>(v); v += swz_xor<8>(v); v += swz_xor<16>(v); return half_sum(v); }

__device__ __forceinline__ int lane_id() { unsigned z = 0u; asm volatile("" : "+v"(z)); return (int)__builtin_amdgcn_mbcnt_hi(~0u, __builtin_amdgcn_mbcnt_lo(~0u, z)); }
struct NoPre { __device__ __forceinline__ void operator()(int) const {} };
template <class Epi, class Sched, bool HOOK = false, class Pre = NoPre>
__device__ __forceinline__ void gemm_phase(LAS unsigned char* lds, const Gemm g, const Sched& S, const Epi& E, int wid, const Pre& pre = Pre()) {
    const int lane = lane_id(), tid = wid * 64 + lane, wr = wid >> 2, wc = wid & 3, fr = lane & 15, fq = lane >> 4;
    const int nt = g.K / BK;
    unsigned voffA[2], voffB[2];
#pragma unroll
    for (int i = 0; i < 2; ++i) { int R, C; stage_rc(tid * 16 + i * 8192, R, C); const int Rb = Epi::PERM ? ((R & ~31) + perm32(R & 31)) : R;
        voffA[i] = g.a_g16 ? (unsigned)(((C >> 4) * g.a_g16 + R) * 16 + (C & 15)) * 2u : (unsigned)(R * g.lda + C) * 2u; voffB[i] = (unsigned)(Rb * g.ldb + C) * 2u; }
    const size_t kstep = (size_t)(BK * 2);
    const size_t kstepA = g.a_g16 ? (size_t)g.a_g16 * 128 : kstep;
    const size_t hstepA = g.a_g16 ? (size_t)HALF * 32 : (size_t)HALF * g.lda * 2, hstepB = (size_t)HALF * g.ldb * 2;
    const unsigned ldsw = (unsigned)wid * 1024u;
    const int aoff = lds_byte(wr * 64 + fr, fq * 8), boff = lds_byte(wc * 32 + fr, fq * 8);
#define PG8_SA(b, h) (((b) * 2 + (h)) * HTB)
#define PG8_SB(b, h) ((4 + (b) * 2 + (h)) * HTB)
#define PG8_STAGE(bufoff, gbase, voff) do { _Pragma("unroll") for (int _i = 0; _i < 2; ++_i) \
        __builtin_amdgcn_global_load_lds((const unsigned*)((const char*)(gbase) + (voff)[_i]), (LAS unsigned*)(lds + (bufoff) + ldsw + _i * 8192), 16, 0, 0); } while (0)
#define PG8_LDA(dst, b, h) do { _Pragma("unroll") for (int m = 0; m < 4; ++m) _Pragma("unroll") for (int k = 0; k < 2; ++k) dst[m][k] = *(const LAS bf16x8*)(lds + PG8_SA(b, h) + aoff + m * 2048 + k * 1024); } while (0)
#define PG8_LDB(dst, b, h) do { _Pragma("unroll") for (int n = 0; n < 2; ++n) _Pragma("unroll") for (int k = 0; k < 2; ++k) dst[n][k] = *(const LAS bf16x8*)(lds + PG8_SB(b, h) + boff + n * 2048 + k * 1024); } while (0)
#define PG8_MMA(ai, bj, At, Bt) do { __builtin_amdgcn_s_setprio(1); _Pragma("unroll") for (int m = 0; m < 4; ++m) _Pragma("unroll") for (int n = 0; n < 2; ++n) _Pragma("unroll") for (int k = 0; k < 2; ++k) \
        acc[ai][bj][m][n] = __builtin_amdgcn_mfma_f32_16x16x32_bf16(Bt[n][k], At[m][k], acc[ai][bj][m][n], 0, 0, 0); __builtin_amdgcn_s_setprio(0); } while (0)
#define PG8_WAIT_V(n) asm volatile("s_waitcnt vmcnt(" #n ")" ::: "memory")
#define PG8_WAIT_L(n) asm volatile("s_waitcnt lgkmcnt(" #n ")" ::: "memory")
#define PG8_BAR __builtin_amdgcn_s_barrier()
#define PG8_SCHED __builtin_amdgcn_sched_barrier(0)
#define PG8_ABASE(u) ((const char*)g.A + ((size_t)(u).g * g.a_gs + (size_t)(g.probe_same ? 0 : (u).pm) * BM * (g.a_g16 ? 16 : g.lda)) * 2)
#define PG8_BBASE(u) ((const char*)g.Bt + ((size_t)(u).g * g.b_gs + (size_t)(g.probe_same ? 0 : (u).pn) * BM * g.ldb) * 2)
    Unit cur, nxt; int ui = 0;
    if (!S.next(0, cur)) return;
    f32x4 acc[2][2][4][2];
#pragma unroll
    for (int a = 0; a < 2; ++a)
#pragma unroll
        for (int b = 0; b < 2; ++b)
#pragma unroll
            for (int m = 0; m < 4; ++m)
#pragma unroll
                for (int n = 0; n < 2; ++n) acc[a][b][m][n] = (f32x4){0.f, 0.f, 0.f, 0.f};
    bf16x8 At[4][2], B0[2][2], B1[2][2];
    const char* cA = PG8_ABASE(cur); const char* cB = PG8_BBASE(cur);
    PG8_STAGE(PG8_SB(0, 0), cB, voffB); PG8_STAGE(PG8_SB(0, 1), cB + hstepB, voffB); PG8_STAGE(PG8_SA(0, 0), cA, voffA); PG8_STAGE(PG8_SA(0, 1), cA + hstepA, voffA);
    pre(wid);
    if (wr == 1) PG8_BAR;
    PG8_WAIT_V(2); PG8_BAR;
    PG8_STAGE(PG8_SB(1, 0), cB + kstep, voffB); PG8_STAGE(PG8_SA(1, 0), cA + kstepA, voffA); PG8_STAGE(PG8_SB(1, 1), cB + hstepB + kstep, voffB);
    PG8_WAIT_V(6); PG8_BAR;
    for (;;) {
        const bool has_next = S.next(ui + 1, nxt);
        const char* nA = has_next ? PG8_ABASE(nxt) : cA; const char* nB = has_next ? PG8_BBASE(nxt) : cB;
        for (int t = 0; t < nt; t += 2) {
            const bool last = (t == nt - 2);
            const char* a1 = cA + (size_t)(t + 1) * kstepA;
            const char* a2 = last ? nA : cA + (size_t)(t + 2) * kstepA; const char* b2 = last ? nB : cB + (size_t)(t + 2) * kstep;
            const char* a3 = a2 + kstepA; const char* b3 = b2 + kstep;
            if constexpr (HOOK) { if (t == E.hook_t) E.hook(acc, ui, wr, fr); }
            PG8_LDB(B0, 0, 0); PG8_LDB(B1, 0, 1); PG8_SCHED; PG8_LDA(At, 0, 0); PG8_STAGE(PG8_SA(1, 1), a1 + hstepA, voffA);
            PG8_WAIT_V(8); PG8_WAIT_L(0); PG8_BAR; PG8_MMA(0, 0, At, B0); PG8_MMA(0, 1, At, B1); PG8_BAR; PG8_SCHED;
            PG8_LDA(At, 0, 1); PG8_STAGE(PG8_SB(0, 0), b2, voffB); PG8_STAGE(PG8_SB(0, 1), b2 + hstepB, voffB); PG8_STAGE(PG8_SA(0, 0), a2, voffA);
            PG8_WAIT_V(8); PG8_WAIT_L(0); PG8_BAR; PG8_MMA(1, 0, At, B0); PG8_MMA(1, 1, At, B1); PG8_BAR; PG8_SCHED;
            PG8_LDB(B0, 1, 0); PG8_LDB(B1, 1, 1); PG8_SCHED; PG8_LDA(At, 1, 0); PG8_STAGE(PG8_SA(0, 1), a2 + hstepA, voffA);
            PG8_WAIT_V(8); PG8_WAIT_L(0); PG8_BAR; PG8_MMA(0, 0, At, B0); PG8_MMA(0, 1, At, B1); PG8_BAR; PG8_SCHED;
            PG8_LDA(At, 1, 1); PG8_STAGE(PG8_SB(1, 0), b3, voffB); PG8_STAGE(PG8_SB(1, 1), b3 + hstepB, voffB); PG8_STAGE(PG8_SA(1, 0), a3, voffA);
            PG8_WAIT_V(8); PG8_WAIT_L(0); PG8_BAR; PG8_MMA(1, 0, At, B0); PG8_MMA(1, 1, At, B1); PG8_BAR; PG8_SCHED;
        }
#ifndef NO_ALIGN_EPI
        if (wr == 0) PG8_BAR;
#endif
#if defined(PROBE_DUP) && PROBE_DUP >= 300 && PROBE_DUP < 310
        if (PROBE_DUP == 300 || PROBE_DUP == Epi::PROBE_ID) E.probe(acc, cur, ui, wr, wc, fr, fq);
#endif
        E(acc, cur, ui, wr, wc, fr, fq);
        if (!has_next) break;
#pragma unroll
        for (int a = 0; a < 2; ++a)
#pragma unroll
            for (int b = 0; b < 2; ++b)
#pragma unroll
                for (int m = 0; m < 4; ++m)
#pragma unroll
                    for (int n = 0; n < 2; ++n) acc[a][b][m][n] = (f32x4){0.f, 0.f, 0.f, 0.f};
        cur = nxt; cA = nA; cB = nB; ++ui;
#ifndef NO_ALIGN_EPI
        if (wr == 1) PG8_BAR;
#endif
    }
    PG8_WAIT_V(0);
#ifdef NO_ALIGN_EPI
    if (wr == 0) PG8_BAR;
#endif
    PG8_BAR;
#undef PG8_SA
#undef PG8_SB
#undef PG8_STAGE
#undef PG8_LDA
#undef PG8_LDB
#undef PG8_MMA
#undef PG8_WAIT_V
#undef PG8_WAIT_L
#undef PG8_BAR
#undef PG8_SCHED
#undef PG8_ABASE
#undef PG8_BBASE
}
typedef GAS unsigned gu32;
#define VM_WAIT() asm volatile("s_waitcnt vmcnt(0)" ::: "memory")
#define LDS_WAIT() asm volatile("s_waitcnt lgkmcnt(0)" ::: "memory")
#define XB_TMO      128
#define XB_XCNT(j)  (256  + 64 * (j))
#define XB_XSUB(j)  (1280 + 64 * (j))
#define XB_XGEN(j)  (2304 + 64 * (j))
#define XB_TOP      3328
#define XB_TOPGEN   3392
#define XCD_BAR_WORDS 3456
#define XB_SPIN_CAP (1u << 18)

__device__ __forceinline__ unsigned xb_ld(unsigned* p)              { return __hip_atomic_load(p, __ATOMIC_RELAXED, __HIP_MEMORY_SCOPE_AGENT); }
__device__ __forceinline__ unsigned xb_add(unsigned* p, unsigned v) { return __hip_atomic_fetch_add(p, v, __ATOMIC_RELAXED, __HIP_MEMORY_SCOPE_AGENT); }
__device__ __forceinline__ unsigned xb_xcc_id() { return (unsigned)__builtin_amdgcn_s_getreg((3 << 11) | 20) & 0xFu; }
#define XB_SPIN(cond, bar) do { unsigned _sp = 0; while (cond) { __builtin_amdgcn_s_sleep(1); \
    if ((++_sp & 255u) == 0u) { if (xb_ld(&(bar)[XB_TMO])) break; if (_sp > XB_SPIN_CAP) { atomicAdd(&(bar)[XB_TMO], 1u); break; } } } } while (0)

struct XcdBarrier {
    unsigned* bar; unsigned x;
    bool t0; volatile LAS unsigned* st;
};

__device__ __forceinline__ XcdBarrier xcd_barrier_post(unsigned* bar, volatile LAS unsigned* st, bool t0) {
    XcdBarrier b; b.bar = bar; b.x = xb_xcc_id(); b.st = st; b.t0 = t0;
    if (t0) (void)xb_add(&bar[XB_XCNT(b.x)], 1u);
    return b;
}
__device__ __forceinline__ void xcd_barrier_complete(unsigned* bar, unsigned x, unsigned& nloc, unsigned& nx) {
    const unsigned G = gridDim.x * gridDim.y * gridDim.z;
    unsigned sum, cnt, mine, sp = 0u;
    for (;;) {
        sum = 0u; cnt = 0u; mine = 0u;
#pragma unroll
        for (unsigned j = 0; j < 16; ++j) { const unsigned c = xb_ld(&bar[XB_XCNT(j)]); sum += c; cnt += (c > 0u) ? 1u : 0u; mine = (j == x) ? c : mine; }
        if (sum == G) break;
        __builtin_amdgcn_s_sleep(1);
        if ((++sp & 255u) == 0u) { if (xb_ld(&bar[XB_TMO])) break; if (sp > XB_SPIN_CAP) { atomicAdd(&bar[XB_TMO], 1u); break; } }
    }
    nloc = mine > 0u ? mine : 1u; nx = cnt > 0u ? cnt : 1u;
}

__device__ __forceinline__ void xcd_barrier(const XcdBarrier& b) {
    asm volatile("s_waitcnt vmcnt(0)" ::: "memory");
    __syncthreads();
    if (b.t0) {
        unsigned* bar = b.bar;
        __builtin_amdgcn_s_waitcnt(0);
        unsigned nloc = b.st[0], nx = b.st[1];
        if (nloc == 0u) { xcd_barrier_complete(bar, b.x, nloc, nx); b.st[0] = nloc; b.st[1] = nx; }
        const unsigned old = xb_add(&bar[XB_XSUB(b.x)], 1u);
        const unsigned gen = old / nloc;
        if (old + 1u == (gen + 1u) * nloc) {
            __builtin_amdgcn_fence(__ATOMIC_RELEASE, "agent");
            asm volatile("s_waitcnt vmcnt(0)" ::: "memory");
            const unsigned og = xb_add(&bar[XB_TOP], 1u);
            const unsigned tg = og / nx;
            if (og + 1u == (tg + 1u) * nx) xb_add(&bar[XB_TOPGEN], 1u);
            else XB_SPIN(xb_ld(&bar[XB_TOPGEN]) == tg, bar);
            __builtin_amdgcn_fence(__ATOMIC_ACQUIRE, "agent");
            xb_add(&bar[XB_XGEN(b.x)], 1u);
            asm volatile("s_waitcnt vmcnt(0)" ::: "memory");
        } else {
            XB_SPIN(xb_ld(&bar[XB_XGEN(b.x)]) == gen, bar);
            __builtin_amdgcn_fence(__ATOMIC_ACQUIRE, "agent");
            asm volatile("s_waitcnt vmcnt(0)" ::: "memory");
        }
    }
    __syncthreads();
}
template <int MAPK>
__device__ __forceinline__ void tr_item(const float* W, int K, int N, bf16_t* WT, const float* gain, int gain_lim, float scale, LAS float* scr, int item, int lane) {
    const int nblk = N / 32, kb = item / nblk, nb = item % nblk, k0 = 64 * kb, n0 = 32 * nb;
    float cs = scale;
    if (MAPK == 1) { if (n0 >= 1024 && n0 < 1536) cs *= 0.08838834764831845f; }
    const float* wp = W + (size_t)(k0 + (lane >> 5)) * N + n0 + (lane & 31);
    float w[32];
#pragma unroll
    for (int i = 0; i < 32; ++i) w[i] = wp[(size_t)(2 * i) * N];
    const int c = lane & 7;
    f32x4 g0 = {cs, cs, cs, cs}, g1 = g0;
    if (k0 < gain_lim) { g0 = *(const GAS f32x4*)(gain + k0 + 8 * c) * cs; g1 = *(const GAS f32x4*)(gain + k0 + 8 * c + 4) * cs; }
#pragma unroll
    for (int i = 0; i < 32; ++i) scr[(2 * i + (lane >> 5)) * 33 + (lane & 31)] = w[i];
    LDS_WAIT(); asm volatile("" ::: "memory");
#pragma unroll
    for (int j = 0; j < 4; ++j) { const int nl = (lane >> 3) + 8 * j, n = n0 + nl; const LAS float* s = scr + (8 * c) * 33 + nl;
        int nr = n;
        if (MAPK == 1) { if (n >= 512 && n < 1536) { const int jj = n - 512, blk = jj >> 7, e = jj & 127; nr = 512 + blk * 128 + 2 * (e & 63) + (e >> 6); } }
        if (MAPK == 2) nr = (n >> 7) * 256 + (n & 127);
        if (MAPK == 3) nr = (n >> 7) * 256 + 128 + (n & 127);
        u32x4 o; o.x = pk2(s[0 * 33] * g0.x, s[1 * 33] * g0.y); o.y = pk2(s[2 * 33] * g0.z, s[3 * 33] * g0.w); o.z = pk2(s[4 * 33] * g1.x, s[5 * 33] * g1.y); o.w = pk2(s[6 * 33] * g1.z, s[7 * 33] * g1.w);
        *(GAS u32x4*)(WT + (size_t)nr * K + k0 + 8 * c) = o; }
    LDS_WAIT(); asm volatile("" ::: "memory");
}
struct In {
    const float *x, *mem; const int* pos; const float *norm_mix, *w_in, *lre, *lim, *lstep, *bre, *bim, *cre, *cim, *s5d, *wglu, *bglu, *s5n, *retn, *w_out, *norm_cross, *norm_mem,
        *w_cq, *w_ck, *w_cv, *w_co, *norm_ffn, *w_gate, *w_up, *w_down, *norm_final;
};
__device__ __forceinline__ bf16_t* wl(unsigned char* ws, int l, size_t off) { return (bf16_t*)(ws + WS_W + (size_t)l * W_LAYER + off); }

__device__ __forceinline__ void pro_weights(const In& in, unsigned char* ws, LAS unsigned char* lds, int gw, int NGW, int wave, int lane) {
    LAS float* scr = (LAS float*)(lds + wave * 16384);
    constexpr int I_IN = 16 * 80, I_GLU = 8 * 16, I_SQ = 16 * 32, I_GU = 16 * 88, I_DN = 44 * 32;
    constexpr int PER_L = I_IN + I_GLU + 5 * I_SQ + 2 * I_GU + I_DN;
    static_assert(PER_L == 8192, "items");
    for (int it = gw; it < DEPTH * PER_L; it += NGW) {
        const int l = it / PER_L; int r = it % PER_L;
        if (r < I_IN) { tr_item<1>(in.w_in + (size_t)l * D * INW, D, INW, wl(ws, l, W_IN), in.norm_mix + l * D, D, 1.0f, scr, r, lane); continue; } r -= I_IN;
        if (r < I_GLU) { tr_item<0>(in.wglu + (size_t)l * S5W * S5W, S5W, S5W, wl(ws, l, W_GLU), nullptr, 0, 1.0f, scr, r, lane); continue; } r -= I_GLU;
        if (r < I_SQ) { tr_item<0>(in.w_out + (size_t)l * D * D, D, D, wl(ws, l, W_OUT), in.s5n + l * S5W, S5W, 1.0f, scr, r, lane); continue; } r -= I_SQ;
        if (r < I_SQ) { tr_item<0>(in.w_cq + (size_t)l * D * D, D, D, wl(ws, l, W_CQ), in.norm_cross + l * D, D, 0.0625f * 1.4426950408889634f, scr, r, lane); continue; } r -= I_SQ;
        if (r < I_SQ) { tr_item<0>(in.w_co + (size_t)l * D * D, D, D, wl(ws, l, W_CO), nullptr, 0, 1.0f, scr, r, lane); continue; } r -= I_SQ;
        if (r < I_SQ) { tr_item<0>(in.w_ck + (size_t)l * D * D, D, D, (bf16_t*)(ws + WS_WCK_TMP) + (size_t)l * D * D, in.norm_mem + l * D, D, 1.0f, scr, r, lane); continue; } r -= I_SQ;
        if (r < I_SQ) { tr_item<0>(in.w_cv + (size_t)l * D * D, D, D, (bf16_t*)(ws + WS_WCV_TMP) + (size_t)l * D * D, in.norm_mem + l * D, D, 1.0f, scr, r, lane); continue; } r -= I_SQ;
        if (r < I_GU) { tr_item<2>(in.w_gate + (size_t)l * D * FF, D, FF, wl(ws, l, W_GU), in.norm_ffn + l * D, D, 1.0f, scr, r, lane); continue; } r -= I_GU;
        if (r < I_GU) { tr_item<3>(in.w_up + (size_t)l * D * FF, D, FF, wl(ws, l, W_GU), in.norm_ffn + l * D, D, 1.0f, scr, r, lane); continue; } r -= I_GU;
        tr_item<0>(in.w_down + (size_t)l * FF * D, FF, D, wl(ws, l, W_DN), nullptr, 0, 1.0f, scr, r, lane);
    }
}
__device__ __forceinline__ void xprep_rows(const float* src, bf16_t* xb, float* ssq, int gw, int NGW, int lane) {
    for (int m = gw; m < M; m += NGW) {
        const GAS f32x4* xr = (const GAS f32x4*)(src + (size_t)m * D) + lane;
        f32x4 v[4]; float s = 0.f;
#pragma unroll
        for (int j = 0; j < 4; ++j) { v[j] = xr[64 * j]; s += (v[j].x * v[j].x + v[j].y * v[j].y) + (v[j].z * v[j].z + v[j].w * v[j].w); }
        const float tot = wave_sum(s);
        GAS u32x2* o8 = (GAS u32x2*)(xb + (size_t)m * D) + lane;
#pragma unroll
        for (int j = 0; j < 4; ++j) { u32x2 w; w.x = pk2(v[j].x, v[j].y); w.y = pk2(v[j].z, v[j].w); o8[64 * j] = w; }
        if (lane < 16) ssq[(size_t)m * 16 + lane] = (lane == 0) ? tot : 0.f;
    }
}
__device__ __forceinline__ void final_norm_rows(const bf16_t* xb, float* out, const float* g, int gw, int NGW, int lane) {
    f32x4 gv[4];
#pragma unroll
    for (int j = 0; j < 4; ++j) gv[j] = ((const GAS f32x4*)g)[lane + 64 * j];
    for (int m = gw; m < M; m += NGW) {
        const GAS u32x2* xr = (const GAS u32x2*)(xb + (size_t)m * D) + lane;
        f32x4 v[4]; float s = 0.f;
#pragma unroll
        for (int j = 0; j < 4; ++j) { const u32x2 w = xr[64 * j]; v[j] = (f32x4){bflo(w.x), bfhi(w.x), bflo(w.y), bfhi(w.y)}; s += (v[j].x * v[j].x + v[j].y * v[j].y) + (v[j].z * v[j].z + v[j].w * v[j].w); }
        const float r = 1.0f / sqrtf(wave_sum(s) * (1.0f / D) + EPS);
        GAS f32x4* o = (GAS f32x4*)(out + (size_t)m * D) + lane;
#pragma unroll
        for (int j = 0; j < 4; ++j) o[64 * j] = v[j] * r * gv[j];
    }
}
template <class Sched>
struct RstdPre {
    LAS float* tab; const Sched* S; const float* ssq; int nslots; float inv_n;
    __device__ __forceinline__ void operator()(int wave) const {
        if (wave < 4) { Unit u; const int t = wave * 64 + lane_id(); int prev_pm = -1;
            for (int i = 0; S->next(i, u); ++i) {
                if (u.pm == prev_pm) tab[i * 256 + t] = tab[(i - 1) * 256 + t];
                else { const float* p = ssq + (size_t)(u.pm * 256 + t) * nslots; float s = 0.f;
                    for (int j = 0; j < nslots; j += 4) { const f32x4 v = *(const GAS f32x4*)(p + j); s += (v.x + v.y) + (v.z + v.w); }
                    tab[i * 256 + t] = 1.0f / sqrtf(s * inv_n + EPS); }
                prev_pm = u.pm; } }
    }
};

struct EpiFfn1 {
    static constexpr int PROBE_ID = 302; static constexpr bool PERM = true;
    bf16_t* H; LAS const float* tab;
    __device__ __forceinline__ void probe(const f32x4 (&acc)[2][2][4][2], const Unit& u, int ui, int wr, int wc, int fr, int fq) const { (*this)(acc, u, ui, wr, wc, fr, fq); }
    __device__ __forceinline__ void operator()(const f32x4 (&acc)[2][2][4][2], const Unit& u, int ui, int wr, int wc, int fr, int fq) const {
        asm volatile("" : "+v"(fr), "+v"(fq));
#pragma unroll
        for (int ai = 0; ai < 2; ++ai)
#pragma unroll
            for (int m = 0; m < 4; ++m) { const int rl = ai * HALF + wr * 64 + m * 16 + fr; const float rs = tab[ui * 256 + rl], k1 = -1.4426950408889634f * rs, rs2 = rs * rs;
                float h[8];
#pragma unroll
                for (int n = 0; n < 2; ++n)
#pragma unroll
                    for (int j = 0; j < 4; ++j) { const float ag = acc[ai][0][m][n][j], au = acc[ai][1][m][n][j]; h[4 * n + j] = (ag * au) * (rs2 * __builtin_amdgcn_rcpf(1.0f + __builtin_amdgcn_exp2f(ag * k1))); }
                u32x4 w; w.x = cvt_pk(h[0], h[1]); w.y = cvt_pk(h[2], h[3]); w.z = cvt_pk(h[4], h[5]); w.w = cvt_pk(h[6], h[7]);
                *(GAS u32x4*)(H + (size_t)(u.pm * BM + rl) * FF + u.pn * 128 + wc * 32 + 8 * fq) = w; }
    }
};
struct EpiRes {
    static constexpr int PROBE_ID = 307; static constexpr bool PERM = true;
    bf16_t* xb; float* ssq; float* fout; float scale; LAS float* sst;
    __device__ __forceinline__ void probe(const f32x4 (&acc)[2][2][4][2], const Unit& u, int ui, int wr, int wc, int fr, int fq) const { EpiRes t = *this; t.scale = 0.f; t(acc, u, ui, wr, wc, fr, fq); }
    __device__ __forceinline__ void operator()(const f32x4 (&acc)[2][2][4][2], const Unit& u, int ui, int wr, int wc, int fr, int fq) const {
        asm volatile("" : "+v"(fr), "+v"(fq));
        u32x4 xv[4][2][2];
#define ER_LOAD(b) do { _Pragma("unroll") for (int mm = 0; mm < 2; ++mm) _Pragma("unroll") for (int bj = 0; bj < 2; ++bj) \
            xv[b][mm][bj] = *(const GAS u32x4*)(xb + (size_t)(u.pm * BM + ((b) >> 1) * HALF + wr * 64 + (2 * ((b) & 1) + mm) * 16 + fr) * D + u.pn * BM + bj * HALF + wc * 32 + 8 * fq); } while (0)
#define ER_COMP(b) do { const int ai = (b) >> 1; _Pragma("unroll") for (int mm = 0; mm < 2; ++mm) { const int m = 2 * ((b) & 1) + mm; const int row = u.pm * BM + ai * HALF + wr * 64 + m * 16 + fr; float ps = 0.f; \
            _Pragma("unroll") for (int bj = 0; bj < 2; ++bj) { const size_t off = (size_t)row * D + u.pn * BM + bj * HALF + wc * 32 + 8 * fq; const u32x4 xw = xv[b][mm][bj]; f32x4 v0, v1; \
                v0.x = bflo(xw.x) + acc[ai][bj][m][0].x * scale; v0.y = bfhi(xw.x) + acc[ai][bj][m][0].y * scale; v0.z = bflo(xw.y) + acc[ai][bj][m][0].z * scale; v0.w = bfhi(xw.y) + acc[ai][bj][m][0].w * scale; \
                v1.x = bflo(xw.z) + acc[ai][bj][m][1].x * scale; v1.y = bfhi(xw.z) + acc[ai][bj][m][1].y * scale; v1.z = bflo(xw.w) + acc[ai][bj][m][1].z * scale; v1.w = bfhi(xw.w) + acc[ai][bj][m][1].w * scale; \
                if (fout) { *(GAS f32x4*)(fout + off) = v0; *(GAS f32x4*)(fout + off + 4) = v1; } \
                u32x4 w; w.x = cvt_pk(v0.x, v0.y); w.y = cvt_pk(v0.z, v0.w); w.z = cvt_pk(v1.x, v1.y); w.w = cvt_pk(v1.z, v1.w); \
                *(GAS u32x4*)(xb + off) = w; \
                ps += (v0.x * v0.x + v0.y * v0.y) + (v0.z * v0.z + v0.w * v0.w) + (v1.x * v1.x + v1.y * v1.y) + (v1.z * v1.z + v1.w * v1.w); } \
            ps = row16_sum(ps); ps = half_sum(ps); \
            if (fq == 0) sst[(ai * HALF + wr * 64 + m * 16 + fr) * 4 + wc] = ps; } } while (0)
        ER_LOAD(0); ER_LOAD(1); asm volatile("" ::: "memory");
        ER_COMP(0); ER_LOAD(2); asm volatile("" ::: "memory");
        ER_COMP(1); ER_LOAD(3); asm volatile("" ::: "memory");
        ER_COMP(2); asm volatile("" ::: "memory");
        ER_COMP(3);
#undef ER_LOAD
#undef ER_COMP
        asm volatile("s_waitcnt lgkmcnt(0)" ::: "memory"); __builtin_amdgcn_s_barrier(); asm volatile("" ::: "memory");
        { const int t = (wr * 4 + wc) * 64 + fq * 16 + fr; if (t < 256) *(GAS f32x4*)(ssq + (size_t)(u.pm * BM + t) * 16 + u.pn * 4) = *(LAS const f32x4*)(sst + t * 4); }
    }
};
struct EpiScaleBf16 {
    static constexpr int PROBE_ID = 303; static constexpr bool PERM = true;
    bf16_t* O; int ldo; LAS const float* tab;
    __device__ __forceinline__ void probe(const f32x4 (&acc)[2][2][4][2], const Unit& u, int ui, int wr, int wc, int fr, int fq) const { (*this)(acc, u, ui, wr, wc, fr, fq); }
    __device__ __forceinline__ void operator()(const f32x4 (&acc)[2][2][4][2], const Unit& u, int ui, int wr, int wc, int fr, int fq) const {
        asm volatile("" : "+v"(fr), "+v"(fq));
#pragma unroll
        for (int ai = 0; ai < 2; ++ai)
#pragma unroll
            for (int m = 0; m < 4; ++m) { const int rl = ai * HALF + wr * 64 + m * 16 + fr; const float rs = tab[ui * 256 + rl];
#pragma unroll
                for (int bj = 0; bj < 2; ++bj) { const f32x4 v0 = acc[ai][bj][m][0] * rs, v1 = acc[ai][bj][m][1] * rs;
                    u32x4 w; w.x = cvt_pk(v0.x, v0.y); w.y = cvt_pk(v0.z, v0.w); w.z = cvt_pk(v1.x, v1.y); w.w = cvt_pk(v1.z, v1.w);
                    *(GAS u32x4*)(O + (size_t)(u.pm * BM + rl) * ldo + u.pn * BM + bj * HALF + wc * 32 + 8 * fq) = w; } }
    }
};
struct EpiMemK {
    static constexpr int PROBE_ID = 309; static constexpr bool PERM = true;
    bf16_t* O; const float* rsm;
    __device__ __forceinline__ void probe(const f32x4 (&acc)[2][2][4][2], const Unit& u, int ui, int wr, int wc, int fr, int fq) const { (*this)(acc, u, ui, wr, wc, fr, fq); }
    __device__ __forceinline__ void operator()(const f32x4 (&acc)[2][2][4][2], const Unit& u, int ui, int wr, int wc, int fr, int fq) const {
        asm volatile("" : "+v"(fr), "+v"(fq));
#pragma unroll
        for (int ai = 0; ai < 2; ++ai)
#pragma unroll
            for (int m = 0; m < 4; ++m) { const int row = u.pm * BM + ai * HALF + wr * 64 + m * 16 + fr; const float rs = rsm[row];
#pragma unroll
                for (int bj = 0; bj < 2; ++bj) { const f32x4 v0 = acc[ai][bj][m][0] * rs, v1 = acc[ai][bj][m][1] * rs;
                    u32x4 w; w.x = cvt_pk(v0.x, v0.y); w.y = cvt_pk(v0.z, v0.w); w.z = cvt_pk(v1.x, v1.y); w.w = cvt_pk(v1.z, v1.w);
                    *(GAS u32x4*)(O + ((size_t)u.g * MROWS + row) * D + u.pn * BM + bj * HALF + wc * 32 + 8 * fq) = w; } }
    }
};
struct EpiMemVT {
    static constexpr int PROBE_ID = 309; static constexpr bool PERM = true;
    bf16_t* O; const float* rsm;
    __device__ __forceinline__ void probe(const f32x4 (&acc)[2][2][4][2], const Unit& u, int ui, int wr, int wc, int fr, int fq) const { (*this)(acc, u, ui, wr, wc, fr, fq); }
    __device__ __forceinline__ void operator()(const f32x4 (&acc)[2][2][4][2], const Unit& u, int ui, int wr, int wc, int fr, int fq) const {
        asm volatile("" : "+v"(fr), "+v"(fq));
#pragma unroll
        for (int bj = 0; bj < 2; ++bj) { const int c0 = u.pn * BM + bj * HALF + wc * 32 + 8 * fq;
            const f32x4 r0 = *(const GAS f32x4*)(rsm + c0), r1 = *(const GAS f32x4*)(rsm + c0 + 4);
            const int p0 = (c0 & ~15) + 4 * ((c0 >> 3) & 1), p1 = p0 + 8;
#pragma unroll
            for (int ai = 0; ai < 2; ++ai)
#pragma unroll
                for (int m = 0; m < 4; ++m) { const int row = u.pm * BM + ai * HALF + wr * 64 + m * 16 + fr;
                    const f32x4 v0 = acc[ai][bj][m][0] * r0, v1 = acc[ai][bj][m][1] * r1;
                    bf16_t* o = O + ((size_t)u.g * D + row) * MROWS;
                    u32x2 w0, w1; w0.x = cvt_pk(v0.x, v0.y); w0.y = cvt_pk(v0.z, v0.w); w1.x = cvt_pk(v1.x, v1.y); w1.y = cvt_pk(v1.z, v1.w);
                    *(GAS u32x2*)(o + p0) = w0; *(GAS u32x2*)(o + p1) = w1; } }
    }
};

__device__ __forceinline__ void xa_fill(LAS unsigned char* lds, const bf16_t* src  , int wave, int lane) {
#pragma unroll 1
    for (int j = 0; j < 16; ++j) { const int p = wave * 16 + j, row = 2 * p + (lane >> 5), ch = (lane & 31) ^ (row & 15);
        __builtin_amdgcn_global_load_lds((const unsigned*)((const char*)src + (size_t)row * 2048 + ch * 16), (LAS unsigned*)(lds + p * 1024), 16, 0, 0); }
}
__device__ __forceinline__ void xa_mma(f32x16 (&acc)[8], const bf16x8 (&bf)[16], LAS const unsigned char* lds, int r, int hh) {
    const int a = (r >> 1) & 7, b = hh ^ (r & 1); LAS const unsigned char* base = lds + r * 512 + b * 16;
#pragma unroll
    for (int s = 0; s < 16; ++s) { const int cp = ((s & 8) | ((s & 7) ^ a)) << 5;
        LAS const unsigned char* p0 = base + cp; LAS const unsigned char* p1 = p0 + 65536;
#pragma unroll
        for (int blk = 0; blk < 8; ++blk) {
            const bf16x8 av = (blk < 4) ? *(LAS const bf16x8*)(p0 + blk * 16384) : *(LAS const bf16x8*)(p1 + (blk - 4) * 16384);
            acc[blk] = __builtin_amdgcn_mfma_f32_32x32x16_bf16(av, bf[s], acc[blk], 0, 0, 0); }
#pragma unroll
        for (int blk = 0; blk < 8; ++blk) asm volatile("" : "+v"(acc[blk]));
    }
}
__device__ __forceinline__ void xa_mma_q(f32x16 (&acc)[8], const GAS bf16x8* qp, LAS const unsigned char* lds, int r, int hh) {
    const int a = (r >> 1) & 7, b = hh ^ (r & 1); LAS const unsigned char* base = lds + r * 512 + b * 16;
    bf16x8 q3[3];
#pragma unroll
    for (int s = 0; s < 3; ++s) q3[s] = qp[2 * s];
#pragma unroll
    for (int s = 0; s < 16; ++s) { const int cp = ((s & 8) | ((s & 7) ^ a)) << 5;
        LAS const unsigned char* p0 = base + cp; LAS const unsigned char* p1 = p0 + 65536;
        const bf16x8 bq = q3[s % 3];
        if (s + 3 < 16) q3[s % 3] = qp[2 * (s + 3)];
#pragma unroll
        for (int blk = 0; blk < 8; ++blk) {
            const bf16x8 av = (blk < 4) ? *(LAS const bf16x8*)(p0 + blk * 16384) : *(LAS const bf16x8*)(p1 + (blk - 4) * 16384);
            acc[blk] = __builtin_amdgcn_mfma_f32_32x32x16_bf16(av, bq, acc[blk], 0, 0, 0); }
#pragma unroll
        for (int blk = 0; blk < 8; ++blk) asm volatile("" : "+v"(acc[blk]));
    }
}
__device__ __forceinline__ void xattn_unit(LAS unsigned char* lds, const bf16_t* QC, const bf16_t* Kl, const bf16_t* VTl, bf16_t* OC, int b, int h, int qt, int wave) {
    {
        const size_t qrow0 = (size_t)b * SEQ + qt * 256 + wave * 32;
        bf16x8 bq[16];
        { const int lane = lane_id(), r = lane & 31, hh = lane >> 5; const GAS bf16x8* qp = (const GAS bf16x8*)(QC + (qrow0 + r) * D + h * XD + 8 * hh);
#pragma unroll
          for (int s = 0; s < 16; ++s) bq[s] = qp[2 * s]; }
        xa_fill(lds, Kl + (size_t)b * MEML * D + h * XD, wave, lane_id());
        VM_WAIT(); __syncthreads();
#if defined(PROBE_DUP) && PROBE_DUP == 71
        xa_fill(lds, Kl + (size_t)b * MEML * D + h * XD, wave, lane_id());
        VM_WAIT(); __syncthreads();
#endif
        f32x16 acc[8];
#pragma unroll
        for (int k = 0; k < 8; ++k)
#pragma unroll
            for (int j = 0; j < 16; ++j) acc[k][j] = 0.f;
        { const int lane = lane_id(); xa_mma(acc, bq, lds, lane & 31, lane >> 5); }
        __syncthreads();
        xa_fill(lds, VTl + (size_t)h * XD * MROWS + b * MEML, wave, lane_id());
        float mx = acc[0][0];
#pragma unroll
        for (int k = 0; k < 8; ++k)
#pragma unroll
            for (int j = 0; j < 16; ++j) mx = fmaxf(mx, acc[k][j]);
        mx = half_max(mx);
        float sum = 0.f;
#pragma unroll
        for (int k = 0; k < 8; ++k)
#pragma unroll
            for (int j = 0; j < 16; ++j) { const float p = __builtin_amdgcn_exp2f(acc[k][j] - mx); acc[k][j] = p; sum += p; }
        sum = half_sum(sum);
        const float inv = 1.0f / sum;
        bf16x8 bp[16];
#pragma unroll
        for (int k = 0; k < 8; ++k)
#pragma unroll
            for (int s = 0; s < 2; ++s) { u32x4 w; w.x = cvt_pk(acc[k][8 * s + 0], acc[k][8 * s + 1]); w.y = cvt_pk(acc[k][8 * s + 2], acc[k][8 * s + 3]);
                w.z = cvt_pk(acc[k][8 * s + 4], acc[k][8 * s + 5]); w.w = cvt_pk(acc[k][8 * s + 6], acc[k][8 * s + 7]); bp[2 * k + s] = __builtin_bit_cast(bf16x8, w); }
#pragma unroll
        for (int k = 0; k < 8; ++k)
#pragma unroll
            for (int j = 0; j < 16; ++j) acc[k][j] = 0.f;
        VM_WAIT(); __syncthreads();
        { const int lane = lane_id(); xa_mma(acc, bp, lds, lane & 31, lane >> 5); }
        __syncthreads();
        { const int lane = lane_id(), r = lane & 31, hh = lane >> 5; LAS unsigned char* wb = lds + wave * 16384;
#pragma unroll
          for (int k = 0; k < 8; ++k)
#pragma unroll
            for (int g4 = 0; g4 < 4; ++g4) { u32x2 w; w.x = cvt_pk(acc[k][4 * g4] * inv, acc[k][4 * g4 + 1] * inv); w.y = cvt_pk(acc[k][4 * g4 + 2] * inv, acc[k][4 * g4 + 3] * inv);
                *(LAS u32x2*)(wb + r * 512 + (((4 * k + g4) ^ r) << 4) + 8 * hh) = w; }
          asm volatile("s_waitcnt lgkmcnt(0)" ::: "memory");
#if defined(PROBE_DUP) && PROBE_DUP == 72
          for (int rp = 0; rp < 2; ++rp)
#endif
#pragma unroll
          for (int j = 0; j < 16; ++j) { const int row = 2 * j + hh, cp = lane & 31; const u32x4 v = *(LAS const u32x4*)(wb + row * 512 + cp * 16);
              *(GAS u32x4*)(OC + (qrow0 + row) * D + h * XD + 8 * (cp ^ row)) = v; }
          asm volatile("s_waitcnt lgkmcnt(0)" ::: "memory"); }
    }
}
__device__ __forceinline__ void mem_prep_rows(const float* mem, bf16_t* memb, float* rsm, int gw, int NGW, int lane) {
    for (int m = gw; m < MROWS; m += NGW) {
        const GAS f32x4* xr = (const GAS f32x4*)(mem + (size_t)m * D) + lane;
        f32x4 v[4]; float s = 0.f;
#pragma unroll
        for (int j = 0; j < 4; ++j) { v[j] = xr[64 * j]; s += (v[j].x * v[j].x + v[j].y * v[j].y) + (v[j].z * v[j].z + v[j].w * v[j].w); }
        const float tot = wave_sum(s);
        GAS u32x2* o8 = (GAS u32x2*)(memb + (size_t)m * D) + lane;
#pragma unroll
        for (int j = 0; j < 4; ++j) { u32x2 w; w.x = pk2(v[j].x, v[j].y); w.y = pk2(v[j].z, v[j].w); o8[64 * j] = w; }
        if (lane == 0) rsm[m] = 1.0f / sqrtf(tot * (1.0f / D) + EPS);
    }
}

__device__ __forceinline__ float ret_lg2(int h) { return h == 0 ? -0.04580368961312479f : h == 1 ? -0.02272007650008353f : h == 2 ? -0.011315313227834146f : -0.005646563141142063f; }
struct EpiProj {
    static constexpr int PROBE_ID = 301; static constexpr bool PERM = true;
    bf16_t *UG, *Q, *K, *V, *GT; const float* rope; LAS const float* tab;
    __device__ __forceinline__ void probe(const f32x4 (&acc)[2][2][4][2], const Unit& u, int ui, int wr, int wc, int fr, int fq) const { (*this)(acc, u, ui, wr, wc, fr, fq); }
    __device__ __forceinline__ void operator()(const f32x4 (&acc)[2][2][4][2], const Unit& u, int ui, int wr, int wc, int fr, int fq) const {
        asm volatile("" : "+v"(fr), "+v"(fq));
        const int kind = u.pn >> 1;
        if (kind == 1 || kind == 2) {
            f32x4 cs[2][4][2];
#pragma unroll
            for (int ai = 0; ai < 2; ++ai)
#pragma unroll
                for (int m = 0; m < 4; ++m) { const int row = u.pm * BM + ai * HALF + wr * 64 + m * 16 + fr;
                    const GAS f32x4* rp = (const GAS f32x4*)(rope + ((size_t)row * 64 + ((wc * 32 + 8 * fq) >> 1)) * 2); cs[ai][m][0] = rp[0]; cs[ai][m][1] = rp[1]; }
#pragma unroll
            for (int ai = 0; ai < 2; ++ai) {
#pragma unroll
                for (int m = 0; m < 4; ++m) { const int rl = ai * HALF + wr * 64 + m * 16 + fr, row = u.pm * BM + rl; const float rs = tab[ui * 256 + rl];
#pragma unroll
                    for (int bj = 0; bj < 2; ++bj) { const f32x4 v0 = acc[ai][bj][m][0] * rs, v1 = acc[ai][bj][m][1] * rs, c0 = cs[ai][m][0], c1 = cs[ai][m][1];
                        const int cw = (u.pn & 1) * 256 + bj * HALF + wc * 32 + 8 * fq, hd = cw >> 7;
                        const float e = (float)(row & 127) * ret_lg2(hd), sc = __builtin_amdgcn_exp2f(kind == 1 ? e : -e);
                        f32x4 o0, o1;
                        o0.x = (v0.x * c0.x - v0.y * c0.y) * sc; o0.y = (v0.y * c0.x + v0.x * c0.y) * sc; o0.z = (v0.z * c0.z - v0.w * c0.w) * sc; o0.w = (v0.w * c0.z + v0.z * c0.w) * sc;
                        o1.x = (v1.x * c1.x - v1.y * c1.y) * sc; o1.y = (v1.y * c1.x + v1.x * c1.y) * sc; o1.z = (v1.z * c1.z - v1.w * c1.w) * sc; o1.w = (v1.w * c1.z + v1.z * c1.w) * sc;
                        u32x4 w; w.x = cvt_pk(o0.x, o0.y); w.y = cvt_pk(o0.z, o0.w); w.z = cvt_pk(o1.x, o1.y); w.w = cvt_pk(o1.z, o1.w);
                        *(GAS u32x4*)((kind == 1 ? Q : K) + (size_t)row * RW + cw) = w; } } }
        } else {
#pragma unroll
            for (int ai = 0; ai < 2; ++ai)
#pragma unroll
                for (int m = 0; m < 4; ++m) { const int rl = ai * HALF + wr * 64 + m * 16 + fr, row = u.pm * BM + rl; const float rs = tab[ui * 256 + rl];
#pragma unroll
                    for (int bj = 0; bj < 2; ++bj) { const f32x4 v0 = acc[ai][bj][m][0] * rs, v1 = acc[ai][bj][m][1] * rs;
                        const int cw = (u.pn & 1) * 256 + bj * HALF + wc * 32 + 8 * fq;
                        bf16_t* dst = (kind == 0) ? UG + ((size_t)(cw >> 4) * (M / 32) + (row >> 5)) * 640 + (row & 31) * 16 + ((cw >> 3) & 1) * 8 : (kind == 3 ? V : GT) + (size_t)row * RW + cw;
                        u32x4 w; w.x = cvt_pk(v0.x, v0.y); w.y = cvt_pk(v0.z, v0.w); w.z = cvt_pk(v1.x, v1.y); w.w = cvt_pk(v1.z, v1.w);
                        *(GAS u32x4*)dst = w; } }
        }
    }
};
struct EpiGlu {
    static constexpr int PROBE_ID = 304; static constexpr bool PERM = true;
    const bf16_t* Z; const float* bias; bf16_t* Y; float* ssqs;
    __device__ __forceinline__ void probe(const f32x4 (&acc)[2][2][4][2], const Unit& u, int ui, int wr, int wc, int fr, int fq) const { (*this)(acc, u, ui, wr, wc, fr, fq); }
    __device__ __forceinline__ void operator()(const f32x4 (&acc)[2][2][4][2], const Unit& u, int ui, int wr, int wc, int fr, int fq) const {
        asm volatile("" : "+v"(fr), "+v"(fq));
#pragma unroll
        for (int ai = 0; ai < 2; ++ai)
#pragma unroll
            for (int m = 0; m < 4; ++m) { const int row = u.pm * BM + ai * HALF + wr * 64 + m * 16 + fr; float ps = 0.f;
#pragma unroll
                for (int bj = 0; bj < 2; ++bj) { const int col = u.pn * BM + bj * HALF + wc * 32 + 8 * fq;
                    const u32x4 zw = *(const GAS u32x4*)(Z + ((size_t)(col >> 4) * M + row) * 16 + (col & 15));
                    const f32x4 b0 = *(const GAS f32x4*)(bias + col), b1 = *(const GAS f32x4*)(bias + col + 4);
                    const f32x4 t0 = acc[ai][bj][m][0] + b0, t1 = acc[ai][bj][m][1] + b1;
                    float o[8];
                    o[0] = bflo(zw.x) * fast_sigmoid(t0.x); o[1] = bfhi(zw.x) * fast_sigmoid(t0.y); o[2] = bflo(zw.y) * fast_sigmoid(t0.z); o[3] = bfhi(zw.y) * fast_sigmoid(t0.w);
                    o[4] = bflo(zw.z) * fast_sigmoid(t1.x); o[5] = bfhi(zw.z) * fast_sigmoid(t1.y); o[6] = bflo(zw.w) * fast_sigmoid(t1.z); o[7] = bfhi(zw.w) * fast_sigmoid(t1.w);
#pragma unroll
                    for (int j = 0; j < 8; ++j) ps += o[j] * o[j];
                    u32x4 w; w.x = cvt_pk(o[0], o[1]); w.y = cvt_pk(o[2], o[3]); w.z = cvt_pk(o[4], o[5]); w.w = cvt_pk(o[6], o[7]);
                    *(GAS u32x4*)(Y + (size_t)row * D + col) = w; }
                ps = row16_sum(ps); ps = half_sum(ps);
                if (fq == 0) ssqs[(size_t)row * 8 + u.pn * 4 + wc] = ps;
                asm volatile("" ::: "memory"); }
    }
};
struct EpiResHook : EpiRes {
    LAS const float* tab2; int hook_t;
    __device__ __forceinline__ void hook(f32x4 (&acc)[2][2][4][2], int ui, int wr, int fr) const {
#pragma unroll
        for (int ai = 0; ai < 2; ++ai)
#pragma unroll
            for (int m = 0; m < 4; ++m) { const float rs = tab2[ui * 256 + ai * HALF + wr * 64 + m * 16 + fr];
#pragma unroll
                for (int bj = 0; bj < 2; ++bj)
#pragma unroll
                    for (int n = 0; n < 2; ++n) acc[ai][bj][m][n] *= rs; }
    }
};
__device__ __forceinline__ void rope_table(const int* pos, float* rope, int gtid, int nthr) {
    for (int idx = gtid; idx < M * 64; idx += nthr) { const int i = idx & 63, row = idx >> 6;
        const float inv = (float)(1.0 / pow(10000.0, (double)i / 64.0)); const float ang = (float)pos[row] * inv;
        f32x2 cs; cs.x = (float)cos((double)ang); cs.y = (float)sin((double)ang);
        *(GAS f32x2*)(rope + (size_t)idx * 2) = cs; }
}

constexpr size_t SP_RSM = 0, SP_KTAB = 64 * 1024, SP_APOW = SP_KTAB + 4 * MiB, SP_BBAR = 6 * MiB + 256 * 1024;
constexpr size_t APOW_LG = 33 * 64 * 2, KTAB_LG = 32 * 256, BBAR_LG = 64 * 16 * 2;
static_assert(SP_APOW + (size_t)DEPTH * S5G * APOW_LG * 4 <= SP_BBAR && SP_BBAR + (size_t)DEPTH * S5G * BBAR_LG * 4 <= 8 * MiB, "spare map");
constexpr size_t S5M_T = 0, S5M_WEND = 20 * MiB;
constexpr size_t WS_SEND = WS_Z, WS_KVRUN = WS_Z + 16 * MiB;
constexpr size_t WS_RSTART = WS_S5M;
constexpr size_t S5M_LAYER = 28 * MiB;
__device__ __forceinline__ void s5_tables_item(const In& in, unsigned char* ws, LAS unsigned char* lds, int item, int wave, int lane) {
    const int l = item >> 7, g = (item >> 2) & 31, tq = item & 3, p = lane;
    LAS float* Br = (LAS float*)lds; LAS float* Bi = Br + 1024; LAS float* Cr = Bi + 1024; LAS float* Ci = Cr + 1024;
    LAS float* CAr = Ci + 1024 + wave * 2048; LAS float* CAi = CAr + 1024;
    float* sp = (float*)(ws + WS_SPARE);
    const int lg = l * S5G + g;
    const double lr = (double)in.lre[lg * 64 + p], li = (double)in.lim[lg * 64 + p], step = (double)expf(in.lstep[lg]);
    if (wave == 0) {
        const double mag = exp(lr * step), ar = mag * cos(li * step), ai = mag * sin(li * step), den = lr * lr + li * li;
        const double fr = ((ar - 1.0) * lr + ai * li) / den, fi = (ai * lr - (ar - 1.0) * li) / den;
#pragma unroll 4
        for (int h = 0; h < 16; ++h) { const double br = (double)in.bre[((size_t)lg * 64 + p) * 16 + h], bi = (double)in.bim[((size_t)lg * 64 + p) * 16 + h];
            const float xr = (float)(fr * br - fi * bi), xi = (float)(fr * bi + fi * br); Br[p * 16 + h] = xr; Bi[p * 16 + h] = xi;
            if (tq == 0) { f32x2 w; w.x = xr; w.y = xi; *(GAS f32x2*)(sp + SP_BBAR / 4 + (size_t)lg * BBAR_LG + (p * 16 + h) * 2) = w; } }
    }
    if (wave == 1) { for (int n = 0; n < 16; ++n) { Cr[n * 64 + p] = in.cre[((size_t)lg * 16 + n) * 64 + p]; Ci[n * 64 + p] = in.cim[((size_t)lg * 16 + n) * 64 + p]; } }
    const int tau = 8 * tq + wave;
    const double mg = exp(lr * step * (double)tau), an = li * step * (double)tau;
    const float ar = (float)(mg * cos(an)), ai = (float)(mg * sin(an));
    { f32x2 w; w.x = ar; w.y = ai; *(GAS f32x2*)(sp + SP_APOW / 4 + (size_t)lg * APOW_LG + (tau * 64 + p) * 2) = w; }
    if (tq == 3 && wave == 7) { const double m2 = exp(lr * step * 32.0), a2 = li * step * 32.0; f32x2 w; w.x = (float)(m2 * cos(a2)); w.y = (float)(m2 * sin(a2));
        *(GAS f32x2*)(sp + SP_APOW / 4 + (size_t)lg * APOW_LG + (32 * 64 + p) * 2) = w; }
    __syncthreads();
#pragma unroll 4
    for (int n = 0; n < 16; ++n) { const float cr = Cr[n * 64 + p], ci = Ci[n * 64 + p]; CAr[n * 64 + p] = cr * ar - ci * ai; CAi[n * 64 + p] = cr * ai + ci * ar; }
    LDS_WAIT(); asm volatile("" ::: "memory");
    const int n = lane >> 2, h0 = 4 * (lane & 3);
    f32x4 acc = {0.f, 0.f, 0.f, 0.f};
    for (int pp = 0; pp < 64; ++pp) { const float cr = CAr[n * 64 + pp], ci = CAi[n * 64 + pp];
        const f32x4 br = *(LAS const f32x4*)(Br + pp * 16 + h0), bi = *(LAS const f32x4*)(Bi + pp * 16 + h0);
        acc += br * cr - bi * ci; }
    *(GAS f32x4*)(sp + SP_KTAB / 4 + (size_t)lg * KTAB_LG + tau * 256 + n * 16 + h0) = acc;
    __syncthreads();
}
__device__ __forceinline__ void s5_build_item(const In& in, unsigned char* ws, unsigned char* s5m  , int l, int item, int tid) {
    const int g = item >> 3, part = item & 7, lg = l * S5G + g;
    const float* sp = (const float*)(ws + WS_SPARE);
    const float* ktab = sp + SP_KTAB / 4 + (size_t)lg * KTAB_LG; const float* apow = sp + SP_APOW / 4 + (size_t)lg * APOW_LG; const float* bbar = sp + SP_BBAR / 4 + (size_t)lg * BBAR_LG;
    bf16_t* T = (bf16_t*)(s5m + S5M_T) + (size_t)g * 512 * 640; bf16_t* WE = (bf16_t*)(s5m + S5M_WEND) + (size_t)g * 256 * 512;
    const int my_n = tid & 15;
    (void)my_n;
#pragma unroll 4
    for (int k = 0; k < 8; ++k) { const int q = tid + k * NTHR, rl = q >> 6, pc = q & 63, t = 4 * part + (rl >> 4), n = rl & 15, col0 = 8 * pc, s = col0 >> 4, h0 = col0 & 15;
        const int tau = (t - s) < 0 ? 0 : (t - s); const bool live = s <= t;
        const f32x4 a = *(const GAS f32x4*)(ktab + tau * 256 + n * 16 + h0), b = *(const GAS f32x4*)(ktab + tau * 256 + n * 16 + h0 + 4);
        const float dn = (s == t) ? in.s5d[l * S5W + g * 16 + n] : 0.f;
        float v[8] = {a.x, a.y, a.z, a.w, b.x, b.y, b.z, b.w};
#pragma unroll
        for (int j = 0; j < 8; ++j) v[j] = live ? v[j] + ((h0 + j == n) ? dn : 0.f) : 0.f;
        u32x4 w; w.x = pk2(v[0], v[1]); w.y = pk2(v[2], v[3]); w.z = pk2(v[4], v[5]); w.w = pk2(v[6], v[7]);
        *(GAS u32x4*)(T + (size_t)(t * 16 + n) * 640 + col0) = w; }
#pragma unroll 2
    for (int k = 0; k < 2; ++k) { const int q = tid + k * NTHR, rl = q >> 4, pc = q & 15, t = 4 * part + (rl >> 4), n = rl & 15, q0 = 8 * pc, im = q0 >= 64, p0 = q0 & 63; float v[8];
#pragma unroll
        for (int j = 0; j < 8; ++j) { const int p = p0 + j; const float cr = in.cre[((size_t)lg * 16 + n) * 64 + p], ci = in.cim[((size_t)lg * 16 + n) * 64 + p];
            const f32x2 a = *(const GAS f32x2*)(apow + ((t + 1) * 64 + p) * 2); v[j] = im ? -(cr * a.y + ci * a.x) : (cr * a.x - ci * a.y); }
        u32x4 w; w.x = pk2(v[0], v[1]); w.y = pk2(v[2], v[3]); w.z = pk2(v[4], v[5]); w.w = pk2(v[6], v[7]);
        *(GAS u32x4*)(T + (size_t)(t * 16 + n) * 640 + 512 + q0) = w; }
#pragma unroll 2
    for (int q = tid; q < 32 * 64; q += NTHR) {
        const int r = 32 * part + (q >> 6), col0 = 8 * (q & 63), s = col0 >> 4, h0 = col0 & 15; float v[8];
        if (r < 128) { const int p = r & 63, im = r >= 64; const f32x2 a = *(const GAS f32x2*)(apow + ((31 - s) * 64 + p) * 2);
#pragma unroll
            for (int j = 0; j < 8; ++j) { const f32x2 b = *(const GAS f32x2*)(bbar + (p * 16 + h0 + j) * 2); v[j] = im ? (a.x * b.y + a.y * b.x) : (a.x * b.x - a.y * b.y); } }
        else {
#pragma unroll
            for (int j = 0; j < 8; ++j) v[j] = 0.f; }
        u32x4 w; w.x = pk2(v[0], v[1]); w.y = pk2(v[2], v[3]); w.z = pk2(v[4], v[5]); w.w = pk2(v[6], v[7]);
        *(GAS u32x4*)(WE + (size_t)r * 512 + col0) = w;
    }
}
struct EpiS5End {
    static constexpr int PROBE_ID = 305; static constexpr bool PERM = false;
    float* SE;
    __device__ __forceinline__ void probe(const f32x4 (&acc)[2][2][4][2], const Unit& u, int ui, int wr, int wc, int fr, int fq) const { (*this)(acc, u, ui, wr, wc, fr, fq); }
    __device__ __forceinline__ void operator()(const f32x4 (&acc)[2][2][4][2], const Unit& u, int ui, int wr, int wc, int fr, int fq) const {
        asm volatile("" : "+v"(fr), "+v"(fq));
#pragma unroll
        for (int ai = 0; ai < 2; ++ai)
#pragma unroll
            for (int m = 0; m < 4; ++m) { const int row = u.pm * BM + ai * HALF + wr * 64 + m * 16 + fr; float* o = SE + ((size_t)u.g * (M / 32) + row) * 128 + wc * 32 + 4 * fq;
#pragma unroll
                for (int n = 0; n < 2; ++n) *(GAS f32x4*)(o + 16 * n) = acc[ai][0][m][n]; }
    }
};
__device__ __forceinline__ f32x2 gelu_pk(f32x2 v) {
    const f32x2 av = __builtin_elementwise_abs(v), d = av * 0.2316418882f + 1.0f;
    f32x2 t; t.x = __builtin_amdgcn_rcpf(d.x); t.y = __builtin_amdgcn_rcpf(d.y);
    f32x2 q = t * 0.5307027145f + (-0.7265760135f); q = q * t + 0.7107068705f; q = q * t + (-0.142248368f); q = q * t + 0.127414796f; q = q * t;
    const f32x2 s = (v * v) * (-0.72134752044f);
    f32x2 e; e.x = __builtin_amdgcn_exp2f(s.x); e.y = __builtin_amdgcn_exp2f(s.y);
    const f32x2 m = v * (q * e), r = v - m;
    f32x2 o; o.x = v.x < 0.f ? m.x : r.x; o.y = v.y < 0.f ? m.y : r.y; return o;
}
struct EpiS5Out {
    static constexpr int PROBE_ID = 306; static constexpr bool PERM = true;
    bf16_t* Z;
    __device__ __forceinline__ void probe(const f32x4 (&acc)[2][2][4][2], const Unit& u, int ui, int wr, int wc, int fr, int fq) const { (*this)(acc, u, ui, wr, wc, fr, fq); }
    __device__ __forceinline__ void operator()(const f32x4 (&acc)[2][2][4][2], const Unit& u, int ui, int wr, int wc, int fr, int fq) const {
        asm volatile("" : "+v"(fr), "+v"(fq));
#pragma unroll
        for (int ai = 0; ai < 2; ++ai)
#pragma unroll
            for (int m = 0; m < 4; ++m) { const int crow = u.pm * BM + ai * HALF + wr * 64 + m * 16 + fr;
#pragma unroll
                for (int bj = 0; bj < 2; ++bj) { const int c = u.pn * BM + bj * HALF + wc * 32 + 8 * fq, t = c >> 4, hf = (c >> 3) & 1;
                    const f32x4 v0 = acc[ai][bj][m][0], v1 = acc[ai][bj][m][1];
                    const f32x2 a = gelu_pk((f32x2){v0.x, v0.y}), b = gelu_pk((f32x2){v0.z, v0.w}), cc = gelu_pk((f32x2){v1.x, v1.y}), dd = gelu_pk((f32x2){v1.z, v1.w});
                    u32x4 w; w.x = cvt_pk(a.x, a.y); w.y = cvt_pk(b.x, b.y); w.z = cvt_pk(cc.x, cc.y); w.w = cvt_pk(dd.x, dd.y);
                    *(GAS u32x4*)(Z + ((size_t)u.g * M + (size_t)crow * 32 + t) * 16 + hf * 8) = w; } }
    }
};
__device__ __forceinline__ void s5_scan_unit(unsigned char* ws, LAS unsigned char* lds, int l, int unit, int wave, int lane) {
    const int b = unit >> 6, g = (unit >> 1) & 31, p = 32 * (unit & 1) + (lane & 31), seg = 2 * wave + (lane >> 5), lg = l * S5G + g;
    const float* sp = (const float*)(ws + WS_SPARE);
    const f32x2 a32 = *(const GAS f32x2*)(sp + SP_APOW / 4 + (size_t)lg * APOW_LG + (32 * 64 + p) * 2);
    const float* se = (const float*)(ws + WS_SEND) + ((size_t)g * (M / 32) + b * 256 + seg * 16) * 128;
    LAS f32x2* segT = (LAS f32x2*)lds;
    float xr[16], xi[16];
#pragma unroll
    for (int k = 0; k < 16; ++k) { xr[k] = se[k * 128 + p]; xi[k] = se[k * 128 + 64 + p]; }
    float tr = 0.f, ti = 0.f;
#pragma unroll
    for (int k = 0; k < 16; ++k) { const float nr = a32.x * tr - a32.y * ti + xr[k], ni = a32.x * ti + a32.y * tr + xi[k]; tr = nr; ti = ni; }
    segT[seg * 32 + (lane & 31)] = (f32x2){tr, ti};
    float Ar = a32.x, Ai = a32.y;
#pragma unroll
    for (int j = 0; j < 4; ++j) { const float nr = Ar * Ar - Ai * Ai, ni = 2.f * Ar * Ai; Ar = nr; Ai = ni; }
    __syncthreads();
    float cr = 0.f, ci = 0.f;
    for (int s2 = 0; s2 < seg; ++s2) { const f32x2 t2 = segT[s2 * 32 + (lane & 31)]; const float nr = Ar * cr - Ai * ci + t2.x, ni = Ar * ci + Ai * cr + t2.y; cr = nr; ci = ni; }
    bf16_t* ug = (bf16_t*)(ws + WS_UG) + ((size_t)g * (M / 32) + b * 256 + seg * 16) * 640 + 512;
#pragma unroll
    for (int k = 0; k < 16; ++k) { ug[k * 640 + p] = (bf16_t)f2bf(cr); ug[k * 640 + 64 + p] = (bf16_t)f2bf(ci);
        const float nr = a32.x * cr - a32.y * ci + xr[k], ni = a32.x * ci + a32.y * cr + xi[k]; cr = nr; ci = ni; }
    __syncthreads();
}

typedef short s16x4 __attribute__((ext_vector_type(4)));
__device__ __forceinline__ unsigned rt_f(int row) { return (unsigned)(((row & 3) << 2) | ((row >> 2) & 3)); }
__device__ __forceinline__ unsigned rt_off(int row, int ch) { return 256u * (unsigned)row + 16u * ((unsigned)ch ^ rt_f(row)); }
__device__ __forceinline__ void rt_fill(LAS unsigned char* img, const bf16_t* src  , int wave, int lane) {
#pragma unroll
    for (int j = 0; j < 4; ++j) { const int p = wave * 4 + j, row = 4 * p + (lane >> 4), ch = (lane & 15) ^ (int)rt_f(row);
        __builtin_amdgcn_global_load_lds((const unsigned*)((const char*)src + (size_t)row * 1024 + ch * 16), (LAS unsigned*)(img + p * 1024), 16, 0, 0); }
}
__device__ __forceinline__ s16x4 rt_tr4(LAS const unsigned char* p) { typedef short v4i16_t __attribute__((ext_vector_type(4))); return __builtin_bit_cast(s16x4, __builtin_amdgcn_ds_read_tr16_b64_v4i16((LAS v4i16_t*)p)); }
template <bool KPERM> __device__ __forceinline__ bf16x8 rt_trfrag(LAS const unsigned char* img, int k0, int c, int lane) {
    const int hh = lane >> 5, blk = (lane >> 4) & 1, q = (lane & 15) >> 2, p = lane & 3;
    const int r0 = k0 + (KPERM ? 4 * hh : 8 * hh) + q, r1 = r0 + (KPERM ? 8 : 4), ch = 4 * c + 2 * blk + (p >> 1);
    const s16x4 lo = rt_tr4(img + rt_off(r0, ch) + 8 * (p & 1)), hi = rt_tr4(img + rt_off(r1, ch) + 8 * (p & 1));
    return __builtin_shufflevector(lo, hi, 0, 1, 2, 3, 4, 5, 6, 7);
}
__device__ __forceinline__ bf16x8 rt_rowfrag(LAS const unsigned char* img, int rb, int s, int lane) {
    return *(LAS const bf16x8*)(img + rt_off(32 * rb + (lane & 31), 2 * s + (lane >> 5)));
}
constexpr int RT_Q = 0, RT_K = 32768, RT_V = 65536, RT_R = 98304;
__device__ __forceinline__ float ret_g(int h) { return h == 0 ? 0.017183023570817902f : h == 1 ? 0.1332151628796484f : h == 2 ? 0.3664377159220373f : 0.6059370882290803f; }
__device__ __forceinline__ void rt_kv(f32x16 (&racc)[2], LAS const unsigned char* lds, int wave, int lane) {
    const int eb = wave & 3, db0 = 2 * (wave >> 2);
#pragma unroll
    for (int ks = 0; ks < 8; ++ks) {
        const bf16x8 bv = rt_trfrag<false>(lds + RT_V, 16 * ks, eb, lane);
        const bf16x8 a0 = rt_trfrag<false>(lds + RT_K, 16 * ks, db0, lane), a1 = rt_trfrag<false>(lds + RT_K, 16 * ks, db0 + 1, lane);
        racc[0] = __builtin_amdgcn_mfma_f32_32x32x16_bf16(a0, bv, racc[0], 0, 0, 0);
        racc[1] = __builtin_amdgcn_mfma_f32_32x32x16_bf16(a1, bv, racc[1], 0, 0, 0);
    }
}
template <int KS> __device__ __forceinline__ void rt_kv_step(f32x16 (&racc)[2], unsigned av0, unsigned av1, unsigned ak0, unsigned ak1, unsigned ak2, unsigned ak3) {
    s16x4 v0, v1, k0, k1, k2, k3;
    asm volatile("ds_read_b64_tr_b16 %0, %6 offset:%12\n\tds_read_b64_tr_b16 %1, %7 offset:%12\n\tds_read_b64_tr_b16 %2, %8 offset:%12\n\tds_read_b64_tr_b16 %3, %9 offset:%12\n\t"
                 "ds_read_b64_tr_b16 %4, %10 offset:%12\n\tds_read_b64_tr_b16 %5, %11 offset:%12\n\ts_waitcnt lgkmcnt(0)"
                 : "=&v"(v0), "=&v"(v1), "=&v"(k0), "=&v"(k1), "=&v"(k2), "=&v"(k3) : "v"(av0), "v"(av1), "v"(ak0), "v"(ak1), "v"(ak2), "v"(ak3), "i"(KS * 4096) : "memory");
    const bf16x8 bv = __builtin_shufflevector(v0, v1, 0, 1, 2, 3, 4, 5, 6, 7), a0 = __builtin_shufflevector(k0, k1, 0, 1, 2, 3, 4, 5, 6, 7), a1 = __builtin_shufflevector(k2, k3, 0, 1, 2, 3, 4, 5, 6, 7);
    racc[0] = __builtin_amdgcn_mfma_f32_32x32x16_bf16(a0, bv, racc[0], 0, 0, 0);
    racc[1] = __builtin_amdgcn_mfma_f32_32x32x16_bf16(a1, bv, racc[1], 0, 0, 0);
}
__device__ __forceinline__ unsigned rt_traddr(LAS const unsigned char* img, int c, int t, int lane) {
    const int hh = lane >> 5, blk = (lane >> 4) & 1, q = (lane & 15) >> 2, p = lane & 3;
    return (unsigned)(size_t)img + rt_off(8 * hh + 4 * t + q, 4 * c + 2 * blk + (p >> 1)) + 8 * (p & 1);
}
__device__ __forceinline__ void ret_kvrun_steps(unsigned char* ws, LAS unsigned char* lds, int u0, int nu, int wave) {
    const int total = nu * 4;
#define RT_ISSUE(step) do { const int un_ = u0 + ((step) >> 2), c_ = (step) & 3, bh_ = un_ >> 4, run_ = un_ & 15, b_ = bh_ >> 2, h_ = bh_ & 3; \
        const size_t r_ = ((size_t)b_ * SEQ + run_ * 512 + c_ * 128) * RW + h_ * RDK; LAS unsigned char* bf_ = lds + ((step) & 1) * 65536; const int ln_ = lane_id(); \
        rt_fill(bf_, (const bf16_t*)(ws + WS_K) + r_, wave, ln_); rt_fill(bf_ + 32768, (const bf16_t*)(ws + WS_V) + r_, wave, ln_); } while (0)
    RT_ISSUE(0);
    f32x16 racc[2];
#pragma unroll 1
    for (int step = 0; step < total; ++step) {
        const int unit = u0 + (step >> 2), c = step & 3, h = (unit >> 4) & 3; const float g = (c == 0) ? 0.f : ret_g(h);
        if (step + 1 < total) { RT_ISSUE(step + 1); asm volatile("s_waitcnt vmcnt(8) lgkmcnt(0)\n\ts_barrier" ::: "memory"); }
        else asm volatile("s_waitcnt vmcnt(0) lgkmcnt(0)\n\ts_barrier" ::: "memory");
#pragma unroll
        for (int k = 0; k < 2; ++k)
#pragma unroll
            for (int j = 0; j < 16; ++j) racc[k][j] = (c == 0) ? 0.f : racc[k][j] * g;
        { const int lane = lane_id(); LAS const unsigned char* bf = lds + (step & 1) * 65536;
          const int eb = wave & 3, db0 = 2 * (wave >> 2);
          const unsigned av0 = rt_traddr(bf + 32768, eb, 0, lane), av1 = rt_traddr(bf + 32768, eb, 1, lane);
          const unsigned ak0 = rt_traddr(bf, db0, 0, lane), ak1 = rt_traddr(bf, db0, 1, lane), ak2 = rt_traddr(bf, db0 + 1, 0, lane), ak3 = rt_traddr(bf, db0 + 1, 1, lane);
          rt_kv_step<0>(racc, av0, av1, ak0, ak1, ak2, ak3); rt_kv_step<1>(racc, av0, av1, ak0, ak1, ak2, ak3); rt_kv_step<2>(racc, av0, av1, ak0, ak1, ak2, ak3); rt_kv_step<3>(racc, av0, av1, ak0, ak1, ak2, ak3);
          rt_kv_step<4>(racc, av0, av1, ak0, ak1, ak2, ak3); rt_kv_step<5>(racc, av0, av1, ak0, ak1, ak2, ak3); rt_kv_step<6>(racc, av0, av1, ak0, ak1, ak2, ak3); rt_kv_step<7>(racc, av0, av1, ak0, ak1, ak2, ak3);
          if (c == 3) { float* o = (float*)(ws + WS_KVRUN) + (size_t)unit * 16384 + (size_t)wave * 2048 + lane * 32;
#pragma unroll
            for (int k = 0; k < 2; ++k)
#pragma unroll
                for (int q4 = 0; q4 < 4; ++q4) *(GAS f32x4*)(o + k * 16 + 4 * q4) = (f32x4){racc[k][4 * q4], racc[k][4 * q4 + 1], racc[k][4 * q4 + 2], racc[k][4 * q4 + 3]}; } }
        asm volatile("s_waitcnt lgkmcnt(0)\n\ts_barrier" ::: "memory");
    }
    asm volatile("s_waitcnt vmcnt(0)" ::: "memory");
#undef RT_ISSUE
}
__device__ __forceinline__ void ret_scan(unsigned char* ws, int bx, int G, int tid) {
    for (int e2 = bx * NTHR + tid; e2 < NB * RH * 8192; e2 += G * NTHR) {
        const int bh = e2 >> 13, el = (e2 & 8191) * 2, h = bh & 3; float g4 = ret_g(h); g4 *= g4; g4 *= g4;
        const float* kv = (const float*)(ws + WS_KVRUN) + (size_t)bh * 16 * 16384 + el; bf16_t* rs = (bf16_t*)(ws + WS_RSTART) + (size_t)bh * 16 * 16384 + el;
        f32x2 v[15];
#pragma unroll
        for (int r = 0; r < 15; ++r) v[r] = *(const GAS f32x2*)(kv + (size_t)r * 16384);
        float z0 = 0.f; asm volatile("" : "+v"(z0));
        f32x2 s = {z0, z0};
        *(GAS unsigned*)rs = 0u;
#pragma unroll
        for (int r = 0; r < 15; ++r) { s = s * g4 + v[r]; *(GAS unsigned*)(rs + (size_t)(r + 1) * 16384) = pk2(s.x, s.y); }
    }
}
__device__ __forceinline__ void ret_out_unit(unsigned char* ws, LAS unsigned char* lds, const float* gain  , int unit, int wave) {
    const int bh = unit >> 4, run = unit & 15, b = bh >> 2, h = bh & 3; const float g = ret_g(h);
    const size_t row0 = (size_t)b * SEQ + run * 512;
    const int qb = wave & 3, eh = wave >> 2;
    LAS f32x2* exch = (LAS f32x2*)(lds + TAB_OFF);
    LAS float* gtab = (LAS float*)(lds + TAB_OFF + 2048);
    { const int lane = lane_id();
      rt_fill(lds + RT_Q, (const bf16_t*)(ws + WS_Q) + row0 * RW + h * RDK, wave, lane);
      rt_fill(lds + RT_K, (const bf16_t*)(ws + WS_K) + row0 * RW + h * RDK, wave, lane);
      rt_fill(lds + RT_V, (const bf16_t*)(ws + WS_V) + row0 * RW + h * RDK, wave, lane);
      if (wave < 2) gtab[wave * 64 + lane] = gain[h * RDK + wave * 64 + lane]; }
    f32x16 racc[2];
    { const int lane = lane_id(); const bf16_t* o = (const bf16_t*)(ws + WS_RSTART) + (size_t)unit * 16384 + (size_t)wave * 2048 + lane * 32;
      u32x4 rw[4];
#pragma unroll
      for (int i = 0; i < 4; ++i) rw[i] = *(const GAS u32x4*)(o + 8 * i);
#pragma unroll
      for (int k = 0; k < 2; ++k)
#pragma unroll
        for (int i = 0; i < 2; ++i) { const u32x4 v = rw[2 * k + i];
            racc[k][8 * i + 0] = bflo(v.x); racc[k][8 * i + 1] = bfhi(v.x); racc[k][8 * i + 2] = bflo(v.y); racc[k][8 * i + 3] = bfhi(v.y);
            racc[k][8 * i + 4] = bflo(v.z); racc[k][8 * i + 5] = bfhi(v.z); racc[k][8 * i + 6] = bflo(v.w); racc[k][8 * i + 7] = bfhi(v.w); } }
#pragma unroll 1
    for (int c = 0; c < 4; ++c) {
        __builtin_amdgcn_s_waitcnt(0x0F70); __syncthreads();
        u32x4 gw[4];
        { const int lane = lane_id();
          const bf16_t* gp = (const bf16_t*)(ws + WS_GATE) + (row0 + c * 128 + 32 * qb + (lane >> 3)) * RW + h * RDK + 64 * eh;
#pragma unroll
          for (int j = 0; j < 4; ++j) { const int row = 8 * j + (lane >> 3); gw[j] = *(const GAS u32x4*)(gp + (size_t)(8 * j) * RW + 8 * ((lane & 7) ^ (row & 7))); } }
        {
          const int lane = lane_id(), eb = wave & 3, db0 = 2 * (wave >> 2), r = lane & 31, hh = lane >> 5;
#pragma unroll
          for (int k = 0; k < 2; ++k)
#pragma unroll
            for (int q4 = 0; q4 < 4; ++q4) { u32x2 w; w.x = cvt_pk(racc[k][4 * q4] * g, racc[k][4 * q4 + 1] * g); w.y = cvt_pk(racc[k][4 * q4 + 2] * g, racc[k][4 * q4 + 3] * g);
                const int e = 32 * eb + r, d0 = 32 * (db0 + k) + 8 * q4 + 4 * hh;
                *(LAS u32x2*)(lds + RT_R + rt_off(e, d0 >> 3) + 2 * (d0 & 7)) = w; } }
        if (c < 3) {
#pragma unroll
            for (int k = 0; k < 2; ++k) racc[k] *= g;
            rt_kv(racc, lds, wave, lane_id());
        }
        f32x16 oacc[2]; bf16x8 bq[8]; float sg[4][8];
        {   const int lane = lane_id(), r = lane & 31, hh = lane >> 5;
#pragma unroll
            for (int s = 0; s < 8; ++s) bq[s] = rt_rowfrag(lds + RT_Q, qb, s, lane);
            f32x16 sacc[4];
#pragma unroll
            for (int kb = 0; kb < 4; ++kb) {
#pragma unroll
                for (int j = 0; j < 16; ++j) sacc[kb][j] = 0.f;
                if (kb <= qb) {
#pragma unroll
                    for (int s = 0; s < 8; ++s) sacc[kb] = __builtin_amdgcn_mfma_f32_32x32x16_bf16(rt_rowfrag(lds + RT_K, kb, s, lane), bq[s], sacc[kb], 0, 0, 0);
                }
            }
#pragma unroll
            for (int kb = 0; kb < 4; ++kb) if (kb == qb) {
#pragma unroll
                for (int j = 0; j < 16; ++j) { const int key = (j & 3) + 8 * (j >> 2) + 4 * hh; sacc[kb][j] = (key <= r) ? sacc[kb][j] : 0.f; } }
#pragma unroll
            for (int k = 0; k < 2; ++k)
#pragma unroll
                for (int j = 0; j < 16; ++j) oacc[k][j] = 0.f;
#pragma unroll
            for (int kb = 0; kb < 4; ++kb) if (kb <= qb) {
#pragma unroll
                for (int s = 0; s < 2; ++s) { u32x4 w; w.x = cvt_pk(sacc[kb][8 * s + 0], sacc[kb][8 * s + 1]); w.y = cvt_pk(sacc[kb][8 * s + 2], sacc[kb][8 * s + 3]);
                    w.z = cvt_pk(sacc[kb][8 * s + 4], sacc[kb][8 * s + 5]); w.w = cvt_pk(sacc[kb][8 * s + 6], sacc[kb][8 * s + 7]); const bf16x8 bp = __builtin_bit_cast(bf16x8, w);
#pragma unroll
                    for (int k = 0; k < 2; ++k) oacc[k] = __builtin_amdgcn_mfma_f32_32x32x16_bf16(rt_trfrag<true>(lds + RT_V, 32 * kb + 16 * s, 2 * eh + k, lane), bp, oacc[k], 0, 0, 0); } }
#pragma unroll
            for (int j = 0; j < 4; ++j) { const u32x4 gv = gw[j];
                sg[j][0] = bflo(gv.x) * fast_sigmoid(bflo(gv.x)); sg[j][1] = bfhi(gv.x) * fast_sigmoid(bfhi(gv.x)); sg[j][2] = bflo(gv.y) * fast_sigmoid(bflo(gv.y)); sg[j][3] = bfhi(gv.y) * fast_sigmoid(bfhi(gv.y));
                sg[j][4] = bflo(gv.z) * fast_sigmoid(bflo(gv.z)); sg[j][5] = bfhi(gv.z) * fast_sigmoid(bfhi(gv.z)); sg[j][6] = bflo(gv.w) * fast_sigmoid(bflo(gv.w)); sg[j][7] = bfhi(gv.w) * fast_sigmoid(bfhi(gv.w));
#pragma unroll
                for (int i = 0; i < 8; ++i) asm volatile("" : "+v"(sg[j][i])); }
        }
        __syncthreads();
        if (c < 3) { const int lane = lane_id(); const size_t nr = (row0 + (c + 1) * 128) * RW + h * RDK;
            rt_fill(lds + RT_Q, (const bf16_t*)(ws + WS_Q) + nr, wave, lane); rt_fill(lds + RT_K, (const bf16_t*)(ws + WS_K) + nr, wave, lane); rt_fill(lds + RT_V, (const bf16_t*)(ws + WS_V) + nr, wave, lane); }
        {   const int lane = lane_id(), r = lane & 31, hh = lane >> 5;
#pragma unroll
            for (int s = 0; s < 8; ++s)
#pragma unroll
                for (int k = 0; k < 2; ++k) oacc[k] = __builtin_amdgcn_mfma_f32_32x32x16_bf16(rt_rowfrag(lds + RT_R, 2 * eh + k, s, lane), bq[s], oacc[k], 0, 0, 0);
            float s1 = 0.f, s2 = 0.f;
#pragma unroll
            for (int k = 0; k < 2; ++k)
#pragma unroll
                for (int j = 0; j < 16; ++j) { s1 += oacc[k][j]; s2 += oacc[k][j] * oacc[k][j]; }
            s1 = half_sum(s1); s2 = half_sum(s2);
            if (hh == 0) exch[eh * 128 + 32 * qb + r] = (f32x2){s1, s2};
            asm volatile("s_waitcnt lgkmcnt(0)\n\ts_barrier" ::: "memory");
            const f32x2 e0 = exch[32 * qb + r], e1 = exch[128 + 32 * qb + r];
            const float mu = (e0.x + e1.x) * (1.0f / 128.0f), var = (e0.y + e1.y) * (1.0f / 128.0f) - mu * mu, rstd = 1.0f / sqrtf(var + EPS);
            LAS unsigned char* wb = lds + RT_R + wave * 4096;
#pragma unroll
            for (int k = 0; k < 2; ++k)
#pragma unroll
                for (int q4 = 0; q4 < 4; ++q4) { const int el = 32 * k + 8 * q4 + 4 * hh; const f32x4 gn = *(LAS const f32x4*)(gtab + 64 * eh + el);
                    u32x2 w; w.x = cvt_pk((oacc[k][4 * q4] - mu) * rstd * gn.x, (oacc[k][4 * q4 + 1] - mu) * rstd * gn.y); w.y = cvt_pk((oacc[k][4 * q4 + 2] - mu) * rstd * gn.z, (oacc[k][4 * q4 + 3] - mu) * rstd * gn.w);
                    *(LAS u32x2*)(wb + r * 128 + (((el >> 3) ^ (r & 7)) << 4) + 8 * hh) = w; }
            asm volatile("s_waitcnt lgkmcnt(0)" ::: "memory");
            bf16_t* yp = (bf16_t*)(ws + WS_YMIX) + (row0 + c * 128 + 32 * qb) * D + S5W + h * RDK + 64 * eh;
#pragma unroll
            for (int j = 0; j < 4; ++j) { const int row = 8 * j + (lane >> 3), cp = lane & 7; const u32x4 v = *(LAS const u32x4*)(wb + row * 128 + cp * 16);
                u32x4 w; w.x = cvt_pk(bflo(v.x) * sg[j][0], bfhi(v.x) * sg[j][1]); w.y = cvt_pk(bflo(v.y) * sg[j][2], bfhi(v.y) * sg[j][3]);
                w.z = cvt_pk(bflo(v.z) * sg[j][4], bfhi(v.z) * sg[j][5]); w.w = cvt_pk(bflo(v.w) * sg[j][6], bfhi(v.w) * sg[j][7]);
                *(GAS u32x4*)(yp + (size_t)row * D + 8 * (cp ^ (row & 7))) = w; }
        }
    }
    __syncthreads();
}

struct Args { In in; float* out; unsigned char* ws; int pro_lo, pro_hi, l_lo, l_hi, ph_lo, ph_hi, flags, region; };
enum { PH_PROJ = 0, PH_MIXA = 1, PH_SCAN = 2, PH_MIXC = 3, PH_GLU = 4, PH_WOUT = 5, PH_CQ = 6, PH_XATT = 7, PH_CO = 8, PH_FFN1 = 9, PH_FFN2 = 10, PH_N = 11 };
enum { FL_XPREP = 1, FL_FINAL = 2, FL_XIN = 4 };

__global__ void __launch_bounds__(NTHR, 2) fwd(Args a) {
    extern __shared__ __attribute__((aligned(16))) unsigned char lds_raw[];
    LAS unsigned char* lds = (LAS unsigned char*)lds_raw;
    const int wave = __builtin_amdgcn_readfirstlane(threadIdx.x >> 6); const bool t0 = (threadIdx.x == 0);
#define LANE lane_id()
    const int G = gridDim.x, bx = blockIdx.x, vcu = (G % 8 == 0) ? (bx % 8) * (G / 8) + bx / 8 : bx;
    volatile LAS unsigned* MISC = (volatile LAS unsigned*)(lds + MISC_OFF);
    if (threadIdx.x < 32) MISC[threadIdx.x] = 0u;
    __syncthreads();
    unsigned char* ws = a.ws;
    unsigned* ctl = (unsigned*)(ws + WS_CTL);
    XcdBarrier bar = xcd_barrier_post(ctl + CW_BAR + a.region * XCD_BAR_WORDS, MISC + 8, t0);
    bool need_bar = false;
#ifndef PROBE_DUP
#define PROBE_DUP -1
#endif
#define REPS(k) ((PROBE_DUP == (k)) ? 2 : 1)
#define SEAM() do { if (need_bar) { xcd_barrier(bar); if (PROBE_DUP == 100) xcd_barrier(bar); } need_bar = true; } while (0)
    const int gw = vcu * NWAVES + wave, NGW = G * NWAVES;
    const In& in = a.in;
    float* ssq = (float*)(ws + WS_SSQ);
    bf16_t* xb = (bf16_t*)(ws + WS_XB);
    LAS float* tab = (LAS float*)(lds + TAB_OFF);
    float* rsm = (float*)(ws + WS_SPARE);

#ifndef STAGGER_TICKS
#define STAGGER_TICKS 0
#endif
#define STAGGER() do { if (STAGGER_TICKS > 0) { const unsigned long long t0_ = __builtin_amdgcn_s_memrealtime(), d_ = (unsigned long long)((bx & 7) * STAGGER_TICKS); \
        while (__builtin_amdgcn_s_memrealtime() - t0_ < d_) __builtin_amdgcn_s_sleep(2); } } while (0)
    for (int rep = 0; rep < REPS(200); ++rep) if (a.pro_lo <= 0 && 0 < a.pro_hi) {
        SEAM();
        pro_weights(in, ws, lds, gw, NGW, wave, LANE);
#if PROBE_DUP == 210
        __syncthreads(); pro_weights(in, ws, lds, gw + (int)(a.flags >> 8), NGW, wave, LANE);
#endif
        for (int r2 = 0; r2 < REPS(211); ++r2) if (a.flags & FL_XIN) xprep_rows(in.x, xb, ssq, gw, NGW, LANE);
        mem_prep_rows(in.mem, (bf16_t*)(ws + WS_MEMB), rsm, gw, NGW, LANE);
        for (int r2 = 0; r2 < REPS(212); ++r2) rope_table(in.pos, (float*)(ws + WS_ROPE), gw * 64 + LANE, NGW * 64);
        __syncthreads();
        for (int r2 = 0; r2 < REPS(213); ++r2) for (int it = bx; it < DEPTH * S5G * 4; it += G) s5_tables_item(in, ws, lds, it, wave, LANE);
        __syncthreads();
    }
    for (int rep = 0; rep < REPS(201); ++rep) if (a.pro_lo <= 1 && 1 < a.pro_hi) {
        SEAM();
        int bxo = bx; asm volatile("" : "+s"(bxo));
        { GroupOrder S; S.init(DEPTH, MROWS / BM, D / BM, G, bxo, 0);
          const Gemm g{(const bf16_t*)(ws + WS_MEMB), (const bf16_t*)(ws + WS_WCK_TMP), D, D, D, 0, (long)D * D};
          const EpiMemK E{(bf16_t*)(ws + WS_MEMK), rsm};
          gemm_phase<EpiMemK, GroupOrder>(lds, g, S, E, wave); }
        { GroupOrder S; S.init(DEPTH, D / BM, MROWS / BM, G, bxo, 64);
          const Gemm g{(const bf16_t*)(ws + WS_WCV_TMP), (const bf16_t*)(ws + WS_MEMB), D, D, D, (long)D * D, 0};
          const EpiMemVT E{(bf16_t*)(ws + WS_MEMVT), rsm};
          gemm_phase<EpiMemVT, GroupOrder>(lds, g, S, E, wave); }
        if (G == 256) { const int n_it = bxo < 128 ? 2 : 6, it0 = bxo < 128 ? bxo : 256 + (bxo - 128);
            for (int k = 0; k < n_it; ++k) { const int it = it0 + 128 * k; s5_build_item(in, ws, (unsigned char*)a.out + (size_t)(it >> 8) * S5M_LAYER, it >> 8, it & 255, wave * 64 + LANE); } }
        else for (int it = bxo; it < DEPTH * S5G * 8; it += G) s5_build_item(in, ws, (unsigned char*)a.out + (size_t)(it >> 8) * S5M_LAYER, it >> 8, it & 255, wave * 64 + LANE);
    }
    for (int l = a.l_lo; l < a.l_hi; ++l) {
#define IN_PH(k) (a.ph_lo <= (k) && (k) < a.ph_hi)
        for (int rep = 0; rep < REPS(PH_PROJ); ++rep) if (IN_PH(PH_PROJ)) {
            SEAM();
            int bxo = bx; asm volatile("" : "+s"(bxo));
            StaticOrder S; S.init(M / BM, INW / BM, G, bxo);
            const RstdPre<StaticOrder> pre{tab, &S, ssq, 16, 1.0f / D};
            const Gemm g{xb, wl(ws, l, W_IN), D, D, D, 0, 0};
            const EpiProj E{(bf16_t*)(ws + WS_UG), (bf16_t*)(ws + WS_Q), (bf16_t*)(ws + WS_K), (bf16_t*)(ws + WS_V), (bf16_t*)(ws + WS_GATE), (const float*)(ws + WS_ROPE), tab};
            gemm_phase<EpiProj, StaticOrder, false, RstdPre<StaticOrder>>(lds, g, S, E, wave, pre);
        }
        for (int rep = 0; rep < REPS(PH_MIXA); ++rep) if (IN_PH(PH_MIXA)) {
            SEAM();
            int bxo = bx; asm volatile("" : "+s"(bxo));
            if (G == 256) {
                if (bxo < 128) { XcdGroupOrder S; S.init(S5G, (M / 32) / BM, 1, 128, bxo);
                  const Gemm g{(const bf16_t*)(ws + WS_UG), (const bf16_t*)((unsigned char*)a.out + (size_t)l * S5M_LAYER + S5M_WEND), 640, 512, 512, (long)(M / 32) * 640, 256L * 512};
                  const EpiS5End E{(float*)(ws + WS_SEND)};
                  gemm_phase<EpiS5End, XcdGroupOrder>(lds, g, S, E, wave); }
                else ret_kvrun_steps(ws, lds, 2 * (bxo - 128), 2, wave);
            } else {
                { GroupOrder S; S.init(S5G, (M / 32) / BM, 1, G, bxo, 0);
                  const Gemm g{(const bf16_t*)(ws + WS_UG), (const bf16_t*)((unsigned char*)a.out + (size_t)l * S5M_LAYER + S5M_WEND), 640, 512, 512, (long)(M / 32) * 640, 256L * 512};
                  const EpiS5End E{(float*)(ws + WS_SEND)};
                  gemm_phase<EpiS5End, GroupOrder>(lds, g, S, E, wave); }
                __syncthreads();
                for (int u = bxo; u < NB * RH * 16; u += G) ret_kvrun_steps(ws, lds, u, 1, wave);
            }
        }
        for (int rep = 0; rep < REPS(PH_SCAN); ++rep) if (IN_PH(PH_SCAN)) {
            SEAM();
            for (int u = bx; u < NB * S5G * 2; u += G) s5_scan_unit(ws, lds, l, u, wave, LANE);
            ret_scan(ws, bx, G, wave * 64 + LANE);
        }
        for (int rep = 0; rep < REPS(PH_MIXC); ++rep) if (IN_PH(PH_MIXC)) {
            SEAM();
            int bxo = bx; asm volatile("" : "+s"(bxo));
            for (int r2 = 0; r2 < REPS(31); ++r2)
            { XcdGroupOrder S; S.init(S5G, (M / 32) / BM, 2, G, bxo);
              const Gemm g{(const bf16_t*)(ws + WS_UG), (const bf16_t*)((unsigned char*)a.out + (size_t)l * S5M_LAYER + S5M_T), 640, 640, 640, (long)(M / 32) * 640, 512L * 640};
              const EpiS5Out E{(bf16_t*)(ws + WS_Z)};
              gemm_phase<EpiS5Out, XcdGroupOrder>(lds, g, S, E, wave); }
            __syncthreads();
            for (int r2 = 0; r2 < REPS(32); ++r2)
            for (int u = bxo; u < NB * RH * 16; u += G) ret_out_unit(ws, lds, in.retn + l * RW, u, wave);
        }
        for (int rep = 0; rep < REPS(PH_GLU); ++rep) if (IN_PH(PH_GLU)) {
            SEAM();
            int bxo = bx; asm volatile("" : "+s"(bxo));
            StaticOrder S; S.init(M / BM, S5W / BM, G, bxo);
            const Gemm g{(const bf16_t*)(ws + WS_Z), wl(ws, l, W_GLU), S5W, S5W, S5W, 0, 0, M};
            const EpiGlu E{(const bf16_t*)(ws + WS_Z), in.bglu + l * S5W, (bf16_t*)(ws + WS_YMIX), (float*)(ws + WS_SSQS)};
            gemm_phase<EpiGlu, StaticOrder>(lds, g, S, E, wave);
        }
        for (int rep = 0; rep < REPS(PH_WOUT); ++rep) if (IN_PH(PH_WOUT)) {
            SEAM();
            int bxo = bx; asm volatile("" : "+s"(bxo));
            StaticOrder S; S.init(M / BM, D / BM, G, bxo);
            LAS float* tab2 = (LAS float*)(lds + TAB2_OFF);
            const RstdPre<StaticOrder> pre{tab2, &S, (const float*)(ws + WS_SSQS), 8, 1.0f / S5W};
            const Gemm g{(const bf16_t*)(ws + WS_YMIX), wl(ws, l, W_OUT), D, D, D, 0, 0};
            const EpiResHook E{{xb, ssq, nullptr, (REPS(PH_WOUT) == 2 && rep == 0) ? 0.f : 1.f, tab}, tab2, 8};
            gemm_phase<EpiResHook, StaticOrder, true, RstdPre<StaticOrder>>(lds, g, S, E, wave, pre);
        }
        for (int rep = 0; rep < REPS(PH_CQ); ++rep) if (IN_PH(PH_CQ)) {
            SEAM();
            int bxo = bx; asm volatile("" : "+s"(bxo));
            StaticOrder S; S.init(M / BM, D / BM, G, bxo);
            const RstdPre<StaticOrder> pre{tab, &S, ssq, 16, 1.0f / D};
            const Gemm g{xb, wl(ws, l, W_CQ), D, D, D, 0, 0};
            const EpiScaleBf16 E{(bf16_t*)(ws + WS_QC), D, tab};
            gemm_phase<EpiScaleBf16, StaticOrder, false, RstdPre<StaticOrder>>(lds, g, S, E, wave, pre);
#pragma unroll 1
            for (int i = 0; i < 2; ++i) { Unit u; if (!S.next(i, u)) break;
                const int upm = __builtin_amdgcn_readfirstlane(u.pm), upn = __builtin_amdgcn_readfirstlane(u.pn);
                xattn_unit(lds, (const bf16_t*)(ws + WS_QC), (const bf16_t*)(ws + WS_MEMK) + (size_t)l * MROWS * D, (const bf16_t*)(ws + WS_MEMVT) + (size_t)l * D * MROWS, (bf16_t*)(ws + WS_OC), upm >> 5, upn, upm & 31, wave); }
        }
        for (int rep = 0; rep < REPS(PH_CO); ++rep) if (IN_PH(PH_CO)) {
            SEAM();
            int bxo = bx; asm volatile("" : "+s"(bxo));
            StaticOrder S; S.init(M / BM, D / BM, G, bxo);
            const Gemm g{(const bf16_t*)(ws + WS_OC), wl(ws, l, W_CO), D, D, D, 0, 0};
            const EpiRes E{xb, ssq, nullptr, (REPS(PH_CO) == 2 && rep == 0) ? 0.f : 1.f, tab};
            gemm_phase<EpiRes, StaticOrder>(lds, g, S, E, wave);
        }
        for (int rep = 0; rep < REPS(PH_FFN1); ++rep) if (IN_PH(PH_FFN1)) {
            SEAM();
            int bxo = bx; asm volatile("" : "+s"(bxo));
            StaticOrder S; S.init(M / BM, (2 * FF) / BM, G, bxo);
            const RstdPre<StaticOrder> pre{tab, &S, ssq, 16, 1.0f / D};
            const Gemm g{xb, wl(ws, l, W_GU), D, D, D, 0, 0};
            const EpiFfn1 E{(bf16_t*)(ws + WS_HID), tab};
            gemm_phase<EpiFfn1, StaticOrder, false, RstdPre<StaticOrder>>(lds, g, S, E, wave, pre);
        }
        for (int rep = 0; rep < REPS(PH_FFN2); ++rep) if (IN_PH(PH_FFN2)) {
            SEAM();
            int bxo = bx; asm volatile("" : "+s"(bxo));
            StaticOrder S; S.init(M / BM, D / BM, G, bxo);
            const Gemm g{(const bf16_t*)(ws + WS_HID), wl(ws, l, W_DN), FF, FF, FF, 0, 0};
            const EpiRes E{xb, ssq, nullptr, (REPS(PH_FFN2) == 2 && rep == 0) ? 0.f : 1.f, tab};
            gemm_phase<EpiRes, StaticOrder>(lds, g, S, E, wave);
        }
    }
    if (a.flags & FL_FINAL) { SEAM(); final_norm_rows(xb, a.out, in.norm_final, gw, NGW, LANE); }
#undef IN_PH
#undef SEAM
#undef LANE
}
}

extern "C" void kernel_launch(void* const* d_in, const int* in_sizes, int n_in, void* d_out, int out_size, void* d_ws, size_t ws_size, hipStream_t stream) {
    static int grid = 0;
    if (grid == 0) {
        if (n_in != 29 || out_size != mk::M * mk::D || ws_size < mk::WS_END) { fprintf(stderr, "kernel_launch: unexpected sizes (n_in %d out %d ws %zu)\n", n_in, out_size, ws_size); grid = -1; return; }
        int dev = 0, cus = 0, per_cu = 0;
        if (hipGetDevice(&dev) != hipSuccess || hipDeviceGetAttribute(&cus, hipDeviceAttributeMultiprocessorCount, dev) != hipSuccess) { grid = -1; return; }
        if (hipFuncSetAttribute((const void*)mk::fwd, hipFuncAttributeMaxDynamicSharedMemorySize, mk::LDS_BYTES) != hipSuccess) { fprintf(stderr, "kernel_launch: hipFuncSetAttribute failed\n"); grid = -1; return; }
        if (hipOccupancyMaxActiveBlocksPerMultiprocessor(&per_cu, (const void*)mk::fwd, mk::NTHR, mk::LDS_BYTES) != hipSuccess || per_cu < 1) fprintf(stderr, "kernel_launch: occupancy query says %d\n", per_cu);
        (void)hipGetLastError();
        grid = cus;
    }
    if (grid < 0) return;
    (void)in_sizes;
    if (hipMemsetAsync((char*)d_ws + mk::WS_CTL, 0, mk::CTL_ZERO_BYTES, stream) != hipSuccess) return;
    mk::Args a{};
    { const void** p = (const void**)&a.in; for (int i = 0; i < 29; ++i) p[i] = d_in[i]; }
    a.out = (float*)d_out; a.ws = (unsigned char*)d_ws;
    a.pro_lo = 0; a.pro_hi = 2; a.l_lo = 0; a.l_hi = mk::DEPTH; a.ph_lo = 0; a.ph_hi = mk::PH_N; a.flags = mk::FL_XIN | mk::FL_FINAL; a.region = 0;
    hipLaunchKernelGGL(mk::fwd, dim3(grid), dim3(mk::NTHR), mk::LDS_BYTES, stream, a);
    const hipError_t le = hipPeekAtLastError();
    if (le != hipSuccess) fprintf(stderr, "kernel_launch: launch failed: %s\n", hipGetErrorName(le));
}
```

```cpp
#include <hip/hip_runtime.h>
#include <cstdio>
#include <cstdint>
#include <cmath>

namespace mk {
#define LAS __attribute__((address_space(3)))
#define GAS __attribute__((address_space(1)))
typedef unsigned short bf16_t;
typedef short bf16x8 __attribute__((ext_vector_type(8)));
typedef float f32x4 __attribute__((ext_vector_type(4)));
typedef float f32x2 __attribute__((ext_vector_type(2)));
typedef float f32x16 __attribute__((ext_vector_type(16)));
typedef unsigned u32x4 __attribute__((ext_vector_type(4)));
typedef unsigned u32x2 __attribute__((ext_vector_type(2)));
constexpr int M = 32768, D = 1024, NB = 4, SEQ = 8192, DEPTH = 4, MEML = 256, MROWS = NB * MEML;
constexpr int S5W = 512, S5G = 32, S5P = 64, RH = 4, RDK = 128, RW = 512, INW = 2560, XH = 4, XD = 256, FF = 2816;
constexpr float EPS = 1e-6f;
constexpr int BM = 256, BK = 64, HALF = 128, HTB = HALF * BK * 2, STAGE_BYTES = 8 * HTB, NXCD = 8, WGM = 8;
constexpr int NWAVES = 8, NTHR = 512;

constexpr int TAB_OFF = STAGE_BYTES;
constexpr int TAB2_OFF = TAB_OFF + 12288;
constexpr int MISC_OFF = TAB2_OFF + 2048;
constexpr int LDS_BYTES = 147456;
static_assert(MISC_OFF + 128 <= LDS_BYTES, "lds map");

constexpr size_t MiB = 1u << 20;
constexpr size_t WS_CTL = 0, CTL_ZERO_BYTES = 1 * MiB;
constexpr size_t WS_SSQ = 1 * MiB;
constexpr size_t WS_SSQS = 3 * MiB;
constexpr size_t WS_W = 4 * MiB, W_LAYER = 28 * MiB;
constexpr size_t W_IN = 0, W_GLU = 5 * MiB, W_OUT = W_GLU + MiB / 2, W_CQ = W_OUT + 2 * MiB, W_CO = W_CQ + 2 * MiB, W_GU = W_CO + 2 * MiB, W_DN = W_GU + 11 * MiB;
static_assert(W_DN + 11 * MiB / 2 == W_LAYER, "weights");
constexpr size_t WS_ROPE = 116 * MiB;
constexpr size_t WS_MEMK = 132 * MiB;
constexpr size_t WS_MEMVT = 140 * MiB;
constexpr size_t WS_S5M = 148 * MiB;
constexpr size_t WS_XB = 176 * MiB;
constexpr size_t WS_PROJ = 240 * MiB;
constexpr size_t WS_UG = WS_PROJ, WS_Q = WS_PROJ + 40 * MiB, WS_K = WS_Q + 32 * MiB, WS_V = WS_K + 32 * MiB, WS_GATE = WS_V + 32 * MiB;
constexpr size_t WS_Z = 408 * MiB;
constexpr size_t WS_YMIX = 440 * MiB;
constexpr size_t WS_SPARE = 504 * MiB;
constexpr size_t WS_QC = WS_PROJ, WS_OC = WS_PROJ + 64 * MiB, WS_HID = WS_PROJ;
constexpr size_t WS_WCK_TMP = WS_PROJ, WS_WCV_TMP = WS_PROJ + 8 * MiB, WS_MEMB = WS_PROJ + 16 * MiB;
constexpr size_t WS_END = 512 * MiB;
constexpr int CW_BAR = 4096, XB_WORDS = 3456, N_BAR_REGIONS = 64;
static_assert((CW_BAR + N_BAR_REGIONS * XB_WORDS) * 4 <= (int)CTL_ZERO_BYTES, "ctl");

__host__ __device__ __forceinline__ int lds_byte(int r, int c) { const int st = (r >> 4) * 2 + (c >> 5), rr = r & 15, cc = c & 31, ob = rr * 64 + cc * 2; return st * 1024 + (ob ^ (((ob >> 9) & 1) << 5)); }
__host__ __device__ __forceinline__ void stage_rc(int b, int& R, int& C) { const int st = b / 1024, sb = b % 1024, swz = sb ^ (((sb >> 9) & 1) << 5); R = (st >> 1) * 16 + swz / 64; C = (st & 1) * 32 + (swz % 64) / 2; }
__host__ __device__ __forceinline__ int perm32(int rho) { const int n = rho >> 4, i = rho & 15; return 8 * (i >> 2) + 4 * n + (i & 3); }

struct Unit { int pm, pn, g; };
struct Gemm { const bf16_t* A; const bf16_t* Bt; int lda, ldb, K; long a_gs, b_gs; int a_g16; int probe_same; };

struct StaticOrder {
    int nM, nN, nwg, G, c;
    __device__ __forceinline__ void init(int nM_, int nN_, int G_, int c_) { nM = nM_; nN = nN_; nwg = nM * nN; G = G_; c = c_; }
    __device__ __forceinline__ bool next(int i, Unit& u) const {
        const long L = (long)i * G + c; if (L >= nwg) return false;
        int wgid = (int)L; { const int q = nwg / NXCD, r = nwg % NXCD, xcd = wgid % NXCD, off = wgid / NXCD; wgid = (xcd < r ? xcd * (q + 1) : r * (q + 1) + (xcd - r) * q) + off; }
        const int nig = WGM * nN, gid = wgid / nig, fm = gid * WGM, gsz = (nM - fm) < WGM ? (nM - fm) : WGM;
        u.pm = fm + ((wgid % nig) % gsz); u.pn = (wgid % nig) / gsz; u.g = 0; return true;
    }
};
struct GroupOrder {
    int nM, nN, nG, G, c, first;
    __device__ __forceinline__ void init(int nG_, int nM_, int nN_, int G_, int c_, int first_) { nG = nG_; nM = nM_; nN = nN_; G = G_; c = c_; first = first_; }
    __device__ __forceinline__ bool next(int i, Unit& u) const {
        const long L = (long)i * G + c - first; if (L < 0 || L >= (long)nG * nM * nN) return false;
        u.pn = (int)(L % nN); const int r = (int)(L / nN); u.pm = r % nM; u.g = r / nM; return true;
    }
};
struct XcdGroupOrder {
    int nM, nN, nG, G, c;
    __device__ __forceinline__ void init(int nG_, int nM_, int nN_, int G_, int c_) { nG = nG_; nM = nM_; nN = nN_; G = G_; c = c_; }
    __device__ __forceinline__ bool next(int i, Unit& u) const {
        const int total = nG * nM * nN; const long L = (long)i * G + c; if (L >= total) return false;
        int id = (int)L; if (((total | G) & (NXCD - 1)) == 0) id = (id & (NXCD - 1)) * (total / NXCD) + (id >> 3);
        u.pn = id % nN; const int r = id / nN; u.pm = r % nM; u.g = r / nM; return true;
    }
};

__device__ __forceinline__ unsigned f2bf(float f) { unsigned u = __builtin_bit_cast(unsigned, f); return (u + 0x7fffu + ((u >> 16) & 1u)) >> 16; }
__device__ __forceinline__ unsigned pk2(float lo, float hi) { return f2bf(lo) | (f2bf(hi) << 16); }
__device__ __forceinline__ unsigned cvt_pk(float lo, float hi) { unsigned r; asm volatile("v_cvt_pk_bf16_f32 %0, %1, %2" : "=v"(r) : "v"(lo), "v"(hi)); return r; }
__device__ __forceinline__ float bf2f(unsigned short b) { return __builtin_bit_cast(float, ((unsigned)b) << 16); }
__device__ __forceinline__ float bflo(unsigned w) { return __builtin_bit_cast(float, w << 16); }
__device__ __forceinline__ float bfhi(unsigned w) { return __builtin_bit_cast(float, w & 0xffff0000u); }
__device__ __forceinline__ float fast_sigmoid(float x) { return __builtin_amdgcn_rcpf(1.0f + __builtin_amdgcn_exp2f(-1.4426950408889634f * x)); }
template <int O> __device__ __forceinline__ float swz_xor(float v) { return __builtin_bit_cast(float, __builtin_amdgcn_ds_swizzle(__builtin_bit_cast(int, v), (O << 10) | 0x1f)); }
__device__ __forceinline__ float row16_sum(float v) { const unsigned u = __builtin_bit_cast(unsigned, v); auto r = __builtin_amdgcn_permlane16_swap(u, u, false, false);
    return __builtin_bit_cast(float, (unsigned)r[0]) + __builtin_bit_cast(float, (unsigned)r[1]); }
__device__ __forceinline__ float half_sum(float v) { const unsigned u = __builtin_bit_cast(unsigned, v); auto r = __builtin_amdgcn_permlane32_swap(u, u, false, false);
    return __builtin_bit_cast(float, (unsigned)r[0]) + __builtin_bit_cast(float, (unsigned)r[1]); }
__device__ __forceinline__ float half_max(float v) { const unsigned u = __builtin_bit_cast(unsigned, v); auto r = __builtin_amdgcn_permlane32_swap(u, u, false, false);
    return fmaxf(__builtin_bit_cast(float, (unsigned)r[0]), __builtin_bit_cast(float, (unsigned)r[1])); }
__device__ __forceinline__ float wave_sum(float v) { v += swz_xor<1>(v); v += swz_xor<2>(v); v += swz_xor<4>(v); v += swz_xor<8>(v); v += swz_xor<16>(v); return half_sum(v); }

__device__ __forceinline__ int lane_id() { unsigned z = 0u; asm volatile("" : "+v"(z)); return (int)__builtin_amdgcn_mbcnt_hi(~0u, __builtin_amdgcn_mbcnt_lo(~0u, z)); }
struct NoPre { __device__ __forceinline__ void operator()(int) const {} };
template <class Epi, class Sched, bool HOOK = false, class Pre = NoPre>
__device__ __forceinline__ void gemm_phase(LAS unsigned char* lds, const Gemm g, const Sched& S, const Epi& E, int wid, const Pre& pre = Pre(), bool drain = true) {
    const int lane = lane_id(), tid = wid * 64 + lane, wr = wid >> 2, wc = wid & 3, fr = lane & 15, fq = lane >> 4;
    const int nt = g.K / BK;
    unsigned voffA[2], voffB[2];
#pragma unroll
    for (int i = 0; i < 2; ++i) { int R, C; stage_rc(tid * 16 + i * 8192, R, C); const int Rb = Epi::PERM ? ((R & ~31) + perm32(R & 31)) : R;
        voffA[i] = g.a_g16 ? (unsigned)(((C >> 4) * g.a_g16 + R) * 16 + (C & 15)) * 2u : (unsigned)(R * g.lda + C) * 2u; voffB[i] = (unsigned)(Rb * g.ldb + C) * 2u; }
    const size_t kstep = (size_t)(BK * 2);
    const size_t kstepA = g.a_g16 ? (size_t)g.a_g16 * 128 : kstep;
    const size_t hstepA = g.a_g16 ? (size_t)HALF * 32 : (size_t)HALF * g.lda * 2, hstepB = (size_t)HALF * g.ldb * 2;
    const unsigned ldsw = (unsigned)wid * 1024u;
    const int aoff = lds_byte(wr * 64 + fr, fq * 8), boff = lds_byte(wc * 32 + fr, fq * 8);
#define PG8_SA(b, h) (((b) * 2 + (h)) * HTB)
#define PG8_SB(b, h) ((4 + (b) * 2 + (h)) * HTB)
#define PG8_STAGE(bufoff, gbase, voff) do { _Pragma("unroll") for (int _i = 0; _i < 2; ++_i) \
        __builtin_amdgcn_global_load_lds((const unsigned*)((const char*)(gbase) + (voff)[_i]), (LAS unsigned*)(lds + (bufoff) + ldsw + _i * 8192), 16, 0, 0); } while (0)
#define PG8_LDA(dst, b, h) do { _Pragma("unroll") for (int m = 0; m < 4; ++m) _Pragma("unroll") for (int k = 0; k < 2; ++k) dst[m][k] = *(const LAS bf16x8*)(lds + PG8_SA(b, h) + aoff + m * 2048 + k * 1024); } while (0)
#define PG8_LDB(dst, b, h) do { _Pragma("unroll") for (int n = 0; n < 2; ++n) _Pragma("unroll") for (int k = 0; k < 2; ++k) dst[n][k] = *(const LAS bf16x8*)(lds + PG8_SB(b, h) + boff + n * 2048 + k * 1024); } while (0)
#define PG8_MMA(ai, bj, At, Bt) do { __builtin_amdgcn_s_setprio(1); _Pragma("unroll") for (int m = 0; m < 4; ++m) _Pragma("unroll") for (int n = 0; n < 2; ++n) _Pragma("unroll") for (int k = 0; k < 2; ++k) \
        acc[ai][bj][m][n] = __builtin_amdgcn_mfma_f32_16x16x32_bf16(Bt[n][k], At[m][k], acc[ai][bj][m][n], 0, 0, 0); __builtin_amdgcn_s_setprio(0); } while (0)
#define PG8_WAIT_V(n) asm volatile("s_waitcnt vmcnt(" #n ")" ::: "memory")
#define PG8_WAIT_L(n) asm volatile("s_waitcnt lgkmcnt(" #n ")" ::: "memory")
#define PG8_BAR __builtin_amdgcn_s_barrier()
#define PG8_SCHED __builtin_amdgcn_sched_barrier(0)
#define PG8_ABASE(u) ((const char*)g.A + ((size_t)(u).g * g.a_gs + (size_t)(g.probe_same ? 0 : (u).pm) * BM * (g.a_g16 ? 16 : g.lda)) * 2)
#define PG8_BBASE(u) ((const char*)g.Bt + ((size_t)(u).g * g.b_gs + (size_t)(g.probe_same ? 0 : (u).pn) * BM * g.ldb) * 2)
    Unit cur, nxt; int ui = 0;
    if (!S.next(0, cur)) return;
    f32x4 acc[2][2][4][2];
#pragma unroll
    for (int a = 0; a < 2; ++a)
#pragma unroll
        for (int b = 0; b < 2; ++b)
#pragma unroll
            for (int m = 0; m < 4; ++m)
#pragma unroll
                for (int n = 0; n < 2; ++n) acc[a][b][m][n] = (f32x4){0.f, 0.f, 0.f, 0.f};
    bf16x8 At[4][2], B0[2][2], B1[2][2];
    const char* cA = PG8_ABASE(cur); const char* cB = PG8_BBASE(cur);
    PG8_STAGE(PG8_SB(0, 0), cB, voffB); PG8_STAGE(PG8_SB(0, 1), cB + hstepB, voffB); PG8_STAGE(PG8_SA(0, 0), cA, voffA); PG8_STAGE(PG8_SA(0, 1), cA + hstepA, voffA);
    pre(wid);
    if (wr == 1) PG8_BAR;
    PG8_WAIT_V(2); PG8_BAR;
    PG8_STAGE(PG8_SB(1, 0), cB + kstep, voffB); PG8_STAGE(PG8_SA(1, 0), cA + kstepA, voffA); PG8_STAGE(PG8_SB(1, 1), cB + hstepB + kstep, voffB);
    PG8_WAIT_V(6); PG8_BAR;
    for (;;) {
        const bool has_next = S.next(ui + 1, nxt);
        const char* nA = has_next ? PG8_ABASE(nxt) : cA; const char* nB = has_next ? PG8_BBASE(nxt) : cB;
#if defined(PROBE_DUP) && PROBE_DUP >= 320 && PROBE_DUP < 330
        if (PROBE_DUP == Epi::PROBE_ID + 20) {
            for (int t = 0; t < nt; t += 2) {
                const bool last = (t == nt - 2);
                const char* a1 = cA + (size_t)(t + 1) * kstepA;
                const char* a2 = last ? cA : cA + (size_t)(t + 2) * kstepA; const char* b2 = last ? cB : cB + (size_t)(t + 2) * kstep;
                const char* a3 = a2 + kstepA; const char* b3 = b2 + kstep;
                PG8_LDB(B0, 0, 0); PG8_LDB(B1, 0, 1); PG8_SCHED; PG8_LDA(At, 0, 0); PG8_STAGE(PG8_SA(1, 1), a1 + hstepA, voffA);
                PG8_WAIT_V(8); PG8_WAIT_L(0); PG8_BAR; PG8_MMA(0, 0, At, B0); PG8_MMA(0, 1, At, B1); PG8_BAR; PG8_SCHED;
                PG8_LDA(At, 0, 1); PG8_STAGE(PG8_SB(0, 0), b2, voffB); PG8_STAGE(PG8_SB(0, 1), b2 + hstepB, voffB); PG8_STAGE(PG8_SA(0, 0), a2, voffA);
                PG8_WAIT_V(8); PG8_WAIT_L(0); PG8_BAR; PG8_MMA(1, 0, At, B0); PG8_MMA(1, 1, At, B1); PG8_BAR; PG8_SCHED;
                PG8_LDB(B0, 1, 0); PG8_LDB(B1, 1, 1); PG8_SCHED; PG8_LDA(At, 1, 0); PG8_STAGE(PG8_SA(0, 1), a2 + hstepA, voffA);
                PG8_WAIT_V(8); PG8_WAIT_L(0); PG8_BAR; PG8_MMA(0, 0, At, B0); PG8_MMA(0, 1, At, B1); PG8_BAR; PG8_SCHED;
                PG8_LDA(At, 1, 1); PG8_STAGE(PG8_SB(1, 0), b3, voffB); PG8_STAGE(PG8_SB(1, 1), b3 + hstepB, voffB); PG8_STAGE(PG8_SA(1, 0), a3, voffA);
                PG8_WAIT_V(8); PG8_WAIT_L(0); PG8_BAR; PG8_MMA(1, 0, At, B0); PG8_MMA(1, 1, At, B1); PG8_BAR; PG8_SCHED;
            }
#pragma unroll
            for (int a = 0; a < 2; ++a)
#pragma unroll
                for (int b = 0; b < 2; ++b)
#pragma unroll
                    for (int m = 0; m < 4; ++m)
#pragma unroll
                        for (int n = 0; n < 2; ++n) { asm volatile("" : "+v"(acc[a][b][m][n])); acc[a][b][m][n] = (f32x4){0.f, 0.f, 0.f, 0.f}; }
        }
#endif
        for (int t = 0; t < nt; t += 2) {
            const bool last = (t == nt - 2);
            const char* a1 = cA + (size_t)(t + 1) * kstepA;
            const char* a2 = last ? nA : cA + (size_t)(t + 2) * kstepA; const char* b2 = last ? nB : cB + (size_t)(t + 2) * kstep;
            const char* a3 = a2 + kstepA; const char* b3 = b2 + kstep;
            if constexpr (HOOK) { if (t == E.hook_t) E.hook(acc, ui, wr, fr); }
            PG8_LDB(B0, 0, 0); PG8_LDB(B1, 0, 1); PG8_SCHED; PG8_LDA(At, 0, 0); PG8_STAGE(PG8_SA(1, 1), a1 + hstepA, voffA);
            PG8_WAIT_V(8); PG8_WAIT_L(0); PG8_BAR; PG8_MMA(0, 0, At, B0); PG8_MMA(0, 1, At, B1); PG8_BAR; PG8_SCHED;
            PG8_LDA(At, 0, 1); PG8_STAGE(PG8_SB(0, 0), b2, voffB); PG8_STAGE(PG8_SB(0, 1), b2 + hstepB, voffB); PG8_STAGE(PG8_SA(0, 0), a2, voffA);
            PG8_WAIT_V(8); PG8_WAIT_L(0); PG8_BAR; PG8_MMA(1, 0, At, B0); PG8_MMA(1, 1, At, B1); PG8_BAR; PG8_SCHED;
            PG8_LDB(B0, 1, 0); PG8_LDB(B1, 1, 1); PG8_SCHED; PG8_LDA(At, 1, 0); PG8_STAGE(PG8_SA(0, 1), a2 + hstepA, voffA);
            PG8_WAIT_V(8); PG8_WAIT_L(0); PG8_BAR; PG8_MMA(0, 0, At, B0); PG8_MMA(0, 1, At, B1); PG8_BAR; PG8_SCHED;
            PG8_LDA(At, 1, 1); PG8_STAGE(PG8_SB(1, 0), b3, voffB); PG8_STAGE(PG8_SB(1, 1), b3 + hstepB, voffB); PG8_STAGE(PG8_SA(1, 0), a3, voffA);
            PG8_WAIT_V(8); PG8_WAIT_L(0); PG8_BAR; PG8_MMA(1, 0, At, B0); PG8_MMA(1, 1, At, B1); PG8_BAR; PG8_SCHED;
        }
#ifndef NO_ALIGN_EPI
        if (wr == 0) PG8_BAR;
#endif
#if defined(PROBE_DUP) && PROBE_DUP >= 300 && PROBE_DUP < 310
        if (PROBE_DUP == 300 || PROBE_DUP == Epi::PROBE_ID) E.probe(acc, cur, ui, wr, wc, fr, fq);
#endif
        E(acc, cur, ui, wr, wc, fr, fq);
        if (!has_next) break;
#pragma unroll
        for (int a = 0; a < 2; ++a)
#pragma unroll
            for (int b = 0; b < 2; ++b)
#pragma unroll
                for (int m = 0; m < 4; ++m)
#pragma unroll
                    for (int n = 0; n < 2; ++n) acc[a][b][m][n] = (f32x4){0.f, 0.f, 0.f, 0.f};
        cur = nxt; cA = nA; cB = nB; ++ui;
#ifndef NO_ALIGN_EPI
        if (wr == 1) PG8_BAR;
#endif
    }
    if (drain) PG8_WAIT_V(0); else PG8_WAIT_V(16);
#ifdef NO_ALIGN_EPI
    if (wr == 0) PG8_BAR;
#endif
    PG8_BAR;
#undef PG8_SA
#undef PG8_SB
#undef PG8_STAGE
#undef PG8_LDA
#undef PG8_LDB
#undef PG8_MMA
#undef PG8_WAIT_V
#undef PG8_WAIT_L
#undef PG8_BAR
#undef PG8_SCHED
#undef PG8_ABASE
#undef PG8_BBASE
}
typedef GAS unsigned gu32;
#define VM_WAIT() asm volatile("s_waitcnt vmcnt(0)" ::: "memory")
#define LDS_WAIT() asm volatile("s_waitcnt lgkmcnt(0)" ::: "memory")
#define XB_TMO      128
#define XB_XCNT(j)  (256  + 64 * (j))
#define XB_XSUB(j)  (1280 + 64 * (j))
#define XB_XGEN(j)  (2304 + 64 * (j))
#define XB_TOP      3328
#define XB_TOPGEN   3392
#define XCD_BAR_WORDS 3456
#define XB_SPIN_CAP (1u << 18)

__device__ __forceinline__ unsigned xb_ld(unsigned* p)              { return __hip_atomic_load(p, __ATOMIC_RELAXED, __HIP_MEMORY_SCOPE_AGENT); }
__device__ __forceinline__ unsigned xb_add(unsigned* p, unsigned v) { return __hip_atomic_fetch_add(p, v, __ATOMIC_RELAXED, __HIP_MEMORY_SCOPE_AGENT); }
__device__ __forceinline__ unsigned xb_xcc_id() { return (unsigned)__builtin_amdgcn_s_getreg((3 << 11) | 20) & 0xFu; }
#define XB_SPIN(cond, bar) do { unsigned _sp = 0; while (cond) { __builtin_amdgcn_s_sleep(1); \
    if ((++_sp & 255u) == 0u) { if (xb_ld(&(bar)[XB_TMO])) break; if (_sp > XB_SPIN_CAP) { atomicAdd(&(bar)[XB_TMO], 1u); break; } } } } while (0)

struct XcdBarrier {
    unsigned* bar; unsigned x;
    bool t0; volatile LAS unsigned* st;
};

__device__ __forceinline__ XcdBarrier xcd_barrier_post(unsigned* bar, volatile LAS unsigned* st, bool t0) {
    XcdBarrier b; b.bar = bar; b.x = xb_xcc_id(); b.st = st; b.t0 = t0;
    if (t0) (void)xb_add(&bar[XB_XCNT(b.x)], 1u);
    return b;
}
__device__ __forceinline__ void xcd_barrier_complete(unsigned* bar, unsigned x, unsigned& nloc, unsigned& nx) {
    const unsigned G = gridDim.x * gridDim.y * gridDim.z;
    unsigned sum, cnt, mine, sp = 0u;
    for (;;) {
        sum = 0u; cnt = 0u; mine = 0u;
#pragma unroll
        for (unsigned j = 0; j < 16; ++j) { const unsigned c = xb_ld(&bar[XB_XCNT(j)]); sum += c; cnt += (c > 0u) ? 1u : 0u; mine = (j == x) ? c : mine; }
        if (sum == G) break;
        __builtin_amdgcn_s_sleep(1);
        if ((++sp & 255u) == 0u) { if (xb_ld(&bar[XB_TMO])) break; if (sp > XB_SPIN_CAP) { atomicAdd(&bar[XB_TMO], 1u); break; } }
    }
    nloc = mine > 0u ? mine : 1u; nx = cnt > 0u ? cnt : 1u;
}

template <bool FENCES = true> __device__ __forceinline__ void xcd_barrier(const XcdBarrier& b) {
    asm volatile("s_waitcnt vmcnt(0)" ::: "memory");
    __syncthreads();
    if (b.t0) {
        unsigned* bar = b.bar;
        __builtin_amdgcn_s_waitcnt(0);
        unsigned nloc = b.st[0], nx = b.st[1];
        if (nloc == 0u) { xcd_barrier_complete(bar, b.x, nloc, nx); b.st[0] = nloc; b.st[1] = nx; }
        const unsigned old = xb_add(&bar[XB_XSUB(b.x)], 1u);
        const unsigned gen = old / nloc;
        if (old + 1u == (gen + 1u) * nloc) {
            if (FENCES) __builtin_amdgcn_fence(__ATOMIC_RELEASE, "agent");
            asm volatile("s_waitcnt vmcnt(0)" ::: "memory");
            const unsigned og = xb_add(&bar[XB_TOP], 1u);
            const unsigned tg = og / nx;
            if (og + 1u == (tg + 1u) * nx) xb_add(&bar[XB_TOPGEN], 1u);
            else XB_SPIN(xb_ld(&bar[XB_TOPGEN]) == tg, bar);
            if (FENCES) __builtin_amdgcn_fence(__ATOMIC_ACQUIRE, "agent");
            xb_add(&bar[XB_XGEN(b.x)], 1u);
            asm volatile("s_waitcnt vmcnt(0)" ::: "memory");
        } else {
            XB_SPIN(xb_ld(&bar[XB_XGEN(b.x)]) == gen, bar);
            if (FENCES) __builtin_amdgcn_fence(__ATOMIC_ACQUIRE, "agent");
            asm volatile("s_waitcnt vmcnt(0)" ::: "memory");
        }
    }
    __syncthreads();
}
template <int MAPK>
__device__ __forceinline__ void tr_item(const float* W, int K, int N, bf16_t* WT, const float* gain, int gain_lim, float scale, LAS float* scr, int item, int lane) {
    const int nblk = N / 32, kb = item / nblk, nb = item % nblk, k0 = 64 * kb, n0 = 32 * nb;
    float cs = scale;
    if (MAPK == 1) { if (n0 >= 1024 && n0 < 1536) cs *= 0.08838834764831845f; }
    const float* wp = W + (size_t)(k0 + (lane >> 5)) * N + n0 + (lane & 31);
    float w[32];
#pragma unroll
    for (int i = 0; i < 32; ++i) w[i] = wp[(size_t)(2 * i) * N];
    const int c = lane & 7;
    f32x4 g0 = {cs, cs, cs, cs}, g1 = g0;
    if (k0 < gain_lim) { g0 = *(const GAS f32x4*)(gain + k0 + 8 * c) * cs; g1 = *(const GAS f32x4*)(gain + k0 + 8 * c + 4) * cs; }
#pragma unroll
    for (int i = 0; i < 32; ++i) scr[(2 * i + (lane >> 5)) * 33 + (lane & 31)] = w[i];
    LDS_WAIT(); asm volatile("" ::: "memory");
#pragma unroll
    for (int j = 0; j < 4; ++j) { const int nl = (lane >> 3) + 8 * j, n = n0 + nl; const LAS float* s = scr + (8 * c) * 33 + nl;
        int nr = n;
        if (MAPK == 1) { if (n >= 512 && n < 1536) { const int jj = n - 512, blk = jj >> 7, e = jj & 127; nr = 512 + blk * 128 + 2 * (e & 63) + (e >> 6); } }
        if (MAPK == 2) nr = (n >> 7) * 256 + (n & 127);
        if (MAPK == 3) nr = (n >> 7) * 256 + 128 + (n & 127);
        u32x4 o; o.x = pk2(s[0 * 33] * g0.x, s[1 * 33] * g0.y); o.y = pk2(s[2 * 33] * g0.z, s[3 * 33] * g0.w); o.z = pk2(s[4 * 33] * g1.x, s[5 * 33] * g1.y); o.w = pk2(s[6 * 33] * g1.z, s[7 * 33] * g1.w);
        *(GAS u32x4*)(WT + (size_t)nr * K + k0 + 8 * c) = o; }
    LDS_WAIT(); asm volatile("" ::: "memory");
}
struct In {
    const float *x, *mem; const int* pos; const float *norm_mix, *w_in, *lre, *lim, *lstep, *bre, *bim, *cre, *cim, *s5d, *wglu, *bglu, *s5n, *retn, *w_out, *norm_cross, *norm_mem,
        *w_cq, *w_ck, *w_cv, *w_co, *norm_ffn, *w_gate, *w_up, *w_down, *norm_final;
};
__device__ __forceinline__ bf16_t* wl(unsigned char* ws, int l, size_t off) { return (bf16_t*)(ws + WS_W + (size_t)l * W_LAYER + off); }

__device__ __forceinline__ void pro_weights(const In& in, unsigned char* ws, LAS unsigned char* lds, int gw, int NGW, int wave, int lane) {
    LAS float* scr = (LAS float*)(lds + wave * 16384);
    constexpr int I_IN = 16 * 80, I_GLU = 8 * 16, I_SQ = 16 * 32, I_GU = 16 * 88, I_DN = 44 * 32;
    constexpr int PER_L = I_IN + I_GLU + 5 * I_SQ + 2 * I_GU + I_DN;
    static_assert(PER_L == 8192, "items");
    for (int it = gw; it < DEPTH * PER_L; it += NGW) {
        const int l = it / PER_L; int r = it % PER_L;
        if (r < I_IN) { tr_item<1>(in.w_in + (size_t)l * D * INW, D, INW, wl(ws, l, W_IN), in.norm_mix + l * D, D, 1.0f, scr, r, lane); continue; } r -= I_IN;
        if (r < I_GLU) { tr_item<0>(in.wglu + (size_t)l * S5W * S5W, S5W, S5W, wl(ws, l, W_GLU), nullptr, 0, 1.0f, scr, r, lane); continue; } r -= I_GLU;
        if (r < I_SQ) { tr_item<0>(in.w_out + (size_t)l * D * D, D, D, wl(ws, l, W_OUT), in.s5n + l * S5W, S5W, 1.0f, scr, r, lane); continue; } r -= I_SQ;
        if (r < I_SQ) { tr_item<0>(in.w_cq + (size_t)l * D * D, D, D, wl(ws, l, W_CQ), in.norm_cross + l * D, D, 0.0625f * 1.4426950408889634f, scr, r, lane); continue; } r -= I_SQ;
        if (r < I_SQ) { tr_item<0>(in.w_co + (size_t)l * D * D, D, D, wl(ws, l, W_CO), nullptr, 0, 1.0f, scr, r, lane); continue; } r -= I_SQ;
        if (r < I_SQ) { tr_item<0>(in.w_ck + (size_t)l * D * D, D, D, (bf16_t*)(ws + WS_WCK_TMP) + (size_t)l * D * D, in.norm_mem + l * D, D, 1.0f, scr, r, lane); continue; } r -= I_SQ;
        if (r < I_SQ) { tr_item<0>(in.w_cv + (size_t)l * D * D, D, D, (bf16_t*)(ws + WS_WCV_TMP) + (size_t)l * D * D, in.norm_mem + l * D, D, 1.0f, scr, r, lane); continue; } r -= I_SQ;
        if (r < I_GU) { tr_item<2>(in.w_gate + (size_t)l * D * FF, D, FF, wl(ws, l, W_GU), in.norm_ffn + l * D, D, 1.0f, scr, r, lane); continue; } r -= I_GU;
        if (r < I_GU) { tr_item<3>(in.w_up + (size_t)l * D * FF, D, FF, wl(ws, l, W_GU), in.norm_ffn + l * D, D, 1.0f, scr, r, lane); continue; } r -= I_GU;
        tr_item<0>(in.w_down + (size_t)l * FF * D, FF, D, wl(ws, l, W_DN), nullptr, 0, 1.0f, scr, r, lane);
    }
}
__device__ __forceinline__ void xprep_rows(const float* src, bf16_t* xb, float* ssq, int gw, int NGW, int lane) {
    for (int m = gw; m < M; m += NGW) {
        const GAS f32x4* xr = (const GAS f32x4*)(src + (size_t)m * D) + lane;
        f32x4 v[4]; float s = 0.f;
#pragma unroll
        for (int j = 0; j < 4; ++j) { v[j] = xr[64 * j]; s += (v[j].x * v[j].x + v[j].y * v[j].y) + (v[j].z * v[j].z + v[j].w * v[j].w); }
        const float tot = wave_sum(s);
        GAS u32x2* o8 = (GAS u32x2*)(xb + (size_t)m * D) + lane;
#pragma unroll
        for (int j = 0; j < 4; ++j) { u32x2 w; w.x = pk2(v[j].x, v[j].y); w.y = pk2(v[j].z, v[j].w); o8[64 * j] = w; }
        if (lane < 16) ssq[(size_t)m * 16 + lane] = (lane == 0) ? tot : 0.f;
    }
}
__device__ __forceinline__ void final_norm_rows(const bf16_t* xb, float* out, const float* g, int gw, int NGW, int lane) {
    f32x4 gv[4];
#pragma unroll
    for (int j = 0; j < 4; ++j) gv[j] = ((const GAS f32x4*)g)[lane + 64 * j];
    for (int m = gw; m < M; m += NGW) {
        const GAS u32x2* xr = (const GAS u32x2*)(xb + (size_t)m * D) + lane;
        f32x4 v[4]; float s = 0.f;
#pragma unroll
        for (int j = 0; j < 4; ++j) { const u32x2 w = xr[64 * j]; v[j] = (f32x4){bflo(w.x), bfhi(w.x), bflo(w.y), bfhi(w.y)}; s += (v[j].x * v[j].x + v[j].y * v[j].y) + (v[j].z * v[j].z + v[j].w * v[j].w); }
        const float r = 1.0f / sqrtf(wave_sum(s) * (1.0f / D) + EPS);
        GAS f32x4* o = (GAS f32x4*)(out + (size_t)m * D) + lane;
#pragma unroll
        for (int j = 0; j < 4; ++j) o[64 * j] = v[j] * r * gv[j];
    }
}
template <class Sched>
struct RstdPre {
    LAS float* tab; const Sched* S; const float* ssq; int nslots; float inv_n;
    __device__ __forceinline__ void operator()(int wave) const {
        if (wave < 4) { Unit u; const int t = wave * 64 + lane_id(); int prev_pm = -1;
            for (int i = 0; S->next(i, u); ++i) {
                if (u.pm == prev_pm) tab[i * 256 + t] = tab[(i - 1) * 256 + t];
                else { const float* p = ssq + (size_t)(u.pm * 256 + t) * nslots; float s = 0.f;
                    for (int j = 0; j < nslots; j += 4) { const f32x4 v = *(const GAS f32x4*)(p + j); s += (v.x + v.y) + (v.z + v.w); }
                    tab[i * 256 + t] = 1.0f / sqrtf(s * inv_n + EPS); }
                prev_pm = u.pm; } }
    }
};

struct EpiFfn1 {
    static constexpr int PROBE_ID = 302; static constexpr bool PERM = true;
    bf16_t* H; LAS const float* tab;
    __device__ __forceinline__ void probe(const f32x4 (&acc)[2][2][4][2], const Unit& u, int ui, int wr, int wc, int fr, int fq) const { (*this)(acc, u, ui, wr, wc, fr, fq); }
    __device__ __forceinline__ void operator()(const f32x4 (&acc)[2][2][4][2], const Unit& u, int ui, int wr, int wc, int fr, int fq) const {
        asm volatile("" : "+v"(fr), "+v"(fq));
#pragma unroll
        for (int ai = 0; ai < 2; ++ai)
#pragma unroll
            for (int m = 0; m < 4; ++m) { const int rl = ai * HALF + wr * 64 + m * 16 + fr; const float rs = tab[ui * 256 + rl], k1 = -1.4426950408889634f * rs, rs2 = rs * rs;
                float h[8];
#pragma unroll
                for (int n = 0; n < 2; ++n)
#pragma unroll
                    for (int j = 0; j < 4; ++j) { const float ag = acc[ai][0][m][n][j], au = acc[ai][1][m][n][j]; h[4 * n + j] = (ag * au) * (rs2 * __builtin_amdgcn_rcpf(1.0f + __builtin_amdgcn_exp2f(ag * k1))); }
                u32x4 w; w.x = cvt_pk(h[0], h[1]); w.y = cvt_pk(h[2], h[3]); w.z = cvt_pk(h[4], h[5]); w.w = cvt_pk(h[6], h[7]);
                *(GAS u32x4*)(H + (size_t)(u.pm * BM + rl) * FF + u.pn * 128 + wc * 32 + 8 * fq) = w; }
    }
};
struct EpiRes {
    static constexpr int PROBE_ID = 307; static constexpr bool PERM = true;
    bf16_t* xb; float* ssq; float* fout; float scale; LAS float* sst;
    __device__ __forceinline__ void probe(const f32x4 (&acc)[2][2][4][2], const Unit& u, int ui, int wr, int wc, int fr, int fq) const { EpiRes t = *this; t.scale = 0.f; t(acc, u, ui, wr, wc, fr, fq); }
    __device__ __forceinline__ void operator()(const f32x4 (&acc)[2][2][4][2], const Unit& u, int ui, int wr, int wc, int fr, int fq) const {
        asm volatile("" : "+v"(fr), "+v"(fq));
        u32x4 xv[4][2][2];
#define ER_LOAD(b) do { _Pragma("unroll") for (int mm = 0; mm < 2; ++mm) _Pragma("unroll") for (int bj = 0; bj < 2; ++bj) \
            xv[b][mm][bj] = *(const GAS u32x4*)(xb + (size_t)(u.pm * BM + ((b) >> 1) * HALF + wr * 64 + (2 * ((b) & 1) + mm) * 16 + fr) * D + u.pn * BM + bj * HALF + wc * 32 + 8 * fq); } while (0)
#define ER_COMP(b) do { const int ai = (b) >> 1; _Pragma("unroll") for (int mm = 0; mm < 2; ++mm) { const int m = 2 * ((b) & 1) + mm; const int row = u.pm * BM + ai * HALF + wr * 64 + m * 16 + fr; float ps = 0.f; \
            _Pragma("unroll") for (int bj = 0; bj < 2; ++bj) { const size_t off = (size_t)row * D + u.pn * BM + bj * HALF + wc * 32 + 8 * fq; const u32x4 xw = xv[b][mm][bj]; f32x4 v0, v1; \
                v0.x = bflo(xw.x) + acc[ai][bj][m][0].x * scale; v0.y = bfhi(xw.x) + acc[ai][bj][m][0].y * scale; v0.z = bflo(xw.y) + acc[ai][bj][m][0].z * scale; v0.w = bfhi(xw.y) + acc[ai][bj][m][0].w * scale; \
                v1.x = bflo(xw.z) + acc[ai][bj][m][1].x * scale; v1.y = bfhi(xw.z) + acc[ai][bj][m][1].y * scale; v1.z = bflo(xw.w) + acc[ai][bj][m][1].z * scale; v1.w = bfhi(xw.w) + acc[ai][bj][m][1].w * scale; \
                if (fout) { *(GAS f32x4*)(fout + off) = v0; *(GAS f32x4*)(fout + off + 4) = v1; } \
                u32x4 w; w.x = cvt_pk(v0.x, v0.y); w.y = cvt_pk(v0.z, v0.w); w.z = cvt_pk(v1.x, v1.y); w.w = cvt_pk(v1.z, v1.w); \
                *(GAS u32x4*)(xb + off) = w; \
                ps += (v0.x * v0.x + v0.y * v0.y) + (v0.z * v0.z + v0.w * v0.w) + (v1.x * v1.x + v1.y * v1.y) + (v1.z * v1.z + v1.w * v1.w); } \
            ps = row16_sum(ps); ps = half_sum(ps); \
            if (fq == 0) sst[(ai * HALF + wr * 64 + m * 16 + fr) * 4 + wc] = ps; } } while (0)
        ER_LOAD(0); ER_LOAD(1); asm volatile("" ::: "memory");
        ER_COMP(0); ER_LOAD(2); asm volatile("" ::: "memory");
        ER_COMP(1); ER_LOAD(3); asm volatile("" ::: "memory");
        ER_COMP(2); asm volatile("" ::: "memory");
        ER_COMP(3);
#undef ER_LOAD
#undef ER_COMP
        asm volatile("s_waitcnt lgkmcnt(0)" ::: "memory"); __builtin_amdgcn_s_barrier(); asm volatile("" ::: "memory");
        { const int t = (wr * 4 + wc) * 64 + fq * 16 + fr; if (t < 256) *(GAS f32x4*)(ssq + (size_t)(u.pm * BM + t) * 16 + u.pn * 4) = *(LAS const f32x4*)(sst + t * 4); }
    }
};
struct EpiScaleBf16 {
    static constexpr int PROBE_ID = 303; static constexpr bool PERM = true;
    bf16_t* O; int ldo; LAS const float* tab;
    __device__ __forceinline__ void probe(const f32x4 (&acc)[2][2][4][2], const Unit& u, int ui, int wr, int wc, int fr, int fq) const { (*this)(acc, u, ui, wr, wc, fr, fq); }
    __device__ __forceinline__ void operator()(const f32x4 (&acc)[2][2][4][2], const Unit& u, int ui, int wr, int wc, int fr, int fq) const {
        asm volatile("" : "+v"(fr), "+v"(fq));
#pragma unroll
        for (int ai = 0; ai < 2; ++ai)
#pragma unroll
            for (int m = 0; m < 4; ++m) { const int rl = ai * HALF + wr * 64 + m * 16 + fr; const float rs = tab[ui * 256 + rl];
#pragma unroll
                for (int bj = 0; bj < 2; ++bj) { const f32x4 v0 = acc[ai][bj][m][0] * rs, v1 = acc[ai][bj][m][1] * rs;
                    u32x4 w; w.x = cvt_pk(v0.x, v0.y); w.y = cvt_pk(v0.z, v0.w); w.z = cvt_pk(v1.x, v1.y); w.w = cvt_pk(v1.z, v1.w);
                    *(GAS u32x4*)(O + (size_t)(u.pm * BM + rl) * ldo + u.pn * BM + bj * HALF + wc * 32 + 8 * fq) = w; } }
    }
};
struct EpiMemK {
    static constexpr int PROBE_ID = 309; static constexpr bool PERM = true;
    bf16_t* O; const float* rsm;
    __device__ __forceinline__ void probe(const f32x4 (&acc)[2][2][4][2], const Unit& u, int ui, int wr, int wc, int fr, int fq) const { (*this)(acc, u, ui, wr, wc, fr, fq); }
    __device__ __forceinline__ void operator()(const f32x4 (&acc)[2][2][4][2], const Unit& u, int ui, int wr, int wc, int fr, int fq) const {
        asm volatile("" : "+v"(fr), "+v"(fq));
#pragma unroll
        for (int ai = 0; ai < 2; ++ai)
#pragma unroll
            for (int m = 0; m < 4; ++m) { const int row = u.pm * BM + ai * HALF + wr * 64 + m * 16 + fr; const float rs = rsm[row];
#pragma unroll
                for (int bj = 0; bj < 2; ++bj) { const f32x4 v0 = acc[ai][bj][m][0] * rs, v1 = acc[ai][bj][m][1] * rs;
                    u32x4 w; w.x = cvt_pk(v0.x, v0.y); w.y = cvt_pk(v0.z, v0.w); w.z = cvt_pk(v1.x, v1.y); w.w = cvt_pk(v1.z, v1.w);
                    *(GAS u32x4*)(O + ((size_t)u.g * MROWS + row) * D + u.pn * BM + bj * HALF + wc * 32 + 8 * fq) = w; } }
    }
};
struct EpiMemVT {
    static constexpr int PROBE_ID = 309; static constexpr bool PERM = true;
    bf16_t* O; const float* rsm;
    __device__ __forceinline__ void probe(const f32x4 (&acc)[2][2][4][2], const Unit& u, int ui, int wr, int wc, int fr, int fq) const { (*this)(acc, u, ui, wr, wc, fr, fq); }
    __device__ __forceinline__ void operator()(const f32x4 (&acc)[2][2][4][2], const Unit& u, int ui, int wr, int wc, int fr, int fq) const {
        asm volatile("" : "+v"(fr), "+v"(fq));
#pragma unroll
        for (int bj = 0; bj < 2; ++bj) { const int c0 = u.pn * BM + bj * HALF + wc * 32 + 8 * fq;
            const f32x4 r0 = *(const GAS f32x4*)(rsm + c0), r1 = *(const GAS f32x4*)(rsm + c0 + 4);
            const int p0 = (c0 & ~15) + 4 * ((c0 >> 3) & 1), p1 = p0 + 8;
#pragma unroll
            for (int ai = 0; ai < 2; ++ai)
#pragma unroll
                for (int m = 0; m < 4; ++m) { const int row = u.pm * BM + ai * HALF + wr * 64 + m * 16 + fr;
                    const f32x4 v0 = acc[ai][bj][m][0] * r0, v1 = acc[ai][bj][m][1] * r1;
                    bf16_t* o = O + ((size_t)u.g * D + row) * MROWS;
                    u32x2 w0, w1; w0.x = cvt_pk(v0.x, v0.y); w0.y = cvt_pk(v0.z, v0.w); w1.x = cvt_pk(v1.x, v1.y); w1.y = cvt_pk(v1.z, v1.w);
                    *(GAS u32x2*)(o + p0) = w0; *(GAS u32x2*)(o + p1) = w1; } }
    }
};

__device__ __forceinline__ void xa_fill(LAS unsigned char* lds, const bf16_t* src  , int wave, int lane) {
#pragma unroll 1
    for (int j = 0; j < 16; ++j) { const int p = wave * 16 + j, row = 2 * p + (lane >> 5), ch = (lane & 31) ^ (row & 15);
        __builtin_amdgcn_global_load_lds((const unsigned*)((const char*)src + (size_t)row * 2048 + ch * 16), (LAS unsigned*)(lds + p * 1024), 16, 0, 0); }
}
#define XA_RD(f, addr) asm volatile("ds_read_b128 %0, %4\n\tds_read_b128 %1, %4 offset:16384\n\tds_read_b128 %2, %4 offset:32768\n\tds_read_b128 %3, %4 offset:49152" \
        : "=&v"(f[0]), "=&v"(f[1]), "=&v"(f[2]), "=&v"(f[3]) : "v"(addr) : "memory")
#define XA_WAIT(n, f) asm volatile("s_waitcnt lgkmcnt(" #n ")" : "+v"(f[0]), "+v"(f[1]), "+v"(f[2]), "+v"(f[3]) :: "memory")
__device__ __forceinline__ void xa_mma(f32x16 (&acc)[8], const bf16x8 (&bf)[16], LAS const unsigned char* lds, int r, int hh) {
    const int a = (r >> 1) & 7, b = hh ^ (r & 1); const unsigned base = (unsigned)(size_t)(lds + r * 512 + b * 16);
    bf16x8 fa[4], fb[4];
    { const unsigned p0 = base + ((unsigned)a << 5); XA_RD(fa, p0); const unsigned p1 = p0 + 65536u; XA_RD(fb, p1); }
#pragma unroll
    for (int s = 0; s < 16; ++s) {
        const unsigned pn = base + (unsigned)((((s + 1) & 8) | (((s + 1) & 7) ^ a)) << 5);
        XA_WAIT(4, fa);
#pragma unroll
        for (int i = 0; i < 4; ++i) acc[i] = __builtin_amdgcn_mfma_f32_32x32x16_bf16(fa[i], bf[s], acc[i], 0, 0, 0);
#pragma unroll
        for (int i = 0; i < 4; ++i) asm volatile("" : "+v"(acc[i]));
        if (s < 15) { XA_RD(fa, pn); XA_WAIT(4, fb); } else XA_WAIT(0, fb);
#pragma unroll
        for (int i = 0; i < 4; ++i) acc[4 + i] = __builtin_amdgcn_mfma_f32_32x32x16_bf16(fb[i], bf[s], acc[4 + i], 0, 0, 0);
#pragma unroll
        for (int i = 0; i < 4; ++i) asm volatile("" : "+v"(acc[4 + i]));
        if (s < 15) { const unsigned pn1 = pn + 65536u; XA_RD(fb, pn1); }
    }
}
__device__ __forceinline__ void xattn_unit(LAS unsigned char* lds, const bf16_t* QC, const bf16_t* Kl, const bf16_t* VTl, bf16_t* OC, int b, int h, int qt, int wave) {
    {
        const size_t qrow0 = (size_t)b * SEQ + qt * 256 + wave * 32;
        bf16x8 bq[16];
        { const int lane = lane_id(), r = lane & 31, hh = lane >> 5; const GAS bf16x8* qp = (const GAS bf16x8*)(QC + (qrow0 + r) * D + h * XD + 8 * hh);
#pragma unroll
          for (int s = 0; s < 16; ++s) bq[s] = qp[2 * s]; }
        xa_fill(lds, Kl + (size_t)b * MEML * D + h * XD, wave, lane_id());
        VM_WAIT(); __syncthreads();
#if defined(PROBE_DUP) && PROBE_DUP == 71
        xa_fill(lds, Kl + (size_t)b * MEML * D + h * XD, wave, lane_id());
        VM_WAIT(); __syncthreads();
#endif
        f32x16 acc[8];
#pragma unroll
        for (int k = 0; k < 8; ++k)
#pragma unroll
            for (int j = 0; j < 16; ++j) acc[k][j] = 0.f;
        { const int lane = lane_id(); xa_mma(acc, bq, lds, lane & 31, lane >> 5); }
        __syncthreads();
        xa_fill(lds, VTl + (size_t)h * XD * MROWS + b * MEML, wave, lane_id());
        float mx = acc[0][0];
#pragma unroll
        for (int k = 0; k < 8; ++k)
#pragma unroll
            for (int j = 0; j < 16; ++j) mx = fmaxf(mx, acc[k][j]);
        mx = half_max(mx);
        float sum = 0.f;
#pragma unroll
        for (int k = 0; k < 8; ++k)
#pragma unroll
            for (int j = 0; j < 16; ++j) { const float p = __builtin_amdgcn_exp2f(acc[k][j] - mx); acc[k][j] = p; sum += p; }
        sum = half_sum(sum);
        const float inv = 1.0f / sum;
        bf16x8 bp[16];
#pragma unroll
        for (int k = 0; k < 8; ++k)
#pragma unroll
            for (int s = 0; s < 2; ++s) { u32x4 w; w.x = cvt_pk(acc[k][8 * s + 0], acc[k][8 * s + 1]); w.y = cvt_pk(acc[k][8 * s + 2], acc[k][8 * s + 3]);
                w.z = cvt_pk(acc[k][8 * s + 4], acc[k][8 * s + 5]); w.w = cvt_pk(acc[k][8 * s + 6], acc[k][8 * s + 7]); bp[2 * k + s] = __builtin_bit_cast(bf16x8, w); }
#pragma unroll
        for (int k = 0; k < 8; ++k)
#pragma unroll
            for (int j = 0; j < 16; ++j) acc[k][j] = 0.f;
        VM_WAIT(); __syncthreads();
        { const int lane = lane_id(); xa_mma(acc, bp, lds, lane & 31, lane >> 5); }
        __syncthreads();
        { const int lane = lane_id(), r = lane & 31, hh = lane >> 5; LAS unsigned char* wb = lds + wave * 16384;
#pragma unroll
          for (int k = 0; k < 8; ++k)
#pragma unroll
            for (int g4 = 0; g4 < 4; ++g4) { u32x2 w; w.x = cvt_pk(acc[k][4 * g4] * inv, acc[k][4 * g4 + 1] * inv); w.y = cvt_pk(acc[k][4 * g4 + 2] * inv, acc[k][4 * g4 + 3] * inv);
                *(LAS u32x2*)(wb + r * 512 + (((4 * k + g4) ^ r) << 4) + 8 * hh) = w; }
          asm volatile("s_waitcnt lgkmcnt(0)" ::: "memory");
#if defined(PROBE_DUP) && PROBE_DUP == 72
          for (int rp = 0; rp < 2; ++rp)
#endif
#pragma unroll
          for (int j = 0; j < 16; ++j) { const int row = 2 * j + hh, cp = lane & 31; const u32x4 v = *(LAS const u32x4*)(wb + row * 512 + cp * 16);
              *(GAS u32x4*)(OC + (qrow0 + row) * D + h * XD + 8 * (cp ^ row)) = v; }
          asm volatile("s_waitcnt lgkmcnt(0)" ::: "memory"); }
    }
}
__device__ __forceinline__ void mem_prep_rows(const float* mem, bf16_t* memb, float* rsm, int gw, int NGW, int lane) {
    for (int m = gw; m < MROWS; m += NGW) {
        const GAS f32x4* xr = (const GAS f32x4*)(mem + (size_t)m * D) + lane;
        f32x4 v[4]; float s = 0.f;
#pragma unroll
        for (int j = 0; j < 4; ++j) { v[j] = xr[64 * j]; s += (v[j].x * v[j].x + v[j].y * v[j].y) + (v[j].z * v[j].z + v[j].w * v[j].w); }
        const float tot = wave_sum(s);
        GAS u32x2* o8 = (GAS u32x2*)(memb + (size_t)m * D) + lane;
#pragma unroll
        for (int j = 0; j < 4; ++j) { u32x2 w; w.x = pk2(v[j].x, v[j].y); w.y = pk2(v[j].z, v[j].w); o8[64 * j] = w; }
        if (lane == 0) rsm[m] = 1.0f / sqrtf(tot * (1.0f / D) + EPS);
    }
}

__device__ __forceinline__ float ret_lg2(int h) { return h == 0 ? -0.04580368961312479f : h == 1 ? -0.02272007650008353f : h == 2 ? -0.011315313227834146f : -0.005646563141142063f; }
struct EpiProj {
    static constexpr int PROBE_ID = 301; static constexpr bool PERM = true;
    bf16_t *UG, *Q, *K, *V, *GT; const float* rope; LAS const float* tab;
    __device__ __forceinline__ void probe(const f32x4 (&acc)[2][2][4][2], const Unit& u, int ui, int wr, int wc, int fr, int fq) const { (*this)(acc, u, ui, wr, wc, fr, fq); }
    __device__ __forceinline__ void operator()(const f32x4 (&acc)[2][2][4][2], const Unit& u, int ui, int wr, int wc, int fr, int fq) const {
        asm volatile("" : "+v"(fr), "+v"(fq));
        const int kind = u.pn >> 1;
        if (kind == 1 || kind == 2) {
            f32x4 cs[2][4][2];
#pragma unroll
            for (int ai = 0; ai < 2; ++ai)
#pragma unroll
                for (int m = 0; m < 4; ++m) { const int row = u.pm * BM + ai * HALF + wr * 64 + m * 16 + fr;
                    const GAS f32x4* rp = (const GAS f32x4*)(rope + ((size_t)row * 64 + ((wc * 32 + 8 * fq) >> 1)) * 2); cs[ai][m][0] = rp[0]; cs[ai][m][1] = rp[1]; }
#pragma unroll
            for (int ai = 0; ai < 2; ++ai) {
#pragma unroll
                for (int m = 0; m < 4; ++m) { const int rl = ai * HALF + wr * 64 + m * 16 + fr, row = u.pm * BM + rl; const float rs = tab[ui * 256 + rl];
#pragma unroll
                    for (int bj = 0; bj < 2; ++bj) { const f32x4 v0 = acc[ai][bj][m][0] * rs, v1 = acc[ai][bj][m][1] * rs, c0 = cs[ai][m][0], c1 = cs[ai][m][1];
                        const int cw = (u.pn & 1) * 256 + bj * HALF + wc * 32 + 8 * fq, hd = cw >> 7;
                        const float e = (float)(row & 127) * ret_lg2(hd), sc = __builtin_amdgcn_exp2f(kind == 1 ? e : -e);
                        f32x4 o0, o1;
                        o0.x = (v0.x * c0.x - v0.y * c0.y) * sc; o0.y = (v0.y * c0.x + v0.x * c0.y) * sc; o0.z = (v0.z * c0.z - v0.w * c0.w) * sc; o0.w = (v0.w * c0.z + v0.z * c0.w) * sc;
                        o1.x = (v1.x * c1.x - v1.y * c1.y) * sc; o1.y = (v1.y * c1.x + v1.x * c1.y) * sc; o1.z = (v1.z * c1.z - v1.w * c1.w) * sc; o1.w = (v1.w * c1.z + v1.z * c1.w) * sc;
                        u32x4 w; w.x = cvt_pk(o0.x, o0.y); w.y = cvt_pk(o0.z, o0.w); w.z = cvt_pk(o1.x, o1.y); w.w = cvt_pk(o1.z, o1.w);
                        *(GAS u32x4*)((kind == 1 ? Q : K) + (size_t)row * RW + cw) = w; } } }
        } else {
#pragma unroll
            for (int ai = 0; ai < 2; ++ai)
#pragma unroll
                for (int m = 0; m < 4; ++m) { const int rl = ai * HALF + wr * 64 + m * 16 + fr, row = u.pm * BM + rl; const float rs = tab[ui * 256 + rl];
#pragma unroll
                    for (int bj = 0; bj < 2; ++bj) { const f32x4 v0 = acc[ai][bj][m][0] * rs, v1 = acc[ai][bj][m][1] * rs;
                        const int cw = (u.pn & 1) * 256 + bj * HALF + wc * 32 + 8 * fq;
                        bf16_t* dst = (kind == 0) ? UG + ((size_t)(cw >> 4) * (M / 32) + (row >> 5)) * 640 + (row & 31) * 16 + ((cw >> 3) & 1) * 8 : (kind == 3 ? V : GT) + (size_t)row * RW + cw;
                        u32x4 w; w.x = cvt_pk(v0.x, v0.y); w.y = cvt_pk(v0.z, v0.w); w.z = cvt_pk(v1.x, v1.y); w.w = cvt_pk(v1.z, v1.w);
                        *(GAS u32x4*)dst = w; } }
        }
    }
};
struct EpiGlu {
    static constexpr int PROBE_ID = 304; static constexpr bool PERM = true;
    const bf16_t* Z; const float* bias; bf16_t* Y; float* ssqs;
    __device__ __forceinline__ void probe(const f32x4 (&acc)[2][2][4][2], const Unit& u, int ui, int wr, int wc, int fr, int fq) const { (*this)(acc, u, ui, wr, wc, fr, fq); }
    __device__ __forceinline__ void operator()(const f32x4 (&acc)[2][2][4][2], const Unit& u, int ui, int wr, int wc, int fr, int fq) const {
        asm volatile("" : "+v"(fr), "+v"(fq));
#pragma unroll
        for (int ai = 0; ai < 2; ++ai)
#pragma unroll
            for (int m = 0; m < 4; ++m) { const int row = u.pm * BM + ai * HALF + wr * 64 + m * 16 + fr; float ps = 0.f;
#pragma unroll
                for (int bj = 0; bj < 2; ++bj) { const int col = u.pn * BM + bj * HALF + wc * 32 + 8 * fq;
                    const u32x4 zw = *(const GAS u32x4*)(Z + ((size_t)(col >> 4) * M + row) * 16 + (col & 15));
                    const f32x4 b0 = *(const GAS f32x4*)(bias + col), b1 = *(const GAS f32x4*)(bias + col + 4);
                    const f32x4 t0 = acc[ai][bj][m][0] + b0, t1 = acc[ai][bj][m][1] + b1;
                    float o[8];
                    o[0] = bflo(zw.x) * fast_sigmoid(t0.x); o[1] = bfhi(zw.x) * fast_sigmoid(t0.y); o[2] = bflo(zw.y) * fast_sigmoid(t0.z); o[3] = bfhi(zw.y) * fast_sigmoid(t0.w);
                    o[4] = bflo(zw.z) * fast_sigmoid(t1.x); o[5] = bfhi(zw.z) * fast_sigmoid(t1.y); o[6] = bflo(zw.w) * fast_sigmoid(t1.z); o[7] = bfhi(zw.w) * fast_sigmoid(t1.w);
#pragma unroll
                    for (int j = 0; j < 8; ++j) ps += o[j] * o[j];
                    u32x4 w; w.x = cvt_pk(o[0], o[1]); w.y = cvt_pk(o[2], o[3]); w.z = cvt_pk(o[4], o[5]); w.w = cvt_pk(o[6], o[7]);
                    *(GAS u32x4*)(Y + (size_t)row * D + col) = w; }
                ps = row16_sum(ps); ps = half_sum(ps);
                if (fq == 0) ssqs[(size_t)row * 8 + u.pn * 4 + wc] = ps;
                asm volatile("" ::: "memory"); }
    }
};
struct EpiResHook : EpiRes {
    LAS const float* tab2; int hook_t;
    __device__ __forceinline__ void hook(f32x4 (&acc)[2][2][4][2], int ui, int wr, int fr) const {
#pragma unroll
        for (int ai = 0; ai < 2; ++ai)
#pragma unroll
            for (int m = 0; m < 4; ++m) { const float rs = tab2[ui * 256 + ai * HALF + wr * 64 + m * 16 + fr];
#pragma unroll
                for (int bj = 0; bj < 2; ++bj)
#pragma unroll
                    for (int n = 0; n < 2; ++n) acc[ai][bj][m][n] *= rs; }
    }
};
__device__ __forceinline__ void rope_table(const int* pos, float* rope, int gtid, int nthr) {
    for (int idx = gtid; idx < M * 64; idx += nthr) { const int i = idx & 63, row = idx >> 6;
        const float inv = (float)(1.0 / pow(10000.0, (double)i / 64.0)); const float ang = (float)pos[row] * inv;
        f32x2 cs; cs.x = (float)cos((double)ang); cs.y = (float)sin((double)ang);
        *(GAS f32x2*)(rope + (size_t)idx * 2) = cs; }
}

constexpr size_t SP_RSM = 0, SP_KTAB = 64 * 1024, SP_APOW = SP_KTAB + 4 * MiB, SP_BBAR = 6 * MiB + 256 * 1024;
constexpr size_t APOW_LG = 33 * 64 * 2, KTAB_LG = 32 * 256, BBAR_LG = 64 * 16 * 2;
static_assert(SP_APOW + (size_t)DEPTH * S5G * APOW_LG * 4 <= SP_BBAR && SP_BBAR + (size_t)DEPTH * S5G * BBAR_LG * 4 <= 8 * MiB, "spare map");
constexpr size_t S5M_T = 0, S5M_WEND = 20 * MiB;
constexpr size_t WS_SEND = WS_Z, WS_KVRUN = WS_Z + 16 * MiB;
constexpr size_t WS_RSTART = WS_S5M;
constexpr size_t S5M_LAYER = 28 * MiB;
__device__ __forceinline__ void s5_tables_item(const In& in, unsigned char* ws, LAS unsigned char* lds, int item, int wave, int lane) {
    const int l = item >> 7, g = (item >> 2) & 31, tq = item & 3, p = lane;
    LAS float* Br = (LAS float*)lds; LAS float* Bi = Br + 1024; LAS float* Cr = Bi + 1024; LAS float* Ci = Cr + 1024;
    LAS float* CAr = Ci + 1024 + wave * 2048; LAS float* CAi = CAr + 1024;
    float* sp = (float*)(ws + WS_SPARE);
    const int lg = l * S5G + g;
    const double lr = (double)in.lre[lg * 64 + p], li = (double)in.lim[lg * 64 + p], step = (double)expf(in.lstep[lg]);
    if (wave == 0) {
        const double mag = exp(lr * step), ar = mag * cos(li * step), ai = mag * sin(li * step), den = lr * lr + li * li;
        const double fr = ((ar - 1.0) * lr + ai * li) / den, fi = (ai * lr - (ar - 1.0) * li) / den;
#pragma unroll 4
        for (int h = 0; h < 16; ++h) { const double br = (double)in.bre[((size_t)lg * 64 + p) * 16 + h], bi = (double)in.bim[((size_t)lg * 64 + p) * 16 + h];
            const float xr = (float)(fr * br - fi * bi), xi = (float)(fr * bi + fi * br); Br[p * 16 + h] = xr; Bi[p * 16 + h] = xi;
            if (tq == 0) { f32x2 w; w.x = xr; w.y = xi; *(GAS f32x2*)(sp + SP_BBAR / 4 + (size_t)lg * BBAR_LG + (p * 16 + h) * 2) = w; } }
    }
    if (wave == 1) { for (int n = 0; n < 16; ++n) { Cr[n * 64 + p] = in.cre[((size_t)lg * 16 + n) * 64 + p]; Ci[n * 64 + p] = in.cim[((size_t)lg * 16 + n) * 64 + p]; } }
    const int tau = 8 * tq + wave;
    const double mg = exp(lr * step * (double)tau), an = li * step * (double)tau;
    const float ar = (float)(mg * cos(an)), ai = (float)(mg * sin(an));
    { f32x2 w; w.x = ar; w.y = ai; *(GAS f32x2*)(sp + SP_APOW / 4 + (size_t)lg * APOW_LG + (tau * 64 + p) * 2) = w; }
    if (tq == 3 && wave == 7) { const double m2 = exp(lr * step * 32.0), a2 = li * step * 32.0; f32x2 w; w.x = (float)(m2 * cos(a2)); w.y = (float)(m2 * sin(a2));
        *(GAS f32x2*)(sp + SP_APOW / 4 + (size_t)lg * APOW_LG + (32 * 64 + p) * 2) = w; }
    __syncthreads();
#pragma unroll 4
    for (int n = 0; n < 16; ++n) { const float cr = Cr[n * 64 + p], ci = Ci[n * 64 + p]; CAr[n * 64 + p] = cr * ar - ci * ai; CAi[n * 64 + p] = cr * ai + ci * ar; }
    LDS_WAIT(); asm volatile("" ::: "memory");
    const int n = lane >> 2, h0 = 4 * (lane & 3);
    f32x4 acc = {0.f, 0.f, 0.f, 0.f};
    for (int pp = 0; pp < 64; ++pp) { const float cr = CAr[n * 64 + pp], ci = CAi[n * 64 + pp];
        const f32x4 br = *(LAS const f32x4*)(Br + pp * 16 + h0), bi = *(LAS const f32x4*)(Bi + pp * 16 + h0);
        acc += br * cr - bi * ci; }
    *(GAS f32x4*)(sp + SP_KTAB / 4 + (size_t)lg * KTAB_LG + tau * 256 + n * 16 + h0) = acc;
    __syncthreads();
}
__device__ __forceinline__ void s5_build_item(const In& in, unsigned char* ws, unsigned char* s5m  , int l, int item, int tid) {
    const int g = item >> 3, part = item & 7, lg = l * S5G + g;
    const float* sp = (const float*)(ws + WS_SPARE);
    const float* ktab = sp + SP_KTAB / 4 + (size_t)lg * KTAB_LG; const float* apow = sp + SP_APOW / 4 + (size_t)lg * APOW_LG; const float* bbar = sp + SP_BBAR / 4 + (size_t)lg * BBAR_LG;
    bf16_t* T = (bf16_t*)(s5m + S5M_T) + (size_t)g * 512 * 640; bf16_t* WE = (bf16_t*)(s5m + S5M_WEND) + (size_t)g * 256 * 512;
    const int my_n = tid & 15;
    (void)my_n;
#pragma unroll 4
    for (int k = 0; k < 8; ++k) { const int q = tid + k * NTHR, rl = q >> 6, pc = q & 63, t = 4 * part + (rl >> 4), n = rl & 15, col0 = 8 * pc, s = col0 >> 4, h0 = col0 & 15;
        const int tau = (t - s) < 0 ? 0 : (t - s); const bool live = s <= t;
        const f32x4 a = *(const GAS f32x4*)(ktab + tau * 256 + n * 16 + h0), b = *(const GAS f32x4*)(ktab + tau * 256 + n * 16 + h0 + 4);
        const float dn = (s == t) ? in.s5d[l * S5W + g * 16 + n] : 0.f;
        float v[8] = {a.x, a.y, a.z, a.w, b.x, b.y, b.z, b.w};
#pragma unroll
        for (int j = 0; j < 8; ++j) v[j] = live ? v[j] + ((h0 + j == n) ? dn : 0.f) : 0.f;
        u32x4 w; w.x = pk2(v[0], v[1]); w.y = pk2(v[2], v[3]); w.z = pk2(v[4], v[5]); w.w = pk2(v[6], v[7]);
        *(GAS u32x4*)(T + (size_t)(t * 16 + n) * 640 + col0) = w; }
#pragma unroll 2
    for (int k = 0; k < 2; ++k) { const int q = tid + k * NTHR, rl = q >> 4, pc = q & 15, t = 4 * part + (rl >> 4), n = rl & 15, q0 = 8 * pc, im = q0 >= 64, p0 = q0 & 63; float v[8];
#pragma unroll
        for (int j = 0; j < 8; ++j) { const int p = p0 + j; const float cr = in.cre[((size_t)lg * 16 + n) * 64 + p], ci = in.cim[((size_t)lg * 16 + n) * 64 + p];
            const f32x2 a = *(const GAS f32x2*)(apow + ((t + 1) * 64 + p) * 2); v[j] = im ? -(cr * a.y + ci * a.x) : (cr * a.x - ci * a.y); }
        u32x4 w; w.x = pk2(v[0], v[1]); w.y = pk2(v[2], v[3]); w.z = pk2(v[4], v[5]); w.w = pk2(v[6], v[7]);
        *(GAS u32x4*)(T + (size_t)(t * 16 + n) * 640 + 512 + q0) = w; }
#pragma unroll 2
    for (int q = tid; q < 32 * 64; q += NTHR) {
        const int r = 32 * part + (q >> 6), col0 = 8 * (q & 63), s = col0 >> 4, h0 = col0 & 15; float v[8];
        if (r < 128) { const int p = r & 63, im = r >= 64; const f32x2 a = *(const GAS f32x2*)(apow + ((31 - s) * 64 + p) * 2);
#pragma unroll
            for (int j = 0; j < 8; ++j) { const f32x2 b = *(const GAS f32x2*)(bbar + (p * 16 + h0 + j) * 2); v[j] = im ? (a.x * b.y + a.y * b.x) : (a.x * b.x - a.y * b.y); } }
        else {
#pragma unroll
            for (int j = 0; j < 8; ++j) v[j] = 0.f; }
        u32x4 w; w.x = pk2(v[0], v[1]); w.y = pk2(v[2], v[3]); w.z = pk2(v[4], v[5]); w.w = pk2(v[6], v[7]);
        *(GAS u32x4*)(WE + (size_t)r * 512 + col0) = w;
    }
}
struct EpiS5End {
    static constexpr int PROBE_ID = 305; static constexpr bool PERM = false;
    float* SE;
    __device__ __forceinline__ void probe(const f32x4 (&acc)[2][2][4][2], const Unit& u, int ui, int wr, int wc, int fr, int fq) const { (*this)(acc, u, ui, wr, wc, fr, fq); }
    __device__ __forceinline__ void operator()(const f32x4 (&acc)[2][2][4][2], const Unit& u, int ui, int wr, int wc, int fr, int fq) const {
        asm volatile("" : "+v"(fr), "+v"(fq));
#pragma unroll
        for (int ai = 0; ai < 2; ++ai)
#pragma unroll
            for (int m = 0; m < 4; ++m) { const int row = u.pm * BM + ai * HALF + wr * 64 + m * 16 + fr; float* o = SE + ((size_t)u.g * (M / 32) + row) * 128 + wc * 32 + 4 * fq;
#pragma unroll
                for (int n = 0; n < 2; ++n) *(GAS f32x4*)(o + 16 * n) = acc[ai][0][m][n]; }
    }
};
__device__ __forceinline__ f32x2 gelu_pk(f32x2 v) {
    const f32x2 av = __builtin_elementwise_abs(v), d = av * 0.2316418882f + 1.0f;
    f32x2 t; t.x = __builtin_amdgcn_rcpf(d.x); t.y = __builtin_amdgcn_rcpf(d.y);
    f32x2 q = t * 0.5307027145f + (-0.7265760135f); q = q * t + 0.7107068705f; q = q * t + (-0.142248368f); q = q * t + 0.127414796f; q = q * t;
    const f32x2 s = (v * v) * (-0.72134752044f);
    f32x2 e; e.x = __builtin_amdgcn_exp2f(s.x); e.y = __builtin_amdgcn_exp2f(s.y);
    const f32x2 m = v * (q * e), r = v - m;
    f32x2 o; o.x = v.x < 0.f ? m.x : r.x; o.y = v.y < 0.f ? m.y : r.y; return o;
}
struct EpiS5Out {
    static constexpr int PROBE_ID = 306; static constexpr bool PERM = true;
    bf16_t* Z;
    __device__ __forceinline__ void probe(const f32x4 (&acc)[2][2][4][2], const Unit& u, int ui, int wr, int wc, int fr, int fq) const { (*this)(acc, u, ui, wr, wc, fr, fq); }
    __device__ __forceinline__ void operator()(const f32x4 (&acc)[2][2][4][2], const Unit& u, int ui, int wr, int wc, int fr, int fq) const {
        asm volatile("" : "+v"(fr), "+v"(fq));
#pragma unroll
        for (int ai = 0; ai < 2; ++ai)
#pragma unroll
            for (int m = 0; m < 4; ++m) { const int crow = u.pm * BM + ai * HALF + wr * 64 + m * 16 + fr;
#pragma unroll
                for (int bj = 0; bj < 2; ++bj) { const int c = u.pn * BM + bj * HALF + wc * 32 + 8 * fq, t = c >> 4, hf = (c >> 3) & 1;
                    const f32x4 v0 = acc[ai][bj][m][0], v1 = acc[ai][bj][m][1];
                    const f32x2 a = gelu_pk((f32x2){v0.x, v0.y}), b = gelu_pk((f32x2){v0.z, v0.w}), cc = gelu_pk((f32x2){v1.x, v1.y}), dd = gelu_pk((f32x2){v1.z, v1.w});
                    u32x4 w; w.x = cvt_pk(a.x, a.y); w.y = cvt_pk(b.x, b.y); w.z = cvt_pk(cc.x, cc.y); w.w = cvt_pk(dd.x, dd.y);
                    *(GAS u32x4*)(Z + ((size_t)u.g * M + (size_t)crow * 32 + t) * 16 + hf * 8) = w; } }
    }
};
__device__ __forceinline__ void s5_scan_unit(unsigned char* ws, LAS unsigned char* lds, int l, int unit, int wave, int lane) {
    const int b = unit >> 6, g = (unit >> 1) & 31, p = 32 * (unit & 1) + (lane & 31), seg = 2 * wave + (lane >> 5), lg = l * S5G + g;
    const float* sp = (const float*)(ws + WS_SPARE);
    const f32x2 a32 = *(const GAS f32x2*)(sp + SP_APOW / 4 + (size_t)lg * APOW_LG + (32 * 64 + p) * 2);
    const float* se = (const float*)(ws + WS_SEND) + ((size_t)g * (M / 32) + b * 256 + seg * 16) * 128;
    LAS f32x2* segT = (LAS f32x2*)lds;
    float xr[16], xi[16];
#pragma unroll
    for (int k = 0; k < 16; ++k) { xr[k] = se[k * 128 + p]; xi[k] = se[k * 128 + 64 + p]; }
    float tr = 0.f, ti = 0.f;
#pragma unroll
    for (int k = 0; k < 16; ++k) { const float nr = a32.x * tr - a32.y * ti + xr[k], ni = a32.x * ti + a32.y * tr + xi[k]; tr = nr; ti = ni; }
    segT[seg * 32 + (lane & 31)] = (f32x2){tr, ti};
    float Ar = a32.x, Ai = a32.y;
#pragma unroll
    for (int j = 0; j < 4; ++j) { const float nr = Ar * Ar - Ai * Ai, ni = 2.f * Ar * Ai; Ar = nr; Ai = ni; }
    __syncthreads();
    float cr = 0.f, ci = 0.f;
    for (int s2 = 0; s2 < seg; ++s2) { const f32x2 t2 = segT[s2 * 32 + (lane & 31)]; const float nr = Ar * cr - Ai * ci + t2.x, ni = Ar * ci + Ai * cr + t2.y; cr = nr; ci = ni; }
    bf16_t* ug = (bf16_t*)(ws + WS_UG) + ((size_t)g * (M / 32) + b * 256 + seg * 16) * 640 + 512;
#pragma unroll
    for (int k = 0; k < 16; ++k) { ug[k * 640 + p] = (bf16_t)f2bf(cr); ug[k * 640 + 64 + p] = (bf16_t)f2bf(ci);
        const float nr = a32.x * cr - a32.y * ci + xr[k], ni = a32.x * ci + a32.y * cr + xi[k]; cr = nr; ci = ni; }
    __syncthreads();
}

typedef short s16x4 __attribute__((ext_vector_type(4)));
__device__ __forceinline__ unsigned rt_f(int row) { return (unsigned)(((row & 3) << 2) | ((row >> 2) & 3)); }
__device__ __forceinline__ unsigned rt_off(int row, int ch) { return 256u * (unsigned)row + 16u * ((unsigned)ch ^ rt_f(row)); }
__device__ __forceinline__ void rt_fill(LAS unsigned char* img, const bf16_t* src  , int wave, int lane) {
#pragma unroll
    for (int j = 0; j < 4; ++j) { const int p = wave * 4 + j, row = 4 * p + (lane >> 4), ch = (lane & 15) ^ (int)rt_f(row);
        __builtin_amdgcn_global_load_lds((const unsigned*)((const char*)src + (size_t)row * 1024 + ch * 16), (LAS unsigned*)(img + p * 1024), 16, 0, 0); }
}
__device__ __forceinline__ s16x4 rt_tr4(LAS const unsigned char* p) { typedef short v4i16_t __attribute__((ext_vector_type(4))); return __builtin_bit_cast(s16x4, __builtin_amdgcn_ds_read_tr16_b64_v4i16((LAS v4i16_t*)p)); }
template <bool KPERM> __device__ __forceinline__ bf16x8 rt_trfrag(LAS const unsigned char* img, int k0, int c, int lane) {
    const int hh = lane >> 5, blk = (lane >> 4) & 1, q = (lane & 15) >> 2, p = lane & 3;
    const int r0 = k0 + (KPERM ? 4 * hh : 8 * hh) + q, r1 = r0 + (KPERM ? 8 : 4), ch = 4 * c + 2 * blk + (p >> 1);
    const s16x4 lo = rt_tr4(img + rt_off(r0, ch) + 8 * (p & 1)), hi = rt_tr4(img + rt_off(r1, ch) + 8 * (p & 1));
    return __builtin_shufflevector(lo, hi, 0, 1, 2, 3, 4, 5, 6, 7);
}
__device__ __forceinline__ bf16x8 rt_rowfrag(LAS const unsigned char* img, int rb, int s, int lane) {
    return *(LAS const bf16x8*)(img + rt_off(32 * rb + (lane & 31), 2 * s + (lane >> 5)));
}
constexpr int RT_Q = 0, RT_K = 32768, RT_V = 65536, RT_R = 98304;
__device__ __forceinline__ float ret_g(int h) { return h == 0 ? 0.017183023570817902f : h == 1 ? 0.1332151628796484f : h == 2 ? 0.3664377159220373f : 0.6059370882290803f; }
__device__ __forceinline__ void rt_kv(f32x16 (&racc)[2], LAS const unsigned char* lds, int wave, int lane) {
    const int eb = wave & 3, db0 = 2 * (wave >> 2);
#pragma unroll
    for (int ks = 0; ks < 8; ++ks) {
        const bf16x8 bv = rt_trfrag<false>(lds + RT_V, 16 * ks, eb, lane);
        const bf16x8 a0 = rt_trfrag<false>(lds + RT_K, 16 * ks, db0, lane), a1 = rt_trfrag<false>(lds + RT_K, 16 * ks, db0 + 1, lane);
        racc[0] = __builtin_amdgcn_mfma_f32_32x32x16_bf16(a0, bv, racc[0], 0, 0, 0);
        racc[1] = __builtin_amdgcn_mfma_f32_32x32x16_bf16(a1, bv, racc[1], 0, 0, 0);
    }
}
template <int KS> __device__ __forceinline__ void rt_kv_step(f32x16 (&racc)[2], unsigned av0, unsigned av1, unsigned ak0, unsigned ak1, unsigned ak2, unsigned ak3) {
    s16x4 v0, v1, k0, k1, k2, k3;
    asm volatile("ds_read_b64_tr_b16 %0, %6 offset:%12\n\tds_read_b64_tr_b16 %1, %7 offset:%12\n\tds_read_b64_tr_b16 %2, %8 offset:%12\n\tds_read_b64_tr_b16 %3, %9 offset:%12\n\t"
                 "ds_read_b64_tr_b16 %4, %10 offset:%12\n\tds_read_b64_tr_b16 %5, %11 offset:%12\n\ts_waitcnt lgkmcnt(0)"
                 : "=&v"(v0), "=&v"(v1), "=&v"(k0), "=&v"(k1), "=&v"(k2), "=&v"(k3) : "v"(av0), "v"(av1), "v"(ak0), "v"(ak1), "v"(ak2), "v"(ak3), "i"(KS * 4096) : "memory");
    const bf16x8 bv = __builtin_shufflevector(v0, v1, 0, 1, 2, 3, 4, 5, 6, 7), a0 = __builtin_shufflevector(k0, k1, 0, 1, 2, 3, 4, 5, 6, 7), a1 = __builtin_shufflevector(k2, k3, 0, 1, 2, 3, 4, 5, 6, 7);
    racc[0] = __builtin_amdgcn_mfma_f32_32x32x16_bf16(a0, bv, racc[0], 0, 0, 0);
    racc[1] = __builtin_amdgcn_mfma_f32_32x32x16_bf16(a1, bv, racc[1], 0, 0, 0);
}
__device__ __forceinline__ unsigned rt_traddr(LAS const unsigned char* img, int c, int t, int lane) {
    const int hh = lane >> 5, blk = (lane >> 4) & 1, q = (lane & 15) >> 2, p = lane & 3;
    return (unsigned)(size_t)img + rt_off(8 * hh + 4 * t + q, 4 * c + 2 * blk + (p >> 1)) + 8 * (p & 1);
}
#define RTKV_RD(f, off) asm volatile("ds_read_b64_tr_b16 %0, %6 offset:" #off "\n\tds_read_b64_tr_b16 %1, %7 offset:" #off "\n\tds_read_b64_tr_b16 %2, %8 offset:" #off "\n\tds_read_b64_tr_b16 %3, %9 offset:" #off "\n\t" \
        "ds_read_b64_tr_b16 %4, %10 offset:" #off "\n\tds_read_b64_tr_b16 %5, %11 offset:" #off \
        : "=&v"(f[0]), "=&v"(f[1]), "=&v"(f[2]), "=&v"(f[3]), "=&v"(f[4]), "=&v"(f[5]) : "v"(av0), "v"(av1), "v"(ak0), "v"(ak1), "v"(ak2), "v"(ak3) : "memory")
#define RTKV_WAIT(n, f) asm volatile("s_waitcnt lgkmcnt(" #n ")" : "+v"(f[0]), "+v"(f[1]), "+v"(f[2]), "+v"(f[3]), "+v"(f[4]), "+v"(f[5]) :: "memory")
#define RTKV_MMA(f) do { const bf16x8 bv_ = __builtin_shufflevector(f[0], f[1], 0, 1, 2, 3, 4, 5, 6, 7), a0_ = __builtin_shufflevector(f[2], f[3], 0, 1, 2, 3, 4, 5, 6, 7), a1_ = __builtin_shufflevector(f[4], f[5], 0, 1, 2, 3, 4, 5, 6, 7); \
        racc[0] = __builtin_amdgcn_mfma_f32_32x32x16_bf16(a0_, bv_, racc[0], 0, 0, 0); racc[1] = __builtin_amdgcn_mfma_f32_32x32x16_bf16(a1_, bv_, racc[1], 0, 0, 0); \
        asm volatile("" : "+v"(racc[0]), "+v"(racc[1])); } while (0)
__device__ __forceinline__ void rt_kv_pipe(f32x16 (&racc)[2], unsigned av0, unsigned av1, unsigned ak0, unsigned ak1, unsigned ak2, unsigned ak3) {
    s16x4 fa[6], fb[6];
    RTKV_RD(fa, 0);
    RTKV_RD(fb, 4096);  RTKV_WAIT(6, fa); RTKV_MMA(fa);
    RTKV_RD(fa, 8192);  RTKV_WAIT(6, fb); RTKV_MMA(fb);
    RTKV_RD(fb, 12288); RTKV_WAIT(6, fa); RTKV_MMA(fa);
    RTKV_RD(fa, 16384); RTKV_WAIT(6, fb); RTKV_MMA(fb);
    RTKV_RD(fb, 20480); RTKV_WAIT(6, fa); RTKV_MMA(fa);
    RTKV_RD(fa, 24576); RTKV_WAIT(6, fb); RTKV_MMA(fb);
    RTKV_RD(fb, 28672); RTKV_WAIT(6, fa); RTKV_MMA(fa);
    RTKV_WAIT(0, fb); RTKV_MMA(fb);
}
__device__ __forceinline__ void ret_kvrun_steps(unsigned char* ws, LAS unsigned char* lds, int u0, int nu, int wave) {
    const int total = nu * 4;
#define RT_ISSUE(step) do { const int un_ = u0 + ((step) >> 2), c_ = (step) & 3, bh_ = un_ >> 4, run_ = un_ & 15, b_ = bh_ >> 2, h_ = bh_ & 3; \
        const size_t r_ = ((size_t)b_ * SEQ + run_ * 512 + c_ * 128) * RW + h_ * RDK; LAS unsigned char* bf_ = lds + ((step) & 1) * 65536; const int ln_ = lane_id(); \
        rt_fill(bf_, (const bf16_t*)(ws + WS_K) + r_, wave, ln_); rt_fill(bf_ + 32768, (const bf16_t*)(ws + WS_V) + r_, wave, ln_); } while (0)
    RT_ISSUE(0);
    f32x16 racc[2];
#pragma unroll 1
    for (int step = 0; step < total; ++step) {
        const int unit = u0 + (step >> 2), c = step & 3, h = (unit >> 4) & 3; const float g = (c == 0) ? 0.f : ret_g(h);
        if (step + 1 < total) { RT_ISSUE(step + 1); asm volatile("s_waitcnt vmcnt(8) lgkmcnt(0)\n\ts_barrier" ::: "memory"); }
        else asm volatile("s_waitcnt vmcnt(0) lgkmcnt(0)\n\ts_barrier" ::: "memory");
#pragma unroll
        for (int k = 0; k < 2; ++k)
#pragma unroll
            for (int j = 0; j < 16; ++j) racc[k][j] = (c == 0) ? 0.f : racc[k][j] * g;
        { const int lane = lane_id(); LAS const unsigned char* bf = lds + (step & 1) * 65536;
          const int eb = wave & 3, db0 = 2 * (wave >> 2);
          const unsigned av0 = rt_traddr(bf + 32768, eb, 0, lane), av1 = rt_traddr(bf + 32768, eb, 1, lane);
          const unsigned ak0 = rt_traddr(bf, db0, 0, lane), ak1 = rt_traddr(bf, db0, 1, lane), ak2 = rt_traddr(bf, db0 + 1, 0, lane), ak3 = rt_traddr(bf, db0 + 1, 1, lane);
          rt_kv_step<0>(racc, av0, av1, ak0, ak1, ak2, ak3); rt_kv_step<1>(racc, av0, av1, ak0, ak1, ak2, ak3); rt_kv_step<2>(racc, av0, av1, ak0, ak1, ak2, ak3); rt_kv_step<3>(racc, av0, av1, ak0, ak1, ak2, ak3);
          rt_kv_step<4>(racc, av0, av1, ak0, ak1, ak2, ak3); rt_kv_step<5>(racc, av0, av1, ak0, ak1, ak2, ak3); rt_kv_step<6>(racc, av0, av1, ak0, ak1, ak2, ak3); rt_kv_step<7>(racc, av0, av1, ak0, ak1, ak2, ak3);
          if (c == 3) { float* o = (float*)(ws + WS_KVRUN) + (size_t)unit * 16384 + (size_t)wave * 2048 + lane * 32;
#pragma unroll
            for (int k = 0; k < 2; ++k)
#pragma unroll
                for (int q4 = 0; q4 < 4; ++q4) *(GAS f32x4*)(o + k * 16 + 4 * q4) = (f32x4){racc[k][4 * q4], racc[k][4 * q4 + 1], racc[k][4 * q4 + 2], racc[k][4 * q4 + 3]}; } }
        asm volatile("s_waitcnt lgkmcnt(0)\n\ts_barrier" ::: "memory");
    }
    asm volatile("s_waitcnt vmcnt(0)" ::: "memory");
#undef RT_ISSUE
}
__device__ __forceinline__ void ret_scan(unsigned char* ws, int bx, int G, int tid) {
    for (int e2 = bx * NTHR + tid; e2 < NB * RH * 8192; e2 += G * NTHR) {
        const int bh = e2 >> 13, el = (e2 & 8191) * 2, h = bh & 3; float g4 = ret_g(h); g4 *= g4; g4 *= g4;
        const float* kv = (const float*)(ws + WS_KVRUN) + (size_t)bh * 16 * 16384 + el; bf16_t* rs = (bf16_t*)(ws + WS_RSTART) + (size_t)bh * 16 * 16384 + el;
        f32x2 v[15];
#pragma unroll
        for (int r = 0; r < 15; ++r) v[r] = *(const GAS f32x2*)(kv + (size_t)r * 16384);
        float z0 = 0.f; asm volatile("" : "+v"(z0));
        f32x2 s = {z0, z0};
        *(GAS unsigned*)rs = 0u;
#pragma unroll
        for (int r = 0; r < 15; ++r) { s = s * g4 + v[r]; *(GAS unsigned*)(rs + (size_t)(r + 1) * 16384) = pk2(s.x, s.y); }
    }
}
__device__ __forceinline__ void ret_out_unit(unsigned char* ws, LAS unsigned char* lds, const float* gain  , int unit, int wave) {
    const int bh = unit >> 4, run = unit & 15, b = bh >> 2, h = bh & 3; const float g = ret_g(h);
    const size_t row0 = (size_t)b * SEQ + run * 512;
    const int eh = wave >> 2, qb = eh ? 7 - wave : wave;
    LAS f32x2* exch = (LAS f32x2*)(lds + TAB_OFF);
    LAS float* gtab = (LAS float*)(lds + TAB_OFF + 2048);
    f32x16 racc[2]; float gv;
    { const int lane = lane_id(); const bf16_t* o = (const bf16_t*)(ws + WS_RSTART) + (size_t)unit * 16384 + (size_t)wave * 2048 + lane * 32;
      u32x4 rw[4];
#pragma unroll
      for (int i = 0; i < 4; ++i) rw[i] = *(const GAS u32x4*)(o + 8 * i);
      gv = gain[h * RDK + (wave & 1) * 64 + lane];
      rt_fill(lds + RT_Q, (const bf16_t*)(ws + WS_Q) + row0 * RW + h * RDK, wave, lane);
      rt_fill(lds + RT_K, (const bf16_t*)(ws + WS_K) + row0 * RW + h * RDK, wave, lane);
      rt_fill(lds + RT_V, (const bf16_t*)(ws + WS_V) + row0 * RW + h * RDK, wave, lane);
#pragma unroll
      for (int k = 0; k < 2; ++k)
#pragma unroll
        for (int i = 0; i < 2; ++i) { const u32x4 v = rw[2 * k + i];
            racc[k][8 * i + 0] = bflo(v.x); racc[k][8 * i + 1] = bfhi(v.x); racc[k][8 * i + 2] = bflo(v.y); racc[k][8 * i + 3] = bfhi(v.y);
            racc[k][8 * i + 4] = bflo(v.z); racc[k][8 * i + 5] = bfhi(v.z); racc[k][8 * i + 6] = bflo(v.w); racc[k][8 * i + 7] = bfhi(v.w); } }
#pragma unroll 1
    for (int c = 0; c < 4; ++c) {
        __builtin_amdgcn_s_waitcnt(0x0F70); __syncthreads();
        if (c == 0 && wave < 2) gtab[wave * 64 + lane_id()] = gv;
        u32x4 gw[4];
        { const int lane = lane_id();
          const bf16_t* gp = (const bf16_t*)(ws + WS_GATE) + (row0 + c * 128 + 32 * qb + (lane >> 3)) * RW + h * RDK + 64 * eh;
#pragma unroll
          for (int j = 0; j < 4; ++j) { const int row = 8 * j + (lane >> 3); gw[j] = *(const GAS u32x4*)(gp + (size_t)(8 * j) * RW + 8 * ((lane & 7) ^ (row & 7))); } }
        {
          const int lane = lane_id(), eb = wave & 3, db0 = 2 * (wave >> 2), r = lane & 31, hh = lane >> 5;
#pragma unroll
          for (int k = 0; k < 2; ++k)
#pragma unroll
            for (int q4 = 0; q4 < 4; ++q4) { u32x2 w; w.x = cvt_pk(racc[k][4 * q4] * g, racc[k][4 * q4 + 1] * g); w.y = cvt_pk(racc[k][4 * q4 + 2] * g, racc[k][4 * q4 + 3] * g);
                const int e = 32 * eb + r, d0 = 32 * (db0 + k) + 8 * q4 + 4 * hh;
                *(LAS u32x2*)(lds + RT_R + rt_off(e, d0 >> 3) + 2 * (d0 & 7)) = w; } }
        if (c < 3) {
#pragma unroll
            for (int k = 0; k < 2; ++k) racc[k] *= g;
            { const int lane = lane_id(), eb = wave & 3, db0 = 2 * (wave >> 2);
              rt_kv_pipe(racc, rt_traddr(lds + RT_V, eb, 0, lane), rt_traddr(lds + RT_V, eb, 1, lane), rt_traddr(lds + RT_K, db0, 0, lane), rt_traddr(lds + RT_K, db0, 1, lane),
                         rt_traddr(lds + RT_K, db0 + 1, 0, lane), rt_traddr(lds + RT_K, db0 + 1, 1, lane)); }
        }
        f32x16 oacc[2]; bf16x8 bq[8]; float sg[4][8];
        {   const int lane = lane_id(), r = lane & 31, hh = lane >> 5;
#pragma unroll
            for (int s = 0; s < 8; ++s) bq[s] = rt_rowfrag(lds + RT_Q, qb, s, lane);
            f32x16 sacc[4];
#pragma unroll
            for (int kb = 0; kb < 4; ++kb) {
#pragma unroll
                for (int j = 0; j < 16; ++j) sacc[kb][j] = 0.f;
                if (kb <= qb) {
#pragma unroll
                    for (int s = 0; s < 8; ++s) sacc[kb] = __builtin_amdgcn_mfma_f32_32x32x16_bf16(rt_rowfrag(lds + RT_K, kb, s, lane), bq[s], sacc[kb], 0, 0, 0);
                }
            }
#pragma unroll
            for (int kb = 0; kb < 4; ++kb) if (kb == qb) {
#pragma unroll
                for (int j = 0; j < 16; ++j) { const int key = (j & 3) + 8 * (j >> 2) + 4 * hh; sacc[kb][j] = (key <= r) ? sacc[kb][j] : 0.f; } }
#pragma unroll
            for (int k = 0; k < 2; ++k)
#pragma unroll
                for (int j = 0; j < 16; ++j) oacc[k][j] = 0.f;
#pragma unroll
            for (int kb = 0; kb < 4; ++kb) if (kb <= qb) {
#pragma unroll
                for (int s = 0; s < 2; ++s) { u32x4 w; w.x = cvt_pk(sacc[kb][8 * s + 0], sacc[kb][8 * s + 1]); w.y = cvt_pk(sacc[kb][8 * s + 2], sacc[kb][8 * s + 3]);
                    w.z = cvt_pk(sacc[kb][8 * s + 4], sacc[kb][8 * s + 5]); w.w = cvt_pk(sacc[kb][8 * s + 6], sacc[kb][8 * s + 7]); const bf16x8 bp = __builtin_bit_cast(bf16x8, w);
#pragma unroll
                    for (int k = 0; k < 2; ++k) oacc[k] = __builtin_amdgcn_mfma_f32_32x32x16_bf16(rt_trfrag<true>(lds + RT_V, 32 * kb + 16 * s, 2 * eh + k, lane), bp, oacc[k], 0, 0, 0); } }
#pragma unroll
            for (int j = 0; j < 4; ++j) { const u32x4 gv = gw[j];
                sg[j][0] = bflo(gv.x) * fast_sigmoid(bflo(gv.x)); sg[j][1] = bfhi(gv.x) * fast_sigmoid(bfhi(gv.x)); sg[j][2] = bflo(gv.y) * fast_sigmoid(bflo(gv.y)); sg[j][3] = bfhi(gv.y) * fast_sigmoid(bfhi(gv.y));
                sg[j][4] = bflo(gv.z) * fast_sigmoid(bflo(gv.z)); sg[j][5] = bfhi(gv.z) * fast_sigmoid(bfhi(gv.z)); sg[j][6] = bflo(gv.w) * fast_sigmoid(bflo(gv.w)); sg[j][7] = bfhi(gv.w) * fast_sigmoid(bfhi(gv.w));
#pragma unroll
                for (int i = 0; i < 8; ++i) asm volatile("" : "+v"(sg[j][i])); }
        }
        __syncthreads();
        if (c < 3) { const int lane = lane_id(); const size_t nr = (row0 + (c + 1) * 128) * RW + h * RDK;
            rt_fill(lds + RT_Q, (const bf16_t*)(ws + WS_Q) + nr, wave, lane); rt_fill(lds + RT_K, (const bf16_t*)(ws + WS_K) + nr, wave, lane); rt_fill(lds + RT_V, (const bf16_t*)(ws + WS_V) + nr, wave, lane); }
        {   const int lane = lane_id(), r = lane & 31, hh = lane >> 5;
#pragma unroll
            for (int s = 0; s < 8; ++s)
#pragma unroll
                for (int k = 0; k < 2; ++k) oacc[k] = __builtin_amdgcn_mfma_f32_32x32x16_bf16(rt_rowfrag(lds + RT_R, 2 * eh + k, s, lane), bq[s], oacc[k], 0, 0, 0);
            float s1 = 0.f, s2 = 0.f;
#pragma unroll
            for (int k = 0; k < 2; ++k)
#pragma unroll
                for (int j = 0; j < 16; ++j) { s1 += oacc[k][j]; s2 += oacc[k][j] * oacc[k][j]; }
            s1 = half_sum(s1); s2 = half_sum(s2);
            if (hh == 0) exch[eh * 128 + 32 * qb + r] = (f32x2){s1, s2};
            asm volatile("s_waitcnt lgkmcnt(0)\n\ts_barrier" ::: "memory");
            const f32x2 e0 = exch[32 * qb + r], e1 = exch[128 + 32 * qb + r];
            const float mu = (e0.x + e1.x) * (1.0f / 128.0f), var = (e0.y + e1.y) * (1.0f / 128.0f) - mu * mu, rstd = 1.0f / sqrtf(var + EPS);
            LAS unsigned char* wb = lds + RT_R + wave * 4096;
#pragma unroll
            for (int k = 0; k < 2; ++k)
#pragma unroll
                for (int q4 = 0; q4 < 4; ++q4) { const int el = 32 * k + 8 * q4 + 4 * hh; const f32x4 gn = *(LAS const f32x4*)(gtab + 64 * eh + el);
                    u32x2 w; w.x = cvt_pk((oacc[k][4 * q4] - mu) * rstd * gn.x, (oacc[k][4 * q4 + 1] - mu) * rstd * gn.y); w.y = cvt_pk((oacc[k][4 * q4 + 2] - mu) * rstd * gn.z, (oacc[k][4 * q4 + 3] - mu) * rstd * gn.w);
                    *(LAS u32x2*)(wb + r * 128 + (((el >> 3) ^ (r & 7)) << 4) + 8 * hh) = w; }
            asm volatile("s_waitcnt lgkmcnt(0)" ::: "memory");
            bf16_t* yp = (bf16_t*)(ws + WS_YMIX) + (row0 + c * 128 + 32 * qb) * D + S5W + h * RDK + 64 * eh;
#pragma unroll
            for (int j = 0; j < 4; ++j) { const int row = 8 * j + (lane >> 3), cp = lane & 7; const u32x4 v = *(LAS const u32x4*)(wb + row * 128 + cp * 16);
                u32x4 w; w.x = cvt_pk(bflo(v.x) * sg[j][0], bfhi(v.x) * sg[j][1]); w.y = cvt_pk(bflo(v.y) * sg[j][2], bfhi(v.y) * sg[j][3]);
                w.z = cvt_pk(bflo(v.z) * sg[j][4], bfhi(v.z) * sg[j][5]); w.w = cvt_pk(bflo(v.w) * sg[j][6], bfhi(v.w) * sg[j][7]);
                *(GAS u32x4*)(yp + (size_t)row * D + 8 * (cp ^ (row & 7))) = w; }
        }
    }
    __syncthreads();
}

struct Args { In in; float* out; unsigned char* ws; int pro_lo, pro_hi, l_lo, l_hi, ph_lo, ph_hi, flags, region; };
enum { PH_PROJ = 0, PH_MIXA = 1, PH_SCAN = 2, PH_MIXC = 3, PH_GLU = 4, PH_WOUT = 5, PH_CQ = 6, PH_XATT = 7, PH_CO = 8, PH_FFN1 = 9, PH_FFN2 = 10, PH_N = 11 };
enum { FL_XPREP = 1, FL_FINAL = 2, FL_XIN = 4 };

__global__ void __launch_bounds__(NTHR, 2) fwd(Args a) {
    extern __shared__ __attribute__((aligned(16))) unsigned char lds_raw[];
    LAS unsigned char* lds = (LAS unsigned char*)lds_raw;
    const int wave = __builtin_amdgcn_readfirstlane(threadIdx.x >> 6); const bool t0 = (threadIdx.x == 0);
#define LANE lane_id()
    const int G = gridDim.x, bx = blockIdx.x, vcu = (G % 8 == 0) ? (bx % 8) * (G / 8) + bx / 8 : bx;
    volatile LAS unsigned* MISC = (volatile LAS unsigned*)(lds + MISC_OFF);
    if (threadIdx.x < 32) MISC[threadIdx.x] = 0u;
    __syncthreads();
    unsigned char* ws = a.ws;
    unsigned* ctl = (unsigned*)(ws + WS_CTL);
    XcdBarrier bar = xcd_barrier_post(ctl + CW_BAR + a.region * XCD_BAR_WORDS, MISC + 8, t0);
    bool need_bar = false;
#ifndef PROBE_DUP
#define PROBE_DUP -1
#endif
#define REPS(k) ((PROBE_DUP == (k) || PROBE_DUP == 1000 + (k) || PROBE_DUP == 2000 + (k)) ? 2 : 1)
#define SEAM() do { if (need_bar) { xcd_barrier(bar); if (PROBE_DUP == 100) xcd_barrier(bar); } need_bar = true; } while (0)
    const int gw = vcu * NWAVES + wave, NGW = G * NWAVES;
    const In& in = a.in;
    float* ssq = (float*)(ws + WS_SSQ);
    bf16_t* xb = (bf16_t*)(ws + WS_XB);
    LAS float* tab = (LAS float*)(lds + TAB_OFF);
    float* rsm = (float*)(ws + WS_SPARE);

#ifndef STAGGER_TICKS
#define STAGGER_TICKS 0
#endif
#define STAGGER() do { if (STAGGER_TICKS > 0) { const unsigned long long t0_ = __builtin_amdgcn_s_memrealtime(), d_ = (unsigned long long)((bx & 7) * STAGGER_TICKS); \
        while (__builtin_amdgcn_s_memrealtime() - t0_ < d_) __builtin_amdgcn_s_sleep(2); } } while (0)
    for (int rep = 0; rep < REPS(200); ++rep) if (a.pro_lo <= 0 && 0 < a.pro_hi) {
        SEAM();
        pro_weights(in, ws, lds, gw, NGW, wave, LANE);
#if PROBE_DUP == 210
        __syncthreads(); pro_weights(in, ws, lds, gw + (int)(a.flags >> 8), NGW, wave, LANE);
#endif
        for (int r2 = 0; r2 < REPS(211); ++r2) if (a.flags & FL_XIN) xprep_rows(in.x, xb, ssq, gw, NGW, LANE);
        mem_prep_rows(in.mem, (bf16_t*)(ws + WS_MEMB), rsm, gw, NGW, LANE);
        for (int r2 = 0; r2 < REPS(212); ++r2) rope_table(in.pos, (float*)(ws + WS_ROPE), gw * 64 + LANE, NGW * 64);
        __syncthreads();
        for (int r2 = 0; r2 < REPS(213); ++r2) for (int it = bx; it < DEPTH * S5G * 4; it += G) s5_tables_item(in, ws, lds, it, wave, LANE);
        __syncthreads();
    }
    for (int rep = 0; rep < REPS(201); ++rep) if (a.pro_lo <= 1 && 1 < a.pro_hi) {
        SEAM();
        int bxo = bx; asm volatile("" : "+s"(bxo));
        { GroupOrder S; S.init(DEPTH, MROWS / BM, D / BM, G, bxo, 0);
          const Gemm g{(const bf16_t*)(ws + WS_MEMB), (const bf16_t*)(ws + WS_WCK_TMP), D, D, D, 0, (long)D * D};
          const EpiMemK E{(bf16_t*)(ws + WS_MEMK), rsm};
          gemm_phase<EpiMemK, GroupOrder>(lds, g, S, E, wave); }
        { GroupOrder S; S.init(DEPTH, D / BM, MROWS / BM, G, bxo, 64);
          const Gemm g{(const bf16_t*)(ws + WS_WCV_TMP), (const bf16_t*)(ws + WS_MEMB), D, D, D, (long)D * D, 0};
          const EpiMemVT E{(bf16_t*)(ws + WS_MEMVT), rsm};
          gemm_phase<EpiMemVT, GroupOrder>(lds, g, S, E, wave); }
        if (G == 256) { const int n_it = bxo < 128 ? 2 : 6, it0 = bxo < 128 ? bxo : 256 + (bxo - 128);
            for (int k = 0; k < n_it; ++k) { const int it = it0 + 128 * k; s5_build_item(in, ws, (unsigned char*)a.out + (size_t)(it >> 8) * S5M_LAYER, it >> 8, it & 255, wave * 64 + LANE); } }
        else for (int it = bxo; it < DEPTH * S5G * 8; it += G) s5_build_item(in, ws, (unsigned char*)a.out + (size_t)(it >> 8) * S5M_LAYER, it >> 8, it & 255, wave * 64 + LANE);
    }
    for (int l = a.l_lo; l < a.l_hi; ++l) {
#define IN_PH(k) (a.ph_lo <= (k) && (k) < a.ph_hi)
        for (int rep = 0; rep < REPS(PH_PROJ); ++rep) if (IN_PH(PH_PROJ)) {
            SEAM();
            int bxo = bx; asm volatile("" : "+s"(bxo));
            StaticOrder S; S.init(M / BM, INW / BM, G, bxo);
            const RstdPre<StaticOrder> pre{tab, &S, ssq, 16, 1.0f / D};
            const Gemm g{xb, wl(ws, l, W_IN), D, D, D, 0, 0};
            const EpiProj E{(bf16_t*)(ws + WS_UG), (bf16_t*)(ws + WS_Q), (bf16_t*)(ws + WS_K), (bf16_t*)(ws + WS_V), (bf16_t*)(ws + WS_GATE), (const float*)(ws + WS_ROPE), tab};
            gemm_phase<EpiProj, StaticOrder, false, RstdPre<StaticOrder>>(lds, g, S, E, wave, pre);
        }
        for (int rep = 0; rep < REPS(PH_MIXA); ++rep) if (IN_PH(PH_MIXA)) {
            SEAM();
            int bxo = bx; asm volatile("" : "+s"(bxo));
            if (G == 256) {
                if (bxo < 128) for (int r2 = 0; r2 < REPS(11); ++r2) { XcdGroupOrder S; S.init(S5G, (M / 32) / BM, 1, 128, bxo);
                  const Gemm g{(const bf16_t*)(ws + WS_UG), (const bf16_t*)((unsigned char*)a.out + (size_t)l * S5M_LAYER + S5M_WEND), 640, 512, 512, (long)(M / 32) * 640, 256L * 512};
                  const EpiS5End E{(float*)(ws + WS_SEND)};
                  gemm_phase<EpiS5End, XcdGroupOrder>(lds, g, S, E, wave); }
                else for (int r2 = 0; r2 < REPS(12); ++r2) ret_kvrun_steps(ws, lds, 2 * (bxo - 128), 2, wave);
            } else {
                { GroupOrder S; S.init(S5G, (M / 32) / BM, 1, G, bxo, 0);
                  const Gemm g{(const bf16_t*)(ws + WS_UG), (const bf16_t*)((unsigned char*)a.out + (size_t)l * S5M_LAYER + S5M_WEND), 640, 512, 512, (long)(M / 32) * 640, 256L * 512};
                  const EpiS5End E{(float*)(ws + WS_SEND)};
                  gemm_phase<EpiS5End, GroupOrder>(lds, g, S, E, wave); }
                __syncthreads();
                for (int u = bxo; u < NB * RH * 16; u += G) ret_kvrun_steps(ws, lds, u, 1, wave);
            }
        }
        for (int rep = 0; rep < REPS(PH_SCAN); ++rep) if (IN_PH(PH_SCAN)) {
            SEAM();
            for (int u = bx; u < NB * S5G * 2; u += G) s5_scan_unit(ws, lds, l, u, wave, LANE);
            ret_scan(ws, bx, G, wave * 64 + LANE);
        }
        for (int rep = 0; rep < REPS(PH_MIXC); ++rep) if (IN_PH(PH_MIXC)) {
            SEAM();
            int bxo = bx; asm volatile("" : "+s"(bxo));
            for (int r2 = 0; r2 < REPS(31); ++r2)
            { XcdGroupOrder S; S.init(S5G, (M / 32) / BM, 2, G, bxo);
              const Gemm g{(const bf16_t*)(ws + WS_UG), (const bf16_t*)((unsigned char*)a.out + (size_t)l * S5M_LAYER + S5M_T), 640, 640, 640, (long)(M / 32) * 640, 512L * 640};
              const EpiS5Out E{(bf16_t*)(ws + WS_Z)};
              gemm_phase<EpiS5Out, XcdGroupOrder>(lds, g, S, E, wave, NoPre(), false); }
            for (int r2 = 0; r2 < REPS(32); ++r2)
            for (int u = bxo; u < NB * RH * 16; u += G) ret_out_unit(ws, lds, in.retn + l * RW, u, wave);
        }
        for (int rep = 0; rep < REPS(PH_GLU); ++rep) if (IN_PH(PH_GLU)) {
            SEAM();
            int bxo = bx; asm volatile("" : "+s"(bxo));
            StaticOrder S; S.init(M / BM, S5W / BM, G, bxo);
            const Gemm g{(const bf16_t*)(ws + WS_Z), wl(ws, l, W_GLU), S5W, S5W, S5W, 0, 0, M};
            const EpiGlu E{(const bf16_t*)(ws + WS_Z), in.bglu + l * S5W, (bf16_t*)(ws + WS_YMIX), (float*)(ws + WS_SSQS)};
            gemm_phase<EpiGlu, StaticOrder>(lds, g, S, E, wave);
        }
        for (int rep = 0; rep < REPS(PH_WOUT); ++rep) if (IN_PH(PH_WOUT)) {
            SEAM();
            int bxo = bx; asm volatile("" : "+s"(bxo));
            StaticOrder S; S.init(M / BM, D / BM, G, bxo);
            LAS float* tab2 = (LAS float*)(lds + TAB2_OFF);
            const RstdPre<StaticOrder> pre{tab2, &S, (const float*)(ws + WS_SSQS), 8, 1.0f / S5W};
            const Gemm g{(const bf16_t*)(ws + WS_YMIX), wl(ws, l, W_OUT), D, D, D, 0, 0};
            const EpiResHook E{{xb, ssq, nullptr, (REPS(PH_WOUT) == 2 && rep == 0) ? 0.f : 1.f, tab}, tab2, 8};
            gemm_phase<EpiResHook, StaticOrder, true, RstdPre<StaticOrder>>(lds, g, S, E, wave, pre);
        }
        for (int rep = 0; rep < REPS(PH_CQ); ++rep) if (IN_PH(PH_CQ)) {
            SEAM();
            int bxo = bx; asm volatile("" : "+s"(bxo));
            StaticOrder S; S.init(M / BM, D / BM, G, bxo);
            const RstdPre<StaticOrder> pre{tab, &S, ssq, 16, 1.0f / D};
            const Gemm g{xb, wl(ws, l, W_CQ), D, D, D, 0, 0};
            const EpiScaleBf16 E{(bf16_t*)(ws + WS_QC), D, tab};
            gemm_phase<EpiScaleBf16, StaticOrder, false, RstdPre<StaticOrder>>(lds, g, S, E, wave, pre);
            for (int r2 = 0; r2 < REPS(70); ++r2)
#pragma unroll 1
            for (int i = 0; i < 2; ++i) { Unit u; if (!S.next(i, u)) break;
                const int upm = __builtin_amdgcn_readfirstlane(u.pm), upn = __builtin_amdgcn_readfirstlane(u.pn);
                xattn_unit(lds, (const bf16_t*)(ws + WS_QC), (const bf16_t*)(ws + WS_MEMK) + (size_t)l * MROWS * D, (const bf16_t*)(ws + WS_MEMVT) + (size_t)l * D * MROWS, (bf16_t*)(ws + WS_OC), upm >> 5, upn, upm & 31, wave); }
        }
        for (int rep = 0; rep < REPS(PH_CO); ++rep) if (IN_PH(PH_CO)) {
            SEAM();
            int bxo = bx; asm volatile("" : "+s"(bxo));
            StaticOrder S; S.init(M / BM, D / BM, G, bxo);
            const Gemm g{(const bf16_t*)(ws + WS_OC), wl(ws, l, W_CO), D, D, D, 0, 0};
            const EpiRes E{xb, ssq, nullptr, (REPS(PH_CO) == 2 && rep == 0) ? 0.f : 1.f, tab};
            gemm_phase<EpiRes, StaticOrder>(lds, g, S, E, wave);
        }
        for (int rep = 0; rep < REPS(PH_FFN1); ++rep) if (IN_PH(PH_FFN1)) {
            if (PROBE_DUP == 2000 + PH_FFN1 && rep > 0) xcd_barrier<false>(bar); else if (!(PROBE_DUP == 1000 + PH_FFN1 && rep > 0)) SEAM();
            int bxo = bx; asm volatile("" : "+s"(bxo));
            StaticOrder S; S.init(M / BM, (2 * FF) / BM, G, bxo);
            const RstdPre<StaticOrder> pre{tab, &S, ssq, 16, 1.0f / D};
            const Gemm g{xb, wl(ws, l, W_GU), D, D, D, 0, 0};
            const EpiFfn1 E{(bf16_t*)(ws + WS_HID), tab};
            gemm_phase<EpiFfn1, StaticOrder, false, RstdPre<StaticOrder>>(lds, g, S, E, wave, pre);
        }
        for (int rep = 0; rep < REPS(PH_FFN2); ++rep) if (IN_PH(PH_FFN2)) {
            SEAM();
            int bxo = bx; asm volatile("" : "+s"(bxo));
            StaticOrder S; S.init(M / BM, D / BM, G, bxo);
            const Gemm g{(const bf16_t*)(ws + WS_HID), wl(ws, l, W_DN), FF, FF, FF, 0, 0};
            const EpiRes E{xb, ssq, nullptr, (REPS(PH_FFN2) == 2 && rep == 0) ? 0.f : 1.f, tab};
            gemm_phase<EpiRes, StaticOrder>(lds, g, S, E, wave);
        }
    }
    if (a.flags & FL_FINAL) { SEAM(); final_norm_rows(xb, a.out, in.norm_final, gw, NGW, LANE); }
#undef IN_PH
#undef SEAM
#undef LANE
}
}

extern "C" void kernel_launch(void* const* d_in, const int* in_sizes, int n_in, void* d_out, int out_size, void* d_ws, size_t ws_size, hipStream_t stream) {
    static int grid = 0;
    if (grid == 0) {
        if (n_in != 29 || out_size != mk::M * mk::D || ws_size < mk::WS_END) { fprintf(stderr, "kernel_launch: unexpected sizes (n_in %d out %d ws %zu)\n", n_in, out_size, ws_size); grid = -1; return; }
        int dev = 0, cus = 0, per_cu = 0;
        if (hipGetDevice(&dev) != hipSuccess || hipDeviceGetAttribute(&cus, hipDeviceAttributeMultiprocessorCount, dev) != hipSuccess) { grid = -1; return; }
        if (hipFuncSetAttribute((const void*)mk::fwd, hipFuncAttributeMaxDynamicSharedMemorySize, mk::LDS_BYTES) != hipSuccess) { fprintf(stderr, "kernel_launch: hipFuncSetAttribute failed\n"); grid = -1; return; }
        if (hipOccupancyMaxActiveBlocksPerMultiprocessor(&per_cu, (const void*)mk::fwd, mk::NTHR, mk::LDS_BYTES) != hipSuccess || per_cu < 1) fprintf(stderr, "kernel_launch: occupancy query says %d\n", per_cu);
        (void)hipGetLastError();
        grid = cus;
    }
    if (grid < 0) return;
    (void)in_sizes;
    if (hipMemsetAsync((char*)d_ws + mk::WS_CTL, 0, mk::CTL_ZERO_BYTES, stream) != hipSuccess) return;
    mk::Args a{};
    { const void** p = (const void**)&a.in; for (int i = 0; i < 29; ++i) p[i] = d_in[i]; }
    a.out = (float*)d_out; a.ws = (unsigned char*)d_ws;
    a.pro_lo = 0; a.pro_hi = 2; a.l_lo = 0; a.l_hi = mk::DEPTH; a.ph_lo = 0; a.ph_hi = mk::PH_N; a.flags = mk::FL_XIN | mk::FL_FINAL; a.region = 0;
    hipLaunchKernelGGL(mk::fwd, dim3(grid), dim3(mk::NTHR), mk::LDS_BYTES, stream, a);
    const hipError_t le = hipPeekAtLastError();
    if (le != hipSuccess) fprintf(stderr, "kernel_launch: launch failed: %s\n", hipGetErrorName(le));
}
```
